# Optimizing an MI355X kernel written in HIP

```python
import math
import jax
import jax.numpy as jnp
from jax import lax
import numpy as np

D_MODEL = 1024
BATCH = 4
SEQ = 8192
DEPTH = 2

GRID_W = 64
CTX_LEN = 256
MLA_HEADS = 8
MLA_Q_RANK = 256
MLA_KV_RANK = 128
MLA_NOPE = 64
MLA_ROPE = 32
MLA_V = 64
MLA_QK = MLA_NOPE + MLA_ROPE
MLA_W = MLA_HEADS * MLA_V
SWA_HEADS = 8
SWA_KV_HEADS = 2
SWA_DIM = 64
SWA_W = SWA_HEADS * SWA_DIM
WINDOW = 128
DIFF_HEADS = 4
DIFF_DIM = 64
DIFF_W = DIFF_HEADS * 2 * DIFF_DIM
D_FF = 4 * D_MODEL
N_MOD = 6
Q_BLOCK = 128
ROPE_BASE = 10000.0
EPS = 1e-6
NEG_INF = -1e30
MLA_SCALE = MLA_QK ** -0.5
SWA_SCALE = SWA_DIM ** -0.5
DIFF_SCALE = DIFF_DIM ** -0.5
IN_SPLITS = (MLA_Q_RANK, MLA_KV_RANK, MLA_ROPE,
             SWA_HEADS * SWA_DIM, SWA_KV_HEADS * SWA_DIM, SWA_KV_HEADS * SWA_DIM,
             DIFF_W, DIFF_W, DIFF_W,
             D_MODEL, D_MODEL, D_MODEL)
IN_COLS = sum(IN_SPLITS)

kernel_name = "hybrid_dit_mla_swa_diff_prefix"


def rms_norm(x, g):
    xf = x.astype(jnp.float32)
    y = xf * lax.rsqrt(jnp.mean(xf * xf, axis=-1, keepdims=True) + EPS)
    return (y * g.astype(jnp.float32)).astype(x.dtype)


def modulate(x, shift, scale):
    return x * (1.0 + scale) + shift


def axial_rope_tables(n_tokens, rot_dim):
    rows = n_tokens // GRID_W
    row = jnp.repeat(jnp.arange(rows), GRID_W).astype(jnp.float32)
    col = jnp.tile(jnp.arange(GRID_W), rows).astype(jnp.float32)
    half = rot_dim // 2
    freqs = ROPE_BASE ** (-jnp.arange(0, half, 2, dtype=jnp.float32) / half)
    ar = row[:, None] * freqs
    ac = col[:, None] * freqs
    return (jnp.cos(ar), jnp.sin(ar), jnp.cos(ac), jnp.sin(ac))


def _rotate_half(x, cos, sin):
    n = x.shape[-1] // 2
    x1, x2 = x[..., :n], x[..., n:]
    cos = cos[:, None, :].astype(x.dtype)
    sin = sin[:, None, :].astype(x.dtype)
    return jnp.concatenate([x1 * cos - x2 * sin, x2 * cos + x1 * sin], axis=-1)


def axial_rope(x, tab):
    cr, sr, cc, sc = tab
    half = x.shape[-1] // 2
    return jnp.concatenate([_rotate_half(x[..., :half], cr, sr),
                            _rotate_half(x[..., half:], cc, sc)], axis=-1)


def split_columns(proj):
    cuts = np.cumsum(IN_SPLITS)[:-1].tolist()
    return jnp.split(proj, cuts, axis=-1)


def prep_stream(proj, rope_mla, rope_hd, g_q_lora, w_uq, g_kv_lora, w_ukv,
                g_mla_q, g_mla_k, g_swa_q, g_swa_k, g_diff_q, g_diff_k):
    B, L = proj.shape[:2]
    q_lat, kv_lat, k_pe, sq, sk, sv, dq, dk, dv, ga, gb, gc = split_columns(proj)
    mq = (rms_norm(q_lat, g_q_lora) @ w_uq).reshape(B, L, MLA_HEADS, MLA_QK)
    kv = (rms_norm(kv_lat, g_kv_lora) @ w_ukv).reshape(B, L, MLA_HEADS, MLA_NOPE + MLA_V)
    k_pe = jnp.broadcast_to(k_pe[:, :, None, :], (B, L, MLA_HEADS, MLA_ROPE))
    mk = jnp.concatenate([kv[..., :MLA_NOPE], k_pe], axis=-1)
    mv = kv[..., MLA_NOPE:]
    mq = rms_norm(mq, g_mla_q)
    mk = rms_norm(mk, g_mla_k)
    sq = rms_norm(sq.reshape(B, L, SWA_HEADS, SWA_DIM), g_swa_q)
    sk = rms_norm(sk.reshape(B, L, SWA_KV_HEADS, SWA_DIM), g_swa_k)
    sv = sv.reshape(B, L, SWA_KV_HEADS, SWA_DIM)
    dq = rms_norm(dq.reshape(B, L, 2 * DIFF_HEADS, DIFF_DIM), g_diff_q)
    dk = rms_norm(dk.reshape(B, L, 2 * DIFF_HEADS, DIFF_DIM), g_diff_k)
    dv = dv.reshape(B, L, DIFF_HEADS, 2 * DIFF_DIM)
    if rope_mla is not None:
        mq = jnp.concatenate([mq[..., :MLA_NOPE], axial_rope(mq[..., MLA_NOPE:], rope_mla)], axis=-1)
        mk = jnp.concatenate([mk[..., :MLA_NOPE], axial_rope(mk[..., MLA_NOPE:], rope_mla)], axis=-1)
        sq = axial_rope(sq, rope_hd)
        sk = axial_rope(sk, rope_hd)
        dq = axial_rope(dq, rope_hd)
        dk = axial_rope(dk, rope_hd)
    dq = dq.reshape(B, L, DIFF_HEADS, 2, DIFF_DIM)
    dk = dk.reshape(B, L, DIFF_HEADS, 2, DIFF_DIM)
    return {"mla": (mq, mk, mv), "swa": (sq, sk, sv),
            "diff": (dq[..., 0, :], dq[..., 1, :], dk[..., 0, :], dk[..., 1, :], dv),
            "gates": (ga, gb, gc)}


def sweep_query_blocks(fn, qs):
    B, L = qs[0].shape[:2]
    nb = L // Q_BLOCK
    blocks = tuple(jnp.swapaxes(q.reshape((B, nb, Q_BLOCK) + q.shape[2:]), 0, 1) for q in qs)
    out = lax.map(lambda a: fn(a[0], a[1]), (blocks, jnp.arange(nb)))
    return jnp.swapaxes(out, 0, 1).reshape((B, L) + out.shape[3:])


def mla_attend(q, k, v):
    s = jnp.einsum('bqhd,bkhd->bhqk', q, k).astype(jnp.float32) * MLA_SCALE
    p = jax.nn.softmax(s, axis=-1)
    return jnp.einsum('bhqk,bkhd->bqhd', p.astype(v.dtype), v)


def diff_attend(q1, q2, k1, k2, v, lam):
    s1 = jnp.einsum('bqhd,bkhd->bhqk', q1, k1).astype(jnp.float32) * DIFF_SCALE
    s2 = jnp.einsum('bqhd,bkhd->bhqk', q2, k2).astype(jnp.float32) * DIFF_SCALE
    p = jax.nn.softmax(s1, axis=-1) - lam * jax.nn.softmax(s2, axis=-1)
    return jnp.einsum('bhqk,bkhd->bqhd', p.astype(v.dtype), v)


def gqa_sink_attend(q, k, v, sink, valid):
    B, Lq, H, d = q.shape
    kvh = k.shape[2]
    G = H // kvh
    qg = q.reshape(B, Lq, kvh, G, d)
    s = jnp.einsum('bqkgd,bjkd->bkgqj', qg, k).astype(jnp.float32) * SWA_SCALE
    if valid is not None:
        s = jnp.where(valid, s, NEG_INF)
    sink_col = jnp.broadcast_to(sink.astype(jnp.float32).reshape(kvh, G)[None, :, :, None, None],
                                s.shape[:-1] + (1,))
    p = jax.nn.softmax(jnp.concatenate([s, sink_col], axis=-1), axis=-1)[..., :-1]
    o = jnp.einsum('bkgqj,bjkd->bqkgd', p.astype(v.dtype), v)
    return o.reshape(B, Lq, H, d)


def latent_mixers(lat, ctp, sink, lam):
    mq, mk, mv = lat["mla"]
    _, cmk, cmv = ctp["mla"]
    mk_all = jnp.concatenate([cmk, mk], axis=1)
    mv_all = jnp.concatenate([cmv, mv], axis=1)
    y_mla = sweep_query_blocks(lambda qb, b: mla_attend(qb[0], mk_all, mv_all), (mq,))
    sq, sk, sv = lat["swa"]
    _, csk, csv = ctp["swa"]
    L = sq.shape[1]
    n_ctx = csk.shape[1]
    pad = ((0, 0), (Q_BLOCK, Q_BLOCK), (0, 0), (0, 0))
    kp = jnp.pad(sk, pad)
    vp = jnp.pad(sv, pad)

    def swa_block(qb, b):
        start = b * Q_BLOCK
        kw = lax.dynamic_slice_in_dim(kp, start, 3 * Q_BLOCK, axis=1)
        vw = lax.dynamic_slice_in_dim(vp, start, 3 * Q_BLOCK, axis=1)
        qpos = start + jnp.arange(Q_BLOCK)
        kpos = start - Q_BLOCK + jnp.arange(3 * Q_BLOCK)
        win = (jnp.abs(qpos[:, None] - kpos[None, :]) <= WINDOW) & (kpos[None, :] >= 0) & (kpos[None, :] < L)
        valid = jnp.concatenate([jnp.ones((Q_BLOCK, n_ctx), dtype=bool), win], axis=1)
        return gqa_sink_attend(qb[0], jnp.concatenate([csk, kw], axis=1),
                               jnp.concatenate([csv, vw], axis=1), sink, valid)

    y_swa = sweep_query_blocks(swa_block, (sq,))
    q1, q2, k1, k2, dv = lat["diff"]
    _, _, ck1, ck2, cdv = ctp["diff"]
    k1_all = jnp.concatenate([ck1, k1], axis=1)
    k2_all = jnp.concatenate([ck2, k2], axis=1)
    dv_all = jnp.concatenate([cdv, dv], axis=1)
    y_diff = sweep_query_blocks(lambda qb, b: diff_attend(qb[0], qb[1], k1_all, k2_all, dv_all, lam), (q1, q2))
    return y_mla, y_swa, y_diff


def context_mixers(ctp, sink, lam):
    mq, mk, mv = ctp["mla"]
    sq, sk, sv = ctp["swa"]
    q1, q2, k1, k2, dv = ctp["diff"]
    return (mla_attend(mq, mk, mv), gqa_sink_attend(sq, sk, sv, sink, None),
            diff_attend(q1, q2, k1, k2, dv, lam))


def merge_branches(ys, gates, g_diff_sub, lam_init, w_up_mla, w_up_swa, w_up_diff, w_o):
    y_mla, y_swa, y_diff = ys
    ga, gb, gc = gates
    B, L = y_mla.shape[:2]
    y_diff = rms_norm(y_diff, g_diff_sub) * (1.0 - lam_init)
    m = (jax.nn.sigmoid(ga) * (y_mla.reshape(B, L, MLA_W) @ w_up_mla)
         + jax.nn.sigmoid(gb) * (y_swa.reshape(B, L, SWA_W) @ w_up_swa)
         + jax.nn.sigmoid(gc) * (y_diff.reshape(B, L, DIFF_W) @ w_up_diff))
    return m @ w_o


def sq_relu_mlp(h, w_in, w_out):
    return jnp.square(jax.nn.relu(h @ w_in)) @ w_out


def setup_inputs(seed: int = 0) -> dict:
    key = jax.random.key(seed)
    ks = jax.random.split(key, 31)
    f32 = jnp.float32

    def nrm(i, shape, scale):
        return jax.random.normal(ks[i], shape, f32) * scale

    def gain(i, shape):
        return 1.0 + 0.05 * jax.random.normal(ks[i], shape, f32)

    D = D_MODEL
    return {
        "x": nrm(0, (BATCH, SEQ, D), 1.0),
        "c": nrm(1, (BATCH, D), 1.0),
        "ctx": nrm(2, (BATCH, CTX_LEN, D), 1.0),
        "c_ctx": nrm(3, (D,), 1.0),
        "w_mod": nrm(4, (DEPTH, D, N_MOD * D), 0.5 * D ** -0.5),
        "b_mod": nrm(5, (DEPTH, N_MOD * D), 0.01),
        "g_norm_attn": gain(6, (DEPTH, D)),
        "g_norm_mlp": gain(7, (DEPTH, D)),
        "w_in": nrm(8, (DEPTH, D, IN_COLS), D ** -0.5),
        "g_q_lora": gain(9, (DEPTH, MLA_Q_RANK)),
        "w_uq": nrm(10, (DEPTH, MLA_Q_RANK, MLA_HEADS * MLA_QK), MLA_Q_RANK ** -0.5),
        "g_kv_lora": gain(11, (DEPTH, MLA_KV_RANK)),
        "w_ukv": nrm(12, (DEPTH, MLA_KV_RANK, MLA_HEADS * (MLA_NOPE + MLA_V)), MLA_KV_RANK ** -0.5),
        "g_mla_q": gain(13, (DEPTH, MLA_QK)),
        "g_mla_k": gain(14, (DEPTH, MLA_QK)),
        "w_up_mla": nrm(15, (DEPTH, MLA_W, D), MLA_W ** -0.5),
        "g_swa_q": gain(16, (DEPTH, SWA_DIM)),
        "g_swa_k": gain(17, (DEPTH, SWA_DIM)),
        "swa_sink": nrm(18, (DEPTH, SWA_HEADS), 0.5),
        "w_up_swa": nrm(19, (DEPTH, SWA_W, D), SWA_W ** -0.5),
        "g_diff_q": gain(20, (DEPTH, DIFF_DIM)),
        "g_diff_k": gain(21, (DEPTH, DIFF_DIM)),
        "lambda_q1": nrm(22, (DEPTH, DIFF_DIM), 0.1),
        "lambda_k1": nrm(23, (DEPTH, DIFF_DIM), 0.1),
        "lambda_q2": nrm(24, (DEPTH, DIFF_DIM), 0.1),
        "lambda_k2": nrm(25, (DEPTH, DIFF_DIM), 0.1),
        "g_diff_sub": gain(26, (DEPTH, 2 * DIFF_DIM)),
        "w_up_diff": nrm(27, (DEPTH, DIFF_W, D), DIFF_W ** -0.5),
        "w_o": nrm(28, (DEPTH, D, D), D ** -0.5),
        "w_mlp_in": nrm(29, (DEPTH, D, D_FF), D ** -0.5),
        "w_mlp_out": nrm(30, (DEPTH, D_FF, D), D_FF ** -0.5),
    }


def reference(x, c, ctx, c_ctx, w_mod, b_mod, g_norm_attn, g_norm_mlp, w_in,
              g_q_lora, w_uq, g_kv_lora, w_ukv, g_mla_q, g_mla_k, w_up_mla,
              g_swa_q, g_swa_k, swa_sink, w_up_swa,
              g_diff_q, g_diff_k, lambda_q1, lambda_k1, lambda_q2, lambda_k2, g_diff_sub, w_up_diff,
              w_o, w_mlp_in, w_mlp_out):
    L = x.shape[1]
    rope_mla = axial_rope_tables(L, MLA_ROPE)
    rope_hd = axial_rope_tables(L, SWA_DIM)
    silu_c = jax.nn.silu(c)
    silu_cc = jax.nn.silu(c_ctx)
    cx = ctx
    for l in range(DEPTH):
        last = l == DEPTH - 1
        mod = silu_c @ w_mod[l] + b_mod[l]
        mod_c = silu_cc @ w_mod[l] + b_mod[l]
        sh1, sc1, g1, sh2, sc2, g2 = jnp.split(mod[:, None, :], N_MOD, axis=-1)
        csh1, csc1, cg1, csh2, csc2, cg2 = jnp.split(mod_c[None, None, :], N_MOD, axis=-1)
        group_params = (g_q_lora[l], w_uq[l], g_kv_lora[l], w_ukv[l], g_mla_q[l], g_mla_k[l],
                        g_swa_q[l], g_swa_k[l], g_diff_q[l], g_diff_k[l])
        h = modulate(rms_norm(x, g_norm_attn[l]), sh1, sc1)
        hc = modulate(rms_norm(cx, g_norm_attn[l]), csh1, csc1)
        lat = prep_stream(h @ w_in[l], rope_mla, rope_hd, *group_params)
        ctp = prep_stream(hc @ w_in[l], None, None, *group_params)
        lam_init = 0.8 - 0.6 * math.exp(-0.3 * l)
        lam = (jnp.exp(jnp.sum(lambda_q1[l].astype(jnp.float32) * lambda_k1[l].astype(jnp.float32)))
               - jnp.exp(jnp.sum(lambda_q2[l].astype(jnp.float32) * lambda_k2[l].astype(jnp.float32)))
               + lam_init)
        out_params = (g_diff_sub[l], lam_init, w_up_mla[l], w_up_swa[l], w_up_diff[l], w_o[l])
        y = merge_branches(latent_mixers(lat, ctp, swa_sink[l], lam), lat["gates"], *out_params)
        x = x + g1 * y
        x = x + g2 * sq_relu_mlp(modulate(rms_norm(x, g_norm_mlp[l]), sh2, sc2), w_mlp_in[l], w_mlp_out[l])
        if not last:
            yc = merge_branches(context_mixers(ctp, swa_sink[l], lam), ctp["gates"], *out_params)
            cx = cx + cg1 * yc
            cx = cx + cg2 * sq_relu_mlp(modulate(rms_norm(cx, g_norm_mlp[l]), csh2, csc2),
                                        w_mlp_in[l], w_mlp_out[l])
    return x
```

```cpp
#include <hip/hip_runtime.h>
#include <hip/hip_cooperative_groups.h>
#include <cstdio>
#include <cstdint>
namespace cg = cooperative_groups;

typedef unsigned short bf16_t;
typedef short bf16x8 __attribute__((ext_vector_type(8)));
typedef short s16x4 __attribute__((ext_vector_type(4)));
typedef float f32x16 __attribute__((ext_vector_type(16)));
typedef float f32x4 __attribute__((ext_vector_type(4)));
typedef float f32x2 __attribute__((ext_vector_type(2)));
typedef __bf16 bf16x2_t __attribute__((ext_vector_type(2)));
typedef unsigned u32x2 __attribute__((ext_vector_type(2)));
typedef unsigned u32x4 __attribute__((ext_vector_type(4)));
#define LDS_AS __attribute__((address_space(3)))
#define DI __device__ __forceinline__

constexpr int D = 1024, NB = 4, SEQ = 8192, NCTX = 256;
constexpr int TL = NB * SEQ;
constexpr int TC = NB * NCTX;
constexpr int T = TL + TC;
constexpr int PN = 2720;
constexpr int C_QLAT = 0, C_KVLAT = 256, C_KPE = 384, C_SQ = 416, C_SK = 928, C_SV = 1056, C_DQ = 1184, C_DK = 1696, C_DV = 2208;
constexpr float EPS = 1e-6f;
constexpr float LOG2E = 1.4426950408889634f;
constexpr size_t W_IN = 0;
constexpr size_t W_UQ = W_IN + (size_t)5888 * 1024;
constexpr size_t W_UKV = W_UQ + 768 * 256;
constexpr size_t W_UPM = W_UKV + 1024 * 128;
constexpr size_t W_UPS = W_UPM + 1024 * 512;
constexpr size_t W_UPD = W_UPS + 1024 * 512;
constexpr size_t W_O = W_UPD + 1024 * 512;
constexpr size_t W_M1 = W_O + 1024 * 1024;
constexpr size_t W_M2 = W_M1 + (size_t)4096 * 1024;
constexpr size_t W_LAYER = W_M2 + (size_t)4096 * 1024;

struct Params {
  const float *x, *c, *ctx, *c_ctx, *w_mod, *b_mod, *g_norm_attn, *g_norm_mlp, *w_in, *g_q_lora, *w_uq, *g_kv_lora, *w_ukv,
      *g_mla_q, *g_mla_k, *w_up_mla, *g_swa_q, *g_swa_k, *swa_sink, *w_up_swa, *g_diff_q, *g_diff_k, *lambda_q1, *lambda_k1,
      *lambda_q2, *lambda_k2, *g_diff_sub, *w_up_diff, *w_o, *w_mlp_in, *w_mlp_out;
  float* out;
  float* modtab;
  float* consts;
  bf16_t* WB;
  bf16_t* H;
  bf16_t* PROJ;
  bf16_t* MQ;
  bf16_t* KV;
  bf16_t* KM;
  float* CX;
  bf16_t* YD0;
};

template <class Tp> DI Tp* opq(Tp* ptr) { asm volatile("" : "+s"(ptr)); return ptr; }
DI int tidx() { int t = threadIdx.x; asm volatile("" : "+v"(t)); return t; }
DI float bf2f(bf16_t v) { return __uint_as_float((unsigned)v << 16); }
DI unsigned pk2(float a, float b) { f32x2 v = {a, b}; bf16x2_t r = __builtin_convertvector(v, bf16x2_t); return __builtin_bit_cast(unsigned, r); }
DI bf16_t f2bf(float a) { return (bf16_t)(pk2(a, 0.f) & 0xffffu); }
DI float wave_sum(float v) {
#pragma unroll
  for (int o = 32; o; o >>= 1) v += __shfl_xor(v, o);
  return v;
}
DI float wave_max(float v) {
#pragma unroll
  for (int o = 32; o; o >>= 1) v = fmaxf(v, __shfl_xor(v, o));
  return v;
}
DI float silu(float x) { return x / (1.f + __expf(-x)); }
DI int xcd_remap(int L, int n) {
  const int q = n >> 3, r = n & 7, xcd = L & 7, off = L >> 3;
  return (xcd < r ? xcd * (q + 1) : r * (q + 1) + (xcd - r) * q) + off;
}
DI void glds16(const void* g, LDS_AS unsigned char* l) {
  __builtin_amdgcn_global_load_lds((const unsigned*)g, (LDS_AS unsigned*)l, 16, 0, 0);
}
DI bf16x8 lds128(LDS_AS unsigned char* p) { return *(LDS_AS bf16x8*)p; }
#define MFMA32(a, b, c) __builtin_amdgcn_mfma_f32_32x32x16_bf16((a), (b), (c), 0, 0, 0)

DI void conv_tile(const float* src, int ld, int K, int k0, int n0, bool is_win, bf16_t* dst, LDS_AS float* tile) {
  const int tid = tidx(), ty = tid >> 4, tx = tid & 15;
  const int n = n0 + 4 * tx;
  int sc = n;
  if (is_win) sc = (n < 2720) ? n : (n < 2816 ? -1 : n - 96);
#pragma unroll
  for (int i = 0; i < 4; ++i) {
    const int k = ty + 16 * i;
    f32x4 v = {0.f, 0.f, 0.f, 0.f};
    if (sc >= 0) v = *(const f32x4*)(src + (size_t)(k0 + k) * ld + sc);
    tile[k * 65 + 4 * tx + 0] = v[0]; tile[k * 65 + 4 * tx + 1] = v[1]; tile[k * 65 + 4 * tx + 2] = v[2]; tile[k * 65 + 4 * tx + 3] = v[3];
  }
  __syncthreads();
#pragma unroll
  for (int i = 0; i < 2; ++i) {
    const int r = (tid >> 3) + 32 * i, c = tid & 7;
    u32x4 w;
    w[0] = pk2(tile[(8 * c + 0) * 65 + r], tile[(8 * c + 1) * 65 + r]);
    w[1] = pk2(tile[(8 * c + 2) * 65 + r], tile[(8 * c + 3) * 65 + r]);
    w[2] = pk2(tile[(8 * c + 4) * 65 + r], tile[(8 * c + 5) * 65 + r]);
    w[3] = pk2(tile[(8 * c + 6) * 65 + r], tile[(8 * c + 7) * 65 + r]);
    *(u32x4*)(dst + (size_t)(n0 + r) * K + k0 + 8 * c) = w;
  }
  __syncthreads();
}

DI void phase0(const Params& p, LDS_AS unsigned char* smem) {
  const int tid_ = tidx(), lane = tid_ & 63, wave = tid_ >> 6;
  if (blockIdx.x == 0 && wave == 0) {
    for (int l = 0; l < 2; ++l) {
      const float s1 = wave_sum(p.lambda_q1[l * 64 + lane] * p.lambda_k1[l * 64 + lane]);
      const float s2 = wave_sum(p.lambda_q2[l * 64 + lane] * p.lambda_k2[l * 64 + lane]);
      const float lam_init = 0.8f - 0.6f * expf(-0.3f * (float)l);
      const float lam = expf(s1) - expf(s2) + lam_init;
      float a = fabsf(p.g_mla_q[l * 96 + lane]); if (lane < 32) a = fmaxf(a, fabsf(p.g_mla_q[l * 96 + 64 + lane]));
      float b = fabsf(p.g_mla_k[l * 96 + lane]); if (lane < 32) b = fmaxf(b, fabsf(p.g_mla_k[l * 96 + 64 + lane]));
      const float mq = wave_max(a), mk = wave_max(b);
      const float sq = wave_max(fabsf(p.g_swa_q[l * 64 + lane])), sk = wave_max(fabsf(p.g_swa_k[l * 64 + lane]));
      const float dq = wave_max(fabsf(p.g_diff_q[l * 64 + lane])), dk = wave_max(fabsf(p.g_diff_k[l * 64 + lane]));
      if (lane == 0) {
        float* cs = p.consts + l * 16;
        cs[0] = lam; cs[1] = lam_init;
        cs[2] = LOG2E * sqrtf(96.f) * mq * mk;
        cs[3] = LOG2E * 8.f * sq * sk;
        cs[4] = LOG2E * 8.f * dq * dk;
      }
    }
  }
  for (int task = blockIdx.x * 4 + wave; task < 3072; task += gridDim.x * 4) {
    const int l = task / 1536, rem = task % 1536, chunk = rem >> 4, ks = rem & 15;
    const int n = chunk * 64 + lane;
    float acc[5] = {0.f, 0.f, 0.f, 0.f, 0.f};
    const float* w = p.w_mod + ((size_t)l * 1024 + ks * 64) * 6144 + n;
#pragma unroll 8
    for (int k = 0; k < 64; ++k) {
      const float wv = w[(size_t)k * 6144];
      const int kk = ks * 64 + k;
#pragma unroll
      for (int r = 0; r < 4; ++r) acc[r] += silu(p.c[r * 1024 + kk]) * wv;
      acc[4] += silu(p.c_ctx[kk]) * wv;
    }
    const float bias = (ks == 0) ? p.b_mod[l * 6144 + n] : 0.f;
#pragma unroll
    for (int r = 0; r < 5; ++r) atomicAdd(p.modtab + (size_t)(l * 5 + r) * 6144 + n, acc[r] + bias);
  }
  LDS_AS float* tile = (LDS_AS float*)smem;
  for (int t = blockIdx.x; t < 2 * 4240; t += gridDim.x) {
    const int l = t / 4240; int u = t % 4240;
    const float* src; int ld, K; bool is_win = false; size_t doff;
    if (u < 1472) { src = p.w_in + (size_t)l * 1024 * 5792; ld = 5792; K = 1024; is_win = true; doff = W_IN; }
    else if (u < 1520) { u -= 1472; src = p.w_uq + (size_t)l * 256 * 768; ld = 768; K = 256; doff = W_UQ; }
    else if (u < 1552) { u -= 1520; src = p.w_ukv + (size_t)l * 128 * 1024; ld = 1024; K = 128; doff = W_UKV; }
    else if (u < 1680) { u -= 1552; src = p.w_up_mla + (size_t)l * 512 * 1024; ld = 1024; K = 512; doff = W_UPM; }
    else if (u < 1808) { u -= 1680; src = p.w_up_swa + (size_t)l * 512 * 1024; ld = 1024; K = 512; doff = W_UPS; }
    else if (u < 1936) { u -= 1808; src = p.w_up_diff + (size_t)l * 512 * 1024; ld = 1024; K = 512; doff = W_UPD; }
    else if (u < 2192) { u -= 1936; src = p.w_o + (size_t)l * 1024 * 1024; ld = 1024; K = 1024; doff = W_O; }
    else if (u < 3216) { u -= 2192; src = p.w_mlp_in + (size_t)l * 1024 * 4096; ld = 4096; K = 1024; doff = W_M1; }
    else { u -= 3216; src = p.w_mlp_out + (size_t)l * 4096 * 1024; ld = 1024; K = 4096; doff = W_M2; }
    const int nkt = K >> 6, kt = u % nkt, nt = u / nkt;
    conv_tile(src, ld, K, kt * 64, nt * 64, is_win, p.WB + (size_t)l * W_LAYER + doff, tile);
  }
}

DI void norm_phase(const Params& p, int l, int which) {
  const int tid_ = tidx(), lane = tid_ & 63, wave = tid_ >> 6;
  const float* g = (which == 0 ? p.g_norm_attn : p.g_norm_mlp) + l * 1024;
  const int shoff = which == 0 ? 0 : 3072, scoff = shoff + 1024;
  const int nrows = (which == 1 && l == 1) ? TL : T;
  const bool first = (which == 0 && l == 0);
  const float* px = opq(p.x); const float* pctx = opq(p.ctx); const float* pout = opq((const float*)p.out); const float* pcx = opq((const float*)p.CX);
  const float* slat = first ? px : pout; const float* sctx = first ? pctx : pcx;
  for (int row = blockIdx.x * 4 + wave; row < nrows; row += gridDim.x * 4) {
    const float* xr; int bidx;
    if (row < TL) { xr = slat + (size_t)row * 1024; bidx = row >> 13; }
    else { xr = sctx + (size_t)(row - TL) * 1024; bidx = 4; }
    const float* mod = p.modtab + (size_t)(l * 5 + bidx) * 6144;
    f32x4 v[4]; float ss = 0.f;
#pragma unroll
    for (int i = 0; i < 4; ++i) { v[i] = *(const f32x4*)(xr + i * 256 + lane * 4); ss += v[i][0] * v[i][0] + v[i][1] * v[i][1] + v[i][2] * v[i][2] + v[i][3] * v[i][3]; }
    ss = wave_sum(ss);
    const float rstd = rsqrtf(ss * (1.f / 1024.f) + EPS);
#pragma unroll
    for (int i = 0; i < 4; ++i) {
      const int col = i * 256 + lane * 4;
      const f32x4 gv = *(const f32x4*)(g + col), sh = *(const f32x4*)(mod + shoff + col), sc = *(const f32x4*)(mod + scoff + col);
      float o[4];
#pragma unroll
      for (int j = 0; j < 4; ++j) o[j] = (v[i][j] * rstd * gv[j]) * (1.f + sc[j]) + sh[j];
      u32x2 w = {pk2(o[0], o[1]), pk2(o[2], o[3])};
      *(u32x2*)(p.H + (size_t)row * 1024 + col) = w;
    }
  }
}

DI void gemm_kloop(const bf16_t* Ag, int lda, int a_kstep, const bf16_t* Bg, int ldb, int nkt, f32x16 (&acc)[2][2], LDS_AS unsigned char* smem) {
  const int tid_ = tidx(), lane = tid_ & 63, wave = tid_ >> 6, h = lane >> 5, wm = wave >> 1, wn = wave & 1;
  unsigned aoff[4], boff[4];
#pragma unroll
  for (int i = 0; i < 4; ++i) {
    const int r = wave * 32 + i * 8 + (lane >> 3), c = (lane & 7) ^ ((r >> 1) & 7);
    aoff[i] = (unsigned)(r * lda + c * 8) * 2u; boff[i] = (unsigned)(r * ldb + c * 8) * 2u;
  }
  LDS_AS unsigned char* ldst = smem + wave * 4096 + lane * 16;
  const int swz = (lane >> 1) & 7;
  const int arow = (wm * 64 + (lane & 31)) * 128, brow = (wn * 64 + (lane & 31)) * 128;
  __syncthreads();
#pragma unroll
  for (int i = 0; i < 4; ++i) { glds16((const char*)Ag + aoff[i], ldst + i * 1024); glds16((const char*)Bg + boff[i], ldst + 16384 + i * 1024); }
#pragma unroll 1
  for (int kt = 0; kt < nkt; ++kt) {
    asm volatile("s_waitcnt vmcnt(0)" ::: "memory");
    __syncthreads();
    if (kt + 1 < nkt) {
      const char* An = (const char*)(Ag + (size_t)(kt + 1) * a_kstep); const char* Bn = (const char*)(Bg + (size_t)(kt + 1) * 64);
      LDS_AS unsigned char* dn = ldst + ((kt + 1) & 1) * 32768;
#pragma unroll
      for (int i = 0; i < 4; ++i) { glds16(An + aoff[i], dn + i * 1024); glds16(Bn + boff[i], dn + 16384 + i * 1024); }
    }
    LDS_AS unsigned char* sa = smem + (kt & 1) * 32768; LDS_AS unsigned char* sb = sa + 16384;
#pragma unroll
    for (int s = 0; s < 4; ++s) {
      const int co = ((2 * s + h) ^ swz) << 4;
      const bf16x8 a0 = lds128(sa + arow + co), a1 = lds128(sa + arow + 32 * 128 + co);
      const bf16x8 b0 = lds128(sb + brow + co), b1 = lds128(sb + brow + 32 * 128 + co);
      acc[0][0] = MFMA32(b0, a0, acc[0][0]); acc[0][1] = MFMA32(b1, a0, acc[0][1]);
      acc[1][0] = MFMA32(b0, a1, acc[1][0]); acc[1][1] = MFMA32(b1, a1, acc[1][1]);
    }
  }
}
DI void zero_acc(f32x16 (&acc)[2][2]) {
#pragma unroll
  for (int a = 0; a < 2; ++a)
#pragma unroll
    for (int b = 0; b < 2; ++b)
#pragma unroll
      for (int i = 0; i < 16; ++i) acc[a][b][i] = 0.f;
}
DI void tile_decode(int id, int NT, int& mt, int& nt) { const int per = 8 * NT, g = id / per, w = id % per; mt = g * 8 + (w & 7); nt = w >> 3; }

template <int ACT> DI void epi_store_bf16(const f32x16 (&acc)[2][2], bf16_t* dst, int ldc, int row0, int col0, int ncols) {
  const int tid_ = tidx(), lane = tid_ & 63, wave = tid_ >> 6, h = lane >> 5, wm = wave >> 1, wn = wave & 1;
#pragma unroll
  for (int bi = 0; bi < 2; ++bi)
#pragma unroll
    for (int bj = 0; bj < 2; ++bj)
#pragma unroll
      for (int g = 0; g < 4; ++g) {
        const int row = row0 + wm * 64 + bi * 32 + (lane & 31), col = col0 + wn * 64 + bj * 32 + 8 * g + 4 * h;
        float v[4];
#pragma unroll
        for (int j = 0; j < 4; ++j) { v[j] = acc[bi][bj][4 * g + j]; if (ACT == 1) { v[j] = fmaxf(v[j], 0.f); v[j] *= v[j]; } }
        if (col < ncols) { u32x2 w = {pk2(v[0], v[1]), pk2(v[2], v[3])}; *(u32x2*)(dst + (size_t)row * ldc + col) = w; }
      }
}
DI void epi_residual(const f32x16 (&acc)[2][2], const float* xin, float* xout, const float* gate, int row0, int col0) {
  const int tid_ = tidx(), lane = tid_ & 63, wave = tid_ >> 6, h = lane >> 5, wm = wave >> 1, wn = wave & 1;
#pragma unroll
  for (int bi = 0; bi < 2; ++bi)
#pragma unroll
    for (int bj = 0; bj < 2; ++bj)
#pragma unroll
      for (int g = 0; g < 4; ++g) {
        const int row = row0 + wm * 64 + bi * 32 + (lane & 31), col = col0 + wn * 64 + bj * 32 + 8 * g + 4 * h;
        const f32x4 xi = *(const f32x4*)(xin + (size_t)row * 1024 + col), gv = *(const f32x4*)(gate + col);
        f32x4 o;
#pragma unroll
        for (int j = 0; j < 4; ++j) o[j] = xi[j] + gv[j] * acc[bi][bj][4 * g + j];
        *(f32x4*)(xout + (size_t)row * 1024 + col) = o;
      }
}

DI void phase_gemm_in(const Params& p, int l, LDS_AS unsigned char* smem) {
  const bf16_t* W = p.WB + (size_t)l * W_LAYER + W_IN;
  const int NT = 22, ntiles = (T / 128) * NT;
  for (int i = blockIdx.x; i < ntiles; i += gridDim.x) {
    int mt, nt; tile_decode(xcd_remap(i, ntiles), NT, mt, nt);
    f32x16 acc[2][2]; zero_acc(acc);
    gemm_kloop(p.H + (size_t)mt * 128 * 1024, 1024, 64, W + (size_t)nt * 128 * 1024, 1024, 16, acc, smem);
    epi_store_bf16<0>(acc, p.PROJ, PN, mt * 128, nt * 128, PN);
  }
}
DI void phase_gemm_mla(const Params& p, int l, LDS_AS unsigned char* smem) {
  const bf16_t* WQ = p.WB + (size_t)l * W_LAYER + W_UQ; const bf16_t* WK = p.WB + (size_t)l * W_LAYER + W_UKV;
  const int NT = 14, ntiles = (T / 128) * NT;
  for (int i = blockIdx.x; i < ntiles; i += gridDim.x) {
    int mt, nt; tile_decode(xcd_remap(i, ntiles), NT, mt, nt);
    f32x16 acc[2][2]; zero_acc(acc);
    if (nt < 6) {
      gemm_kloop(p.PROJ + (size_t)mt * 128 * PN + C_QLAT, PN, 64, WQ + (size_t)nt * 128 * 256, 256, 4, acc, smem);
      epi_store_bf16<0>(acc, p.MQ, 768, mt * 128, nt * 128, 768);
    } else {
      gemm_kloop(p.PROJ + (size_t)mt * 128 * PN + C_KVLAT, PN, 64, WK + (size_t)(nt - 6) * 128 * 128, 128, 2, acc, smem);
      epi_store_bf16<0>(acc, p.KV, 1024, mt * 128, (nt - 6) * 128, 1024);
    }
  }
}
DI void phase_merge(const Params& p, int l, LDS_AS unsigned char* smem) {
  const bf16_t* WL = p.WB + (size_t)l * W_LAYER;
  const int NT = 8, MT = (l == 1) ? TL / 128 : T / 128, ntiles = MT * NT;
  bf16_t* M = p.KV;
  for (int i = blockIdx.x; i < ntiles; i += gridDim.x) {
    int mt, nt; tile_decode(xcd_remap(i, ntiles), NT, mt, nt);
    unsigned tp[2][2][8];
#pragma unroll
    for (int a = 0; a < 2; ++a)
#pragma unroll
      for (int b = 0; b < 2; ++b)
#pragma unroll
        for (int e = 0; e < 8; ++e) tp[a][b][e] = 0u;
#pragma unroll 1
    for (int br = 0; br < 3; ++br) {
      unsigned gp[2][2][8];
      {
        f32x16 ag[2][2]; zero_acc(ag);
        gemm_kloop(p.H + (size_t)mt * 128 * 1024, 1024, 64, WL + W_IN + (size_t)(2816 + br * 1024 + nt * 128) * 1024, 1024, 16, ag, smem);
#pragma unroll
        for (int a = 0; a < 2; ++a)
#pragma unroll
          for (int b = 0; b < 2; ++b)
#pragma unroll
            for (int e = 0; e < 8; ++e)
              gp[a][b][e] = pk2(__builtin_amdgcn_rcpf(1.f + __builtin_amdgcn_exp2f(-LOG2E * ag[a][b][2 * e])),
                                __builtin_amdgcn_rcpf(1.f + __builtin_amdgcn_exp2f(-LOG2E * ag[a][b][2 * e + 1])));
      }
      f32x16 ay[2][2]; zero_acc(ay);
      const int lda = (br == 0) ? 768 : PN, kstep = (br == 0) ? 96 : 64;
      const size_t aofs = (br == 0) ? (size_t)T * PN : (size_t)(br == 1 ? C_SQ : C_DQ);
      __builtin_amdgcn_sched_barrier(0);
      gemm_kloop(p.PROJ + aofs + (size_t)mt * 128 * lda, lda, kstep, WL + W_UPM + (size_t)br * 1024 * 512 + (size_t)nt * 128 * 512, 512, 8, ay, smem);
#pragma unroll
      for (int a = 0; a < 2; ++a)
#pragma unroll
        for (int b = 0; b < 2; ++b)
#pragma unroll
          for (int e = 0; e < 8; ++e) {
            const float t0 = __uint_as_float(tp[a][b][e] << 16) + __uint_as_float(gp[a][b][e] << 16) * ay[a][b][2 * e];
            const float t1 = __uint_as_float(tp[a][b][e] & 0xffff0000u) + __uint_as_float(gp[a][b][e] & 0xffff0000u) * ay[a][b][2 * e + 1];
            tp[a][b][e] = pk2(t0, t1);
          }
    }
    {
      const int tid_ = tidx(), lane = tid_ & 63, wave = tid_ >> 6, h = lane >> 5, wm = wave >> 1, wn = wave & 1;
#pragma unroll
      for (int bi = 0; bi < 2; ++bi)
#pragma unroll
        for (int bj = 0; bj < 2; ++bj)
#pragma unroll
          for (int g = 0; g < 4; ++g) {
            const int row = mt * 128 + wm * 64 + bi * 32 + (lane & 31), col = nt * 128 + wn * 64 + bj * 32 + 8 * g + 4 * h;
            u32x2 w = {tp[bi][bj][2 * g], tp[bi][bj][2 * g + 1]};
            *(u32x2*)(M + (size_t)row * 1024 + col) = w;
          }
    }
  }
}
DI void phase_residual_gemm(const Params& p, int l, int which, LDS_AS unsigned char* smem) {
  const bf16_t* WL = p.WB + (size_t)l * W_LAYER;
  const int NT = 8, MT = (l == 1) ? TL / 128 : T / 128, ntiles = MT * NT;
  const bf16_t* Abase = which == 0 ? (const bf16_t*)opq(p.KV) : (const bf16_t*)opq(p.PROJ);
  const int K = which == 0 ? 1024 : 4096;
  const bf16_t* W = WL + (which == 0 ? W_O : W_M2);
  const bool first = (which == 0 && l == 0);
  const float* px = opq(p.x); const float* pctx = opq(p.ctx); float* pout = opq(p.out); float* pcx = opq(p.CX);
  const float* slat = first ? px : (const float*)pout; const float* sctx = first ? pctx : (const float*)pcx;
  for (int i = blockIdx.x; i < ntiles; i += gridDim.x) {
    int mt, nt; tile_decode(xcd_remap(i, ntiles), NT, mt, nt);
    f32x16 acc[2][2]; zero_acc(acc);
    gemm_kloop(Abase + (size_t)mt * 128 * K, K, 64, W + (size_t)nt * 128 * K, K, K / 64, acc, smem);
    const int row0 = mt * 128;
    const float* xin; float* xout; int bidx, r0;
    if (row0 < TL) { xin = slat; xout = pout; bidx = row0 >> 13; r0 = row0; }
    else { xin = sctx; xout = pcx; bidx = 4; r0 = row0 - TL; }
    const float* gate = p.modtab + (size_t)(l * 5 + bidx) * 6144 + (which == 0 ? 2048 : 5120);
    epi_residual(acc, xin, xout, gate, r0, nt * 128);
  }
}
DI void phase_mlp_in(const Params& p, int l, LDS_AS unsigned char* smem) {
  const bf16_t* W = p.WB + (size_t)l * W_LAYER + W_M1;
  const int NT = 32, MT = (l == 1) ? TL / 128 : T / 128, ntiles = MT * NT;
  bf16_t* U = p.PROJ;
  for (int i = blockIdx.x; i < ntiles; i += gridDim.x) {
    int mt, nt; tile_decode(xcd_remap(i, ntiles), NT, mt, nt);
    f32x16 acc[2][2]; zero_acc(acc);
    gemm_kloop(p.H + (size_t)mt * 128 * 1024, 1024, 64, W + (size_t)nt * 128 * 1024, 1024, 16, acc, smem);
    epi_store_bf16<1>(acc, U, 4096, mt * 128, nt * 128, 4096);
  }
}

DI void phase_prep_a(const Params& p, int l) {
  const int tid_ = tidx(), lane = tid_ & 63, wave = tid_ >> 6;
  const float gsq = p.g_swa_q[l * 64 + lane], gsk = p.g_swa_k[l * 64 + lane], gdq = p.g_diff_q[l * 64 + lane], gdk = p.g_diff_k[l * 64 + lane];
  const f32x4 gql = *(const f32x4*)(p.g_q_lora + l * 256 + lane * 4);
  const f32x2 gkl = *(const f32x2*)(p.g_kv_lora + l * 128 + lane * 2);
  const float freq = __builtin_amdgcn_exp2f(-(float)(lane & 15) * (13.287712379549449f / 16.f));
  const float sgn = ((lane >> 4) & 1) ? 1.f : -1.f;
  for (int row = blockIdx.x * 4 + wave; row < T; row += gridDim.x * 4) {
    bf16_t* base = p.PROJ + (size_t)row * PN;
    const bool islat = row < TL;
    float cs = 1.f, sn = 0.f;
    if (islat) {
      const int t = row & 8191; const float pos = (float)((lane >> 5) ? (t & 63) : (t >> 6));
      const float rev = (pos * freq) * 0.15915494309189535f;
      cs = __builtin_amdgcn_cosf(rev); sn = __builtin_amdgcn_sinf(rev);
    }
    {
      const u32x2 raw = *(const u32x2*)(base + C_QLAT + lane * 4);
      float v[4] = {__uint_as_float(raw[0] << 16), __uint_as_float(raw[0] & 0xffff0000u), __uint_as_float(raw[1] << 16), __uint_as_float(raw[1] & 0xffff0000u)};
      const float ss = wave_sum(v[0] * v[0] + v[1] * v[1] + v[2] * v[2] + v[3] * v[3]);
      const float rstd = rsqrtf(ss * (1.f / 256.f) + EPS);
      u32x2 w = {pk2(v[0] * rstd * gql[0], v[1] * rstd * gql[1]), pk2(v[2] * rstd * gql[2], v[3] * rstd * gql[3])};
      *(u32x2*)(base + C_QLAT + lane * 4) = w;
    }
    {
      const unsigned raw = *(const unsigned*)(base + C_KVLAT + lane * 2);
      const float v0 = __uint_as_float(raw << 16), v1 = __uint_as_float(raw & 0xffff0000u);
      const float ss = wave_sum(v0 * v0 + v1 * v1);
      const float rstd = rsqrtf(ss * (1.f / 128.f) + EPS);
      *(unsigned*)(base + C_KVLAT + lane * 2) = pk2(v0 * rstd * gkl[0], v1 * rstd * gkl[1]);
    }
#pragma unroll 2
    for (int vi = 0; vi < 26; ++vi) {
      int cb; float g, sc;
      if (vi < 8) { cb = C_SQ + vi * 64; g = gsq; sc = 0.125f * LOG2E; }
      else if (vi < 10) { cb = C_SK + (vi - 8) * 64; g = gsk; sc = 1.f; }
      else if (vi < 18) { cb = C_DQ + (vi - 10) * 64; g = gdq; sc = 0.125f * LOG2E; }
      else { cb = C_DK + (vi - 18) * 64; g = gdk; sc = 1.f; }
      const float xv = bf2f(base[cb + lane]);
      const float ss = wave_sum(xv * xv);
      float y = xv * rsqrtf(ss * (1.f / 64.f) + EPS) * g;
      const float pr = __shfl_xor(y, 16);
      y = (y * cs + sgn * pr * sn) * sc;
      base[cb + lane] = f2bf(y);
    }
  }
}
DI void phase_prep_c(const Params& p, int l) {
  const int tid_ = tidx(), lane = tid_ & 63, wave = tid_ >> 6, l32 = lane & 31;
  const float gq0 = p.g_mla_q[l * 96 + lane], gq1 = p.g_mla_q[l * 96 + 64 + l32], gk0 = p.g_mla_k[l * 96 + lane], gk1 = p.g_mla_k[l * 96 + 64 + l32];
  const float freq = __builtin_amdgcn_exp2f(-(float)(lane & 7) * (13.287712379549449f / 8.f));
  const float sgn = ((lane >> 3) & 1) ? 1.f : -1.f;
  const float qs = 0.10206207261596575f * LOG2E;
  for (int row = blockIdx.x * 4 + wave; row < T; row += gridDim.x * 4) {
    const bool islat = row < TL;
    float cs = 1.f, sn = 0.f;
    if (islat) {
      const int t = row & 8191; const float pos = (float)(((lane >> 4) & 1) ? (t & 63) : (t >> 6));
      const float rev = (pos * freq) * 0.15915494309189535f;
      cs = __builtin_amdgcn_cosf(rev); sn = __builtin_amdgcn_sinf(rev);
    }
    const float kpe = bf2f(p.PROJ[(size_t)row * PN + C_KPE + l32]);
    bf16_t* mq = p.MQ + (size_t)row * 768; const bf16_t* kv = p.KV + (size_t)row * 1024; bf16_t* km = p.KM + (size_t)row * 768;
#pragma unroll 2
    for (int hd = 0; hd < 8; ++hd) {
      {
        const float x0 = bf2f(mq[hd * 96 + lane]), x1 = bf2f(mq[hd * 96 + 64 + l32]);
        const float ss = wave_sum(x0 * x0 + (lane < 32 ? x1 * x1 : 0.f));
        const float rstd = rsqrtf(ss * (1.f / 96.f) + EPS);
        const float y0 = x0 * rstd * gq0; float y1 = x1 * rstd * gq1;
        const float pr = __shfl_xor(y1, 8);
        y1 = y1 * cs + sgn * pr * sn;
        mq[hd * 96 + lane] = f2bf(y0 * qs);
        if (lane < 32) mq[hd * 96 + 64 + lane] = f2bf(y1 * qs);
      }
      {
        const float x0 = bf2f(kv[hd * 128 + lane]), x1 = kpe;
        const float ss = wave_sum(x0 * x0 + (lane < 32 ? x1 * x1 : 0.f));
        const float rstd = rsqrtf(ss * (1.f / 96.f) + EPS);
        const float y0 = x0 * rstd * gk0; float y1 = x1 * rstd * gk1;
        const float pr = __shfl_xor(y1, 8);
        y1 = y1 * cs + sgn * pr * sn;
        km[hd * 96 + lane] = f2bf(y0);
        if (lane < 32) km[hd * 96 + 64 + lane] = f2bf(y1);
      }
    }
  }
}

struct AttnArgs {
  const bf16_t* q; int qpitch;
  const bf16_t* k; int kpitch;
  const bf16_t* v; int vpitch;
  bf16_t* o; int opitch;
  int krow_ctx, krow_lat;
  int nct, lt0, lt1;
  int qrow0, qpos0;
  float mb, sinkterm;
  float lam, osc; const float* gsub;
  bf16_t* o0;
};

template <int QSTEPS> DI void load_q(const AttnArgs& a, int colofs, bf16x8 (&qf)[QSTEPS]) {
  const int tid_ = tidx(), lane = tid_ & 63, wave = tid_ >> 6, h = lane >> 5, l32 = lane & 31;
  const bf16_t* qr = a.q + (size_t)(a.qrow0 + wave * 32 + l32) * a.qpitch + 8 * h + colofs;
#pragma unroll
  for (int s = 0; s < QSTEPS; ++s) qf[s] = *(const bf16x8*)(qr + s * 16);
}
template <int NKA, bool KB, int DV, int EPI, bool WIN>
DI void attn_item(const AttnArgs& a, const bf16x8 (&qfr)[4 + (KB ? 2 : 0)], int kcolofs, LDS_AS unsigned char* smem) {
  const int tid_ = tidx(), lane = tid_ & 63, wave = tid_ >> 6, h = lane >> 5, l32 = lane & 31;
  constexpr int NMAP = 1;
  constexpr int QSTEPS = 4 + (KB ? 2 : 0);
  constexpr int NDB = DV / 32;
  constexpr int VP = DV * 2;
  const int ntile = a.nct + (a.lt1 - a.lt0);
  unsigned kaoff[2], kboff = 0, voff[DV == 64 ? 2 : 4];
#pragma unroll
  for (int j = 0; j < 2; ++j) { const int r = (j * 4 + wave) * 8 + (lane >> 3), c = (lane & 7) ^ ((r >> 1) & 7); kaoff[j] = (unsigned)(r * a.kpitch + c * 8) * 2u; }
  if (KB) { const int r = wave * 16 + (lane >> 2), c = (lane & 3) ^ ((r >> 2) & 3); kboff = (unsigned)(r * a.kpitch + 64 + c * 8) * 2u; }
  if (DV == 64) {
#pragma unroll
    for (int j = 0; j < 2; ++j) { const int r = (j * 4 + wave) * 8 + (lane >> 3), c = (lane & 7) ^ (((r >> 1) & 1) << 2); voff[j] = (unsigned)(r * a.vpitch + c * 8) * 2u; }
  } else {
#pragma unroll
    for (int j = 0; j < 4; ++j) { const int r = (j * 4 + wave) * 4 + (lane >> 4), c = (lane & 15) ^ ((r & 3) << 2); voff[j] = (unsigned)(r * a.vpitch + c * 8) * 2u; }
  }
  LDS_AS unsigned char* ldst = smem + wave * 1024 + lane * 16;
  auto issue = [&](int ti) {
    const int trow = (ti < a.nct) ? (a.krow_ctx + ti * 64) : (a.krow_lat + (a.lt0 + ti - a.nct) * 64);
    const char* kb = (const char*)(a.k + (size_t)trow * a.kpitch + kcolofs); const char* vb = (const char*)(a.v + (size_t)trow * a.vpitch);
    LDS_AS unsigned char* d = ldst + (ti & 1) * 32768;
#pragma unroll
    for (int ga = 0; ga < NKA; ++ga)
#pragma unroll
      for (int j = 0; j < 2; ++j) glds16(kb + ga * 128 + kaoff[j], d + ga * 8192 + j * 4096);
    if (KB) glds16(kb + kboff, d + NKA * 8192);
#pragma unroll
    for (int j = 0; j < (DV == 64 ? 2 : 4); ++j) glds16(vb + voff[j], d + 16384 + j * 4096);
  };
  const int kswzA = (lane >> 1) & 7, kswzB = (lane >> 2) & 3;
  const int krowA = l32 * 128, krowB = l32 * 64;
  int vbase[NDB];
  {
    const int l16 = lane & 15, qq = l16 >> 2, pp = l16 & 3, g16 = (lane >> 4) & 1;
#pragma unroll
    for (int db = 0; db < NDB; ++db) {
      const int cl = 2 * g16 + (pp >> 1);
      const int c = (DV == 64) ? (4 * (db ^ (qq >> 1)) + cl) : (4 * (db ^ qq) + cl);
      vbase[db] = (4 * h + qq) * VP + c * 16 + (pp & 1) * 8;
    }
  }
  f32x16 O[NMAP][NDB];
#pragma unroll
  for (int m = 0; m < NMAP; ++m)
#pragma unroll
    for (int db = 0; db < NDB; ++db)
#pragma unroll
      for (int i = 0; i < 16; ++i) O[m][db][i] = 0.f;
  float lsum[NMAP];
#pragma unroll
  for (int m = 0; m < NMAP; ++m) lsum[m] = 0.f;
  const float negmb = -a.mb;
  const int qpos = a.qpos0 + wave * 32 + l32;

  __syncthreads();
  issue(0);
#pragma unroll 1
  for (int ti = 0; ti < ntile; ++ti) {
    asm volatile("s_waitcnt vmcnt(0)" ::: "memory");
    __syncthreads();
    if (ti + 1 < ntile) issue(ti + 1);
    __builtin_amdgcn_sched_barrier(0);
    LDS_AS unsigned char* st = smem + (ti & 1) * 32768;
    LDS_AS unsigned char* sv = st + 16384;
#pragma unroll
    for (int m = 0; m < NMAP; ++m) {
      float ls = 0.f;
#pragma unroll
      for (int kb = 0; kb < 2; ++kb) {
        f32x16 S;
#pragma unroll
        for (int i = 0; i < 16; ++i) S[i] = (DV == 128) ? 0.f : negmb;
        LDS_AS unsigned char* ka = st + (NKA == 2 ? m * 8192 : 0) + kb * 32 * 128 + krowA;
#pragma unroll
        for (int s = 0; s < 4; ++s) S = MFMA32(lds128(ka + (((2 * s + h) ^ kswzA) << 4)), qfr[s], S);
        if (KB) {
          LDS_AS unsigned char* kbp = st + NKA * 8192 + kb * 32 * 64 + krowB;
#pragma unroll
          for (int s = 0; s < 2; ++s) S = MFMA32(lds128(kbp + (((2 * s + h) ^ kswzB) << 4)), qfr[4 + s], S);
        }
        if (WIN) {
          if (ti >= a.nct) {
            const int kp0 = (a.lt0 + ti - a.nct) * 64 + 4 * h - qpos + kb * 32;
#pragma unroll
            for (int i = 0; i < 16; ++i) {
              const int dlt = kp0 + (i & 3) + 8 * (i >> 2);
              if (dlt > 128 || dlt < -128) S[i] = -INFINITY;
            }
          }
        }
#pragma unroll
        for (int i = 0; i < 16; ++i) { S[i] = __builtin_amdgcn_exp2f((DV == 128) ? S[i] + negmb : S[i]); ls += S[i]; }
#pragma unroll
        for (int s = 0; s < 2; ++s) {
          u32x4 pw;
#pragma unroll
          for (int j = 0; j < 4; ++j) pw[j] = pk2(S[8 * s + 2 * j], S[8 * s + 2 * j + 1]);
          const bf16x8 pb = __builtin_bit_cast(bf16x8, pw);
          const int rc = (kb * 32 + 16 * s) * VP;
#pragma unroll
          for (int db = 0; db < NDB; ++db) {
            const s16x4 lo = __builtin_amdgcn_ds_read_tr16_b64_v4i16((LDS_AS s16x4*)(sv + vbase[db] + rc));
            const s16x4 hi = __builtin_amdgcn_ds_read_tr16_b64_v4i16((LDS_AS s16x4*)(sv + vbase[db] + rc + 8 * VP));
            const bf16x8 vf = __builtin_shufflevector(lo, hi, 0, 1, 2, 3, 4, 5, 6, 7);
            O[m][db] = MFMA32(vf, pb, O[m][db]);
          }
        }
        __builtin_amdgcn_sched_barrier(0);
      }
      lsum[m] += ls;
    }
  }
  const float lt = lsum[0] + __shfl_xor(lsum[0], 32) + a.sinkterm;
  const float inv = 1.f / lt;
  bf16_t* orow = a.o + (size_t)(a.qrow0 + wave * 32 + l32) * a.opitch + 4 * h;
  if (EPI == 0) {
#pragma unroll
    for (int db = 0; db < NDB; ++db)
#pragma unroll
      for (int g = 0; g < 4; ++g) {
        u32x2 w = {pk2(O[0][db][4 * g] * inv, O[0][db][4 * g + 1] * inv), pk2(O[0][db][4 * g + 2] * inv, O[0][db][4 * g + 3] * inv)};
        *(u32x2*)(orow + db * 32 + 8 * g) = w;
      }
  } else {
    const float c1 = inv * a.lam;
    float ss = 0.f;
#pragma unroll
    for (int db = 0; db < NDB; ++db)
#pragma unroll
      for (int g = 0; g < 4; ++g) {
        const u32x2 raw = *(const u32x2*)(a.o0 + (size_t)(a.qrow0 + wave * 32 + l32) * 512 + 4 * h + db * 32 + 8 * g);
        const float o0[4] = {__uint_as_float(raw[0] << 16), __uint_as_float(raw[0] & 0xffff0000u), __uint_as_float(raw[1] << 16), __uint_as_float(raw[1] & 0xffff0000u)};
#pragma unroll
        for (int j = 0; j < 4; ++j) { const float v = o0[j] - O[0][db][4 * g + j] * c1; O[0][db][4 * g + j] = v; ss += v * v; }
      }
    ss += __shfl_xor(ss, 32);
    const float rstd = rsqrtf(ss * (1.f / (float)DV) + EPS) * a.osc;
#pragma unroll
    for (int db = 0; db < NDB; ++db)
#pragma unroll
      for (int g = 0; g < 4; ++g) {
        const f32x4 gs = *(const f32x4*)(a.gsub + db * 32 + 8 * g + 4 * h);
        u32x2 w = {pk2(O[0][db][4 * g] * rstd * gs[0], O[0][db][4 * g + 1] * rstd * gs[1]), pk2(O[0][db][4 * g + 2] * rstd * gs[2], O[0][db][4 * g + 3] * rstd * gs[3])};
        *(u32x2*)(orow + db * 32 + 8 * g) = w;
      }
  }
}

DI void attn_diff_item(const AttnArgs& a, LDS_AS unsigned char* smem) {
  AttnArgs a0 = a; a0.o = a.o0; a0.opitch = 512;
  { bf16x8 q0[4]; load_q<4>(a, 0, q0); attn_item<1, false, 128, 0, false>(a0, q0, 0, smem); }
  { bf16x8 q1[4]; load_q<4>(a, 64, q1); attn_item<1, false, 128, 1, false>(a, q1, 64, smem); }
}

DI void phase_attention(const Params& p, int l, LDS_AS unsigned char* smem) {
  const float* cs = p.consts + l * 16;
  const float lam = cs[0], lam_init = cs[1], mb_mla = cs[2], mb_swa = cs[3], mb_diff = cs[4];
  const int nc_d = (l == 0) ? 32 : 0, nc_m = (l == 0) ? 64 : 0;
#pragma unroll 1
  for (int i = blockIdx.x; i < 1024 + nc_d; i += gridDim.x) {
    AttnArgs a;
    int b, hd;
    if (i < 1024) {
      const int id = xcd_remap(i, 1024), pair = id >> 6, qb = id & 63; b = pair >> 2; hd = pair & 3;
      a.lt0 = 0; a.lt1 = 128; a.qrow0 = b * 8192 + qb * 128;
    } else {
      const int j = i - 1024, qb = j & 1; b = j >> 3; hd = (j >> 1) & 3;
      a.lt0 = 0; a.lt1 = 0; a.qrow0 = TL + b * 256 + qb * 128;
    }
    a.q = p.PROJ + C_DQ + hd * 128; a.qpitch = PN; a.k = p.PROJ + C_DK + hd * 128; a.kpitch = PN; a.v = p.PROJ + C_DV + hd * 128; a.vpitch = PN;
    a.o = p.PROJ + C_DQ + hd * 128; a.opitch = PN; a.o0 = p.YD0 + hd * 128;
    a.krow_ctx = TL + b * 256; a.krow_lat = b * 8192; a.nct = 4; a.qpos0 = 0;
    a.mb = mb_diff; a.sinkterm = 0.f; a.lam = lam; a.osc = 1.f - lam_init; a.gsub = p.g_diff_sub + l * 128;
    attn_diff_item(a, smem);
  }
#pragma unroll 1
  for (int i = blockIdx.x; i < 2048 + nc_m; i += gridDim.x) {
    AttnArgs a;
    int b, hd;
    if (i < 2048) {
      const int id = xcd_remap(i, 2048), pair = id >> 6, qb = id & 63; b = pair >> 3; hd = pair & 7;
      a.lt0 = 0; a.lt1 = 128; a.qrow0 = b * 8192 + qb * 128;
    } else {
      const int j = i - 2048, qb = j & 1; b = j >> 4; hd = (j >> 1) & 7;
      a.lt0 = 0; a.lt1 = 0; a.qrow0 = TL + b * 256 + qb * 128;
    }
    a.q = p.MQ + hd * 96; a.qpitch = 768; a.k = p.KM + hd * 96; a.kpitch = 768; a.v = p.KV + hd * 128 + 64; a.vpitch = 1024;
    a.o = p.MQ + hd * 96; a.opitch = 768; a.o0 = nullptr;
    a.krow_ctx = TL + b * 256; a.krow_lat = b * 8192; a.nct = 4; a.qpos0 = 0;
    a.mb = mb_mla; a.sinkterm = 0.f; a.lam = 0.f; a.osc = 0.f; a.gsub = nullptr;
    bf16x8 qf[6]; load_q<6>(a, 0, qf);
    attn_item<1, true, 64, 0, false>(a, qf, 0, smem);
  }
#pragma unroll 1
  for (int i = blockIdx.x; i < 2048 + nc_m; i += gridDim.x) {
    AttnArgs a;
    int b, hq;
    if (i < 2048) {
      const int id = xcd_remap(i, 2048), pair = id >> 6, qb = id & 63; b = pair >> 3; hq = pair & 7;
      a.lt0 = (2 * qb - 2 < 0) ? 0 : 2 * qb - 2; a.lt1 = (2 * qb + 4 > 128) ? 128 : 2 * qb + 4;
      a.qrow0 = b * 8192 + qb * 128; a.qpos0 = qb * 128;
    } else {
      const int j = i - 2048, qb = j & 1; b = j >> 4; hq = (j >> 1) & 7;
      a.lt0 = 0; a.lt1 = 0; a.qrow0 = TL + b * 256 + qb * 128; a.qpos0 = 0;
    }
    const int kvh = hq >> 2;
    a.q = p.PROJ + C_SQ + hq * 64; a.qpitch = PN; a.k = p.PROJ + C_SK + kvh * 64; a.kpitch = PN; a.v = p.PROJ + C_SV + kvh * 64; a.vpitch = PN;
    a.o = p.PROJ + C_SQ + hq * 64; a.opitch = PN; a.o0 = nullptr;
    a.krow_ctx = TL + b * 256; a.krow_lat = b * 8192; a.nct = 4;
    a.mb = mb_swa; a.sinkterm = __builtin_amdgcn_exp2f(p.swa_sink[l * 8 + hq] * LOG2E - mb_swa); a.lam = 0.f; a.osc = 0.f; a.gsub = nullptr;
    bf16x8 qf[4]; load_q<4>(a, 0, qf);
    attn_item<1, false, 64, 0, true>(a, qf, 0, smem);
  }
}

constexpr int NPH = 1 + 2 * 11;
DI void run_phase(const Params& p, int ph, LDS_AS unsigned char* smem) {
#ifdef ONLY_S
  if (ONLY_S == 99) { if (ph == 0) phase0(p, smem); return; }
  if (ph == 0) return;
  const int l = (ph - 1) / 11, s = ONLY_S;
#else
  if (ph == 0) { phase0(p, smem); return; }
  const int l = (ph - 1) / 11, s = (ph - 1) % 11;
#endif
  switch (s) {
    case 0: norm_phase(p, l, 0); break;
    case 1: phase_gemm_in(p, l, smem); break;
    case 2: phase_prep_a(p, l); break;
    case 3: phase_gemm_mla(p, l, smem); break;
    case 4: phase_prep_c(p, l); break;
    case 5: phase_attention(p, l, smem); break;
    case 6: phase_merge(p, l, smem); break;
    case 7: phase_residual_gemm(p, l, 0, smem); break;
    case 8: norm_phase(p, l, 1); break;
    case 9: phase_mlp_in(p, l, smem); break;
    default: phase_residual_gemm(p, l, 1, smem); break;
  }
}

__global__ void __launch_bounds__(256, 2) mega_kernel(Params p) {
  __shared__ __attribute__((aligned(16))) unsigned char smem_raw[65536];
  LDS_AS unsigned char* smem = (LDS_AS unsigned char*)smem_raw;
  cg::grid_group grid = cg::this_grid();
#pragma unroll 1
  for (int ph = 0; ph < NPH; ++ph) {
    run_phase(p, ph, smem);
    if (ph + 1 < NPH) grid.sync();
  }
}
#ifdef MK_MULTI
__global__ void __launch_bounds__(256, 2) phase_kernel(Params p, int ph) {
  __shared__ __attribute__((aligned(16))) unsigned char smem_raw[65536];
  run_phase(p, ph, (LDS_AS unsigned char*)smem_raw);
}
#endif

extern "C" void kernel_launch(void* const* d_in, const int* in_sizes, int n_in, void* d_out, int out_size, void* d_ws, size_t ws_size,
                              hipStream_t stream) {
  Params p{};
  const float* const* in = (const float* const*)d_in;
  p.x = in[0]; p.c = in[1]; p.ctx = in[2]; p.c_ctx = in[3]; p.w_mod = in[4]; p.b_mod = in[5]; p.g_norm_attn = in[6]; p.g_norm_mlp = in[7];
  p.w_in = in[8]; p.g_q_lora = in[9]; p.w_uq = in[10]; p.g_kv_lora = in[11]; p.w_ukv = in[12]; p.g_mla_q = in[13]; p.g_mla_k = in[14];
  p.w_up_mla = in[15]; p.g_swa_q = in[16]; p.g_swa_k = in[17]; p.swa_sink = in[18]; p.w_up_swa = in[19]; p.g_diff_q = in[20]; p.g_diff_k = in[21];
  p.lambda_q1 = in[22]; p.lambda_k1 = in[23]; p.lambda_q2 = in[24]; p.lambda_k2 = in[25]; p.g_diff_sub = in[26]; p.w_up_diff = in[27];
  p.w_o = in[28]; p.w_mlp_in = in[29]; p.w_mlp_out = in[30];
  p.out = (float*)d_out;
  unsigned char* ws = (unsigned char*)d_ws;
  size_t off = 0;
  auto take = [&](size_t bytes) { unsigned char* r = ws + off; off += (bytes + 255) & ~(size_t)255; return r; };
  p.modtab = (float*)take(2 * 5 * 6144 * 4);
  p.consts = (float*)take(256);
  p.WB = (bf16_t*)take(2 * W_LAYER * 2);
  p.H = (bf16_t*)take((size_t)T * 1024 * 2);
  p.PROJ = (bf16_t*)take((size_t)T * PN * 2);
  p.MQ = (bf16_t*)take((size_t)T * 768 * 2);
  p.KV = (bf16_t*)take((size_t)T * 1024 * 2);
  p.KM = (bf16_t*)take((size_t)T * 768 * 2);
  p.CX = (float*)take((size_t)TC * 1024 * 4);
  p.YD0 = (bf16_t*)take((size_t)T * 512 * 2);
  if (off > ws_size) { fprintf(stderr, "workspace too small: need %zu have %zu\n", off, ws_size); return; }
  hipMemsetAsync(p.modtab, 0, 2 * 5 * 6144 * 4, stream);
#ifdef MK_MULTI
  for (int ph = 0; ph < NPH; ++ph) phase_kernel<<<512, 256, 0, stream>>>(p, ph);
#else
  static int grid_blocks = 0;
  if (!grid_blocks) {
    int dev = 0, cus = 0, per_cu = 0;
    hipGetDevice(&dev);
    hipDeviceGetAttribute(&cus, hipDeviceAttributeMultiprocessorCount, dev);
    hipOccupancyMaxActiveBlocksPerMultiprocessor(&per_cu, mega_kernel, 256, 0);
    if (per_cu > 2) per_cu = 2;
    grid_blocks = cus * per_cu;
    if (grid_blocks <= 0) grid_blocks = 256;
  }
  void* args[] = {&p};
  hipError_t e = hipLaunchCooperativeKernel((void*)mega_kernel, dim3(grid_blocks), dim3(256), args, 0, stream);
  if (e != hipSuccess) fprintf(stderr, "cooperative launch failed: %s (grid %d)\n", hipGetErrorString(e), grid_blocks);
#endif
}
```

```cpp
#include <hip/hip_runtime.h>
#include <hip/hip_cooperative_groups.h>
#include <cstdio>
#include <cstdint>
namespace cg = cooperative_groups;

typedef unsigned short bf16_t;
typedef short bf16x8 __attribute__((ext_vector_type(8)));
typedef short s16x4 __attribute__((ext_vector_type(4)));
typedef float f32x16 __attribute__((ext_vector_type(16)));
typedef float f32x4 __attribute__((ext_vector_type(4)));
typedef float f32x2 __attribute__((ext_vector_type(2)));
typedef __bf16 bf16x2_t __attribute__((ext_vector_type(2)));
typedef unsigned u32x2 __attribute__((ext_vector_type(2)));
typedef unsigned u32x4 __attribute__((ext_vector_type(4)));
#define LDS_AS __attribute__((address_space(3)))
#define DI __device__ __forceinline__

constexpr int D = 1024, NB = 4, SEQ = 8192, NCTX = 256;
constexpr int TL = NB * SEQ;
constexpr int TC = NB * NCTX;
constexpr int T = TL + TC;
constexpr int PN = 2720;
constexpr int C_QLAT = 0, C_KVLAT = 256, C_KPE = 384, C_SQ = 416, C_SK = 928, C_SV = 1056, C_DQ = 1184, C_DK = 1696, C_DV = 2208;
constexpr float EPS = 1e-6f;
constexpr float LOG2E = 1.4426950408889634f;
constexpr size_t W_IN = 0;
constexpr size_t W_UQ = W_IN + (size_t)5888 * 1024;
constexpr size_t W_UKV = W_UQ + 768 * 256;
constexpr size_t W_UPM = W_UKV + 1024 * 128;
constexpr size_t W_UPS = W_UPM + 1024 * 512;
constexpr size_t W_UPD = W_UPS + 1024 * 512;
constexpr size_t W_O = W_UPD + 1024 * 512;
constexpr size_t W_M1 = W_O + 1024 * 1024;
constexpr size_t W_M2 = W_M1 + (size_t)4096 * 1024;
constexpr size_t W_LAYER = W_M2 + (size_t)4096 * 1024;

struct Params {
  const float *x, *c, *ctx, *c_ctx, *w_mod, *b_mod, *g_norm_attn, *g_norm_mlp, *w_in, *g_q_lora, *w_uq, *g_kv_lora, *w_ukv,
      *g_mla_q, *g_mla_k, *w_up_mla, *g_swa_q, *g_swa_k, *swa_sink, *w_up_swa, *g_diff_q, *g_diff_k, *lambda_q1, *lambda_k1,
      *lambda_q2, *lambda_k2, *g_diff_sub, *w_up_diff, *w_o, *w_mlp_in, *w_mlp_out;
  float* out;
  float* modtab;
  float* consts;
  unsigned* bar;
  bf16_t* WB;
  bf16_t* H;
  bf16_t* PROJ;
  bf16_t* MQ;
  bf16_t* KV;
  bf16_t* KM;
  float* CX;
  bf16_t* YD0;
  int probe, pad_;
};

template <class Tp> DI Tp* opq(Tp* ptr) { asm volatile("" : "+s"(ptr)); return ptr; }
DI int tidx() { int t = threadIdx.x; asm volatile("" : "+v"(t)); return t; }
DI float bf2f(bf16_t v) { return __uint_as_float((unsigned)v << 16); }
DI unsigned pk2(float a, float b) { f32x2 v = {a, b}; bf16x2_t r = __builtin_convertvector(v, bf16x2_t); return __builtin_bit_cast(unsigned, r); }
DI bf16_t f2bf(float a) { return (bf16_t)(pk2(a, 0.f) & 0xffffu); }
DI float wave_sum(float v) {
#pragma unroll
  for (int o = 32; o; o >>= 1) v += __shfl_xor(v, o);
  return v;
}
DI float wave_max(float v) {
#pragma unroll
  for (int o = 32; o; o >>= 1) v = fmaxf(v, __shfl_xor(v, o));
  return v;
}
DI float silu(float x) { return x / (1.f + __expf(-x)); }
DI int xcd_remap(int L, int n) {
  const int q = n >> 3, r = n & 7, xcd = L & 7, off = L >> 3;
  return (xcd < r ? xcd * (q + 1) : r * (q + 1) + (xcd - r) * q) + off;
}
DI void glds16(const void* g, LDS_AS unsigned char* l) {
  __builtin_amdgcn_global_load_lds((const unsigned*)g, (LDS_AS unsigned*)l, 16, 0, 0);
}
DI void glds16a(const void* base, unsigned voff, unsigned ldsaddr) {
  unsigned keep;
  asm volatile("s_mov_b32 %0, m0\n\ts_mov_b32 m0, %3\n\ts_nop 0\n\tglobal_load_lds_dwordx4 %1, %2\n\ts_mov_b32 m0, %0"
               : "=&s"(keep) : "v"(voff), "s"(base), "s"(ldsaddr) : "memory");
}
DI unsigned lds_u32(LDS_AS unsigned char* p) { return (unsigned)(uintptr_t)p; }
DI bf16x8 lds128(LDS_AS unsigned char* p) { return *(LDS_AS bf16x8*)p; }
#define MFMA32(a, b, c) __builtin_amdgcn_mfma_f32_32x32x16_bf16((a), (b), (c), 0, 0, 0)

#define XB_TMO      128
#define XB_XCNT(j)  (256  + 64 * (j))
#define XB_XSUB(j)  (1280 + 64 * (j))
#define XB_XGEN(j)  (2304 + 64 * (j))
#define XB_TOP      3328
#define XB_TOPGEN   3392
#define XCD_BAR_WORDS 3456
#define XB_SPIN_CAP (1u << 22)
DI unsigned xb_ld(unsigned* p) { return __hip_atomic_load(p, __ATOMIC_RELAXED, __HIP_MEMORY_SCOPE_AGENT); }
DI unsigned xb_add(unsigned* p, unsigned v) { return __hip_atomic_fetch_add(p, v, __ATOMIC_RELAXED, __HIP_MEMORY_SCOPE_AGENT); }
DI unsigned xb_xcc_id() { return (unsigned)__builtin_amdgcn_s_getreg((3 << 11) | 20) & 0xFu; }
#define XB_SPIN(cond, bar) do { unsigned _sp = 0; while (cond) { __builtin_amdgcn_s_sleep(1); \
    if ((++_sp & 255u) == 0u) { if (xb_ld(&(bar)[XB_TMO])) break; if (_sp > XB_SPIN_CAP) { atomicAdd(&(bar)[XB_TMO], 1u); break; } } } } while (0)
struct XcdBarrier { unsigned* bar; unsigned x; volatile LDS_AS unsigned* st; };
DI XcdBarrier xcd_barrier_post(unsigned* bar, volatile LDS_AS unsigned* st) {
  XcdBarrier b; b.bar = bar; b.x = xb_xcc_id(); b.st = st;
  if (threadIdx.x == 0) (void)xb_add(&bar[XB_XCNT(b.x)], 1u);
  return b;
}
DI void xcd_barrier_complete(unsigned* bar, unsigned x, unsigned& nloc, unsigned& nx) {
  const unsigned G = gridDim.x * gridDim.y * gridDim.z;
  unsigned sum, cnt, mine, sp = 0u;
  for (;;) {
    sum = 0u; cnt = 0u; mine = 0u;
#pragma unroll
    for (unsigned j = 0; j < 16; ++j) { const unsigned c = xb_ld(&bar[XB_XCNT(j)]); sum += c; cnt += (c > 0u) ? 1u : 0u; mine = (j == x) ? c : mine; }
    if (sum == G) break;
    __builtin_amdgcn_s_sleep(1);
    if ((++sp & 255u) == 0u) { if (xb_ld(&bar[XB_TMO])) break; if (sp > XB_SPIN_CAP) { atomicAdd(&bar[XB_TMO], 1u); break; } }
  }
  nloc = mine > 0u ? mine : 1u; nx = cnt > 0u ? cnt : 1u;
}
DI void xcd_barrier(const XcdBarrier& b) {
  asm volatile("s_waitcnt vmcnt(0)" ::: "memory");
  __syncthreads();
  if (threadIdx.x == 0) {
    unsigned* bar = b.bar;
    __builtin_amdgcn_s_waitcnt(0);
    unsigned nloc = b.st[0], nx = b.st[1];
    if (nloc == 0u) { xcd_barrier_complete(bar, b.x, nloc, nx); b.st[0] = nloc; b.st[1] = nx; }
    const unsigned old = xb_add(&bar[XB_XSUB(b.x)], 1u);
    const unsigned gen = old / nloc;
    if (old + 1u == (gen + 1u) * nloc) {
      __builtin_amdgcn_fence(__ATOMIC_RELEASE, "agent");
      asm volatile("s_waitcnt vmcnt(0)" ::: "memory");
      const unsigned og = xb_add(&bar[XB_TOP], 1u);
      const unsigned tg = og / nx;
      if (og + 1u == (tg + 1u) * nx) xb_add(&bar[XB_TOPGEN], 1u);
      else XB_SPIN(xb_ld(&bar[XB_TOPGEN]) == tg, bar);
      __builtin_amdgcn_fence(__ATOMIC_ACQUIRE, "agent");
      xb_add(&bar[XB_XGEN(b.x)], 1u);
      asm volatile("s_waitcnt vmcnt(0)" ::: "memory");
    } else {
      XB_SPIN(xb_ld(&bar[XB_XGEN(b.x)]) == gen, bar);
      __builtin_amdgcn_fence(__ATOMIC_ACQUIRE, "agent");
      asm volatile("s_waitcnt vmcnt(0)" ::: "memory");
    }
  }
  __syncthreads();
}

DI void conv_tile(const float* src, int ld, int K, int k0, int n0, bool is_win, bf16_t* dst, LDS_AS float* tile, int dry) {
  const int tid = tidx(), ty = tid >> 4, tx = tid & 15;
  const int n = n0 + 4 * tx;
  int sc = n;
  if (is_win) sc = (n < 2720) ? n : (n < 2816 ? -1 : n - 96);
#pragma unroll
  for (int i = 0; i < 2; ++i) {
    const int k = ty + 32 * i;
    f32x4 v = {0.f, 0.f, 0.f, 0.f};
    if (sc >= 0) v = *(const f32x4*)(src + (size_t)(k0 + k) * ld + sc);
    tile[k * 65 + 4 * tx + 0] = v[0]; tile[k * 65 + 4 * tx + 1] = v[1]; tile[k * 65 + 4 * tx + 2] = v[2]; tile[k * 65 + 4 * tx + 3] = v[3];
  }
  __syncthreads();
  {
    const int r = tid >> 3, c = tid & 7;
    u32x4 w;
    w[0] = pk2(tile[(8 * c + 0) * 65 + r], tile[(8 * c + 1) * 65 + r]);
    w[1] = pk2(tile[(8 * c + 2) * 65 + r], tile[(8 * c + 3) * 65 + r]);
    w[2] = pk2(tile[(8 * c + 4) * 65 + r], tile[(8 * c + 5) * 65 + r]);
    w[3] = pk2(tile[(8 * c + 6) * 65 + r], tile[(8 * c + 7) * 65 + r]);
    if (!dry) *(u32x4*)(dst + (size_t)(n0 + r) * K + k0 + 8 * c) = w;
  }
  __syncthreads();
}

DI void phase0(const Params& p, LDS_AS unsigned char* smem, int dry) {
  const int tid_ = tidx(), lane = tid_ & 63, wave = tid_ >> 6;
  if (blockIdx.x == 0 && wave == 0) {
    for (int l = 0; l < 2; ++l) {
      const float s1 = wave_sum(p.lambda_q1[l * 64 + lane] * p.lambda_k1[l * 64 + lane]);
      const float s2 = wave_sum(p.lambda_q2[l * 64 + lane] * p.lambda_k2[l * 64 + lane]);
      const float lam_init = 0.8f - 0.6f * expf(-0.3f * (float)l);
      const float lam = expf(s1) - expf(s2) + lam_init;
      float a = fabsf(p.g_mla_q[l * 96 + lane]); if (lane < 32) a = fmaxf(a, fabsf(p.g_mla_q[l * 96 + 64 + lane]));
      float b = fabsf(p.g_mla_k[l * 96 + lane]); if (lane < 32) b = fmaxf(b, fabsf(p.g_mla_k[l * 96 + 64 + lane]));
      const float mq = wave_max(a), mk = wave_max(b);
      const float sq = wave_max(fabsf(p.g_swa_q[l * 64 + lane])), sk = wave_max(fabsf(p.g_swa_k[l * 64 + lane]));
      const float dq = wave_max(fabsf(p.g_diff_q[l * 64 + lane])), dk = wave_max(fabsf(p.g_diff_k[l * 64 + lane]));
      if (lane == 0) {
        float* cs = p.consts + l * 16;
        cs[0] = lam; cs[1] = lam_init;
        cs[2] = LOG2E * sqrtf(96.f) * mq * mk;
        cs[3] = LOG2E * 8.f * sq * sk;
        cs[4] = LOG2E * 8.f * dq * dk;
      }
    }
  }
  for (int task = blockIdx.x * 8 + wave; task < 3072; task += gridDim.x * 8) {
    const int l = task / 1536, rem = task % 1536, chunk = rem >> 4, ks = rem & 15;
    const int n = chunk * 64 + lane;
    float acc[5] = {0.f, 0.f, 0.f, 0.f, 0.f};
    const float* w = p.w_mod + ((size_t)l * 1024 + ks * 64) * 6144 + n;
#pragma unroll 8
    for (int k = 0; k < 64; ++k) {
      const float wv = w[(size_t)k * 6144];
      const int kk = ks * 64 + k;
#pragma unroll
      for (int r = 0; r < 4; ++r) acc[r] += silu(p.c[r * 1024 + kk]) * wv;
      acc[4] += silu(p.c_ctx[kk]) * wv;
    }
    const float bias = (ks == 0) ? p.b_mod[l * 6144 + n] : 0.f;
    if (!dry)
#pragma unroll
      for (int r = 0; r < 5; ++r) atomicAdd(p.modtab + (size_t)(l * 5 + r) * 6144 + n, acc[r] + bias);
  }
  LDS_AS float* tile = (LDS_AS float*)smem;
  for (int t = blockIdx.x; t < 2 * 4240; t += gridDim.x) {
    const int l = t / 4240; int u = t % 4240;
    const float* src; int ld, K; bool is_win = false; size_t doff;
    if (u < 1472) { src = p.w_in + (size_t)l * 1024 * 5792; ld = 5792; K = 1024; is_win = true; doff = W_IN; }
    else if (u < 1520) { u -= 1472; src = p.w_uq + (size_t)l * 256 * 768; ld = 768; K = 256; doff = W_UQ; }
    else if (u < 1552) { u -= 1520; src = p.w_ukv + (size_t)l * 128 * 1024; ld = 1024; K = 128; doff = W_UKV; }
    else if (u < 1680) { u -= 1552; src = p.w_up_mla + (size_t)l * 512 * 1024; ld = 1024; K = 512; doff = W_UPM; }
    else if (u < 1808) { u -= 1680; src = p.w_up_swa + (size_t)l * 512 * 1024; ld = 1024; K = 512; doff = W_UPS; }
    else if (u < 1936) { u -= 1808; src = p.w_up_diff + (size_t)l * 512 * 1024; ld = 1024; K = 512; doff = W_UPD; }
    else if (u < 2192) { u -= 1936; src = p.w_o + (size_t)l * 1024 * 1024; ld = 1024; K = 1024; doff = W_O; }
    else if (u < 3216) { u -= 2192; src = p.w_mlp_in + (size_t)l * 1024 * 4096; ld = 4096; K = 1024; doff = W_M1; }
    else { u -= 3216; src = p.w_mlp_out + (size_t)l * 4096 * 1024; ld = 1024; K = 4096; doff = W_M2; }
    const int nkt = K >> 6, kt = u % nkt, nt = u / nkt;
    conv_tile(src, ld, K, kt * 64, nt * 64, is_win, p.WB + (size_t)l * W_LAYER + doff, tile, dry);
  }
}

DI void norm_phase(const Params& p, int l, int which, int dry) {
  const int tid_ = tidx(), lane = tid_ & 63, wave = tid_ >> 6;
  const float* g = (which == 0 ? p.g_norm_attn : p.g_norm_mlp) + l * 1024;
  const int shoff = which == 0 ? 0 : 3072, scoff = shoff + 1024;
  const int nrows = (which == 1 && l == 1) ? TL : T;
  const bool first = (which == 0 && l == 0);
  const float* px = opq(p.x); const float* pctx = opq(p.ctx); const float* pout = opq((const float*)p.out); const float* pcx = opq((const float*)p.CX);
  const float* slat = first ? px : pout; const float* sctx = first ? pctx : pcx;
  for (int row = blockIdx.x * 8 + wave; row < nrows; row += gridDim.x * 8) {
    const float* xr; int bidx;
    if (row < TL) { xr = slat + (size_t)row * 1024; bidx = row >> 13; }
    else { xr = sctx + (size_t)(row - TL) * 1024; bidx = 4; }
    const float* mod = p.modtab + (size_t)(l * 5 + bidx) * 6144;
    f32x4 v[4]; float ss = 0.f;
#pragma unroll
    for (int i = 0; i < 4; ++i) { v[i] = *(const f32x4*)(xr + i * 256 + lane * 4); ss += v[i][0] * v[i][0] + v[i][1] * v[i][1] + v[i][2] * v[i][2] + v[i][3] * v[i][3]; }
    ss = wave_sum(ss);
    const float rstd = rsqrtf(ss * (1.f / 1024.f) + EPS);
#pragma unroll
    for (int i = 0; i < 4; ++i) {
      const int col = i * 256 + lane * 4;
      const f32x4 gv = *(const f32x4*)(g + col), sh = *(const f32x4*)(mod + shoff + col), sc = *(const f32x4*)(mod + scoff + col);
      float o[4];
#pragma unroll
      for (int j = 0; j < 4; ++j) o[j] = (v[i][j] * rstd * gv[j]) * (1.f + sc[j]) + sh[j];
      u32x2 w = {pk2(o[0], o[1]), pk2(o[2], o[3])};
      if (!dry) *(u32x2*)(p.H + (size_t)row * 1024 + col) = w;
    }
  }
}

constexpr int GST = 49152;
DI void gemm_kloop(const bf16_t* Ag, int lda, int a_kstep, const bf16_t* Bg, int ldb, int nkt, f32x16 (&acc)[2][2], LDS_AS unsigned char* smem) {
  const int tid_ = tidx(), lane = tid_ & 63, wave = tid_ >> 6, h = lane >> 5, wm = wave >> 1, wn = wave & 1;
  unsigned aoff[4], boff[2];
#pragma unroll
  for (int i = 0; i < 4; ++i) {
    const int r = wave * 32 + i * 8 + (lane >> 3), c = (lane & 7) ^ ((r >> 1) & 7);
    aoff[i] = (unsigned)(r * lda + c * 8) * 2u;
  }
#pragma unroll
  for (int i = 0; i < 2; ++i) {
    const int r = wave * 16 + i * 8 + (lane >> 3), c = (lane & 7) ^ ((r >> 1) & 7);
    boff[i] = (unsigned)(r * ldb + c * 8) * 2u;
  }
  const unsigned dstA = (unsigned)__builtin_amdgcn_readfirstlane((int)(lds_u32(smem) + wave * 4096));
  const unsigned dstB = (unsigned)__builtin_amdgcn_readfirstlane((int)(lds_u32(smem) + 32768 + wave * 2048));
  const int swz = (lane >> 1) & 7;
  const int arow = (wm * 64 + (lane & 31)) * 128, brow = 32768 + (wn * 64 + (lane & 31)) * 128;
  asm volatile("s_waitcnt vmcnt(0)" ::: "memory");
  __syncthreads();
  auto issue = [&](int kt, int stg) {
    const char* An = (const char*)(Ag + (size_t)kt * a_kstep); const char* Bn = (const char*)(Bg + (size_t)kt * 64);
#pragma unroll
    for (int i = 0; i < 4; ++i) glds16a(An, aoff[i], dstA + stg * GST + i * 1024);
#pragma unroll
    for (int i = 0; i < 2; ++i) glds16a(Bn, boff[i], dstB + stg * GST + i * 1024);
  };
  issue(0, 0);
  if (nkt > 1) issue(1, 1);
  int st = 0;
#pragma unroll 1
  for (int kt = 0; kt < nkt; ++kt) {
    if (kt + 1 < nkt) asm volatile("s_waitcnt vmcnt(6)" ::: "memory"); else asm volatile("s_waitcnt vmcnt(0)" ::: "memory");
    __builtin_amdgcn_s_barrier();
    asm volatile("" ::: "memory");
    if (kt + 2 < nkt) issue(kt + 2, st >= 1 ? st - 1 : 2);
    LDS_AS unsigned char* sa = smem + st * GST;
#pragma unroll
    for (int s = 0; s < 4; ++s) {
      const int co = ((2 * s + h) ^ swz) << 4;
      const bf16x8 a0 = lds128(sa + arow + co), a1 = lds128(sa + arow + 32 * 128 + co);
      const bf16x8 b0 = lds128(sa + brow + co), b1 = lds128(sa + brow + 32 * 128 + co);
      acc[0][0] = MFMA32(b0, a0, acc[0][0]); acc[0][1] = MFMA32(b1, a0, acc[0][1]);
      acc[1][0] = MFMA32(b0, a1, acc[1][0]); acc[1][1] = MFMA32(b1, a1, acc[1][1]);
    }
    st = (st == 2) ? 0 : st + 1;
  }
}
DI void zero_acc(f32x16 (&acc)[2][2]) {
#pragma unroll
  for (int a = 0; a < 2; ++a)
#pragma unroll
    for (int b = 0; b < 2; ++b)
#pragma unroll
      for (int i = 0; i < 16; ++i) acc[a][b][i] = 0.f;
}
DI void tile_decode(int id, int NT, int& mt, int& nt) { const int per = 4 * NT, g = id / per, w = id % per; mt = g * 4 + (w & 3); nt = w >> 2; }

template <int ACT> DI void epi_store_bf16(const f32x16 (&acc)[2][2], bf16_t* dst, int ldc, int row0, int col0, int ncols) {
  const int tid_ = tidx(), lane = tid_ & 63, wave = tid_ >> 6, h = lane >> 5, wm = wave >> 1, wn = wave & 1;
#pragma unroll
  for (int bi = 0; bi < 2; ++bi)
#pragma unroll
    for (int bj = 0; bj < 2; ++bj)
#pragma unroll
      for (int g = 0; g < 4; ++g) {
        const int row = row0 + wm * 64 + bi * 32 + (lane & 31), col = col0 + wn * 64 + bj * 32 + 8 * g + 4 * h;
        float v[4];
#pragma unroll
        for (int j = 0; j < 4; ++j) { v[j] = acc[bi][bj][4 * g + j]; if (ACT == 1) { v[j] = fmaxf(v[j], 0.f); v[j] *= v[j]; } }
        if (col < ncols) { u32x2 w = {pk2(v[0], v[1]), pk2(v[2], v[3])}; *(u32x2*)(dst + (size_t)row * ldc + col) = w; }
      }
}
DI void epi_residual(const f32x16 (&acc)[2][2], const float* xin, float* xout, const float* gate, int row0, int col0) {
  const int tid_ = tidx(), lane = tid_ & 63, wave = tid_ >> 6, h = lane >> 5, wm = wave >> 1, wn = wave & 1;
#pragma unroll
  for (int bi = 0; bi < 2; ++bi)
#pragma unroll
    for (int bj = 0; bj < 2; ++bj)
#pragma unroll
      for (int g = 0; g < 4; ++g) {
        const int row = row0 + wm * 64 + bi * 32 + (lane & 31), col = col0 + wn * 64 + bj * 32 + 8 * g + 4 * h;
        const f32x4 xi = *(const f32x4*)(xin + (size_t)row * 1024 + col), gv = *(const f32x4*)(gate + col);
        f32x4 o;
#pragma unroll
        for (int j = 0; j < 4; ++j) o[j] = xi[j] + gv[j] * acc[bi][bj][4 * g + j];
        *(f32x4*)(xout + (size_t)row * 1024 + col) = o;
      }
}

DI void phase_gemm_in(const Params& p, int l, LDS_AS unsigned char* smem, int dry) {
  const bf16_t* W = p.WB + (size_t)l * W_LAYER + W_IN;
  const int NT = 22, ntiles = (T / 256) * NT;
  for (int i = blockIdx.x; i < ntiles; i += gridDim.x) {
    int mt, nt; tile_decode(xcd_remap(i, ntiles), NT, mt, nt);
    f32x16 acc[2][2]; zero_acc(acc);
    gemm_kloop(p.H + (size_t)mt * 256 * 1024, 1024, 64, W + (size_t)nt * 128 * 1024, 1024, 16, acc, smem);
    if (!dry) epi_store_bf16<0>(acc, p.PROJ, PN, mt * 256, nt * 128, PN);
  }
}
DI void phase_gemm_mla(const Params& p, int l, LDS_AS unsigned char* smem, int dry) {
  const bf16_t* WQ = p.WB + (size_t)l * W_LAYER + W_UQ; const bf16_t* WK = p.WB + (size_t)l * W_LAYER + W_UKV;
  const int NT = 14, ntiles = (T / 256) * NT;
  for (int i = blockIdx.x; i < ntiles; i += gridDim.x) {
    int mt, nt; tile_decode(xcd_remap(i, ntiles), NT, mt, nt);
    f32x16 acc[2][2]; zero_acc(acc);
    if (nt < 6) {
      gemm_kloop(p.PROJ + (size_t)mt * 256 * PN + C_QLAT, PN, 64, WQ + (size_t)nt * 128 * 256, 256, 4, acc, smem);
      if (!dry) epi_store_bf16<0>(acc, p.MQ, 768, mt * 256, nt * 128, 768);
    } else {
      gemm_kloop(p.PROJ + (size_t)mt * 256 * PN + C_KVLAT, PN, 64, WK + (size_t)(nt - 6) * 128 * 128, 128, 2, acc, smem);
      if (!dry) epi_store_bf16<0>(acc, p.KV, 1024, mt * 256, (nt - 6) * 128, 1024);
    }
  }
}
DI void phase_merge(const Params& p, int l, LDS_AS unsigned char* smem, int dry) {
  const bf16_t* WL = p.WB + (size_t)l * W_LAYER;
  const int NT = 8, MT = (l == 1) ? TL / 256 : T / 256, ntiles = MT * NT;
  bf16_t* M = p.KV;
  for (int i = blockIdx.x; i < ntiles; i += gridDim.x) {
    int mt, nt; tile_decode(xcd_remap(i, ntiles), NT, mt, nt);
    unsigned tp[2][2][8];
#pragma unroll
    for (int a = 0; a < 2; ++a)
#pragma unroll
      for (int b = 0; b < 2; ++b)
#pragma unroll
        for (int e = 0; e < 8; ++e) tp[a][b][e] = 0u;
#pragma unroll 1
    for (int br = 0; br < 3; ++br) {
      unsigned gp[2][2][8];
      {
        f32x16 ag[2][2]; zero_acc(ag);
        gemm_kloop(p.H + (size_t)mt * 256 * 1024, 1024, 64, WL + W_IN + (size_t)(2816 + br * 1024 + nt * 128) * 1024, 1024, 16, ag, smem);
#pragma unroll
        for (int a = 0; a < 2; ++a)
#pragma unroll
          for (int b = 0; b < 2; ++b)
#pragma unroll
            for (int e = 0; e < 8; ++e)
              gp[a][b][e] = pk2(__builtin_amdgcn_rcpf(1.f + __builtin_amdgcn_exp2f(-LOG2E * ag[a][b][2 * e])),
                                __builtin_amdgcn_rcpf(1.f + __builtin_amdgcn_exp2f(-LOG2E * ag[a][b][2 * e + 1])));
      }
      f32x16 ay[2][2]; zero_acc(ay);
      const int lda = (br == 0) ? 768 : PN, kstep = (br == 0) ? 96 : 64;
      const size_t aofs = (br == 0) ? (size_t)T * PN : (size_t)(br == 1 ? C_SQ : C_DQ);
      __builtin_amdgcn_sched_barrier(0);
      gemm_kloop(p.PROJ + aofs + (size_t)mt * 256 * lda, lda, kstep, WL + W_UPM + (size_t)br * 1024 * 512 + (size_t)nt * 128 * 512, 512, 8, ay, smem);
#pragma unroll
      for (int a = 0; a < 2; ++a)
#pragma unroll
        for (int b = 0; b < 2; ++b)
#pragma unroll
          for (int e = 0; e < 8; ++e) {
            const float t0 = __uint_as_float(tp[a][b][e] << 16) + __uint_as_float(gp[a][b][e] << 16) * ay[a][b][2 * e];
            const float t1 = __uint_as_float(tp[a][b][e] & 0xffff0000u) + __uint_as_float(gp[a][b][e] & 0xffff0000u) * ay[a][b][2 * e + 1];
            tp[a][b][e] = pk2(t0, t1);
          }
    }
    {
      const int tid_ = tidx(), lane = tid_ & 63, wave = tid_ >> 6, h = lane >> 5, wm = wave >> 1, wn = wave & 1;
#pragma unroll
      for (int bi = 0; bi < 2; ++bi)
#pragma unroll
        for (int bj = 0; bj < 2; ++bj)
#pragma unroll
          for (int g = 0; g < 4; ++g) {
            const int row = mt * 256 + wm * 64 + bi * 32 + (lane & 31), col = nt * 128 + wn * 64 + bj * 32 + 8 * g + 4 * h;
            u32x2 w = {tp[bi][bj][2 * g], tp[bi][bj][2 * g + 1]};
            if (!dry) *(u32x2*)(M + (size_t)row * 1024 + col) = w;
          }
    }
  }
}
DI void phase_residual_gemm(const Params& p, int l, int which, LDS_AS unsigned char* smem, int dry) {
  const bf16_t* WL = p.WB + (size_t)l * W_LAYER;
  const int NT = 8, MT = (l == 1) ? TL / 256 : T / 256, ntiles = MT * NT;
  const bf16_t* Abase = which == 0 ? (const bf16_t*)opq(p.KV) : (const bf16_t*)opq(p.PROJ);
  const int K = which == 0 ? 1024 : 4096;
  const bf16_t* W = WL + (which == 0 ? W_O : W_M2);
  const bool first = (which == 0 && l == 0);
  const float* px = opq(p.x); const float* pctx = opq(p.ctx); float* pout = opq(p.out); float* pcx = opq(p.CX);
  const float* slat = first ? px : (const float*)pout; const float* sctx = first ? pctx : (const float*)pcx;
  for (int i = blockIdx.x; i < ntiles; i += gridDim.x) {
    int mt, nt; tile_decode(xcd_remap(i, ntiles), NT, mt, nt);
    f32x16 acc[2][2]; zero_acc(acc);
    gemm_kloop(Abase + (size_t)mt * 256 * K, K, 64, W + (size_t)nt * 128 * K, K, K / 64, acc, smem);
    const int row0 = mt * 256;
    const float* xin; float* xout; int bidx, r0;
    if (row0 < TL) { xin = slat; xout = pout; bidx = row0 >> 13; r0 = row0; }
    else { xin = sctx; xout = pcx; bidx = 4; r0 = row0 - TL; }
    const float* gate = p.modtab + (size_t)(l * 5 + bidx) * 6144 + (which == 0 ? 2048 : 5120);
    if (!dry) epi_residual(acc, xin, xout, gate, r0, nt * 128);
  }
}
DI void phase_mlp_in(const Params& p, int l, LDS_AS unsigned char* smem, int dry) {
  const bf16_t* W = p.WB + (size_t)l * W_LAYER + W_M1;
  const int NT = 32, MT = (l == 1) ? TL / 256 : T / 256, ntiles = MT * NT;
  bf16_t* U = p.PROJ;
  for (int i = blockIdx.x; i < ntiles; i += gridDim.x) {
    int mt, nt; tile_decode(xcd_remap(i, ntiles), NT, mt, nt);
    f32x16 acc[2][2]; zero_acc(acc);
    gemm_kloop(p.H + (size_t)mt * 256 * 1024, 1024, 64, W + (size_t)nt * 128 * 1024, 1024, 16, acc, smem);
    if (!dry) epi_store_bf16<1>(acc, U, 4096, mt * 256, nt * 128, 4096);
  }
}

DI void phase_prep_a(const Params& p, int l, int dry) {
  const int tid_ = tidx(), lane = tid_ & 63, wave = tid_ >> 6;
  const float gsq = p.g_swa_q[l * 64 + lane], gsk = p.g_swa_k[l * 64 + lane], gdq = p.g_diff_q[l * 64 + lane], gdk = p.g_diff_k[l * 64 + lane];
  const f32x4 gql = *(const f32x4*)(p.g_q_lora + l * 256 + lane * 4);
  const f32x2 gkl = *(const f32x2*)(p.g_kv_lora + l * 128 + lane * 2);
  const float freq = __builtin_amdgcn_exp2f(-(float)(lane & 15) * (13.287712379549449f / 16.f));
  const float sgn = ((lane >> 4) & 1) ? 1.f : -1.f;
  for (int row = blockIdx.x * 8 + wave; row < T; row += gridDim.x * 8) {
    bf16_t* base = p.PROJ + (size_t)row * PN;
    const bool islat = row < TL;
    float cs = 1.f, sn = 0.f;
    if (islat) {
      const int t = row & 8191; const float pos = (float)((lane >> 5) ? (t & 63) : (t >> 6));
      const float rev = (pos * freq) * 0.15915494309189535f;
      cs = __builtin_amdgcn_cosf(rev); sn = __builtin_amdgcn_sinf(rev);
    }
    {
      const u32x2 raw = *(const u32x2*)(base + C_QLAT + lane * 4);
      float v[4] = {__uint_as_float(raw[0] << 16), __uint_as_float(raw[0] & 0xffff0000u), __uint_as_float(raw[1] << 16), __uint_as_float(raw[1] & 0xffff0000u)};
      const float ss = wave_sum(v[0] * v[0] + v[1] * v[1] + v[2] * v[2] + v[3] * v[3]);
      const float rstd = rsqrtf(ss * (1.f / 256.f) + EPS);
      u32x2 w = {pk2(v[0] * rstd * gql[0], v[1] * rstd * gql[1]), pk2(v[2] * rstd * gql[2], v[3] * rstd * gql[3])};
      if (!dry) *(u32x2*)(base + C_QLAT + lane * 4) = w;
    }
    {
      const unsigned raw = *(const unsigned*)(base + C_KVLAT + lane * 2);
      const float v0 = __uint_as_float(raw << 16), v1 = __uint_as_float(raw & 0xffff0000u);
      const float ss = wave_sum(v0 * v0 + v1 * v1);
      const float rstd = rsqrtf(ss * (1.f / 128.f) + EPS);
      if (!dry) *(unsigned*)(base + C_KVLAT + lane * 2) = pk2(v0 * rstd * gkl[0], v1 * rstd * gkl[1]);
    }
#pragma unroll 2
    for (int vi = 0; vi < 26; ++vi) {
      int cb; float g, sc;
      if (vi < 8) { cb = C_SQ + vi * 64; g = gsq; sc = 0.125f * LOG2E; }
      else if (vi < 10) { cb = C_SK + (vi - 8) * 64; g = gsk; sc = 1.f; }
      else if (vi < 18) { cb = C_DQ + (vi - 10) * 64; g = gdq; sc = 0.125f * LOG2E; }
      else { cb = C_DK + (vi - 18) * 64; g = gdk; sc = 1.f; }
      const float xv = bf2f(base[cb + lane]);
      const float ss = wave_sum(xv * xv);
      float y = xv * rsqrtf(ss * (1.f / 64.f) + EPS) * g;
      const float pr = __shfl_xor(y, 16);
      y = (y * cs + sgn * pr * sn) * sc;
      if (!dry) base[cb + lane] = f2bf(y);
    }
  }
}
DI void phase_prep_c(const Params& p, int l, int dry) {
  const int tid_ = tidx(), lane = tid_ & 63, wave = tid_ >> 6, l32 = lane & 31;
  const float gq0 = p.g_mla_q[l * 96 + lane], gq1 = p.g_mla_q[l * 96 + 64 + l32], gk0 = p.g_mla_k[l * 96 + lane], gk1 = p.g_mla_k[l * 96 + 64 + l32];
  const float freq = __builtin_amdgcn_exp2f(-(float)(lane & 7) * (13.287712379549449f / 8.f));
  const float sgn = ((lane >> 3) & 1) ? 1.f : -1.f;
  const float qs = 0.10206207261596575f * LOG2E;
  for (int row = blockIdx.x * 8 + wave; row < T; row += gridDim.x * 8) {
    const bool islat = row < TL;
    float cs = 1.f, sn = 0.f;
    if (islat) {
      const int t = row & 8191; const float pos = (float)(((lane >> 4) & 1) ? (t & 63) : (t >> 6));
      const float rev = (pos * freq) * 0.15915494309189535f;
      cs = __builtin_amdgcn_cosf(rev); sn = __builtin_amdgcn_sinf(rev);
    }
    const float kpe = bf2f(p.PROJ[(size_t)row * PN + C_KPE + l32]);
    bf16_t* mq = p.MQ + (size_t)row * 768; const bf16_t* kv = p.KV + (size_t)row * 1024; bf16_t* km = p.KM + (size_t)row * 768;
#pragma unroll 2
    for (int hd = 0; hd < 8; ++hd) {
      {
        const float x0 = bf2f(mq[hd * 96 + lane]), x1 = bf2f(mq[hd * 96 + 64 + l32]);
        const float ss = wave_sum(x0 * x0 + (lane < 32 ? x1 * x1 : 0.f));
        const float rstd = rsqrtf(ss * (1.f / 96.f) + EPS);
        const float y0 = x0 * rstd * gq0; float y1 = x1 * rstd * gq1;
        const float pr = __shfl_xor(y1, 8);
        y1 = y1 * cs + sgn * pr * sn;
        if (!dry) { mq[hd * 96 + lane] = f2bf(y0 * qs); if (lane < 32) mq[hd * 96 + 64 + lane] = f2bf(y1 * qs); }
      }
      {
        const float x0 = bf2f(kv[hd * 128 + lane]), x1 = kpe;
        const float ss = wave_sum(x0 * x0 + (lane < 32 ? x1 * x1 : 0.f));
        const float rstd = rsqrtf(ss * (1.f / 96.f) + EPS);
        const float y0 = x0 * rstd * gk0; float y1 = x1 * rstd * gk1;
        const float pr = __shfl_xor(y1, 8);
        y1 = y1 * cs + sgn * pr * sn;
        if (!dry) { km[hd * 96 + lane] = f2bf(y0); if (lane < 32) km[hd * 96 + 64 + lane] = f2bf(y1); }
      }
    }
  }
}

struct AttnArgs {
  const bf16_t* q; int qpitch;
  const bf16_t* k; int kpitch;
  const bf16_t* v; int vpitch;
  bf16_t* o; int opitch;
  int krow_ctx, krow_lat;
  int nct, lt0, lt1;
  int qrow0, qpos0;
  float mb, sinkterm;
  float lam, osc; const float* gsub;
  int dry;
  bf16_t* o0;
};

template <int QSTEPS> DI void load_q(const AttnArgs& a, int colofs, bf16x8 (&qf)[QSTEPS]) {
  const int tid_ = tidx(), lane = tid_ & 63, wave = tid_ >> 6, h = lane >> 5, l32 = lane & 31;
  const bf16_t* qr = a.q + (size_t)(a.qrow0 + wave * 32 + l32) * a.qpitch + 8 * h + colofs;
#pragma unroll
  for (int s = 0; s < QSTEPS; ++s) qf[s] = *(const bf16x8*)(qr + s * 16);
}
template <int NKA, bool KB, int DV, int EPI, bool WIN>
DI void attn_item(const AttnArgs& a, const bf16x8 (&qfr)[4 + (KB ? 2 : 0)], int kcolofs, LDS_AS unsigned char* smem) {
  const int tid_ = tidx(), lane = tid_ & 63, wave = tid_ >> 6, h = lane >> 5, l32 = lane & 31;
  constexpr int NMAP = 1;
  constexpr int QSTEPS = 4 + (KB ? 2 : 0);
  constexpr int NDB = DV / 32;
  constexpr int VP = DV * 2;
  constexpr int AST = 24576, NST = 4;
  constexpr int NLD = 1 + (KB ? 1 : 0) + (DV == 64 ? 1 : 2);
  const int ntile = a.nct + (a.lt1 - a.lt0);
  unsigned kaoff, kboff = 0, voff[DV == 64 ? 1 : 2];
  { const int r = wave * 8 + (lane >> 3), c = (lane & 7) ^ ((r >> 1) & 7); kaoff = (unsigned)(r * a.kpitch + c * 8) * 2u; }
  if (KB) { const int r = (wave & 3) * 16 + (lane >> 2), c = (lane & 3) ^ ((r >> 2) & 3); kboff = (unsigned)(r * a.kpitch + 64 + c * 8) * 2u; }
  if (DV == 64) {
    const int r = wave * 8 + (lane >> 3), c = (lane & 7) ^ (((r >> 1) & 1) << 2); voff[0] = (unsigned)(r * a.vpitch + c * 8) * 2u;
  } else {
#pragma unroll
    for (int j = 0; j < 2; ++j) { const int r = (j * 8 + wave) * 4 + (lane >> 4), c = (lane & 15) ^ ((r & 3) << 2); voff[j] = (unsigned)(r * a.vpitch + c * 8) * 2u; }
  }
  const unsigned ldst = (unsigned)__builtin_amdgcn_readfirstlane((int)(lds_u32(smem) + wave * 1024));
  const unsigned ldstb = (unsigned)__builtin_amdgcn_readfirstlane((int)(lds_u32(smem) + 16384 + (wave & 3) * 1024));
  auto issue = [&](int ti, int stg) {
    const int trow = (ti < a.nct) ? (a.krow_ctx + ti * 64) : (a.krow_lat + (a.lt0 + ti - a.nct) * 64);
    const char* kb = (const char*)(a.k + (size_t)trow * a.kpitch + kcolofs); const char* vb = (const char*)(a.v + (size_t)trow * a.vpitch);
    const unsigned d = ldst + stg * AST;
    glds16a(kb, kaoff, d);
    if (KB) glds16a(kb, kboff, ldstb + stg * AST);
#pragma unroll
    for (int j = 0; j < (DV == 64 ? 1 : 2); ++j) glds16a(vb, voff[j], d + 8192 + j * 8192);
  };
  const int kswzA = (lane >> 1) & 7, kswzB = (lane >> 2) & 3;
  const int krowA = l32 * 128, krowB = l32 * 64;
  int vbase[NDB];
  {
    const int l16 = lane & 15, qq = l16 >> 2, pp = l16 & 3, g16 = (lane >> 4) & 1;
#pragma unroll
    for (int db = 0; db < NDB; ++db) {
      const int cl = 2 * g16 + (pp >> 1);
      const int c = (DV == 64) ? (4 * (db ^ (qq >> 1)) + cl) : (4 * (db ^ qq) + cl);
      vbase[db] = (4 * h + qq) * VP + c * 16 + (pp & 1) * 8;
    }
  }
  f32x16 O[NMAP][NDB];
#pragma unroll
  for (int m = 0; m < NMAP; ++m)
#pragma unroll
    for (int db = 0; db < NDB; ++db)
#pragma unroll
      for (int i = 0; i < 16; ++i) O[m][db][i] = 0.f;
  float lsum[NMAP];
#pragma unroll
  for (int m = 0; m < NMAP; ++m) lsum[m] = 0.f;
  const float negmb = -a.mb;
  const int qpos = a.qpos0 + wave * 32 + l32;

  asm volatile("s_waitcnt vmcnt(0)" ::: "memory");
  __syncthreads();
  issue(0, 0);
  if (ntile > 1) issue(1, 1);
  if (ntile > 2) issue(2, 2);
#pragma unroll 1
  for (int ti = 0; ti < ntile; ++ti) {
    const int rem = ntile - 1 - ti;
    if (rem >= 2) { if (NLD == 2) asm volatile("s_waitcnt vmcnt(4)" ::: "memory"); else asm volatile("s_waitcnt vmcnt(6)" ::: "memory"); }
    else if (rem == 1) { if (NLD == 2) asm volatile("s_waitcnt vmcnt(2)" ::: "memory"); else asm volatile("s_waitcnt vmcnt(3)" ::: "memory"); }
    else asm volatile("s_waitcnt vmcnt(0)" ::: "memory");
    __builtin_amdgcn_s_barrier();
    asm volatile("" ::: "memory");
    if (ti + 3 < ntile) issue(ti + 3, (ti + 3) & 3);
    __builtin_amdgcn_sched_barrier(0);
    LDS_AS unsigned char* st = smem + (ti & 3) * AST;
    LDS_AS unsigned char* sv = st + 8192;
#pragma unroll
    for (int m = 0; m < NMAP; ++m) {
      float ls = 0.f;
#pragma unroll
      for (int kb = 0; kb < 2; ++kb) {
        f32x16 S;
#pragma unroll
        for (int i = 0; i < 16; ++i) S[i] = (DV == 128) ? 0.f : negmb;
        LDS_AS unsigned char* ka = st + (NKA == 2 ? m * 8192 : 0) + kb * 32 * 128 + krowA;
#pragma unroll
        for (int s = 0; s < 4; ++s) S = MFMA32(lds128(ka + (((2 * s + h) ^ kswzA) << 4)), qfr[s], S);
        if (KB) {
          LDS_AS unsigned char* kbp = st + 16384 + kb * 32 * 64 + krowB;
#pragma unroll
          for (int s = 0; s < 2; ++s) S = MFMA32(lds128(kbp + (((2 * s + h) ^ kswzB) << 4)), qfr[4 + s], S);
        }
        if (WIN) {
          if (ti >= a.nct) {
            const int kp0 = (a.lt0 + ti - a.nct) * 64 + 4 * h - qpos + kb * 32;
#pragma unroll
            for (int i = 0; i < 16; ++i) {
              const int dlt = kp0 + (i & 3) + 8 * (i >> 2);
              if (dlt > 128 || dlt < -128) S[i] = -INFINITY;
            }
          }
        }
#pragma unroll
        for (int i = 0; i < 16; ++i) { S[i] = __builtin_amdgcn_exp2f((DV == 128) ? S[i] + negmb : S[i]); ls += S[i]; }
#pragma unroll
        for (int s = 0; s < 2; ++s) {
          u32x4 pw;
#pragma unroll
          for (int j = 0; j < 4; ++j) pw[j] = pk2(S[8 * s + 2 * j], S[8 * s + 2 * j + 1]);
          const bf16x8 pb = __builtin_bit_cast(bf16x8, pw);
          const int rc = (kb * 32 + 16 * s) * VP;
#pragma unroll
          for (int db = 0; db < NDB; ++db) {
            const s16x4 lo = __builtin_amdgcn_ds_read_tr16_b64_v4i16((LDS_AS s16x4*)(sv + vbase[db] + rc));
            const s16x4 hi = __builtin_amdgcn_ds_read_tr16_b64_v4i16((LDS_AS s16x4*)(sv + vbase[db] + rc + 8 * VP));
            const bf16x8 vf = __builtin_shufflevector(lo, hi, 0, 1, 2, 3, 4, 5, 6, 7);
            O[m][db] = MFMA32(vf, pb, O[m][db]);
          }
        }
        __builtin_amdgcn_sched_barrier(0);
      }
      lsum[m] += ls;
    }
  }
  const float lt = lsum[0] + __shfl_xor(lsum[0], 32) + a.sinkterm;
  const float inv = 1.f / lt;
  bf16_t* orow = a.o + (size_t)(a.qrow0 + wave * 32 + l32) * a.opitch + 4 * h;
  if (a.dry) return;
  if (EPI == 0) {
#pragma unroll
    for (int db = 0; db < NDB; ++db)
#pragma unroll
      for (int g = 0; g < 4; ++g) {
        u32x2 w = {pk2(O[0][db][4 * g] * inv, O[0][db][4 * g + 1] * inv), pk2(O[0][db][4 * g + 2] * inv, O[0][db][4 * g + 3] * inv)};
        *(u32x2*)(orow + db * 32 + 8 * g) = w;
      }
  } else {
    const float c1 = inv * a.lam;
    float ss = 0.f;
#pragma unroll
    for (int db = 0; db < NDB; ++db)
#pragma unroll
      for (int g = 0; g < 4; ++g) {
        const u32x2 raw = *(const u32x2*)(a.o0 + (size_t)(a.qrow0 + wave * 32 + l32) * 512 + 4 * h + db * 32 + 8 * g);
        const float o0[4] = {__uint_as_float(raw[0] << 16), __uint_as_float(raw[0] & 0xffff0000u), __uint_as_float(raw[1] << 16), __uint_as_float(raw[1] & 0xffff0000u)};
#pragma unroll
        for (int j = 0; j < 4; ++j) { const float v = o0[j] - O[0][db][4 * g + j] * c1; O[0][db][4 * g + j] = v; ss += v * v; }
      }
    ss += __shfl_xor(ss, 32);
    const float rstd = rsqrtf(ss * (1.f / (float)DV) + EPS) * a.osc;
#pragma unroll
    for (int db = 0; db < NDB; ++db)
#pragma unroll
      for (int g = 0; g < 4; ++g) {
        const f32x4 gs = *(const f32x4*)(a.gsub + db * 32 + 8 * g + 4 * h);
        u32x2 w = {pk2(O[0][db][4 * g] * rstd * gs[0], O[0][db][4 * g + 1] * rstd * gs[1]), pk2(O[0][db][4 * g + 2] * rstd * gs[2], O[0][db][4 * g + 3] * rstd * gs[3])};
        *(u32x2*)(orow + db * 32 + 8 * g) = w;
      }
  }
}

DI void attn_diff_item(const AttnArgs& a, LDS_AS unsigned char* smem) {
  AttnArgs a0 = a; a0.o = a.o0; a0.opitch = 512; a0.dry = 0;
  { bf16x8 q0[4]; load_q<4>(a, 0, q0); attn_item<1, false, 128, 0, false>(a0, q0, 0, smem); }
  { bf16x8 q1[4]; load_q<4>(a, 64, q1); attn_item<1, false, 128, 1, false>(a, q1, 64, smem); }
}

DI void phase_attention(const Params& p, int l, LDS_AS unsigned char* smem, int dry) {
  const float* cs = p.consts + l * 16;
  const float lam = cs[0], lam_init = cs[1], mb_mla = cs[2], mb_swa = cs[3], mb_diff = cs[4];
  const int nc_d = (l == 0) ? 16 : 0, nc_m = (l == 0) ? 32 : 0;
#pragma unroll 1
  for (int i = blockIdx.x; i < 512 + nc_d; i += gridDim.x) {
    AttnArgs a; a.dry = dry;
    int b, hd;
    if (i < 512) {
      const int id = xcd_remap(i, 512), pair = id >> 5, qb = id & 31; b = pair >> 2; hd = pair & 3;
      a.lt0 = 0; a.lt1 = 128; a.qrow0 = b * 8192 + qb * 256;
    } else {
      const int j = i - 512; b = j >> 2; hd = j & 3;
      a.lt0 = 0; a.lt1 = 0; a.qrow0 = TL + b * 256;
    }
    a.q = p.PROJ + C_DQ + hd * 128; a.qpitch = PN; a.k = p.PROJ + C_DK + hd * 128; a.kpitch = PN; a.v = p.PROJ + C_DV + hd * 128; a.vpitch = PN;
    a.o = p.PROJ + C_DQ + hd * 128; a.opitch = PN; a.o0 = p.YD0 + hd * 128;
    a.krow_ctx = TL + b * 256; a.krow_lat = b * 8192; a.nct = 4; a.qpos0 = 0;
    a.mb = mb_diff; a.sinkterm = 0.f; a.lam = lam; a.osc = 1.f - lam_init; a.gsub = p.g_diff_sub + l * 128;
    attn_diff_item(a, smem);
  }
#pragma unroll 1
  for (int i = blockIdx.x; i < 1024 + nc_m; i += gridDim.x) {
    AttnArgs a; a.dry = dry;
    int b, hd;
    if (i < 1024) {
      const int id = xcd_remap(i, 1024), pair = id >> 5, qb = id & 31; b = pair >> 3; hd = pair & 7;
      a.lt0 = 0; a.lt1 = 128; a.qrow0 = b * 8192 + qb * 256;
    } else {
      const int j = i - 1024; b = j >> 3; hd = j & 7;
      a.lt0 = 0; a.lt1 = 0; a.qrow0 = TL + b * 256;
    }
    a.q = p.MQ + hd * 96; a.qpitch = 768; a.k = p.KM + hd * 96; a.kpitch = 768; a.v = p.KV + hd * 128 + 64; a.vpitch = 1024;
    a.o = p.MQ + hd * 96; a.opitch = 768; a.o0 = nullptr;
    a.krow_ctx = TL + b * 256; a.krow_lat = b * 8192; a.nct = 4; a.qpos0 = 0;
    a.mb = mb_mla; a.sinkterm = 0.f; a.lam = 0.f; a.osc = 0.f; a.gsub = nullptr;
    bf16x8 qf[6]; load_q<6>(a, 0, qf);
    attn_item<1, true, 64, 0, false>(a, qf, 0, smem);
  }
#pragma unroll 1
  for (int i = blockIdx.x; i < 1024 + nc_m; i += gridDim.x) {
    AttnArgs a; a.dry = dry;
    int b, hq;
    if (i < 1024) {
      const int id = xcd_remap(i, 1024), pair = id >> 5, qb = id & 31; b = pair >> 3; hq = pair & 7;
      a.lt0 = (4 * qb - 2 < 0) ? 0 : 4 * qb - 2; a.lt1 = (4 * qb + 6 > 128) ? 128 : 4 * qb + 6;
      a.qrow0 = b * 8192 + qb * 256; a.qpos0 = qb * 256;
    } else {
      const int j = i - 1024; b = j >> 3; hq = j & 7;
      a.lt0 = 0; a.lt1 = 0; a.qrow0 = TL + b * 256; a.qpos0 = 0;
    }
    const int kvh = hq >> 2;
    a.q = p.PROJ + C_SQ + hq * 64; a.qpitch = PN; a.k = p.PROJ + C_SK + kvh * 64; a.kpitch = PN; a.v = p.PROJ + C_SV + kvh * 64; a.vpitch = PN;
    a.o = p.PROJ + C_SQ + hq * 64; a.opitch = PN; a.o0 = nullptr;
    a.krow_ctx = TL + b * 256; a.krow_lat = b * 8192; a.nct = 4;
    a.mb = mb_swa; a.sinkterm = __builtin_amdgcn_exp2f(p.swa_sink[l * 8 + hq] * LOG2E - mb_swa); a.lam = 0.f; a.osc = 0.f; a.gsub = nullptr;
    bf16x8 qf[4]; load_q<4>(a, 0, qf);
    attn_item<1, false, 64, 0, true>(a, qf, 0, smem);
  }
}

constexpr int NPH = 1 + 2 * 11;
DI void run_phase(const Params& p, int ph, LDS_AS unsigned char* smem, int dry) {
#ifdef ONLY_S
  if (ONLY_S == 99) { if (ph == 0) phase0(p, smem, dry); return; }
  if (ph == 0) return;
  const int l = (ph - 1) / 11, s = ONLY_S;
#else
  if (ph == 0) { phase0(p, smem, dry); return; }
  const int l = (ph - 1) / 11, s = (ph - 1) % 11;
#endif
  switch (s) {
    case 0: norm_phase(p, l, 0, dry); break;
    case 1: phase_gemm_in(p, l, smem, dry); break;
    case 2: phase_prep_a(p, l, dry); break;
    case 3: phase_gemm_mla(p, l, smem, dry); break;
    case 4: phase_prep_c(p, l, dry); break;
    case 5: phase_attention(p, l, smem, dry); break;
    case 6: phase_merge(p, l, smem, dry); break;
    case 7: phase_residual_gemm(p, l, 0, smem, dry); break;
    case 8: norm_phase(p, l, 1, dry); break;
    case 9: phase_mlp_in(p, l, smem, dry); break;
    default: phase_residual_gemm(p, l, 1, smem, dry); break;
  }
}

__global__ void __launch_bounds__(512, 2) mega_kernel(Params p) {
  __shared__ __attribute__((aligned(16))) unsigned char smem_raw[3 * GST];
  LDS_AS unsigned char* smem = (LDS_AS unsigned char*)smem_raw;
  __shared__ uint4 xb_words;
  cg::grid_group grid = cg::this_grid();
  if (threadIdx.x == 0) xb_words = make_uint4(0u, 0u, 0u, 0u);
  __syncthreads();
  const XcdBarrier xb = xcd_barrier_post(p.bar, (volatile LDS_AS unsigned*)&xb_words);
#pragma unroll 1
  for (int ph = 0; ph < NPH; ++ph) {
    const int st = (ph == 0) ? 31 : (ph - 1) % 11;
    const int nrep = (((unsigned)p.probe >> st) & 1u) ? 2 : 1;
    for (int rep = 0; rep < nrep; ++rep) run_phase(p, ph, smem, rep + 1 < nrep);
    if (ph + 1 < NPH) { if (ph == 0) grid.sync(); else xcd_barrier(xb); }
  }
}
#ifdef MK_MULTI
__global__ void __launch_bounds__(512, 2) phase_kernel(Params p, int ph) {
  __shared__ __attribute__((aligned(16))) unsigned char smem_raw[3 * GST];
  run_phase(p, ph, (LDS_AS unsigned char*)smem_raw, 0);
}
#endif

extern "C" void kernel_launch(void* const* d_in, const int* in_sizes, int n_in, void* d_out, int out_size, void* d_ws, size_t ws_size,
                              hipStream_t stream) {
  Params p{};
  const float* const* in = (const float* const*)d_in;
  p.x = in[0]; p.c = in[1]; p.ctx = in[2]; p.c_ctx = in[3]; p.w_mod = in[4]; p.b_mod = in[5]; p.g_norm_attn = in[6]; p.g_norm_mlp = in[7];
  p.w_in = in[8]; p.g_q_lora = in[9]; p.w_uq = in[10]; p.g_kv_lora = in[11]; p.w_ukv = in[12]; p.g_mla_q = in[13]; p.g_mla_k = in[14];
  p.w_up_mla = in[15]; p.g_swa_q = in[16]; p.g_swa_k = in[17]; p.swa_sink = in[18]; p.w_up_swa = in[19]; p.g_diff_q = in[20]; p.g_diff_k = in[21];
  p.lambda_q1 = in[22]; p.lambda_k1 = in[23]; p.lambda_q2 = in[24]; p.lambda_k2 = in[25]; p.g_diff_sub = in[26]; p.w_up_diff = in[27];
  p.w_o = in[28]; p.w_mlp_in = in[29]; p.w_mlp_out = in[30];
#ifndef PROBE_MASK
#define PROBE_MASK 0
#endif
  p.probe = PROBE_MASK; p.pad_ = 0;
  p.out = (float*)d_out;
  unsigned char* ws = (unsigned char*)d_ws;
  size_t off = 0;
  auto take = [&](size_t bytes) { unsigned char* r = ws + off; off += (bytes + 255) & ~(size_t)255; return r; };
  p.modtab = (float*)take(2 * 5 * 6144 * 4);
  p.consts = (float*)take(256);
  p.bar = (unsigned*)take(XCD_BAR_WORDS * 4);
  p.WB = (bf16_t*)take(2 * W_LAYER * 2);
  p.H = (bf16_t*)take((size_t)T * 1024 * 2);
  p.PROJ = (bf16_t*)take((size_t)T * PN * 2);
  p.MQ = (bf16_t*)take((size_t)T * 768 * 2);
  p.KV = (bf16_t*)take((size_t)T * 1024 * 2);
  p.KM = (bf16_t*)take((size_t)T * 768 * 2);
  p.CX = (float*)take((size_t)TC * 1024 * 4);
  p.YD0 = (bf16_t*)take((size_t)T * 512 * 2);
  if (off > ws_size) { fprintf(stderr, "workspace too small: need %zu have %zu\n", off, ws_size); return; }
  (void)hipMemsetAsync(p.modtab, 0, (size_t)((unsigned char*)p.bar - (unsigned char*)p.modtab) + XCD_BAR_WORDS * 4, stream);
#ifdef MK_MULTI
  for (int ph = 0; ph < NPH; ++ph) phase_kernel<<<256, 512, 0, stream>>>(p, ph);
#else
  static int grid_blocks = 0;
  if (!grid_blocks) {
    int dev = 0, cus = 0, per_cu = 0;
    hipGetDevice(&dev);
    hipDeviceGetAttribute(&cus, hipDeviceAttributeMultiprocessorCount, dev);
    hipOccupancyMaxActiveBlocksPerMultiprocessor(&per_cu, mega_kernel, 512, 0);
    if (per_cu > 1) per_cu = 1;
    grid_blocks = cus * per_cu;
    if (grid_blocks <= 0) grid_blocks = 256;
  }
  void* args[] = {&p};
  hipError_t e = hipLaunchCooperativeKernel((void*)mega_kernel, dim3(grid_blocks), dim3(512), args, 0, stream);
  if (e != hipSuccess) fprintf(stderr, "cooperative launch failed: %s (grid %d)\n", hipGetErrorString(e), grid_blocks);
#endif
}
```

```cpp
#include <hip/hip_runtime.h>
#include <hip/hip_cooperative_groups.h>
#include <cstdio>
#include <cstdint>
namespace cg = cooperative_groups;

typedef unsigned short bf16_t;
typedef short bf16x8 __attribute__((ext_vector_type(8)));
typedef short s16x4 __attribute__((ext_vector_type(4)));
typedef float f32x16 __attribute__((ext_vector_type(16)));
typedef float f32x4 __attribute__((ext_vector_type(4)));
typedef float f32x2 __attribute__((ext_vector_type(2)));
typedef __bf16 bf16x2_t __attribute__((ext_vector_type(2)));
typedef unsigned u32x2 __attribute__((ext_vector_type(2)));
typedef unsigned u32x4 __attribute__((ext_vector_type(4)));
#define LDS_AS __attribute__((address_space(3)))
#define DI __device__ __forceinline__

constexpr int D = 1024, NB = 4, SEQ = 8192, NCTX = 256;
constexpr int TL = NB * SEQ;
constexpr int TC = NB * NCTX;
constexpr int T = TL + TC;
constexpr int PN = 2720;
constexpr int C_QLAT = 0, C_KVLAT = 256, C_KPE = 384, C_SQ = 416, C_SK = 928, C_SV = 1056, C_DQ = 1184, C_DK = 1696, C_DV = 2208;
constexpr float EPS = 1e-6f;
constexpr float LOG2E = 1.4426950408889634f;
constexpr size_t W_IN = 0;
constexpr size_t W_UQ = W_IN + (size_t)5888 * 1024;
constexpr size_t W_UKV = W_UQ + 768 * 256;
constexpr size_t W_UPM = W_UKV + 1024 * 128;
constexpr size_t W_UPS = W_UPM + 1024 * 512;
constexpr size_t W_UPD = W_UPS + 1024 * 512;
constexpr size_t W_O = W_UPD + 1024 * 512;
constexpr size_t W_M1 = W_O + 1024 * 1024;
constexpr size_t W_M2 = W_M1 + (size_t)4096 * 1024;
constexpr size_t W_LAYER = W_M2 + (size_t)4096 * 1024;

struct Params {
  const float *x, *c, *ctx, *c_ctx, *w_mod, *b_mod, *g_norm_attn, *g_norm_mlp, *w_in, *g_q_lora, *w_uq, *g_kv_lora, *w_ukv,
      *g_mla_q, *g_mla_k, *w_up_mla, *g_swa_q, *g_swa_k, *swa_sink, *w_up_swa, *g_diff_q, *g_diff_k, *lambda_q1, *lambda_k1,
      *lambda_q2, *lambda_k2, *g_diff_sub, *w_up_diff, *w_o, *w_mlp_in, *w_mlp_out;
  float* out;
  float* modtab;
  float* consts;
  unsigned* bar;
  bf16_t* WB;
  bf16_t* H;
  bf16_t* PROJ;
  bf16_t* MQ;
  bf16_t* KV;
  bf16_t* KM;
  float* CX;
  bf16_t* YD0;
  int probe, pad_;
};

template <class Tp> DI Tp* opq(Tp* ptr) { asm volatile("" : "+s"(ptr)); return ptr; }
DI int tidx() { int t = threadIdx.x; asm volatile("" : "+v"(t)); return t; }
DI float bf2f(bf16_t v) { return __uint_as_float((unsigned)v << 16); }
DI unsigned pk2(float a, float b) { f32x2 v = {a, b}; bf16x2_t r = __builtin_convertvector(v, bf16x2_t); return __builtin_bit_cast(unsigned, r); }
DI bf16_t f2bf(float a) { return (bf16_t)(pk2(a, 0.f) & 0xffffu); }
DI float wave_sum(float v) {
#pragma unroll
  for (int o = 32; o; o >>= 1) v += __shfl_xor(v, o);
  return v;
}
DI float wave_max(float v) {
#pragma unroll
  for (int o = 32; o; o >>= 1) v = fmaxf(v, __shfl_xor(v, o));
  return v;
}
DI float silu(float x) { return x / (1.f + __expf(-x)); }
DI int xcd_remap(int L, int n) {
  const int q = n >> 3, r = n & 7, xcd = L & 7, off = L >> 3;
  return (xcd < r ? xcd * (q + 1) : r * (q + 1) + (xcd - r) * q) + off;
}
DI void glds16(const void* g, LDS_AS unsigned char* l) {
  __builtin_amdgcn_global_load_lds((const unsigned*)g, (LDS_AS unsigned*)l, 16, 0, 0);
}
DI void glds16a(const void* base, unsigned voff, unsigned ldsaddr) {
  unsigned keep;
  asm volatile("s_mov_b32 %0, m0\n\ts_mov_b32 m0, %3\n\ts_nop 0\n\tglobal_load_lds_dwordx4 %1, %2\n\ts_mov_b32 m0, %0"
               : "=&s"(keep) : "v"(voff), "s"(base), "s"(ldsaddr) : "memory");
}
DI unsigned lds_u32(LDS_AS unsigned char* p) { return (unsigned)(uintptr_t)p; }
DI bf16x8 lds128(LDS_AS unsigned char* p) { return *(LDS_AS bf16x8*)p; }
#define MFMA32(a, b, c) __builtin_amdgcn_mfma_f32_32x32x16_bf16((a), (b), (c), 0, 0, 0)

#define XB_TMO      128
#define XB_XCNT(j)  (256  + 64 * (j))
#define XB_XSUB(j)  (1280 + 64 * (j))
#define XB_XGEN(j)  (2304 + 64 * (j))
#define XB_TOP      3328
#define XB_TOPGEN   3392
#define XCD_BAR_WORDS 3456
#define XB_SPIN_CAP (1u << 22)
DI unsigned xb_ld(unsigned* p) { return __hip_atomic_load(p, __ATOMIC_RELAXED, __HIP_MEMORY_SCOPE_AGENT); }
DI unsigned xb_add(unsigned* p, unsigned v) { return __hip_atomic_fetch_add(p, v, __ATOMIC_RELAXED, __HIP_MEMORY_SCOPE_AGENT); }
DI unsigned xb_xcc_id() { return (unsigned)__builtin_amdgcn_s_getreg((3 << 11) | 20) & 0xFu; }
#define XB_SPIN(cond, bar) do { unsigned _sp = 0; while (cond) { __builtin_amdgcn_s_sleep(1); \
    if ((++_sp & 255u) == 0u) { if (xb_ld(&(bar)[XB_TMO])) break; if (_sp > XB_SPIN_CAP) { atomicAdd(&(bar)[XB_TMO], 1u); break; } } } } while (0)
struct XcdBarrier { unsigned* bar; unsigned x; volatile LDS_AS unsigned* st; };
DI XcdBarrier xcd_barrier_post(unsigned* bar, volatile LDS_AS unsigned* st) {
  XcdBarrier b; b.bar = bar; b.x = xb_xcc_id(); b.st = st;
  if (threadIdx.x == 0) (void)xb_add(&bar[XB_XCNT(b.x)], 1u);
  return b;
}
DI void xcd_barrier_complete(unsigned* bar, unsigned x, unsigned& nloc, unsigned& nx) {
  const unsigned G = gridDim.x * gridDim.y * gridDim.z;
  unsigned sum, cnt, mine, sp = 0u;
  for (;;) {
    sum = 0u; cnt = 0u; mine = 0u;
#pragma unroll
    for (unsigned j = 0; j < 16; ++j) { const unsigned c = xb_ld(&bar[XB_XCNT(j)]); sum += c; cnt += (c > 0u) ? 1u : 0u; mine = (j == x) ? c : mine; }
    if (sum == G) break;
    __builtin_amdgcn_s_sleep(1);
    if ((++sp & 255u) == 0u) { if (xb_ld(&bar[XB_TMO])) break; if (sp > XB_SPIN_CAP) { atomicAdd(&bar[XB_TMO], 1u); break; } }
  }
  nloc = mine > 0u ? mine : 1u; nx = cnt > 0u ? cnt : 1u;
}
DI void xcd_barrier(const XcdBarrier& b) {
  asm volatile("s_waitcnt vmcnt(0)" ::: "memory");
  __syncthreads();
  if (threadIdx.x == 0) {
    unsigned* bar = b.bar;
    __builtin_amdgcn_s_waitcnt(0);
    unsigned nloc = b.st[0], nx = b.st[1];
    if (nloc == 0u) { xcd_barrier_complete(bar, b.x, nloc, nx); b.st[0] = nloc; b.st[1] = nx; }
    const unsigned old = xb_add(&bar[XB_XSUB(b.x)], 1u);
    const unsigned gen = old / nloc;
    if (old + 1u == (gen + 1u) * nloc) {
      __builtin_amdgcn_fence(__ATOMIC_RELEASE, "agent");
      asm volatile("s_waitcnt vmcnt(0)" ::: "memory");
      const unsigned og = xb_add(&bar[XB_TOP], 1u);
      const unsigned tg = og / nx;
      if (og + 1u == (tg + 1u) * nx) xb_add(&bar[XB_TOPGEN], 1u);
      else XB_SPIN(xb_ld(&bar[XB_TOPGEN]) == tg, bar);
      __builtin_amdgcn_fence(__ATOMIC_ACQUIRE, "agent");
      xb_add(&bar[XB_XGEN(b.x)], 1u);
      asm volatile("s_waitcnt vmcnt(0)" ::: "memory");
    } else {
      XB_SPIN(xb_ld(&bar[XB_XGEN(b.x)]) == gen, bar);
      __builtin_amdgcn_fence(__ATOMIC_ACQUIRE, "agent");
      asm volatile("s_waitcnt vmcnt(0)" ::: "memory");
    }
  }
  __syncthreads();
}

DI void conv_tile(const float* src, int ld, int K, int k0, int n0, bool is_win, bf16_t* dst, LDS_AS float* tile, int dry) {
  const int tid = tidx(), ty = tid >> 4, tx = tid & 15;
  const int n = n0 + 4 * tx;
  int sc = n;
  if (is_win) sc = (n < 2720) ? n : (n < 2816 ? -1 : n - 96);
#pragma unroll
  for (int i = 0; i < 2; ++i) {
    const int k = ty + 32 * i;
    f32x4 v = {0.f, 0.f, 0.f, 0.f};
    if (sc >= 0) v = *(const f32x4*)(src + (size_t)(k0 + k) * ld + sc);
    tile[k * 65 + 4 * tx + 0] = v[0]; tile[k * 65 + 4 * tx + 1] = v[1]; tile[k * 65 + 4 * tx + 2] = v[2]; tile[k * 65 + 4 * tx + 3] = v[3];
  }
  __syncthreads();
  {
    const int r = tid >> 3, c = tid & 7;
    u32x4 w;
    w[0] = pk2(tile[(8 * c + 0) * 65 + r], tile[(8 * c + 1) * 65 + r]);
    w[1] = pk2(tile[(8 * c + 2) * 65 + r], tile[(8 * c + 3) * 65 + r]);
    w[2] = pk2(tile[(8 * c + 4) * 65 + r], tile[(8 * c + 5) * 65 + r]);
    w[3] = pk2(tile[(8 * c + 6) * 65 + r], tile[(8 * c + 7) * 65 + r]);
    if (!dry) *(u32x4*)(dst + (size_t)(n0 + r) * K + k0 + 8 * c) = w;
  }
  __syncthreads();
}

DI void phase0(const Params& p, LDS_AS unsigned char* smem, int dry) {
  const int tid_ = tidx(), lane = tid_ & 63, wave = tid_ >> 6;
  if (blockIdx.x == 0 && wave == 0) {
    for (int l = 0; l < 2; ++l) {
      const float s1 = wave_sum(p.lambda_q1[l * 64 + lane] * p.lambda_k1[l * 64 + lane]);
      const float s2 = wave_sum(p.lambda_q2[l * 64 + lane] * p.lambda_k2[l * 64 + lane]);
      const float lam_init = 0.8f - 0.6f * expf(-0.3f * (float)l);
      const float lam = expf(s1) - expf(s2) + lam_init;
      float a = fabsf(p.g_mla_q[l * 96 + lane]); if (lane < 32) a = fmaxf(a, fabsf(p.g_mla_q[l * 96 + 64 + lane]));
      float b = fabsf(p.g_mla_k[l * 96 + lane]); if (lane < 32) b = fmaxf(b, fabsf(p.g_mla_k[l * 96 + 64 + lane]));
      const float mq = wave_max(a), mk = wave_max(b);
      const float sq = wave_max(fabsf(p.g_swa_q[l * 64 + lane])), sk = wave_max(fabsf(p.g_swa_k[l * 64 + lane]));
      const float dq = wave_max(fabsf(p.g_diff_q[l * 64 + lane])), dk = wave_max(fabsf(p.g_diff_k[l * 64 + lane]));
      if (lane == 0) {
        float* cs = p.consts + l * 16;
        cs[0] = lam; cs[1] = lam_init;
        cs[2] = LOG2E * sqrtf(96.f) * mq * mk;
        cs[3] = LOG2E * 8.f * sq * sk;
        cs[4] = LOG2E * 8.f * dq * dk;
      }
    }
  }
  for (int task = blockIdx.x * 8 + wave; task < 3072; task += gridDim.x * 8) {
    const int l = task / 1536, rem = task % 1536, chunk = rem >> 4, ks = rem & 15;
    const int n = chunk * 64 + lane;
    float acc[5] = {0.f, 0.f, 0.f, 0.f, 0.f};
    const float* w = p.w_mod + ((size_t)l * 1024 + ks * 64) * 6144 + n;
#pragma unroll 8
    for (int k = 0; k < 64; ++k) {
      const float wv = w[(size_t)k * 6144];
      const int kk = ks * 64 + k;
#pragma unroll
      for (int r = 0; r < 4; ++r) acc[r] += silu(p.c[r * 1024 + kk]) * wv;
      acc[4] += silu(p.c_ctx[kk]) * wv;
    }
    const float bias = (ks == 0) ? p.b_mod[l * 6144 + n] : 0.f;
    if (!dry)
#pragma unroll
      for (int r = 0; r < 5; ++r) atomicAdd(p.modtab + (size_t)(l * 5 + r) * 6144 + n, acc[r] + bias);
  }
  LDS_AS float* tile = (LDS_AS float*)smem;
  for (int t = blockIdx.x; t < 2 * 4240; t += gridDim.x) {
    const int l = t / 4240; int u = t % 4240;
    const float* src; int ld, K; bool is_win = false; size_t doff;
    if (u < 1472) { src = p.w_in + (size_t)l * 1024 * 5792; ld = 5792; K = 1024; is_win = true; doff = W_IN; }
    else if (u < 1520) { u -= 1472; src = p.w_uq + (size_t)l * 256 * 768; ld = 768; K = 256; doff = W_UQ; }
    else if (u < 1552) { u -= 1520; src = p.w_ukv + (size_t)l * 128 * 1024; ld = 1024; K = 128; doff = W_UKV; }
    else if (u < 1680) { u -= 1552; src = p.w_up_mla + (size_t)l * 512 * 1024; ld = 1024; K = 512; doff = W_UPM; }
    else if (u < 1808) { u -= 1680; src = p.w_up_swa + (size_t)l * 512 * 1024; ld = 1024; K = 512; doff = W_UPS; }
    else if (u < 1936) { u -= 1808; src = p.w_up_diff + (size_t)l * 512 * 1024; ld = 1024; K = 512; doff = W_UPD; }
    else if (u < 2192) { u -= 1936; src = p.w_o + (size_t)l * 1024 * 1024; ld = 1024; K = 1024; doff = W_O; }
    else if (u < 3216) { u -= 2192; src = p.w_mlp_in + (size_t)l * 1024 * 4096; ld = 4096; K = 1024; doff = W_M1; }
    else { u -= 3216; src = p.w_mlp_out + (size_t)l * 4096 * 1024; ld = 1024; K = 4096; doff = W_M2; }
    const int nkt = K >> 6, kt = u % nkt, nt = u / nkt;
    conv_tile(src, ld, K, kt * 64, nt * 64, is_win, p.WB + (size_t)l * W_LAYER + doff, tile, dry);
  }
}

DI void norm_phase(const Params& p, int l, int which, int dry) {
  const int tid_ = tidx(), lane = tid_ & 63, wave = tid_ >> 6;
  const float* g = (which == 0 ? p.g_norm_attn : p.g_norm_mlp) + l * 1024;
  const int shoff = which == 0 ? 0 : 3072, scoff = shoff + 1024;
  const int nrows = (which == 1 && l == 1) ? TL : T;
  const bool first = (which == 0 && l == 0);
  const float* px = opq(p.x); const float* pctx = opq(p.ctx); const float* pout = opq((const float*)p.out); const float* pcx = opq((const float*)p.CX);
  const float* slat = first ? px : pout; const float* sctx = first ? pctx : pcx;
  for (int row = blockIdx.x * 8 + wave; row < nrows; row += gridDim.x * 8) {
    const float* xr; int bidx;
    if (row < TL) { xr = slat + (size_t)row * 1024; bidx = row >> 13; }
    else { xr = sctx + (size_t)(row - TL) * 1024; bidx = 4; }
    const float* mod = p.modtab + (size_t)(l * 5 + bidx) * 6144;
    f32x4 v[4]; float ss = 0.f;
#pragma unroll
    for (int i = 0; i < 4; ++i) { v[i] = *(const f32x4*)(xr + i * 256 + lane * 4); ss += v[i][0] * v[i][0] + v[i][1] * v[i][1] + v[i][2] * v[i][2] + v[i][3] * v[i][3]; }
    ss = wave_sum(ss);
    const float rstd = rsqrtf(ss * (1.f / 1024.f) + EPS);
#pragma unroll
    for (int i = 0; i < 4; ++i) {
      const int col = i * 256 + lane * 4;
      const f32x4 gv = *(const f32x4*)(g + col), sh = *(const f32x4*)(mod + shoff + col), sc = *(const f32x4*)(mod + scoff + col);
      float o[4];
#pragma unroll
      for (int j = 0; j < 4; ++j) o[j] = (v[i][j] * rstd * gv[j]) * (1.f + sc[j]) + sh[j];
      u32x2 w = {pk2(o[0], o[1]), pk2(o[2], o[3])};
      if (!dry) *(u32x2*)(p.H + (size_t)row * 1024 + col) = w;
    }
  }
}

constexpr int GST = 49152;
DI void gemm_kloop(const bf16_t* Ag, int lda, int a_kstep, const bf16_t* Bg, int ldb, int nkt, f32x16 (&acc)[2][2], LDS_AS unsigned char* smem) {
  const int tid_ = tidx(), lane = tid_ & 63, wave = tid_ >> 6, h = lane >> 5, wm = wave >> 1, wn = wave & 1;
  unsigned aoff[4], boff[2];
#pragma unroll
  for (int i = 0; i < 4; ++i) {
    const int r = wave * 32 + i * 8 + (lane >> 3), c = (lane & 7) ^ ((r >> 1) & 7);
    aoff[i] = (unsigned)(r * lda + c * 8) * 2u;
  }
#pragma unroll
  for (int i = 0; i < 2; ++i) {
    const int r = wave * 16 + i * 8 + (lane >> 3), c = (lane & 7) ^ ((r >> 1) & 7);
    boff[i] = (unsigned)(r * ldb + c * 8) * 2u;
  }
  const unsigned dstA = (unsigned)__builtin_amdgcn_readfirstlane((int)(lds_u32(smem) + wave * 4096));
  const unsigned dstB = (unsigned)__builtin_amdgcn_readfirstlane((int)(lds_u32(smem) + 32768 + wave * 2048));
  const int swz = (lane >> 1) & 7;
  const int arow = (wm * 64 + (lane & 31)) * 128, brow = 32768 + (wn * 64 + (lane & 31)) * 128;
  asm volatile("s_waitcnt vmcnt(0)" ::: "memory");
  __syncthreads();
  auto issue = [&](int kt, int stg) {
    const char* An = (const char*)(Ag + (size_t)kt * a_kstep); const char* Bn = (const char*)(Bg + (size_t)kt * 64);
#pragma unroll
    for (int i = 0; i < 4; ++i) glds16a(An, aoff[i], dstA + stg * GST + i * 1024);
#pragma unroll
    for (int i = 0; i < 2; ++i) glds16a(Bn, boff[i], dstB + stg * GST + i * 1024);
  };
  issue(0, 0);
  if (nkt > 1) issue(1, 1);
  int st = 0;
#pragma unroll 1
  for (int kt = 0; kt < nkt; ++kt) {
    if (kt + 1 < nkt) asm volatile("s_waitcnt vmcnt(6)" ::: "memory"); else asm volatile("s_waitcnt vmcnt(0)" ::: "memory");
    __builtin_amdgcn_s_barrier();
    asm volatile("" ::: "memory");
    if (kt + 2 < nkt) issue(kt + 2, st >= 1 ? st - 1 : 2);
    LDS_AS unsigned char* sa = smem + st * GST;
#pragma unroll
    for (int s = 0; s < 4; ++s) {
      const int co = ((2 * s + h) ^ swz) << 4;
      const bf16x8 a0 = lds128(sa + arow + co), a1 = lds128(sa + arow + 32 * 128 + co);
      const bf16x8 b0 = lds128(sa + brow + co), b1 = lds128(sa + brow + 32 * 128 + co);
      acc[0][0] = MFMA32(b0, a0, acc[0][0]); acc[0][1] = MFMA32(b1, a0, acc[0][1]);
      acc[1][0] = MFMA32(b0, a1, acc[1][0]); acc[1][1] = MFMA32(b1, a1, acc[1][1]);
    }
    st = (st == 2) ? 0 : st + 1;
  }
}
DI void zero_acc(f32x16 (&acc)[2][2]) {
#pragma unroll
  for (int a = 0; a < 2; ++a)
#pragma unroll
    for (int b = 0; b < 2; ++b)
#pragma unroll
      for (int i = 0; i < 16; ++i) acc[a][b][i] = 0.f;
}
DI void tile_decode(int id, int NT, int& mt, int& nt) { const int per = 4 * NT, g = id / per, w = id % per; mt = g * 4 + (w & 3); nt = w >> 2; }

constexpr int EPW = 17408;
template <int ACT> DI LDS_AS unsigned char* stage_tile(const f32x16 (&acc)[2][2], LDS_AS unsigned char* smem) {
  const int tid_ = tidx(), lane = tid_ & 63, wave = tid_ >> 6, h = lane >> 5;
  __syncthreads();
  LDS_AS unsigned char* reg = smem + wave * EPW;
#pragma unroll
  for (int bi = 0; bi < 2; ++bi)
#pragma unroll
    for (int bj = 0; bj < 2; ++bj)
#pragma unroll
      for (int g = 0; g < 4; ++g) {
        f32x4 v;
#pragma unroll
        for (int j = 0; j < 4; ++j) { v[j] = acc[bi][bj][4 * g + j]; if (ACT == 1) { v[j] = fmaxf(v[j], 0.f); v[j] *= v[j]; } }
        *(LDS_AS f32x4*)(reg + (bi * 32 + (lane & 31)) * 272 + (bj * 32 + 8 * g + 4 * h) * 4) = v;
      }
  return reg;
}
template <int ACT> DI void epi_store_bf16(const f32x16 (&acc)[2][2], bf16_t* dst, int ldc, int row0, int col0, int ncols, LDS_AS unsigned char* smem) {
  LDS_AS unsigned char* reg = stage_tile<ACT>(acc, smem);
  const int tid_ = tidx(), lane = tid_ & 63, wave = tid_ >> 6, wm = wave >> 1, wn = wave & 1;
  const int c = (lane & 7) * 8, col = col0 + wn * 64 + c;
#pragma unroll
  for (int i = 0; i < 8; ++i) {
    const int r = i * 8 + (lane >> 3);
    const f32x4 a = *(LDS_AS f32x4*)(reg + r * 272 + c * 4), b = *(LDS_AS f32x4*)(reg + r * 272 + c * 4 + 16);
    u32x4 w = {pk2(a[0], a[1]), pk2(a[2], a[3]), pk2(b[0], b[1]), pk2(b[2], b[3])};
    if (col < ncols) *(u32x4*)(dst + (size_t)(row0 + wm * 64 + r) * ldc + col) = w;
  }
}
DI void epi_residual(const f32x16 (&acc)[2][2], const float* xin, float* xout, const float* gate, int row0, int col0, LDS_AS unsigned char* smem) {
  LDS_AS unsigned char* reg = stage_tile<0>(acc, smem);
  const int tid_ = tidx(), lane = tid_ & 63, wave = tid_ >> 6, wm = wave >> 1, wn = wave & 1;
  const int c = (lane & 15) * 4, col = col0 + wn * 64 + c;
  const f32x4 gv = *(const f32x4*)(gate + col);
#pragma unroll
  for (int i = 0; i < 16; ++i) {
    const int r = i * 4 + (lane >> 4);
    const size_t off = (size_t)(row0 + wm * 64 + r) * 1024 + col;
    const f32x4 a = *(LDS_AS f32x4*)(reg + r * 272 + c * 4), xi = *(const f32x4*)(xin + off);
    f32x4 o;
#pragma unroll
    for (int j = 0; j < 4; ++j) o[j] = xi[j] + gv[j] * a[j];
    *(f32x4*)(xout + off) = o;
  }
}

DI void phase_gemm_in(const Params& p, int l, LDS_AS unsigned char* smem, int dry) {
  const bf16_t* W = p.WB + (size_t)l * W_LAYER + W_IN;
  const int NT = 22, ntiles = (T / 256) * NT;
  for (int i = blockIdx.x; i < ntiles; i += gridDim.x) {
    int mt, nt; tile_decode(xcd_remap(i, ntiles), NT, mt, nt);
    f32x16 acc[2][2]; zero_acc(acc);
    gemm_kloop(p.H + (size_t)mt * 256 * 1024, 1024, 64, W + (size_t)nt * 128 * 1024, 1024, 16, acc, smem);
    if (!dry) epi_store_bf16<0>(acc, p.PROJ, PN, mt * 256, nt * 128, PN, smem);
  }
}
DI void phase_gemm_mla(const Params& p, int l, LDS_AS unsigned char* smem, int dry) {
  const bf16_t* WQ = p.WB + (size_t)l * W_LAYER + W_UQ; const bf16_t* WK = p.WB + (size_t)l * W_LAYER + W_UKV;
  const int NT = 14, ntiles = (T / 256) * NT;
  for (int i = blockIdx.x; i < ntiles; i += gridDim.x) {
    int mt, nt; tile_decode(xcd_remap(i, ntiles), NT, mt, nt);
    f32x16 acc[2][2]; zero_acc(acc);
    if (nt < 6) {
      gemm_kloop(p.PROJ + (size_t)mt * 256 * PN + C_QLAT, PN, 64, WQ + (size_t)nt * 128 * 256, 256, 4, acc, smem);
      if (!dry) epi_store_bf16<0>(acc, p.MQ, 768, mt * 256, nt * 128, 768, smem);
    } else {
      gemm_kloop(p.PROJ + (size_t)mt * 256 * PN + C_KVLAT, PN, 64, WK + (size_t)(nt - 6) * 128 * 128, 128, 2, acc, smem);
      if (!dry) epi_store_bf16<0>(acc, p.KV, 1024, mt * 256, (nt - 6) * 128, 1024, smem);
    }
  }
}
DI void phase_merge(const Params& p, int l, LDS_AS unsigned char* smem, int dry) {
  const bf16_t* WL = p.WB + (size_t)l * W_LAYER;
  const int NT = 8, MT = (l == 1) ? TL / 256 : T / 256, ntiles = MT * NT;
  bf16_t* M = p.KV;
  for (int i = blockIdx.x; i < ntiles; i += gridDim.x) {
    int mt, nt; tile_decode(xcd_remap(i, ntiles), NT, mt, nt);
    unsigned tp[2][2][8];
#pragma unroll
    for (int a = 0; a < 2; ++a)
#pragma unroll
      for (int b = 0; b < 2; ++b)
#pragma unroll
        for (int e = 0; e < 8; ++e) tp[a][b][e] = 0u;
#pragma unroll 1
    for (int br = 0; br < 3; ++br) {
      unsigned gp[2][2][8];
      {
        f32x16 ag[2][2]; zero_acc(ag);
        gemm_kloop(p.H + (size_t)mt * 256 * 1024, 1024, 64, WL + W_IN + (size_t)(2816 + br * 1024 + nt * 128) * 1024, 1024, 16, ag, smem);
#pragma unroll
        for (int a = 0; a < 2; ++a)
#pragma unroll
          for (int b = 0; b < 2; ++b)
#pragma unroll
            for (int e = 0; e < 8; ++e)
              gp[a][b][e] = pk2(__builtin_amdgcn_rcpf(1.f + __builtin_amdgcn_exp2f(-LOG2E * ag[a][b][2 * e])),
                                __builtin_amdgcn_rcpf(1.f + __builtin_amdgcn_exp2f(-LOG2E * ag[a][b][2 * e + 1])));
      }
      f32x16 ay[2][2]; zero_acc(ay);
      const int lda = (br == 0) ? 768 : PN, kstep = (br == 0) ? 96 : 64;
      const size_t aofs = (br == 0) ? (size_t)T * PN : (size_t)(br == 1 ? C_SQ : C_DQ);
      __builtin_amdgcn_sched_barrier(0);
      gemm_kloop(p.PROJ + aofs + (size_t)mt * 256 * lda, lda, kstep, WL + W_UPM + (size_t)br * 1024 * 512 + (size_t)nt * 128 * 512, 512, 8, ay, smem);
#pragma unroll
      for (int a = 0; a < 2; ++a)
#pragma unroll
        for (int b = 0; b < 2; ++b)
#pragma unroll
          for (int e = 0; e < 8; ++e) {
            const float t0 = __uint_as_float(tp[a][b][e] << 16) + __uint_as_float(gp[a][b][e] << 16) * ay[a][b][2 * e];
            const float t1 = __uint_as_float(tp[a][b][e] & 0xffff0000u) + __uint_as_float(gp[a][b][e] & 0xffff0000u) * ay[a][b][2 * e + 1];
            tp[a][b][e] = pk2(t0, t1);
          }
    }
    if (!dry) {
      f32x16 tot[2][2];
#pragma unroll
      for (int a = 0; a < 2; ++a)
#pragma unroll
        for (int b = 0; b < 2; ++b)
#pragma unroll
          for (int e = 0; e < 8; ++e) { tot[a][b][2 * e] = __uint_as_float(tp[a][b][e] << 16); tot[a][b][2 * e + 1] = __uint_as_float(tp[a][b][e] & 0xffff0000u); }
      epi_store_bf16<0>(tot, M, 1024, mt * 256, nt * 128, 1024, smem);
    }
  }
}
DI void phase_residual_gemm(const Params& p, int l, int which, LDS_AS unsigned char* smem, int dry) {
  const bf16_t* WL = p.WB + (size_t)l * W_LAYER;
  const int NT = 8, MT = (l == 1) ? TL / 256 : T / 256, ntiles = MT * NT;
  const bf16_t* Abase = which == 0 ? (const bf16_t*)opq(p.KV) : (const bf16_t*)opq(p.PROJ);
  const int K = which == 0 ? 1024 : 4096;
  const bf16_t* W = WL + (which == 0 ? W_O : W_M2);
  const bool first = (which == 0 && l == 0);
  const float* px = opq(p.x); const float* pctx = opq(p.ctx); float* pout = opq(p.out); float* pcx = opq(p.CX);
  const float* slat = first ? px : (const float*)pout; const float* sctx = first ? pctx : (const float*)pcx;
  for (int i = blockIdx.x; i < ntiles; i += gridDim.x) {
    int mt, nt; tile_decode(xcd_remap(i, ntiles), NT, mt, nt);
    f32x16 acc[2][2]; zero_acc(acc);
    gemm_kloop(Abase + (size_t)mt * 256 * K, K, 64, W + (size_t)nt * 128 * K, K, K / 64, acc, smem);
    const int row0 = mt * 256;
    const float* xin; float* xout; int bidx, r0;
    if (row0 < TL) { xin = slat; xout = pout; bidx = row0 >> 13; r0 = row0; }
    else { xin = sctx; xout = pcx; bidx = 4; r0 = row0 - TL; }
    const float* gate = p.modtab + (size_t)(l * 5 + bidx) * 6144 + (which == 0 ? 2048 : 5120);
    if (!dry) epi_residual(acc, xin, xout, gate, r0, nt * 128, smem);
  }
}
DI void phase_mlp_in(const Params& p, int l, LDS_AS unsigned char* smem, int dry) {
  const bf16_t* W = p.WB + (size_t)l * W_LAYER + W_M1;
  const int NT = 32, MT = (l == 1) ? TL / 256 : T / 256, ntiles = MT * NT;
  bf16_t* U = p.PROJ;
  for (int i = blockIdx.x; i < ntiles; i += gridDim.x) {
    int mt, nt; tile_decode(xcd_remap(i, ntiles), NT, mt, nt);
    f32x16 acc[2][2]; zero_acc(acc);
    gemm_kloop(p.H + (size_t)mt * 256 * 1024, 1024, 64, W + (size_t)nt * 128 * 1024, 1024, 16, acc, smem);
    if (!dry) epi_store_bf16<1>(acc, U, 4096, mt * 256, nt * 128, 4096, smem);
  }
}

DI unsigned ld_u32(const bf16_t* p) { return *(const unsigned*)p; }
DI void unpack4(u32x2 raw, float (&v)[4]) {
  v[0] = __uint_as_float(raw[0] << 16); v[1] = __uint_as_float(raw[0] & 0xffff0000u); v[2] = __uint_as_float(raw[1] << 16); v[3] = __uint_as_float(raw[1] & 0xffff0000u);
}
DI void phase_prep_a(const Params& p, int l, int dry) {
  const int tid_ = tidx(), lane = tid_ & 63, wave = tid_ >> 6, vsel = lane >> 4, j16 = lane & 15;
  const f32x4 gsq = *(const f32x4*)(p.g_swa_q + l * 64 + 4 * j16), gsk = *(const f32x4*)(p.g_swa_k + l * 64 + 4 * j16);
  const f32x4 gdq = *(const f32x4*)(p.g_diff_q + l * 64 + 4 * j16), gdk = *(const f32x4*)(p.g_diff_k + l * 64 + 4 * j16);
  const f32x4 gql = *(const f32x4*)(p.g_q_lora + l * 256 + lane * 4);
  const f32x2 gkl = *(const f32x2*)(p.g_kv_lora + l * 128 + lane * 2);
  float freq[4];
#pragma unroll
  for (int jj = 0; jj < 4; ++jj) freq[jj] = __builtin_amdgcn_exp2f(-(float)(4 * (j16 & 3) + jj) * (13.287712379549449f / 16.f)) * 0.15915494309189535f;
  const float sgn = ((j16 >> 2) & 1) ? 1.f : -1.f;
  const int stride = gridDim.x * 8;
  for (int row0 = blockIdx.x * 8 + wave; row0 < T; row0 += 2 * stride) {
    u32x2 rq[2], rv[2][7]; unsigned rk[2];
#pragma unroll
    for (int t = 0; t < 2; ++t) {
      const int row = (row0 + t * stride < T) ? row0 + t * stride : row0;
      const bf16_t* base = p.PROJ + (size_t)row * PN;
      rq[t] = *(const u32x2*)(base + C_QLAT + lane * 4);
      rk[t] = ld_u32(base + C_KVLAT + lane * 2);
#pragma unroll
      for (int it = 0; it < 7; ++it) rv[t][it] = *(const u32x2*)(base + C_SQ + 64 * (4 * it + vsel) + 4 * j16);
    }
#pragma unroll
    for (int t = 0; t < 2; ++t) {
      const int row = row0 + t * stride;
      if (row >= T) break;
      bf16_t* base = p.PROJ + (size_t)row * PN;
      const bool islat = row < TL;
      float cs[4], sn[4];
      if (islat) {
        const int tt = row & 8191; const float pos = (float)((j16 >> 3) ? (tt & 63) : (tt >> 6));
#pragma unroll
        for (int jj = 0; jj < 4; ++jj) { const float rev = pos * freq[jj]; cs[jj] = __builtin_amdgcn_cosf(rev); sn[jj] = __builtin_amdgcn_sinf(rev); }
      } else {
#pragma unroll
        for (int jj = 0; jj < 4; ++jj) { cs[jj] = 1.f; sn[jj] = 0.f; }
      }
      {
        float v[4]; unpack4(rq[t], v);
        const float ss = wave_sum(v[0] * v[0] + v[1] * v[1] + v[2] * v[2] + v[3] * v[3]);
        const float rstd = rsqrtf(ss * (1.f / 256.f) + EPS);
        u32x2 w = {pk2(v[0] * rstd * gql[0], v[1] * rstd * gql[1]), pk2(v[2] * rstd * gql[2], v[3] * rstd * gql[3])};
        if (!dry) *(u32x2*)(base + C_QLAT + lane * 4) = w;
      }
      {
        const float v0 = __uint_as_float(rk[t] << 16), v1 = __uint_as_float(rk[t] & 0xffff0000u);
        const float ss = wave_sum(v0 * v0 + v1 * v1);
        const float rstd = rsqrtf(ss * (1.f / 128.f) + EPS);
        if (!dry) *(unsigned*)(base + C_KVLAT + lane * 2) = pk2(v0 * rstd * gkl[0], v1 * rstd * gkl[1]);
      }
#pragma unroll
      for (int it = 0; it < 7; ++it) {
        const f32x4 g = (it < 2) ? gsq : (it == 2 ? gsk : (it < 5 ? gdq : gdk));
        const float sc = (it < 2 || it == 3 || it == 4) ? 0.125f * LOG2E : 1.f;
        float v[4]; unpack4(rv[t][it], v);
        float ss = v[0] * v[0] + v[1] * v[1] + v[2] * v[2] + v[3] * v[3];
        ss += __shfl_xor(ss, 8); ss += __shfl_xor(ss, 4); ss += __shfl_xor(ss, 2); ss += __shfl_xor(ss, 1);
        const float rstd = rsqrtf(ss * (1.f / 64.f) + EPS);
        float y[4];
#pragma unroll
        for (int jj = 0; jj < 4; ++jj) {
          const float yy = v[jj] * rstd * g[jj];
          const float pr = __shfl_xor(yy, 4);
          y[jj] = (yy * cs[jj] + sgn * pr * sn[jj]) * sc;
        }
        u32x2 w = {pk2(y[0], y[1]), pk2(y[2], y[3])};
        if (!dry && (it != 2 || vsel < 2)) *(u32x2*)(base + C_SQ + 64 * (4 * it + vsel) + 4 * j16) = w;
      }
    }
  }
}
DI void phase_prep_c(const Params& p, int l, int dry) {
  const int tid_ = tidx(), lane = tid_ & 63, wave = tid_ >> 6, hd = lane >> 3, sub = lane & 7;
  f32x4 gq[3], gk[3];
#pragma unroll
  for (int i = 0; i < 3; ++i) { gq[i] = *(const f32x4*)(p.g_mla_q + l * 96 + 32 * i + 4 * sub); gk[i] = *(const f32x4*)(p.g_mla_k + l * 96 + 32 * i + 4 * sub); }
  float freq[4];
#pragma unroll
  for (int jj = 0; jj < 4; ++jj) freq[jj] = __builtin_amdgcn_exp2f(-(float)(4 * (sub & 1) + jj) * (13.287712379549449f / 8.f)) * 0.15915494309189535f;
  const float sgn = ((sub >> 1) & 1) ? 1.f : -1.f;
  const float qs = 0.10206207261596575f * LOG2E;
  const int stride = gridDim.x * 8;
  for (int row0 = blockIdx.x * 8 + wave; row0 < T; row0 += 2 * stride) {
    u32x2 rq[2][3], rkv[2][2], rpe[2];
#pragma unroll
    for (int t = 0; t < 2; ++t) {
      const int row = (row0 + t * stride < T) ? row0 + t * stride : row0;
#pragma unroll
      for (int i = 0; i < 3; ++i) rq[t][i] = *(const u32x2*)(p.MQ + (size_t)row * 768 + hd * 96 + 32 * i + 4 * sub);
#pragma unroll
      for (int i = 0; i < 2; ++i) rkv[t][i] = *(const u32x2*)(p.KV + (size_t)row * 1024 + hd * 128 + 32 * i + 4 * sub);
      rpe[t] = *(const u32x2*)(p.PROJ + (size_t)row * PN + C_KPE + 4 * sub);
    }
#pragma unroll
    for (int t = 0; t < 2; ++t) {
      const int row = row0 + t * stride;
      if (row >= T) break;
      const bool islat = row < TL;
      float cs[4], sn[4];
      if (islat) {
        const int tt = row & 8191; const float pos = (float)((sub >> 2) ? (tt & 63) : (tt >> 6));
#pragma unroll
        for (int jj = 0; jj < 4; ++jj) { const float rev = pos * freq[jj]; cs[jj] = __builtin_amdgcn_cosf(rev); sn[jj] = __builtin_amdgcn_sinf(rev); }
      } else {
#pragma unroll
        for (int jj = 0; jj < 4; ++jj) { cs[jj] = 1.f; sn[jj] = 0.f; }
      }
#pragma unroll
      for (int qk = 0; qk < 2; ++qk) {
        float v[3][4];
        if (qk == 0) { unpack4(rq[t][0], v[0]); unpack4(rq[t][1], v[1]); unpack4(rq[t][2], v[2]); }
        else { unpack4(rkv[t][0], v[0]); unpack4(rkv[t][1], v[1]); unpack4(rpe[t], v[2]); }
        float ss = 0.f;
#pragma unroll
        for (int i = 0; i < 3; ++i)
#pragma unroll
          for (int jj = 0; jj < 4; ++jj) ss += v[i][jj] * v[i][jj];
        ss += __shfl_xor(ss, 4); ss += __shfl_xor(ss, 2); ss += __shfl_xor(ss, 1);
        const float rstd = rsqrtf(ss * (1.f / 96.f) + EPS);
        const float osc = (qk == 0) ? qs : 1.f;
        u32x2 w[3];
#pragma unroll
        for (int i = 0; i < 3; ++i) {
          float y[4];
#pragma unroll
          for (int jj = 0; jj < 4; ++jj) {
            const float gg = (qk == 0) ? gq[i][jj] : gk[i][jj];
            float yy = v[i][jj] * rstd * gg;
            if (i == 2) { const float pr = __shfl_xor(yy, 2); yy = yy * cs[jj] + sgn * pr * sn[jj]; }
            y[jj] = yy * osc;
          }
          w[i][0] = pk2(y[0], y[1]); w[i][1] = pk2(y[2], y[3]);
        }
        bf16_t* dst = (qk == 0 ? p.MQ : p.KM) + (size_t)row * 768 + hd * 96 + 4 * sub;
        if (!dry) {
#pragma unroll
          for (int i = 0; i < 3; ++i) *(u32x2*)(dst + 32 * i) = w[i];
        }
      }
    }
  }
}

struct AttnArgs {
  const bf16_t* q; int qpitch;
  const bf16_t* k; int kpitch;
  const bf16_t* v; int vpitch;
  bf16_t* o; int opitch;
  int krow_ctx, krow_lat;
  int nct, lt0, lt1;
  int qrow0, qpos0;
  float mb, sinkterm;
  float lam, osc; const float* gsub;
  int dry;
  bf16_t* o0;
};

template <int QSTEPS> DI void load_q(const AttnArgs& a, int colofs, bf16x8 (&qf)[QSTEPS]) {
  const int tid_ = tidx(), lane = tid_ & 63, wave = tid_ >> 6, h = lane >> 5, l32 = lane & 31;
  const bf16_t* qr = a.q + (size_t)(a.qrow0 + wave * 32 + l32) * a.qpitch + 8 * h + colofs;
#pragma unroll
  for (int s = 0; s < QSTEPS; ++s) qf[s] = *(const bf16x8*)(qr + s * 16);
}
template <int NKA, bool KB, int DV, int EPI, bool WIN>
DI void attn_item(const AttnArgs& a, const bf16x8 (&qfr)[4 + (KB ? 2 : 0)], int kcolofs, LDS_AS unsigned char* smem) {
  const int tid_ = tidx(), lane = tid_ & 63, wave = tid_ >> 6, h = lane >> 5, l32 = lane & 31;
  constexpr int NMAP = 1;
  constexpr int QSTEPS = 4 + (KB ? 2 : 0);
  constexpr int NDB = DV / 32;
  constexpr int VP = DV * 2;
  constexpr int AST = 24576, NST = 4;
  constexpr int NLD = 1 + (KB ? 1 : 0) + (DV == 64 ? 1 : 2);
  const int ntile = a.nct + (a.lt1 - a.lt0);
  unsigned kaoff, kboff = 0, voff[DV == 64 ? 1 : 2];
  { const int r = wave * 8 + (lane >> 3), c = (lane & 7) ^ ((r >> 1) & 7); kaoff = (unsigned)(r * a.kpitch + c * 8) * 2u; }
  if (KB) { const int r = (wave & 3) * 16 + (lane >> 2), c = (lane & 3) ^ ((r >> 2) & 3); kboff = (unsigned)(r * a.kpitch + 64 + c * 8) * 2u; }
  if (DV == 64) {
    const int r = wave * 8 + (lane >> 3), c = (lane & 7) ^ (((r >> 1) & 1) << 2); voff[0] = (unsigned)(r * a.vpitch + c * 8) * 2u;
  } else {
#pragma unroll
    for (int j = 0; j < 2; ++j) { const int r = (j * 8 + wave) * 4 + (lane >> 4), c = (lane & 15) ^ ((r & 3) << 2); voff[j] = (unsigned)(r * a.vpitch + c * 8) * 2u; }
  }
  const unsigned ldst = (unsigned)__builtin_amdgcn_readfirstlane((int)(lds_u32(smem) + wave * 1024));
  const unsigned ldstb = (unsigned)__builtin_amdgcn_readfirstlane((int)(lds_u32(smem) + 16384 + (wave & 3) * 1024));
  auto issue = [&](int ti, int stg) {
    const int trow = (ti < a.nct) ? (a.krow_ctx + ti * 64) : (a.krow_lat + (a.lt0 + ti - a.nct) * 64);
    const char* kb = (const char*)(a.k + (size_t)trow * a.kpitch + kcolofs); const char* vb = (const char*)(a.v + (size_t)trow * a.vpitch);
    const unsigned d = ldst + stg * AST;
    glds16a(kb, kaoff, d);
    if (KB) glds16a(kb, kboff, ldstb + stg * AST);
#pragma unroll
    for (int j = 0; j < (DV == 64 ? 1 : 2); ++j) glds16a(vb, voff[j], d + 8192 + j * 8192);
  };
  const int kswzA = (lane >> 1) & 7, kswzB = (lane >> 2) & 3;
  const int krowA = l32 * 128, krowB = l32 * 64;
  int vbase[NDB];
  {
    const int l16 = lane & 15, qq = l16 >> 2, pp = l16 & 3, g16 = (lane >> 4) & 1;
#pragma unroll
    for (int db = 0; db < NDB; ++db) {
      const int cl = 2 * g16 + (pp >> 1);
      const int c = (DV == 64) ? (4 * (db ^ (qq >> 1)) + cl) : (4 * (db ^ qq) + cl);
      vbase[db] = (4 * h + qq) * VP + c * 16 + (pp & 1) * 8;
    }
  }
  f32x16 O[NMAP][NDB];
#pragma unroll
  for (int m = 0; m < NMAP; ++m)
#pragma unroll
    for (int db = 0; db < NDB; ++db)
#pragma unroll
      for (int i = 0; i < 16; ++i) O[m][db][i] = 0.f;
  float lsum[NMAP];
#pragma unroll
  for (int m = 0; m < NMAP; ++m) lsum[m] = 0.f;
  const float negmb = -a.mb;
  const int qpos = a.qpos0 + wave * 32 + l32;

#pragma unroll
  for (int s = 0; s < QSTEPS; ++s) asm volatile("" ::"v"(qfr[s]));
  asm volatile("s_waitcnt vmcnt(0)" ::: "memory");
  __syncthreads();
  issue(0, 0);
  if (ntile > 1) issue(1, 1);
  if (ntile > 2) issue(2, 2);
#pragma unroll 1
  for (int ti = 0; ti < ntile; ++ti) {
    const int rem = ntile - 1 - ti;
    if (rem >= 2) { if (NLD == 2) asm volatile("s_waitcnt vmcnt(4)" ::: "memory"); else asm volatile("s_waitcnt vmcnt(6)" ::: "memory"); }
    else if (rem == 1) { if (NLD == 2) asm volatile("s_waitcnt vmcnt(2)" ::: "memory"); else asm volatile("s_waitcnt vmcnt(3)" ::: "memory"); }
    else asm volatile("s_waitcnt vmcnt(0)" ::: "memory");
    __builtin_amdgcn_s_barrier();
    asm volatile("" ::: "memory");
    if (ti + 3 < ntile) issue(ti + 3, (ti + 3) & 3);
    __builtin_amdgcn_sched_barrier(0);
    LDS_AS unsigned char* st = smem + (ti & 3) * AST;
    LDS_AS unsigned char* sv = st + 8192;
    auto readK = [&](int kb, bf16x8 (&kf)[QSTEPS]) {
      LDS_AS unsigned char* ka = st + kb * 32 * 128 + krowA;
#pragma unroll
      for (int s = 0; s < 4; ++s) kf[s] = lds128(ka + (((2 * s + h) ^ kswzA) << 4));
      if (KB) {
        LDS_AS unsigned char* kbp = st + 16384 + kb * 32 * 64 + krowB;
#pragma unroll
        for (int s = 0; s < 2; ++s) kf[4 + s] = lds128(kbp + (((2 * s + h) ^ kswzB) << 4));
      }
    };
    auto readV = [&](int kb, bf16x8 (&vf)[2][NDB]) {
#pragma unroll
      for (int s = 0; s < 2; ++s)
#pragma unroll
        for (int db = 0; db < NDB; ++db) {
          const int rc = (kb * 32 + 16 * s) * VP;
          const s16x4 lo = __builtin_amdgcn_ds_read_tr16_b64_v4i16((LDS_AS s16x4*)(sv + vbase[db] + rc));
          const s16x4 hi = __builtin_amdgcn_ds_read_tr16_b64_v4i16((LDS_AS s16x4*)(sv + vbase[db] + rc + 8 * VP));
          vf[s][db] = __builtin_shufflevector(lo, hi, 0, 1, 2, 3, 4, 5, 6, 7);
        }
    };
    auto qk = [&](const bf16x8 (&kf)[QSTEPS], f32x16& S) {
#pragma unroll
      for (int i = 0; i < 16; ++i) S[i] = (DV == 128) ? 0.f : negmb;
#pragma unroll
      for (int s = 0; s < QSTEPS; ++s) S = MFMA32(kf[s], qfr[s], S);
    };
    auto softmax = [&](int kb, f32x16& S, bf16x8 (&pb)[2]) {
      if (WIN) {
        if (ti >= a.nct) {
          const int kp0 = (a.lt0 + ti - a.nct) * 64 + 4 * h - qpos + kb * 32;
#pragma unroll
          for (int i = 0; i < 16; ++i) {
            const int dlt = kp0 + (i & 3) + 8 * (i >> 2);
            if (dlt > 128 || dlt < -128) S[i] = -INFINITY;
          }
        }
      }
      float ls = 0.f;
#pragma unroll
      for (int i = 0; i < 16; ++i) { S[i] = __builtin_amdgcn_exp2f((DV == 128) ? S[i] + negmb : S[i]); ls += S[i]; }
      lsum[0] += ls;
#pragma unroll
      for (int s = 0; s < 2; ++s) {
        u32x4 pw;
#pragma unroll
        for (int j = 0; j < 4; ++j) pw[j] = pk2(S[8 * s + 2 * j], S[8 * s + 2 * j + 1]);
        pb[s] = __builtin_bit_cast(bf16x8, pw);
      }
    };
    auto pv = [&](const bf16x8 (&vf)[2][NDB], const bf16x8 (&pb)[2]) {
#pragma unroll
      for (int s = 0; s < 2; ++s)
#pragma unroll
        for (int db = 0; db < NDB; ++db) O[0][db] = MFMA32(vf[s][db], pb[s], O[0][db]);
    };
    {
      bf16x8 kf0[QSTEPS], kf1[QSTEPS], vf0[2][NDB], vf1[2][NDB], p0[2], p1[2];
      f32x16 S0, S1;
      readK(0, kf0); readV(0, vf0);
      __builtin_amdgcn_sched_barrier(0);
      qk(kf0, S0);
      __builtin_amdgcn_sched_barrier(0);
      readK(1, kf1);
      __builtin_amdgcn_sched_barrier(0);
      qk(kf1, S1);
      __builtin_amdgcn_sched_barrier(0);
      softmax(0, S0, p0);
      __builtin_amdgcn_sched_barrier(0);
      pv(vf0, p0);
      __builtin_amdgcn_sched_barrier(0);
      readV(1, vf1);
      __builtin_amdgcn_sched_barrier(0);
      softmax(1, S1, p1);
      __builtin_amdgcn_sched_barrier(0);
      pv(vf1, p1);
      __builtin_amdgcn_sched_barrier(0);
    }
  }
  const float lt = lsum[0] + __shfl_xor(lsum[0], 32) + a.sinkterm;
  const float inv = 1.f / lt;
  bf16_t* orow = a.o + (size_t)(a.qrow0 + wave * 32 + l32) * a.opitch + 4 * h;
  if (a.dry) return;
  if (EPI == 0) {
#pragma unroll
    for (int db = 0; db < NDB; ++db)
#pragma unroll
      for (int g = 0; g < 4; ++g) {
        u32x2 w = {pk2(O[0][db][4 * g] * inv, O[0][db][4 * g + 1] * inv), pk2(O[0][db][4 * g + 2] * inv, O[0][db][4 * g + 3] * inv)};
        *(u32x2*)(orow + db * 32 + 8 * g) = w;
      }
  } else {
    const float c1 = inv * a.lam;
    float ss = 0.f;
#pragma unroll
    for (int db = 0; db < NDB; ++db)
#pragma unroll
      for (int g = 0; g < 4; ++g) {
        const u32x2 raw = *(const u32x2*)(a.o0 + (size_t)(a.qrow0 + wave * 32 + l32) * 512 + 4 * h + db * 32 + 8 * g);
        const float o0[4] = {__uint_as_float(raw[0] << 16), __uint_as_float(raw[0] & 0xffff0000u), __uint_as_float(raw[1] << 16), __uint_as_float(raw[1] & 0xffff0000u)};
#pragma unroll
        for (int j = 0; j < 4; ++j) { const float v = o0[j] - O[0][db][4 * g + j] * c1; O[0][db][4 * g + j] = v; ss += v * v; }
      }
    ss += __shfl_xor(ss, 32);
    const float rstd = rsqrtf(ss * (1.f / (float)DV) + EPS) * a.osc;
#pragma unroll
    for (int db = 0; db < NDB; ++db)
#pragma unroll
      for (int g = 0; g < 4; ++g) {
        const f32x4 gs = *(const f32x4*)(a.gsub + db * 32 + 8 * g + 4 * h);
        u32x2 w = {pk2(O[0][db][4 * g] * rstd * gs[0], O[0][db][4 * g + 1] * rstd * gs[1]), pk2(O[0][db][4 * g + 2] * rstd * gs[2], O[0][db][4 * g + 3] * rstd * gs[3])};
        *(u32x2*)(orow + db * 32 + 8 * g) = w;
      }
  }
}

DI void attn_diff_item(const AttnArgs& a, LDS_AS unsigned char* smem) {
  AttnArgs a0 = a; a0.o = a.o0; a0.opitch = 512; a0.dry = 0;
  { bf16x8 q0[4]; load_q<4>(a, 0, q0); attn_item<1, false, 128, 0, false>(a0, q0, 0, smem); }
  { bf16x8 q1[4]; load_q<4>(a, 64, q1); attn_item<1, false, 128, 1, false>(a, q1, 64, smem); }
}

DI void phase_attention(const Params& p, int l, LDS_AS unsigned char* smem, int dry) {
  const float* cs = p.consts + l * 16;
  const float lam = cs[0], lam_init = cs[1], mb_mla = cs[2], mb_swa = cs[3], mb_diff = cs[4];
  const int nc_d = (l == 0) ? 16 : 0, nc_m = (l == 0) ? 32 : 0;
#pragma unroll 1
  for (int i = blockIdx.x; i < 512 + nc_d; i += gridDim.x) {
    AttnArgs a; a.dry = dry;
    int b, hd;
    if (i < 512) {
      const int id = xcd_remap(i, 512), pair = id >> 5, qb = id & 31; b = pair >> 2; hd = pair & 3;
      a.lt0 = 0; a.lt1 = 128; a.qrow0 = b * 8192 + qb * 256;
    } else {
      const int j = i - 512; b = j >> 2; hd = j & 3;
      a.lt0 = 0; a.lt1 = 0; a.qrow0 = TL + b * 256;
    }
    a.q = p.PROJ + C_DQ + hd * 128; a.qpitch = PN; a.k = p.PROJ + C_DK + hd * 128; a.kpitch = PN; a.v = p.PROJ + C_DV + hd * 128; a.vpitch = PN;
    a.o = p.PROJ + C_DQ + hd * 128; a.opitch = PN; a.o0 = p.YD0 + hd * 128;
    a.krow_ctx = TL + b * 256; a.krow_lat = b * 8192; a.nct = 4; a.qpos0 = 0;
    a.mb = mb_diff; a.sinkterm = 0.f; a.lam = lam; a.osc = 1.f - lam_init; a.gsub = p.g_diff_sub + l * 128;
    attn_diff_item(a, smem);
  }
#pragma unroll 1
  for (int i = blockIdx.x; i < 1024 + nc_m; i += gridDim.x) {
    AttnArgs a; a.dry = dry;
    int b, hd;
    if (i < 1024) {
      const int id = xcd_remap(i, 1024), pair = id >> 5, qb = id & 31; b = pair >> 3; hd = pair & 7;
      a.lt0 = 0; a.lt1 = 128; a.qrow0 = b * 8192 + qb * 256;
    } else {
      const int j = i - 1024; b = j >> 3; hd = j & 7;
      a.lt0 = 0; a.lt1 = 0; a.qrow0 = TL + b * 256;
    }
    a.q = p.MQ + hd * 96; a.qpitch = 768; a.k = p.KM + hd * 96; a.kpitch = 768; a.v = p.KV + hd * 128 + 64; a.vpitch = 1024;
    a.o = p.MQ + hd * 96; a.opitch = 768; a.o0 = nullptr;
    a.krow_ctx = TL + b * 256; a.krow_lat = b * 8192; a.nct = 4; a.qpos0 = 0;
    a.mb = mb_mla; a.sinkterm = 0.f; a.lam = 0.f; a.osc = 0.f; a.gsub = nullptr;
    bf16x8 qf[6]; load_q<6>(a, 0, qf);
    attn_item<1, true, 64, 0, false>(a, qf, 0, smem);
  }
#pragma unroll 1
  for (int i = blockIdx.x; i < 1024 + nc_m; i += gridDim.x) {
    AttnArgs a; a.dry = dry;
    int b, hq;
    if (i < 1024) {
      const int id = xcd_remap(i, 1024), pair = id >> 5, qb = id & 31; b = pair >> 3; hq = pair & 7;
      a.lt0 = (4 * qb - 2 < 0) ? 0 : 4 * qb - 2; a.lt1 = (4 * qb + 6 > 128) ? 128 : 4 * qb + 6;
      a.qrow0 = b * 8192 + qb * 256; a.qpos0 = qb * 256;
    } else {
      const int j = i - 1024; b = j >> 3; hq = j & 7;
      a.lt0 = 0; a.lt1 = 0; a.qrow0 = TL + b * 256; a.qpos0 = 0;
    }
    const int kvh = hq >> 2;
    a.q = p.PROJ + C_SQ + hq * 64; a.qpitch = PN; a.k = p.PROJ + C_SK + kvh * 64; a.kpitch = PN; a.v = p.PROJ + C_SV + kvh * 64; a.vpitch = PN;
    a.o = p.PROJ + C_SQ + hq * 64; a.opitch = PN; a.o0 = nullptr;
    a.krow_ctx = TL + b * 256; a.krow_lat = b * 8192; a.nct = 4;
    a.mb = mb_swa; a.sinkterm = __builtin_amdgcn_exp2f(p.swa_sink[l * 8 + hq] * LOG2E - mb_swa); a.lam = 0.f; a.osc = 0.f; a.gsub = nullptr;
    bf16x8 qf[4]; load_q<4>(a, 0, qf);
    attn_item<1, false, 64, 0, true>(a, qf, 0, smem);
  }
}

constexpr int NPH = 1 + 2 * 11;
DI void run_phase(const Params& p, int ph, LDS_AS unsigned char* smem, int dry) {
#ifdef ONLY_S
  if (ONLY_S == 99) { if (ph == 0) phase0(p, smem, dry); return; }
  if (ph == 0) return;
  const int l = (ph - 1) / 11, s = ONLY_S;
#else
  if (ph == 0) { phase0(p, smem, dry); return; }
  const int l = (ph - 1) / 11, s = (ph - 1) % 11;
#endif
  switch (s) {
    case 0: norm_phase(p, l, 0, dry); break;
    case 1: phase_gemm_in(p, l, smem, dry); break;
    case 2: phase_prep_a(p, l, dry); break;
    case 3: phase_gemm_mla(p, l, smem, dry); break;
    case 4: phase_prep_c(p, l, dry); break;
    case 5: phase_attention(p, l, smem, dry); break;
    case 6: phase_merge(p, l, smem, dry); break;
    case 7: phase_residual_gemm(p, l, 0, smem, dry); break;
    case 8: norm_phase(p, l, 1, dry); break;
    case 9: phase_mlp_in(p, l, smem, dry); break;
    default: phase_residual_gemm(p, l, 1, smem, dry); break;
  }
}

__global__ void __launch_bounds__(512, 2) mega_kernel(Params p) {
  __shared__ __attribute__((aligned(16))) unsigned char smem_raw[3 * GST];
  LDS_AS unsigned char* smem = (LDS_AS unsigned char*)smem_raw;
  __shared__ uint4 xb_words;
  cg::grid_group grid = cg::this_grid();
  if (threadIdx.x == 0) xb_words = make_uint4(0u, 0u, 0u, 0u);
  __syncthreads();
  const XcdBarrier xb = xcd_barrier_post(p.bar, (volatile LDS_AS unsigned*)&xb_words);
#pragma unroll 1
  for (int ph = 0; ph < NPH; ++ph) {
    const int st = (ph == 0) ? 31 : (ph - 1) % 11;
    const int nrep = (((unsigned)p.probe >> st) & 1u) ? 2 : 1;
    for (int rep = 0; rep < nrep; ++rep) run_phase(p, ph, smem, rep + 1 < nrep);
    if (ph + 1 < NPH) { if (ph == 0) grid.sync(); else xcd_barrier(xb); }
  }
}
#ifdef MK_MULTI
__global__ void __launch_bounds__(512, 2) phase_kernel(Params p, int ph) {
  __shared__ __attribute__((aligned(16))) unsigned char smem_raw[3 * GST];
  run_phase(p, ph, (LDS_AS unsigned char*)smem_raw, 0);
}
#endif

extern "C" void kernel_launch(void* const* d_in, const int* in_sizes, int n_in, void* d_out, int out_size, void* d_ws, size_t ws_size,
                              hipStream_t stream) {
  Params p{};
  const float* const* in = (const float* const*)d_in;
  p.x = in[0]; p.c = in[1]; p.ctx = in[2]; p.c_ctx = in[3]; p.w_mod = in[4]; p.b_mod = in[5]; p.g_norm_attn = in[6]; p.g_norm_mlp = in[7];
  p.w_in = in[8]; p.g_q_lora = in[9]; p.w_uq = in[10]; p.g_kv_lora = in[11]; p.w_ukv = in[12]; p.g_mla_q = in[13]; p.g_mla_k = in[14];
  p.w_up_mla = in[15]; p.g_swa_q = in[16]; p.g_swa_k = in[17]; p.swa_sink = in[18]; p.w_up_swa = in[19]; p.g_diff_q = in[20]; p.g_diff_k = in[21];
  p.lambda_q1 = in[22]; p.lambda_k1 = in[23]; p.lambda_q2 = in[24]; p.lambda_k2 = in[25]; p.g_diff_sub = in[26]; p.w_up_diff = in[27];
  p.w_o = in[28]; p.w_mlp_in = in[29]; p.w_mlp_out = in[30];
#ifndef PROBE_MASK
#define PROBE_MASK 0
#endif
  p.probe = PROBE_MASK; p.pad_ = 0;
  p.out = (float*)d_out;
  unsigned char* ws = (unsigned char*)d_ws;
  size_t off = 0;
  auto take = [&](size_t bytes) { unsigned char* r = ws + off; off += (bytes + 255) & ~(size_t)255; return r; };
  p.modtab = (float*)take(2 * 5 * 6144 * 4);
  p.consts = (float*)take(256);
  p.bar = (unsigned*)take(XCD_BAR_WORDS * 4);
  p.WB = (bf16_t*)take(2 * W_LAYER * 2);
  p.H = (bf16_t*)take((size_t)T * 1024 * 2);
  p.PROJ = (bf16_t*)take((size_t)T * PN * 2);
  p.MQ = (bf16_t*)take((size_t)T * 768 * 2);
  p.KV = (bf16_t*)take((size_t)T * 1024 * 2);
  p.KM = (bf16_t*)take((size_t)T * 768 * 2);
  p.CX = (float*)take((size_t)TC * 1024 * 4);
  p.YD0 = (bf16_t*)take((size_t)T * 512 * 2);
  if (off > ws_size) { fprintf(stderr, "workspace too small: need %zu have %zu\n", off, ws_size); return; }
  (void)hipMemsetAsync(p.modtab, 0, (size_t)((unsigned char*)p.bar - (unsigned char*)p.modtab) + XCD_BAR_WORDS * 4, stream);
#ifdef MK_MULTI
  for (int ph = 0; ph < NPH; ++ph) phase_kernel<<<256, 512, 0, stream>>>(p, ph);
#else
  static int grid_blocks = 0;
  if (!grid_blocks) {
    int dev = 0, cus = 0, per_cu = 0;
    hipGetDevice(&dev);
    hipDeviceGetAttribute(&cus, hipDeviceAttributeMultiprocessorCount, dev);
    hipOccupancyMaxActiveBlocksPerMultiprocessor(&per_cu, mega_kernel, 512, 0);
    if (per_cu > 1) per_cu = 1;
    grid_blocks = cus * per_cu;
    if (grid_blocks <= 0) grid_blocks = 256;
  }
  void* args[] = {&p};
  hipError_t e = hipLaunchCooperativeKernel((void*)mega_kernel, dim3(grid_blocks), dim3(512), args, 0, stream);
  if (e != hipSuccess) fprintf(stderr, "cooperative launch failed: %s (grid %d)\n", hipGetErrorString(e), grid_blocks);
#endif
}
```

```cpp
#include <hip/hip_runtime.h>
#include <hip/hip_cooperative_groups.h>
#include <cstdio>
#include <cstdint>
namespace cg = cooperative_groups;

typedef unsigned short bf16_t;
typedef short bf16x8 __attribute__((ext_vector_type(8)));
typedef short s16x4 __attribute__((ext_vector_type(4)));
typedef float f32x16 __attribute__((ext_vector_type(16)));
typedef float f32x4 __attribute__((ext_vector_type(4)));
typedef float f32x2 __attribute__((ext_vector_type(2)));
typedef __bf16 bf16x2_t __attribute__((ext_vector_type(2)));
typedef unsigned u32x2 __attribute__((ext_vector_type(2)));
typedef unsigned u32x4 __attribute__((ext_vector_type(4)));
#define LDS_AS __attribute__((address_space(3)))
#define DI __device__ __forceinline__

constexpr int D = 1024, NB = 4, SEQ = 8192, NCTX = 256;
constexpr int TL = NB * SEQ;
constexpr int TC = NB * NCTX;
constexpr int T = TL + TC;
constexpr int PN = 2720;
constexpr int C_QLAT = 0, C_KVLAT = 256, C_KPE = 384, C_SQ = 416, C_SK = 928, C_SV = 1056, C_DQ = 1184, C_DK = 1696, C_DV = 2208;
constexpr float EPS = 1e-6f;
constexpr float LOG2E = 1.4426950408889634f;
constexpr size_t W_IN = 0;
constexpr size_t W_UQ = W_IN + (size_t)5888 * 1024;
constexpr size_t W_UKV = W_UQ + 768 * 256;
constexpr size_t W_UPM = W_UKV + 1024 * 128;
constexpr size_t W_UPS = W_UPM + 1024 * 512;
constexpr size_t W_UPD = W_UPS + 1024 * 512;
constexpr size_t W_O = W_UPD + 1024 * 512;
constexpr size_t W_M1 = W_O + 1024 * 1024;
constexpr size_t W_M2 = W_M1 + (size_t)4096 * 1024;
constexpr size_t W_LAYER = W_M2 + (size_t)4096 * 1024;

struct Params {
  const float *x, *c, *ctx, *c_ctx, *w_mod, *b_mod, *g_norm_attn, *g_norm_mlp, *w_in, *g_q_lora, *w_uq, *g_kv_lora, *w_ukv,
      *g_mla_q, *g_mla_k, *w_up_mla, *g_swa_q, *g_swa_k, *swa_sink, *w_up_swa, *g_diff_q, *g_diff_k, *lambda_q1, *lambda_k1,
      *lambda_q2, *lambda_k2, *g_diff_sub, *w_up_diff, *w_o, *w_mlp_in, *w_mlp_out;
  float* out;
  float* modtab;
  float* consts;
  unsigned* bar;
  bf16_t* WB;
  bf16_t* H;
  bf16_t* PROJ;
  bf16_t* MQ;
  bf16_t* KV;
  bf16_t* KM;
  float* CX;
  bf16_t* YD0;
  int probe, pad_;
};

template <class Tp> DI Tp* opq(Tp* ptr) { asm volatile("" : "+s"(ptr)); return ptr; }
DI int tidx() { int t = threadIdx.x; asm volatile("" : "+v"(t)); return t; }
DI float bf2f(bf16_t v) { return __uint_as_float((unsigned)v << 16); }
DI unsigned pk2(float a, float b) { f32x2 v = {a, b}; bf16x2_t r = __builtin_convertvector(v, bf16x2_t); return __builtin_bit_cast(unsigned, r); }
DI bf16_t f2bf(float a) { return (bf16_t)(pk2(a, 0.f) & 0xffffu); }
DI float wave_sum(float v) {
#pragma unroll
  for (int o = 32; o; o >>= 1) v += __shfl_xor(v, o);
  return v;
}
DI float wave_max(float v) {
#pragma unroll
  for (int o = 32; o; o >>= 1) v = fmaxf(v, __shfl_xor(v, o));
  return v;
}
DI float silu(float x) { return x / (1.f + __expf(-x)); }
DI int xcd_remap(int L, int n) {
  const int q = n >> 3, r = n & 7, xcd = L & 7, off = L >> 3;
  return (xcd < r ? xcd * (q + 1) : r * (q + 1) + (xcd - r) * q) + off;
}
DI void glds16(const void* g, LDS_AS unsigned char* l) {
  __builtin_amdgcn_global_load_lds((const unsigned*)g, (LDS_AS unsigned*)l, 16, 0, 0);
}
DI void glds16a(const void* base, unsigned voff, unsigned ldsaddr) {
  unsigned keep;
  asm volatile("s_mov_b32 %0, m0\n\ts_mov_b32 m0, %3\n\ts_nop 0\n\tglobal_load_lds_dwordx4 %1, %2\n\ts_mov_b32 m0, %0"
               : "=&s"(keep) : "v"(voff), "s"(base), "s"(ldsaddr) : "memory");
}
DI unsigned lds_u32(LDS_AS unsigned char* p) { return (unsigned)(uintptr_t)p; }
DI bf16x8 lds128(LDS_AS unsigned char* p) { return *(LDS_AS bf16x8*)p; }
#define MFMA32(a, b, c) __builtin_amdgcn_mfma_f32_32x32x16_bf16((a), (b), (c), 0, 0, 0)

#define XB_TMO      128
#define XB_XCNT(j)  (256  + 64 * (j))
#define XB_XSUB(j)  (1280 + 64 * (j))
#define XB_XGEN(j)  (2304 + 64 * (j))
#define XB_TOP      3328
#define XB_TOPGEN   3392
#define XCD_BAR_WORDS 3456
#define XB_SPIN_CAP (1u << 22)
DI unsigned xb_ld(unsigned* p) { return __hip_atomic_load(p, __ATOMIC_RELAXED, __HIP_MEMORY_SCOPE_AGENT); }
DI unsigned xb_add(unsigned* p, unsigned v) { return __hip_atomic_fetch_add(p, v, __ATOMIC_RELAXED, __HIP_MEMORY_SCOPE_AGENT); }
DI unsigned xb_xcc_id() { return (unsigned)__builtin_amdgcn_s_getreg((3 << 11) | 20) & 0xFu; }
#define XB_SPIN(cond, bar) do { unsigned _sp = 0; while (cond) { __builtin_amdgcn_s_sleep(1); \
    if ((++_sp & 255u) == 0u) { if (xb_ld(&(bar)[XB_TMO])) break; if (_sp > XB_SPIN_CAP) { atomicAdd(&(bar)[XB_TMO], 1u); break; } } } } while (0)
struct XcdBarrier { unsigned* bar; unsigned x; volatile LDS_AS unsigned* st; };
DI XcdBarrier xcd_barrier_post(unsigned* bar, volatile LDS_AS unsigned* st) {
  XcdBarrier b; b.bar = bar; b.x = xb_xcc_id(); b.st = st;
  if (threadIdx.x == 0) (void)xb_add(&bar[XB_XCNT(b.x)], 1u);
  return b;
}
DI void xcd_barrier_complete(unsigned* bar, unsigned x, unsigned& nloc, unsigned& nx) {
  const unsigned G = gridDim.x * gridDim.y * gridDim.z;
  unsigned sum, cnt, mine, sp = 0u;
  for (;;) {
    sum = 0u; cnt = 0u; mine = 0u;
#pragma unroll
    for (unsigned j = 0; j < 16; ++j) { const unsigned c = xb_ld(&bar[XB_XCNT(j)]); sum += c; cnt += (c > 0u) ? 1u : 0u; mine = (j == x) ? c : mine; }
    if (sum == G) break;
    __builtin_amdgcn_s_sleep(1);
    if ((++sp & 255u) == 0u) { if (xb_ld(&bar[XB_TMO])) break; if (sp > XB_SPIN_CAP) { atomicAdd(&bar[XB_TMO], 1u); break; } }
  }
  nloc = mine > 0u ? mine : 1u; nx = cnt > 0u ? cnt : 1u;
}
DI void xcd_barrier(const XcdBarrier& b) {
  asm volatile("s_waitcnt vmcnt(0)" ::: "memory");
  __syncthreads();
  if (threadIdx.x == 0) {
    unsigned* bar = b.bar;
    __builtin_amdgcn_s_waitcnt(0);
    unsigned nloc = b.st[0], nx = b.st[1];
    if (nloc == 0u) { xcd_barrier_complete(bar, b.x, nloc, nx); b.st[0] = nloc; b.st[1] = nx; }
    const unsigned old = xb_add(&bar[XB_XSUB(b.x)], 1u);
    const unsigned gen = old / nloc;
    if (old + 1u == (gen + 1u) * nloc) {
      __builtin_amdgcn_fence(__ATOMIC_RELEASE, "agent");
      asm volatile("s_waitcnt vmcnt(0)" ::: "memory");
      const unsigned og = xb_add(&bar[XB_TOP], 1u);
      const unsigned tg = og / nx;
      if (og + 1u == (tg + 1u) * nx) xb_add(&bar[XB_TOPGEN], 1u);
      else XB_SPIN(xb_ld(&bar[XB_TOPGEN]) == tg, bar);
      __builtin_amdgcn_fence(__ATOMIC_ACQUIRE, "agent");
      xb_add(&bar[XB_XGEN(b.x)], 1u);
      asm volatile("s_waitcnt vmcnt(0)" ::: "memory");
    } else {
      XB_SPIN(xb_ld(&bar[XB_XGEN(b.x)]) == gen, bar);
      __builtin_amdgcn_fence(__ATOMIC_ACQUIRE, "agent");
      asm volatile("s_waitcnt vmcnt(0)" ::: "memory");
    }
  }
  __syncthreads();
}

DI void conv_tile(const float* src, int ld, int K, int k0, int n0, bool is_win, bf16_t* dst, LDS_AS float* tile, int dry) {
  const int tid = tidx(), ty = tid >> 4, tx = tid & 15;
  const int n = n0 + 4 * tx;
  int sc = n;
  if (is_win) sc = (n < 2720) ? n : (n < 2816 ? -1 : n - 96);
#pragma unroll
  for (int i = 0; i < 2; ++i) {
    const int k = ty + 32 * i;
    f32x4 v = {0.f, 0.f, 0.f, 0.f};
    if (sc >= 0) v = *(const f32x4*)(src + (size_t)(k0 + k) * ld + sc);
    tile[k * 65 + 4 * tx + 0] = v[0]; tile[k * 65 + 4 * tx + 1] = v[1]; tile[k * 65 + 4 * tx + 2] = v[2]; tile[k * 65 + 4 * tx + 3] = v[3];
  }
  __syncthreads();
  {
    const int r = tid >> 3, c = tid & 7;
    u32x4 w;
    w[0] = pk2(tile[(8 * c + 0) * 65 + r], tile[(8 * c + 1) * 65 + r]);
    w[1] = pk2(tile[(8 * c + 2) * 65 + r], tile[(8 * c + 3) * 65 + r]);
    w[2] = pk2(tile[(8 * c + 4) * 65 + r], tile[(8 * c + 5) * 65 + r]);
    w[3] = pk2(tile[(8 * c + 6) * 65 + r], tile[(8 * c + 7) * 65 + r]);
    if (!dry) *(u32x4*)(dst + (size_t)(n0 + r) * K + k0 + 8 * c) = w;
  }
  __syncthreads();
}

DI void phase0(const Params& p, LDS_AS unsigned char* smem, int dry) {
  const int tid_ = tidx(), lane = tid_ & 63, wave = tid_ >> 6;
  if (blockIdx.x == 0 && wave == 0) {
    for (int l = 0; l < 2; ++l) {
      const float s1 = wave_sum(p.lambda_q1[l * 64 + lane] * p.lambda_k1[l * 64 + lane]);
      const float s2 = wave_sum(p.lambda_q2[l * 64 + lane] * p.lambda_k2[l * 64 + lane]);
      const float lam_init = 0.8f - 0.6f * expf(-0.3f * (float)l);
      const float lam = expf(s1) - expf(s2) + lam_init;
      float a = fabsf(p.g_mla_q[l * 96 + lane]); if (lane < 32) a = fmaxf(a, fabsf(p.g_mla_q[l * 96 + 64 + lane]));
      float b = fabsf(p.g_mla_k[l * 96 + lane]); if (lane < 32) b = fmaxf(b, fabsf(p.g_mla_k[l * 96 + 64 + lane]));
      const float mq = wave_max(a), mk = wave_max(b);
      const float sq = wave_max(fabsf(p.g_swa_q[l * 64 + lane])), sk = wave_max(fabsf(p.g_swa_k[l * 64 + lane]));
      const float dq = wave_max(fabsf(p.g_diff_q[l * 64 + lane])), dk = wave_max(fabsf(p.g_diff_k[l * 64 + lane]));
      if (lane == 0) {
        float* cs = p.consts + l * 16;
        cs[0] = lam; cs[1] = lam_init;
        cs[2] = LOG2E * sqrtf(96.f) * mq * mk;
        cs[3] = LOG2E * 8.f * sq * sk;
        cs[4] = LOG2E * 8.f * dq * dk;
      }
    }
  }
  for (int task = blockIdx.x * 8 + wave; task < 3072; task += gridDim.x * 8) {
    const int l = task / 1536, rem = task % 1536, chunk = rem >> 4, ks = rem & 15;
    const int n = chunk * 64 + lane;
    float acc[5] = {0.f, 0.f, 0.f, 0.f, 0.f};
    const float* w = p.w_mod + ((size_t)l * 1024 + ks * 64) * 6144 + n;
#pragma unroll 8
    for (int k = 0; k < 64; ++k) {
      const float wv = w[(size_t)k * 6144];
      const int kk = ks * 64 + k;
#pragma unroll
      for (int r = 0; r < 4; ++r) acc[r] += silu(p.c[r * 1024 + kk]) * wv;
      acc[4] += silu(p.c_ctx[kk]) * wv;
    }
    const float bias = (ks == 0) ? p.b_mod[l * 6144 + n] : 0.f;
    if (!dry)
#pragma unroll
      for (int r = 0; r < 5; ++r) atomicAdd(p.modtab + (size_t)(l * 5 + r) * 6144 + n, acc[r] + bias);
  }
  LDS_AS float* tile = (LDS_AS float*)smem;
  for (int t = blockIdx.x; t < 2 * 4240; t += gridDim.x) {
    const int l = t / 4240; int u = t % 4240;
    const float* src; int ld, K; bool is_win = false; size_t doff;
    if (u < 1472) { src = p.w_in + (size_t)l * 1024 * 5792; ld = 5792; K = 1024; is_win = true; doff = W_IN; }
    else if (u < 1520) { u -= 1472; src = p.w_uq + (size_t)l * 256 * 768; ld = 768; K = 256; doff = W_UQ; }
    else if (u < 1552) { u -= 1520; src = p.w_ukv + (size_t)l * 128 * 1024; ld = 1024; K = 128; doff = W_UKV; }
    else if (u < 1680) { u -= 1552; src = p.w_up_mla + (size_t)l * 512 * 1024; ld = 1024; K = 512; doff = W_UPM; }
    else if (u < 1808) { u -= 1680; src = p.w_up_swa + (size_t)l * 512 * 1024; ld = 1024; K = 512; doff = W_UPS; }
    else if (u < 1936) { u -= 1808; src = p.w_up_diff + (size_t)l * 512 * 1024; ld = 1024; K = 512; doff = W_UPD; }
    else if (u < 2192) { u -= 1936; src = p.w_o + (size_t)l * 1024 * 1024; ld = 1024; K = 1024; doff = W_O; }
    else if (u < 3216) { u -= 2192; src = p.w_mlp_in + (size_t)l * 1024 * 4096; ld = 4096; K = 1024; doff = W_M1; }
    else { u -= 3216; src = p.w_mlp_out + (size_t)l * 4096 * 1024; ld = 1024; K = 4096; doff = W_M2; }
    const int nkt = K >> 6, kt = u % nkt, nt = u / nkt;
    conv_tile(src, ld, K, kt * 64, nt * 64, is_win, p.WB + (size_t)l * W_LAYER + doff, tile, dry);
  }
}

DI void norm_phase(const Params& p, int l, int which, int dry) {
  const int tid_ = tidx(), lane = tid_ & 63, wave = tid_ >> 6;
  const float* g = (which == 0 ? p.g_norm_attn : p.g_norm_mlp) + l * 1024;
  const int shoff = which == 0 ? 0 : 3072, scoff = shoff + 1024;
  const int nrows = (which == 1 && l == 1) ? TL : T;
  const bool first = (which == 0 && l == 0);
  const float* px = opq(p.x); const float* pctx = opq(p.ctx); const float* pout = opq((const float*)p.out); const float* pcx = opq((const float*)p.CX);
  const float* slat = first ? px : pout; const float* sctx = first ? pctx : pcx;
  for (int row = blockIdx.x * 8 + wave; row < nrows; row += gridDim.x * 8) {
    const float* xr; int bidx;
    if (row < TL) { xr = slat + (size_t)row * 1024; bidx = row >> 13; }
    else { xr = sctx + (size_t)(row - TL) * 1024; bidx = 4; }
    const float* mod = p.modtab + (size_t)(l * 5 + bidx) * 6144;
    f32x4 v[4]; float ss = 0.f;
#pragma unroll
    for (int i = 0; i < 4; ++i) { v[i] = *(const f32x4*)(xr + i * 256 + lane * 4); ss += v[i][0] * v[i][0] + v[i][1] * v[i][1] + v[i][2] * v[i][2] + v[i][3] * v[i][3]; }
    ss = wave_sum(ss);
    const float rstd = rsqrtf(ss * (1.f / 1024.f) + EPS);
#pragma unroll
    for (int i = 0; i < 4; ++i) {
      const int col = i * 256 + lane * 4;
      const f32x4 gv = *(const f32x4*)(g + col), sh = *(const f32x4*)(mod + shoff + col), sc = *(const f32x4*)(mod + scoff + col);
      float o[4];
#pragma unroll
      for (int j = 0; j < 4; ++j) o[j] = (v[i][j] * rstd * gv[j]) * (1.f + sc[j]) + sh[j];
      u32x2 w = {pk2(o[0], o[1]), pk2(o[2], o[3])};
      if (!dry) *(u32x2*)(p.H + (size_t)row * 1024 + col) = w;
    }
  }
}

constexpr int GST = 49152;
DI void gemm_kloop(const bf16_t* Ag, int lda, int a_kstep, const bf16_t* Bg, int ldb, int nkt, f32x16 (&acc)[2][2], LDS_AS unsigned char* smem) {
  const int tid_ = tidx(), lane = tid_ & 63, wave = tid_ >> 6, h = lane >> 5, wm = wave >> 1, wn = wave & 1;
  unsigned aoff[4], boff[2];
#pragma unroll
  for (int i = 0; i < 4; ++i) {
    const int r = wave * 32 + i * 8 + (lane >> 3), c = (lane & 7) ^ ((r >> 1) & 7);
    aoff[i] = (unsigned)(r * lda + c * 8) * 2u;
  }
#pragma unroll
  for (int i = 0; i < 2; ++i) {
    const int r = wave * 16 + i * 8 + (lane >> 3), c = (lane & 7) ^ ((r >> 1) & 7);
    boff[i] = (unsigned)(r * ldb + c * 8) * 2u;
  }
  const unsigned dstA = (unsigned)__builtin_amdgcn_readfirstlane((int)(lds_u32(smem) + wave * 4096));
  const unsigned dstB = (unsigned)__builtin_amdgcn_readfirstlane((int)(lds_u32(smem) + 32768 + wave * 2048));
  const int swz = (lane >> 1) & 7;
  const int arow = (wm * 64 + (lane & 31)) * 128, brow = 32768 + (wn * 64 + (lane & 31)) * 128;
  asm volatile("s_waitcnt vmcnt(0)" ::: "memory");
  __syncthreads();
  auto issue = [&](int kt, int stg) {
    const char* An = (const char*)(Ag + (size_t)kt * a_kstep); const char* Bn = (const char*)(Bg + (size_t)kt * 64);
#pragma unroll
    for (int i = 0; i < 4; ++i) glds16a(An, aoff[i], dstA + stg * GST + i * 1024);
#pragma unroll
    for (int i = 0; i < 2; ++i) glds16a(Bn, boff[i], dstB + stg * GST + i * 1024);
  };
  issue(0, 0);
  if (nkt > 1) issue(1, 1);
  int st = 0;
#pragma unroll 1
  for (int kt = 0; kt < nkt; ++kt) {
    if (kt + 1 < nkt) asm volatile("s_waitcnt vmcnt(6)" ::: "memory"); else asm volatile("s_waitcnt vmcnt(0)" ::: "memory");
    __builtin_amdgcn_s_barrier();
    asm volatile("" ::: "memory");
    if (kt + 2 < nkt) issue(kt + 2, st >= 1 ? st - 1 : 2);
    LDS_AS unsigned char* sa = smem + st * GST;
#pragma unroll
    for (int s = 0; s < 4; ++s) {
      const int co = ((2 * s + h) ^ swz) << 4;
      const bf16x8 a0 = lds128(sa + arow + co), a1 = lds128(sa + arow + 32 * 128 + co);
      const bf16x8 b0 = lds128(sa + brow + co), b1 = lds128(sa + brow + 32 * 128 + co);
      acc[0][0] = MFMA32(b0, a0, acc[0][0]); acc[0][1] = MFMA32(b1, a0, acc[0][1]);
      acc[1][0] = MFMA32(b0, a1, acc[1][0]); acc[1][1] = MFMA32(b1, a1, acc[1][1]);
    }
    st = (st == 2) ? 0 : st + 1;
  }
}
DI void zero_acc(f32x16 (&acc)[2][2]) {
#pragma unroll
  for (int a = 0; a < 2; ++a)
#pragma unroll
    for (int b = 0; b < 2; ++b)
#pragma unroll
      for (int i = 0; i < 16; ++i) acc[a][b][i] = 0.f;
}
DI void tile_decode(int id, int NT, int& mt, int& nt) { const int per = 4 * NT, g = id / per, w = id % per; mt = g * 4 + (w & 3); nt = w >> 2; }

constexpr int EPW = 17408;
template <int ACT> DI LDS_AS unsigned char* stage_tile(const f32x16 (&acc)[2][2], LDS_AS unsigned char* smem) {
  const int tid_ = tidx(), lane = tid_ & 63, wave = tid_ >> 6, h = lane >> 5;
  __syncthreads();
  LDS_AS unsigned char* reg = smem + wave * EPW;
#pragma unroll
  for (int bi = 0; bi < 2; ++bi)
#pragma unroll
    for (int bj = 0; bj < 2; ++bj)
#pragma unroll
      for (int g = 0; g < 4; ++g) {
        f32x4 v;
#pragma unroll
        for (int j = 0; j < 4; ++j) { v[j] = acc[bi][bj][4 * g + j]; if (ACT == 1) { v[j] = fmaxf(v[j], 0.f); v[j] *= v[j]; } }
        *(LDS_AS f32x4*)(reg + (bi * 32 + (lane & 31)) * 272 + (bj * 32 + 8 * g + 4 * h) * 4) = v;
      }
  return reg;
}
template <int ACT> DI void epi_store_bf16(const f32x16 (&acc)[2][2], bf16_t* dst, int ldc, int row0, int col0, int ncols, LDS_AS unsigned char* smem) {
  LDS_AS unsigned char* reg = stage_tile<ACT>(acc, smem);
  const int tid_ = tidx(), lane = tid_ & 63, wave = tid_ >> 6, wm = wave >> 1, wn = wave & 1;
  const int c = (lane & 7) * 8, col = col0 + wn * 64 + c;
#pragma unroll
  for (int i = 0; i < 8; ++i) {
    const int r = i * 8 + (lane >> 3);
    const f32x4 a = *(LDS_AS f32x4*)(reg + r * 272 + c * 4), b = *(LDS_AS f32x4*)(reg + r * 272 + c * 4 + 16);
    u32x4 w = {pk2(a[0], a[1]), pk2(a[2], a[3]), pk2(b[0], b[1]), pk2(b[2], b[3])};
    if (col < ncols) *(u32x4*)(dst + (size_t)(row0 + wm * 64 + r) * ldc + col) = w;
  }
}
DI void epi_residual(const f32x16 (&acc)[2][2], const float* xin, float* xout, const float* gate, int row0, int col0, LDS_AS unsigned char* smem) {
  LDS_AS unsigned char* reg = stage_tile<0>(acc, smem);
  const int tid_ = tidx(), lane = tid_ & 63, wave = tid_ >> 6, wm = wave >> 1, wn = wave & 1;
  const int c = (lane & 15) * 4, col = col0 + wn * 64 + c;
  const f32x4 gv = *(const f32x4*)(gate + col);
#pragma unroll
  for (int i = 0; i < 16; ++i) {
    const int r = i * 4 + (lane >> 4);
    const size_t off = (size_t)(row0 + wm * 64 + r) * 1024 + col;
    const f32x4 a = *(LDS_AS f32x4*)(reg + r * 272 + c * 4), xi = *(const f32x4*)(xin + off);
    f32x4 o;
#pragma unroll
    for (int j = 0; j < 4; ++j) o[j] = xi[j] + gv[j] * a[j];
    *(f32x4*)(xout + off) = o;
  }
}

constexpr int G2ST = 65536;
DI void gemm_kloop2(const bf16_t* Ag, int lda, const bf16_t* Bg, int ldb, int nkt  , f32x16 (&acc)[4][2], LDS_AS unsigned char* smem) {
  const int tid_ = tidx(), lane = tid_ & 63, wave = tid_ >> 6, h = lane >> 5, wm = wave >> 2, wn = wave & 3;
  unsigned aoff[4], boff[4];
#pragma unroll
  for (int i = 0; i < 4; ++i) {
    const int r = wave * 32 + i * 8 + (lane >> 3), c = (lane & 7) ^ ((r >> 1) & 7);
    aoff[i] = (unsigned)(r * lda + c * 8) * 2u; boff[i] = (unsigned)(r * ldb + c * 8) * 2u;
  }
  const unsigned dstA = (unsigned)__builtin_amdgcn_readfirstlane((int)(lds_u32(smem) + wave * 4096));
  const unsigned dstB = dstA + 32768;
  const int swz = (lane >> 1) & 7;
  const int arow = (wm * 128 + (lane & 31)) * 128, brow = 32768 + (wn * 64 + (lane & 31)) * 128;
  asm volatile("s_waitcnt vmcnt(0)" ::: "memory");
  __syncthreads();
  auto issue = [&](int kt, int stg) {
    const char* An = (const char*)(Ag + (size_t)kt * 64); const char* Bn = (const char*)(Bg + (size_t)kt * 64);
#pragma unroll
    for (int i = 0; i < 4; ++i) glds16a(An, aoff[i], dstA + stg * G2ST + i * 1024);
#pragma unroll
    for (int i = 0; i < 4; ++i) glds16a(Bn, boff[i], dstB + stg * G2ST + i * 1024);
  };
  issue(0, 0);
#pragma unroll 1
  for (int kt = 0; kt < nkt; ++kt) {
    asm volatile("s_waitcnt vmcnt(0)" ::: "memory");
    __builtin_amdgcn_s_barrier();
    asm volatile("" ::: "memory");
    if (kt + 1 < nkt) issue(kt + 1, (kt + 1) & 1);
    LDS_AS unsigned char* sa = smem + (kt & 1) * G2ST;
#pragma unroll
    for (int s = 0; s < 4; ++s) {
      const int co = ((2 * s + h) ^ swz) << 4;
      bf16x8 fa[4], fb[2];
#pragma unroll
      for (int bi = 0; bi < 4; ++bi) fa[bi] = lds128(sa + arow + bi * 32 * 128 + co);
#pragma unroll
      for (int bj = 0; bj < 2; ++bj) fb[bj] = lds128(sa + brow + bj * 32 * 128 + co);
#pragma unroll
      for (int bi = 0; bi < 4; ++bi)
#pragma unroll
        for (int bj = 0; bj < 2; ++bj) acc[bi][bj] = MFMA32(fb[bj], fa[bi], acc[bi][bj]);
    }
  }
}
DI void zero_acc2(f32x16 (&acc)[4][2]) {
#pragma unroll
  for (int a = 0; a < 4; ++a)
#pragma unroll
    for (int b = 0; b < 2; ++b)
#pragma unroll
      for (int i = 0; i < 16; ++i) acc[a][b][i] = 0.f;
}
template <int ACT, int HF> DI void stage_half(const f32x16 (&acc)[4][2], LDS_AS unsigned char* reg, int lane, int h) {
#pragma unroll
  for (int bi = 0; bi < 2; ++bi)
#pragma unroll
    for (int bj = 0; bj < 2; ++bj)
#pragma unroll
      for (int g = 0; g < 4; ++g) {
        f32x4 v;
#pragma unroll
        for (int j = 0; j < 4; ++j) { v[j] = acc[2 * HF + bi][bj][4 * g + j]; if (ACT == 1) { v[j] = fmaxf(v[j], 0.f); v[j] *= v[j]; } }
        *(LDS_AS f32x4*)(reg + (bi * 32 + (lane & 31)) * 272 + (bj * 32 + 8 * g + 4 * h) * 4) = v;
      }
}
template <int ACT, int HF> DI void epi2_half_bf16(const f32x16 (&acc)[4][2], bf16_t* dst, int ldc, int row0, int col0, int ncols, LDS_AS unsigned char* smem) {
  const int tid_ = tidx(), lane = tid_ & 63, wave = tid_ >> 6, h = lane >> 5, wm = wave >> 2, wn = wave & 3;
  LDS_AS unsigned char* reg = smem + wave * EPW;
  stage_half<ACT, HF>(acc, reg, lane, h);
  const int c = (lane & 7) * 8, col = col0 + wn * 64 + c;
#pragma unroll
  for (int i = 0; i < 8; ++i) {
    const int r = i * 8 + (lane >> 3);
    const f32x4 a = *(LDS_AS f32x4*)(reg + r * 272 + c * 4), b = *(LDS_AS f32x4*)(reg + r * 272 + c * 4 + 16);
    u32x4 w = {pk2(a[0], a[1]), pk2(a[2], a[3]), pk2(b[0], b[1]), pk2(b[2], b[3])};
    if (col < ncols) *(u32x4*)(dst + (size_t)(row0 + wm * 128 + HF * 64 + r) * ldc + col) = w;
  }
}
template <int ACT> DI void epi2_store_bf16(const f32x16 (&acc)[4][2], bf16_t* dst, int ldc, int row0, int col0, int ncols, LDS_AS unsigned char* smem) {
  __syncthreads();
  epi2_half_bf16<ACT, 0>(acc, dst, ldc, row0, col0, ncols, smem);
  epi2_half_bf16<ACT, 1>(acc, dst, ldc, row0, col0, ncols, smem);
}
template <int HF> DI void epi2_half_residual(const f32x16 (&acc)[4][2], const float* xin, float* xout, const float* gate, int row0, int col0, LDS_AS unsigned char* smem) {
  const int tid_ = tidx(), lane = tid_ & 63, wave = tid_ >> 6, h = lane >> 5, wm = wave >> 2, wn = wave & 3;
  LDS_AS unsigned char* reg = smem + wave * EPW;
  stage_half<0, HF>(acc, reg, lane, h);
  const int c = (lane & 15) * 4, col = col0 + wn * 64 + c;
  const f32x4 gv = *(const f32x4*)(gate + col);
#pragma unroll
  for (int i = 0; i < 16; ++i) {
    const int r = i * 4 + (lane >> 4);
    const size_t off = (size_t)(row0 + wm * 128 + HF * 64 + r) * 1024 + col;
    const f32x4 a = *(LDS_AS f32x4*)(reg + r * 272 + c * 4), xi = *(const f32x4*)(xin + off);
    f32x4 o;
#pragma unroll
    for (int j = 0; j < 4; ++j) o[j] = xi[j] + gv[j] * a[j];
    *(f32x4*)(xout + off) = o;
  }
}
DI void epi2_residual(const f32x16 (&acc)[4][2], const float* xin, float* xout, const float* gate, int row0, int col0, LDS_AS unsigned char* smem) {
  __syncthreads();
  epi2_half_residual<0>(acc, xin, xout, gate, row0, col0, smem);
  epi2_half_residual<1>(acc, xin, xout, gate, row0, col0, smem);
}

DI void phase_gemm_in(const Params& p, int l, LDS_AS unsigned char* smem, int dry) {
  const bf16_t* W = p.WB + (size_t)l * W_LAYER + W_IN;
  const int NT = 11, ntiles = (T / 256) * NT;
  for (int i = blockIdx.x; i < ntiles; i += gridDim.x) {
    int mt, nt; tile_decode(xcd_remap(i, ntiles), NT, mt, nt);
    f32x16 acc[4][2]; zero_acc2(acc);
    gemm_kloop2(p.H + (size_t)mt * 256 * 1024, 1024, W + (size_t)nt * 256 * 1024, 1024, 16, acc, smem);
    if (!dry) epi2_store_bf16<0>(acc, p.PROJ, PN, mt * 256, nt * 256, PN, smem);
  }
}
DI void phase_gemm_mla(const Params& p, int l, LDS_AS unsigned char* smem, int dry) {
  const bf16_t* WQ = p.WB + (size_t)l * W_LAYER + W_UQ; const bf16_t* WK = p.WB + (size_t)l * W_LAYER + W_UKV;
  const int NT = 7, ntiles = (T / 256) * NT;
  for (int i = blockIdx.x; i < ntiles; i += gridDim.x) {
    int mt, nt; tile_decode(xcd_remap(i, ntiles), NT, mt, nt);
    f32x16 acc[4][2]; zero_acc2(acc);
    if (nt < 3) {
      gemm_kloop2(p.PROJ + (size_t)mt * 256 * PN + C_QLAT, PN, WQ + (size_t)nt * 256 * 256, 256, 4, acc, smem);
      if (!dry) epi2_store_bf16<0>(acc, p.MQ, 768, mt * 256, nt * 256, 768, smem);
    } else {
      gemm_kloop2(p.PROJ + (size_t)mt * 256 * PN + C_KVLAT, PN, WK + (size_t)(nt - 3) * 256 * 128, 128, 2, acc, smem);
      if (!dry) epi2_store_bf16<0>(acc, p.KV, 1024, mt * 256, (nt - 3) * 256, 1024, smem);
    }
  }
}
DI void phase_merge(const Params& p, int l, LDS_AS unsigned char* smem, int dry) {
  const bf16_t* WL = p.WB + (size_t)l * W_LAYER;
  const int NT = 8, MT = (l == 1) ? TL / 256 : T / 256, ntiles = MT * NT;
  bf16_t* M = p.KV;
  for (int i = blockIdx.x; i < ntiles; i += gridDim.x) {
    int mt, nt; tile_decode(xcd_remap(i, ntiles), NT, mt, nt);
    unsigned tp[2][2][8];
#pragma unroll
    for (int a = 0; a < 2; ++a)
#pragma unroll
      for (int b = 0; b < 2; ++b)
#pragma unroll
        for (int e = 0; e < 8; ++e) tp[a][b][e] = 0u;
#pragma unroll 1
    for (int br = 0; br < 3; ++br) {
      unsigned gp[2][2][8];
      {
        f32x16 ag[2][2]; zero_acc(ag);
        gemm_kloop(p.H + (size_t)mt * 256 * 1024, 1024, 64, WL + W_IN + (size_t)(2816 + br * 1024 + nt * 128) * 1024, 1024, 16, ag, smem);
#pragma unroll
        for (int a = 0; a < 2; ++a)
#pragma unroll
          for (int b = 0; b < 2; ++b)
#pragma unroll
            for (int e = 0; e < 8; ++e)
              gp[a][b][e] = pk2(__builtin_amdgcn_rcpf(1.f + __builtin_amdgcn_exp2f(-LOG2E * ag[a][b][2 * e])),
                                __builtin_amdgcn_rcpf(1.f + __builtin_amdgcn_exp2f(-LOG2E * ag[a][b][2 * e + 1])));
      }
      f32x16 ay[2][2]; zero_acc(ay);
      const int lda = (br == 0) ? 768 : PN, kstep = (br == 0) ? 96 : 64;
      const size_t aofs = (br == 0) ? (size_t)T * PN : (size_t)(br == 1 ? C_SQ : C_DQ);
      __builtin_amdgcn_sched_barrier(0);
      gemm_kloop(p.PROJ + aofs + (size_t)mt * 256 * lda, lda, kstep, WL + W_UPM + (size_t)br * 1024 * 512 + (size_t)nt * 128 * 512, 512, 8, ay, smem);
#pragma unroll
      for (int a = 0; a < 2; ++a)
#pragma unroll
        for (int b = 0; b < 2; ++b)
#pragma unroll
          for (int e = 0; e < 8; ++e) {
            const float t0 = __uint_as_float(tp[a][b][e] << 16) + __uint_as_float(gp[a][b][e] << 16) * ay[a][b][2 * e];
            const float t1 = __uint_as_float(tp[a][b][e] & 0xffff0000u) + __uint_as_float(gp[a][b][e] & 0xffff0000u) * ay[a][b][2 * e + 1];
            tp[a][b][e] = pk2(t0, t1);
          }
    }
    if (!dry) {
      f32x16 tot[2][2];
#pragma unroll
      for (int a = 0; a < 2; ++a)
#pragma unroll
        for (int b = 0; b < 2; ++b)
#pragma unroll
          for (int e = 0; e < 8; ++e) { tot[a][b][2 * e] = __uint_as_float(tp[a][b][e] << 16); tot[a][b][2 * e + 1] = __uint_as_float(tp[a][b][e] & 0xffff0000u); }
      epi_store_bf16<0>(tot, M, 1024, mt * 256, nt * 128, 1024, smem);
    }
  }
}
DI void phase_residual_gemm(const Params& p, int l, int which, LDS_AS unsigned char* smem, int dry) {
  const bf16_t* WL = p.WB + (size_t)l * W_LAYER;
  const bf16_t* Abase = which == 0 ? (const bf16_t*)opq(p.KV) : (const bf16_t*)opq(p.PROJ);
  const int K = which == 0 ? 1024 : 4096;
  const bf16_t* W = WL + (which == 0 ? W_O : W_M2);
  const bool first = (which == 0 && l == 0);
  const float* px = opq(p.x); const float* pctx = opq(p.ctx); float* pout = opq(p.out); float* pcx = opq(p.CX);
  const float* slat = first ? px : (const float*)pout; const float* sctx = first ? pctx : (const float*)pcx;
  const float* gofs = p.modtab + (size_t)(l * 5) * 6144 + (which == 0 ? 2048 : 5120);
  {
    const int NT = 4, ntiles = (TL / 256) * NT;
    for (int i = blockIdx.x; i < ntiles; i += gridDim.x) {
      int mt, nt; tile_decode(xcd_remap(i, ntiles), NT, mt, nt);
      f32x16 acc[4][2]; zero_acc2(acc);
      gemm_kloop2(Abase + (size_t)mt * 256 * K, K, W + (size_t)nt * 256 * K, K, K / 64, acc, smem);
      const int row0 = mt * 256;
      if (!dry) epi2_residual(acc, slat, pout, gofs + (size_t)(row0 >> 13) * 6144, row0, nt * 256, smem);
    }
  }
  if (l == 0) {
    const int i = (int)gridDim.x - 1 - (int)blockIdx.x;
    if (i < 32) {
      const int mt = TL / 256 + (i & 3), nt = i >> 2;
      f32x16 acc[2][2]; zero_acc(acc);
      gemm_kloop(Abase + (size_t)mt * 256 * K, K, 64, W + (size_t)nt * 128 * K, K, K / 64, acc, smem);
      if (!dry) epi_residual(acc, sctx, pcx, gofs + (size_t)4 * 6144, mt * 256 - TL, nt * 128, smem);
    }
  }
}
DI void phase_mlp_in(const Params& p, int l, LDS_AS unsigned char* smem, int dry) {
  const bf16_t* W = p.WB + (size_t)l * W_LAYER + W_M1;
  const int NT = 16, MT = (l == 1) ? TL / 256 : T / 256, ntiles = MT * NT;
  bf16_t* U = p.PROJ;
  for (int i = blockIdx.x; i < ntiles; i += gridDim.x) {
    int mt, nt; tile_decode(xcd_remap(i, ntiles), NT, mt, nt);
    f32x16 acc[4][2]; zero_acc2(acc);
    gemm_kloop2(p.H + (size_t)mt * 256 * 1024, 1024, W + (size_t)nt * 256 * 1024, 1024, 16, acc, smem);
    if (!dry) epi2_store_bf16<1>(acc, U, 4096, mt * 256, nt * 256, 4096, smem);
  }
}

DI unsigned ld_u32(const bf16_t* p) { return *(const unsigned*)p; }
DI void unpack4(u32x2 raw, float (&v)[4]) {
  v[0] = __uint_as_float(raw[0] << 16); v[1] = __uint_as_float(raw[0] & 0xffff0000u); v[2] = __uint_as_float(raw[1] << 16); v[3] = __uint_as_float(raw[1] & 0xffff0000u);
}
DI void phase_prep_a(const Params& p, int l, int dry) {
  const int tid_ = tidx(), lane = tid_ & 63, wave = tid_ >> 6, vsel = lane >> 4, j16 = lane & 15;
  const f32x4 gsq = *(const f32x4*)(p.g_swa_q + l * 64 + 4 * j16), gsk = *(const f32x4*)(p.g_swa_k + l * 64 + 4 * j16);
  const f32x4 gdq = *(const f32x4*)(p.g_diff_q + l * 64 + 4 * j16), gdk = *(const f32x4*)(p.g_diff_k + l * 64 + 4 * j16);
  const f32x4 gql = *(const f32x4*)(p.g_q_lora + l * 256 + lane * 4);
  const f32x2 gkl = *(const f32x2*)(p.g_kv_lora + l * 128 + lane * 2);
  float freq[4];
#pragma unroll
  for (int jj = 0; jj < 4; ++jj) freq[jj] = __builtin_amdgcn_exp2f(-(float)(4 * (j16 & 3) + jj) * (13.287712379549449f / 16.f)) * 0.15915494309189535f;
  const float sgn = ((j16 >> 2) & 1) ? 1.f : -1.f;
  const int stride = gridDim.x * 8;
  for (int row0 = blockIdx.x * 8 + wave; row0 < T; row0 += 2 * stride) {
    u32x2 rq[2], rv[2][7]; unsigned rk[2];
#pragma unroll
    for (int t = 0; t < 2; ++t) {
      const int row = (row0 + t * stride < T) ? row0 + t * stride : row0;
      const bf16_t* base = p.PROJ + (size_t)row * PN;
      rq[t] = *(const u32x2*)(base + C_QLAT + lane * 4);
      rk[t] = ld_u32(base + C_KVLAT + lane * 2);
#pragma unroll
      for (int it = 0; it < 7; ++it) rv[t][it] = *(const u32x2*)(base + C_SQ + 64 * (4 * it + vsel) + 4 * j16);
    }
#pragma unroll
    for (int t = 0; t < 2; ++t) {
      const int row = row0 + t * stride;
      if (row >= T) break;
      bf16_t* base = p.PROJ + (size_t)row * PN;
      const bool islat = row < TL;
      float cs[4], sn[4];
      if (islat) {
        const int tt = row & 8191; const float pos = (float)((j16 >> 3) ? (tt & 63) : (tt >> 6));
#pragma unroll
        for (int jj = 0; jj < 4; ++jj) { const float rev = pos * freq[jj]; cs[jj] = __builtin_amdgcn_cosf(rev); sn[jj] = __builtin_amdgcn_sinf(rev); }
      } else {
#pragma unroll
        for (int jj = 0; jj < 4; ++jj) { cs[jj] = 1.f; sn[jj] = 0.f; }
      }
      {
        float v[4]; unpack4(rq[t], v);
        const float ss = wave_sum(v[0] * v[0] + v[1] * v[1] + v[2] * v[2] + v[3] * v[3]);
        const float rstd = rsqrtf(ss * (1.f / 256.f) + EPS);
        u32x2 w = {pk2(v[0] * rstd * gql[0], v[1] * rstd * gql[1]), pk2(v[2] * rstd * gql[2], v[3] * rstd * gql[3])};
        if (!dry) *(u32x2*)(base + C_QLAT + lane * 4) = w;
      }
      {
        const float v0 = __uint_as_float(rk[t] << 16), v1 = __uint_as_float(rk[t] & 0xffff0000u);
        const float ss = wave_sum(v0 * v0 + v1 * v1);
        const float rstd = rsqrtf(ss * (1.f / 128.f) + EPS);
        if (!dry) *(unsigned*)(base + C_KVLAT + lane * 2) = pk2(v0 * rstd * gkl[0], v1 * rstd * gkl[1]);
      }
#pragma unroll
      for (int it = 0; it < 7; ++it) {
        const f32x4 g = (it < 2) ? gsq : (it == 2 ? gsk : (it < 5 ? gdq : gdk));
        const float sc = (it < 2 || it == 3 || it == 4) ? 0.125f * LOG2E : 1.f;
        float v[4]; unpack4(rv[t][it], v);
        float ss = v[0] * v[0] + v[1] * v[1] + v[2] * v[2] + v[3] * v[3];
        ss += __shfl_xor(ss, 8); ss += __shfl_xor(ss, 4); ss += __shfl_xor(ss, 2); ss += __shfl_xor(ss, 1);
        const float rstd = rsqrtf(ss * (1.f / 64.f) + EPS);
        float y[4];
#pragma unroll
        for (int jj = 0; jj < 4; ++jj) {
          const float yy = v[jj] * rstd * g[jj];
          const float pr = __shfl_xor(yy, 4);
          y[jj] = (yy * cs[jj] + sgn * pr * sn[jj]) * sc;
        }
        u32x2 w = {pk2(y[0], y[1]), pk2(y[2], y[3])};
        if (!dry && (it != 2 || vsel < 2)) *(u32x2*)(base + C_SQ + 64 * (4 * it + vsel) + 4 * j16) = w;
      }
    }
  }
}
DI void phase_prep_c(const Params& p, int l, int dry) {
  const int tid_ = tidx(), lane = tid_ & 63, wave = tid_ >> 6, hd = lane >> 3, sub = lane & 7;
  f32x4 gq[3], gk[3];
#pragma unroll
  for (int i = 0; i < 3; ++i) { gq[i] = *(const f32x4*)(p.g_mla_q + l * 96 + 32 * i + 4 * sub); gk[i] = *(const f32x4*)(p.g_mla_k + l * 96 + 32 * i + 4 * sub); }
  float freq[4];
#pragma unroll
  for (int jj = 0; jj < 4; ++jj) freq[jj] = __builtin_amdgcn_exp2f(-(float)(4 * (sub & 1) + jj) * (13.287712379549449f / 8.f)) * 0.15915494309189535f;
  const float sgn = ((sub >> 1) & 1) ? 1.f : -1.f;
  const float qs = 0.10206207261596575f * LOG2E;
  const int stride = gridDim.x * 8;
  for (int row0 = blockIdx.x * 8 + wave; row0 < T; row0 += 2 * stride) {
    u32x2 rq[2][3], rkv[2][2], rpe[2];
#pragma unroll
    for (int t = 0; t < 2; ++t) {
      const int row = (row0 + t * stride < T) ? row0 + t * stride : row0;
#pragma unroll
      for (int i = 0; i < 3; ++i) rq[t][i] = *(const u32x2*)(p.MQ + (size_t)row * 768 + hd * 96 + 32 * i + 4 * sub);
#pragma unroll
      for (int i = 0; i < 2; ++i) rkv[t][i] = *(const u32x2*)(p.KV + (size_t)row * 1024 + hd * 128 + 32 * i + 4 * sub);
      rpe[t] = *(const u32x2*)(p.PROJ + (size_t)row * PN + C_KPE + 4 * sub);
    }
#pragma unroll
    for (int t = 0; t < 2; ++t) {
      const int row = row0 + t * stride;
      if (row >= T) break;
      const bool islat = row < TL;
      float cs[4], sn[4];
      if (islat) {
        const int tt = row & 8191; const float pos = (float)((sub >> 2) ? (tt & 63) : (tt >> 6));
#pragma unroll
        for (int jj = 0; jj < 4; ++jj) { const float rev = pos * freq[jj]; cs[jj] = __builtin_amdgcn_cosf(rev); sn[jj] = __builtin_amdgcn_sinf(rev); }
      } else {
#pragma unroll
        for (int jj = 0; jj < 4; ++jj) { cs[jj] = 1.f; sn[jj] = 0.f; }
      }
#pragma unroll
      for (int qk = 0; qk < 2; ++qk) {
        float v[3][4];
        if (qk == 0) { unpack4(rq[t][0], v[0]); unpack4(rq[t][1], v[1]); unpack4(rq[t][2], v[2]); }
        else { unpack4(rkv[t][0], v[0]); unpack4(rkv[t][1], v[1]); unpack4(rpe[t], v[2]); }
        float ss = 0.f;
#pragma unroll
        for (int i = 0; i < 3; ++i)
#pragma unroll
          for (int jj = 0; jj < 4; ++jj) ss += v[i][jj] * v[i][jj];
        ss += __shfl_xor(ss, 4); ss += __shfl_xor(ss, 2); ss += __shfl_xor(ss, 1);
        const float rstd = rsqrtf(ss * (1.f / 96.f) + EPS);
        const float osc = (qk == 0) ? qs : 1.f;
        u32x2 w[3];
#pragma unroll
        for (int i = 0; i < 3; ++i) {
          float y[4];
#pragma unroll
          for (int jj = 0; jj < 4; ++jj) {
            const float gg = (qk == 0) ? gq[i][jj] : gk[i][jj];
            float yy = v[i][jj] * rstd * gg;
            if (i == 2) { const float pr = __shfl_xor(yy, 2); yy = yy * cs[jj] + sgn * pr * sn[jj]; }
            y[jj] = yy * osc;
          }
          w[i][0] = pk2(y[0], y[1]); w[i][1] = pk2(y[2], y[3]);
        }
        bf16_t* dst = (qk == 0 ? p.MQ : p.KM) + (size_t)row * 768 + hd * 96 + 4 * sub;
        if (!dry) {
#pragma unroll
          for (int i = 0; i < 3; ++i) *(u32x2*)(dst + 32 * i) = w[i];
        }
      }
    }
  }
}

struct AttnArgs {
  const bf16_t* q; int qpitch;
  const bf16_t* k; int kpitch;
  const bf16_t* v; int vpitch;
  bf16_t* o; int opitch;
  int krow_ctx, krow_lat;
  int nct, lt0, lt1;
  int qrow0, qpos0;
  float mb, sinkterm;
  float lam, osc; const float* gsub;
  int dry;
  bf16_t* o0;
};

template <int QSTEPS> DI void load_q(const AttnArgs& a, int colofs, bf16x8 (&qf)[QSTEPS]) {
  const int tid_ = tidx(), lane = tid_ & 63, wave = tid_ >> 6, h = lane >> 5, l32 = lane & 31;
  const bf16_t* qr = a.q + (size_t)(a.qrow0 + wave * 32 + l32) * a.qpitch + 8 * h + colofs;
#pragma unroll
  for (int s = 0; s < QSTEPS; ++s) qf[s] = *(const bf16x8*)(qr + s * 16);
}
template <int NKA, bool KB, int DV, int EPI, bool WIN>
DI void attn_item(const AttnArgs& a, const bf16x8 (&qfr)[4 + (KB ? 2 : 0)], int kcolofs, LDS_AS unsigned char* smem) {
  const int tid_ = tidx(), lane = tid_ & 63, wave = tid_ >> 6, h = lane >> 5, l32 = lane & 31;
  constexpr int NMAP = 1;
  constexpr int QSTEPS = 4 + (KB ? 2 : 0);
  constexpr int NDB = DV / 32;
  constexpr int VP = DV * 2;
  constexpr int AST = 24576, NST = 4;
  constexpr int NLD = 1 + (KB ? 1 : 0) + (DV == 64 ? 1 : 2);
  const int ntile = a.nct + (a.lt1 - a.lt0);
  unsigned kaoff, kboff = 0, voff[DV == 64 ? 1 : 2];
  { const int r = wave * 8 + (lane >> 3), c = (lane & 7) ^ ((r >> 1) & 7); kaoff = (unsigned)(r * a.kpitch + c * 8) * 2u; }
  if (KB) { const int r = (wave & 3) * 16 + (lane >> 2), c = (lane & 3) ^ ((r >> 2) & 3); kboff = (unsigned)(r * a.kpitch + 64 + c * 8) * 2u; }
  if (DV == 64) {
    const int r = wave * 8 + (lane >> 3), c = (lane & 7) ^ (((r >> 1) & 1) << 2); voff[0] = (unsigned)(r * a.vpitch + c * 8) * 2u;
  } else {
#pragma unroll
    for (int j = 0; j < 2; ++j) { const int r = (j * 8 + wave) * 4 + (lane >> 4), c = (lane & 15) ^ ((r & 3) << 2); voff[j] = (unsigned)(r * a.vpitch + c * 8) * 2u; }
  }
  const unsigned ldst = (unsigned)__builtin_amdgcn_readfirstlane((int)(lds_u32(smem) + wave * 1024));
  const unsigned ldstb = (unsigned)__builtin_amdgcn_readfirstlane((int)(lds_u32(smem) + 16384 + (wave & 3) * 1024));
  auto issue = [&](int ti, int stg) {
    const int trow = (ti < a.nct) ? (a.krow_ctx + ti * 64) : (a.krow_lat + (a.lt0 + ti - a.nct) * 64);
    const char* kb = (const char*)(a.k + (size_t)trow * a.kpitch + kcolofs); const char* vb = (const char*)(a.v + (size_t)trow * a.vpitch);
    const unsigned d = ldst + stg * AST;
    glds16a(kb, kaoff, d);
    if (KB) glds16a(kb, kboff, ldstb + stg * AST);
#pragma unroll
    for (int j = 0; j < (DV == 64 ? 1 : 2); ++j) glds16a(vb, voff[j], d + 8192 + j * 8192);
  };
  const int kswzA = (lane >> 1) & 7, kswzB = (lane >> 2) & 3;
  const int krowA = l32 * 128, krowB = l32 * 64;
  int vbase[NDB];
  {
    const int l16 = lane & 15, qq = l16 >> 2, pp = l16 & 3, g16 = (lane >> 4) & 1;
#pragma unroll
    for (int db = 0; db < NDB; ++db) {
      const int cl = 2 * g16 + (pp >> 1);
      const int c = (DV == 64) ? (4 * (db ^ (qq >> 1)) + cl) : (4 * (db ^ qq) + cl);
      vbase[db] = (4 * h + qq) * VP + c * 16 + (pp & 1) * 8;
    }
  }
  f32x16 O[NMAP][NDB];
#pragma unroll
  for (int m = 0; m < NMAP; ++m)
#pragma unroll
    for (int db = 0; db < NDB; ++db)
#pragma unroll
      for (int i = 0; i < 16; ++i) O[m][db][i] = 0.f;
  float lsum[NMAP];
#pragma unroll
  for (int m = 0; m < NMAP; ++m) lsum[m] = 0.f;
  const float negmb = -a.mb;
  const int qpos = a.qpos0 + wave * 32 + l32;

#pragma unroll
  for (int s = 0; s < QSTEPS; ++s) asm volatile("" ::"v"(qfr[s]));
  asm volatile("s_waitcnt vmcnt(0)" ::: "memory");
  __syncthreads();
  issue(0, 0);
  if (ntile > 1) issue(1, 1);
  if (ntile > 2) issue(2, 2);
#pragma unroll 1
  for (int ti = 0; ti < ntile; ++ti) {
    const int rem = ntile - 1 - ti;
    if (rem >= 2) { if (NLD == 2) asm volatile("s_waitcnt vmcnt(4)" ::: "memory"); else asm volatile("s_waitcnt vmcnt(6)" ::: "memory"); }
    else if (rem == 1) { if (NLD == 2) asm volatile("s_waitcnt vmcnt(2)" ::: "memory"); else asm volatile("s_waitcnt vmcnt(3)" ::: "memory"); }
    else asm volatile("s_waitcnt vmcnt(0)" ::: "memory");
    __builtin_amdgcn_s_barrier();
    asm volatile("" ::: "memory");
    if (ti + 3 < ntile) issue(ti + 3, (ti + 3) & 3);
    __builtin_amdgcn_sched_barrier(0);
    LDS_AS unsigned char* st = smem + (ti & 3) * AST;
    LDS_AS unsigned char* sv = st + 8192;
    auto readK = [&](int kb, bf16x8 (&kf)[QSTEPS]) {
      LDS_AS unsigned char* ka = st + kb * 32 * 128 + krowA;
#pragma unroll
      for (int s = 0; s < 4; ++s) kf[s] = lds128(ka + (((2 * s + h) ^ kswzA) << 4));
      if (KB) {
        LDS_AS unsigned char* kbp = st + 16384 + kb * 32 * 64 + krowB;
#pragma unroll
        for (int s = 0; s < 2; ++s) kf[4 + s] = lds128(kbp + (((2 * s + h) ^ kswzB) << 4));
      }
    };
    auto readV = [&](int kb, bf16x8 (&vf)[2][NDB]) {
#pragma unroll
      for (int s = 0; s < 2; ++s)
#pragma unroll
        for (int db = 0; db < NDB; ++db) {
          const int rc = (kb * 32 + 16 * s) * VP;
          const s16x4 lo = __builtin_amdgcn_ds_read_tr16_b64_v4i16((LDS_AS s16x4*)(sv + vbase[db] + rc));
          const s16x4 hi = __builtin_amdgcn_ds_read_tr16_b64_v4i16((LDS_AS s16x4*)(sv + vbase[db] + rc + 8 * VP));
          vf[s][db] = __builtin_shufflevector(lo, hi, 0, 1, 2, 3, 4, 5, 6, 7);
        }
    };
    auto qk = [&](const bf16x8 (&kf)[QSTEPS], f32x16& S) {
#pragma unroll
      for (int i = 0; i < 16; ++i) S[i] = (DV == 128) ? 0.f : negmb;
#pragma unroll
      for (int s = 0; s < QSTEPS; ++s) S = MFMA32(kf[s], qfr[s], S);
    };
    auto softmax = [&](int kb, f32x16& S, bf16x8 (&pb)[2]) {
      if (WIN) {
        if (ti >= a.nct) {
          const int kp0 = (a.lt0 + ti - a.nct) * 64 + 4 * h - qpos + kb * 32;
#pragma unroll
          for (int i = 0; i < 16; ++i) {
            const int dlt = kp0 + (i & 3) + 8 * (i >> 2);
            if (dlt > 128 || dlt < -128) S[i] = -INFINITY;
          }
        }
      }
      float ls = 0.f;
#pragma unroll
      for (int i = 0; i < 16; ++i) { S[i] = __builtin_amdgcn_exp2f((DV == 128) ? S[i] + negmb : S[i]); ls += S[i]; }
      lsum[0] += ls;
#pragma unroll
      for (int s = 0; s < 2; ++s) {
        u32x4 pw;
#pragma unroll
        for (int j = 0; j < 4; ++j) pw[j] = pk2(S[8 * s + 2 * j], S[8 * s + 2 * j + 1]);
        pb[s] = __builtin_bit_cast(bf16x8, pw);
      }
    };
    auto pv = [&](const bf16x8 (&vf)[2][NDB], const bf16x8 (&pb)[2]) {
#pragma unroll
      for (int s = 0; s < 2; ++s)
#pragma unroll
        for (int db = 0; db < NDB; ++db) O[0][db] = MFMA32(vf[s][db], pb[s], O[0][db]);
    };
    {
      bf16x8 kf0[QSTEPS], kf1[QSTEPS], vf0[2][NDB], vf1[2][NDB], p0[2], p1[2];
      f32x16 S0, S1;
      readK(0, kf0); readV(0, vf0);
      __builtin_amdgcn_sched_barrier(0);
      qk(kf0, S0);
      __builtin_amdgcn_sched_barrier(0);
      readK(1, kf1);
      __builtin_amdgcn_sched_barrier(0);
      qk(kf1, S1);
      __builtin_amdgcn_sched_barrier(0);
      softmax(0, S0, p0);
      __builtin_amdgcn_sched_barrier(0);
      pv(vf0, p0);
      __builtin_amdgcn_sched_barrier(0);
      readV(1, vf1);
      __builtin_amdgcn_sched_barrier(0);
      softmax(1, S1, p1);
      __builtin_amdgcn_sched_barrier(0);
      pv(vf1, p1);
      __builtin_amdgcn_sched_barrier(0);
    }
  }
  const float lt = lsum[0] + __shfl_xor(lsum[0], 32) + a.sinkterm;
  const float inv = 1.f / lt;
  bf16_t* orow = a.o + (size_t)(a.qrow0 + wave * 32 + l32) * a.opitch + 4 * h;
  if (a.dry) return;
  if (EPI == 0) {
#pragma unroll
    for (int db = 0; db < NDB; ++db)
#pragma unroll
      for (int g = 0; g < 4; ++g) {
        u32x2 w = {pk2(O[0][db][4 * g] * inv, O[0][db][4 * g + 1] * inv), pk2(O[0][db][4 * g + 2] * inv, O[0][db][4 * g + 3] * inv)};
        *(u32x2*)(orow + db * 32 + 8 * g) = w;
      }
  } else {
    const float c1 = inv * a.lam;
    float ss = 0.f;
#pragma unroll
    for (int db = 0; db < NDB; ++db)
#pragma unroll
      for (int g = 0; g < 4; ++g) {
        const u32x2 raw = *(const u32x2*)(a.o0 + (size_t)(a.qrow0 + wave * 32 + l32) * 512 + 4 * h + db * 32 + 8 * g);
        const float o0[4] = {__uint_as_float(raw[0] << 16), __uint_as_float(raw[0] & 0xffff0000u), __uint_as_float(raw[1] << 16), __uint_as_float(raw[1] & 0xffff0000u)};
#pragma unroll
        for (int j = 0; j < 4; ++j) { const float v = o0[j] - O[0][db][4 * g + j] * c1; O[0][db][4 * g + j] = v; ss += v * v; }
      }
    ss += __shfl_xor(ss, 32);
    const float rstd = rsqrtf(ss * (1.f / (float)DV) + EPS) * a.osc;
#pragma unroll
    for (int db = 0; db < NDB; ++db)
#pragma unroll
      for (int g = 0; g < 4; ++g) {
        const f32x4 gs = *(const f32x4*)(a.gsub + db * 32 + 8 * g + 4 * h);
        u32x2 w = {pk2(O[0][db][4 * g] * rstd * gs[0], O[0][db][4 * g + 1] * rstd * gs[1]), pk2(O[0][db][4 * g + 2] * rstd * gs[2], O[0][db][4 * g + 3] * rstd * gs[3])};
        *(u32x2*)(orow + db * 32 + 8 * g) = w;
      }
  }
}

DI void attn_diff_item(const AttnArgs& a, LDS_AS unsigned char* smem) {
  AttnArgs a0 = a; a0.o = a.o0; a0.opitch = 512; a0.dry = 0;
  { bf16x8 q0[4]; load_q<4>(a, 0, q0); attn_item<1, false, 128, 0, false>(a0, q0, 0, smem); }
  { bf16x8 q1[4]; load_q<4>(a, 64, q1); attn_item<1, false, 128, 1, false>(a, q1, 64, smem); }
}

DI void phase_attention(const Params& p, int l, LDS_AS unsigned char* smem, int dry) {
  const float* cs = p.consts + l * 16;
  const float lam = cs[0], lam_init = cs[1], mb_mla = cs[2], mb_swa = cs[3], mb_diff = cs[4];
  const int nc_d = (l == 0) ? 16 : 0, nc_m = (l == 0) ? 32 : 0;
#pragma unroll 1
  for (int i = blockIdx.x; i < 512 + nc_d; i += gridDim.x) {
    AttnArgs a; a.dry = dry;
    int b, hd;
    if (i < 512) {
      const int id = xcd_remap(i, 512), pair = id >> 5, qb = id & 31; b = pair >> 2; hd = pair & 3;
      a.lt0 = 0; a.lt1 = 128; a.qrow0 = b * 8192 + qb * 256;
    } else {
      const int j = i - 512; b = j >> 2; hd = j & 3;
      a.lt0 = 0; a.lt1 = 0; a.qrow0 = TL + b * 256;
    }
    a.q = p.PROJ + C_DQ + hd * 128; a.qpitch = PN; a.k = p.PROJ + C_DK + hd * 128; a.kpitch = PN; a.v = p.PROJ + C_DV + hd * 128; a.vpitch = PN;
    a.o = p.PROJ + C_DQ + hd * 128; a.opitch = PN; a.o0 = p.YD0 + hd * 128;
    a.krow_ctx = TL + b * 256; a.krow_lat = b * 8192; a.nct = 4; a.qpos0 = 0;
    a.mb = mb_diff; a.sinkterm = 0.f; a.lam = lam; a.osc = 1.f - lam_init; a.gsub = p.g_diff_sub + l * 128;
    attn_diff_item(a, smem);
  }
#pragma unroll 1
  for (int i = blockIdx.x; i < 1024 + nc_m; i += gridDim.x) {
    AttnArgs a; a.dry = dry;
    int b, hd;
    if (i < 1024) {
      const int id = xcd_remap(i, 1024), pair = id >> 5, qb = id & 31; b = pair >> 3; hd = pair & 7;
      a.lt0 = 0; a.lt1 = 128; a.qrow0 = b * 8192 + qb * 256;
    } else {
      const int j = i - 1024; b = j >> 3; hd = j & 7;
      a.lt0 = 0; a.lt1 = 0; a.qrow0 = TL + b * 256;
    }
    a.q = p.MQ + hd * 96; a.qpitch = 768; a.k = p.KM + hd * 96; a.kpitch = 768; a.v = p.KV + hd * 128 + 64; a.vpitch = 1024;
    a.o = p.MQ + hd * 96; a.opitch = 768; a.o0 = nullptr;
    a.krow_ctx = TL + b * 256; a.krow_lat = b * 8192; a.nct = 4; a.qpos0 = 0;
    a.mb = mb_mla; a.sinkterm = 0.f; a.lam = 0.f; a.osc = 0.f; a.gsub = nullptr;
    bf16x8 qf[6]; load_q<6>(a, 0, qf);
    attn_item<1, true, 64, 0, false>(a, qf, 0, smem);
  }
#pragma unroll 1
  for (int i = blockIdx.x; i < 1024 + nc_m; i += gridDim.x) {
    AttnArgs a; a.dry = dry;
    int b, hq;
    if (i < 1024) {
      const int id = xcd_remap(i, 1024), pair = id >> 5, qb = id & 31; b = pair >> 3; hq = pair & 7;
      a.lt0 = (4 * qb - 2 < 0) ? 0 : 4 * qb - 2; a.lt1 = (4 * qb + 6 > 128) ? 128 : 4 * qb + 6;
      a.qrow0 = b * 8192 + qb * 256; a.qpos0 = qb * 256;
    } else {
      const int j = i - 1024; b = j >> 3; hq = j & 7;
      a.lt0 = 0; a.lt1 = 0; a.qrow0 = TL + b * 256; a.qpos0 = 0;
    }
    const int kvh = hq >> 2;
    a.q = p.PROJ + C_SQ + hq * 64; a.qpitch = PN; a.k = p.PROJ + C_SK + kvh * 64; a.kpitch = PN; a.v = p.PROJ + C_SV + kvh * 64; a.vpitch = PN;
    a.o = p.PROJ + C_SQ + hq * 64; a.opitch = PN; a.o0 = nullptr;
    a.krow_ctx = TL + b * 256; a.krow_lat = b * 8192; a.nct = 4;
    a.mb = mb_swa; a.sinkterm = __builtin_amdgcn_exp2f(p.swa_sink[l * 8 + hq] * LOG2E - mb_swa); a.lam = 0.f; a.osc = 0.f; a.gsub = nullptr;
    bf16x8 qf[4]; load_q<4>(a, 0, qf);
    attn_item<1, false, 64, 0, true>(a, qf, 0, smem);
  }
}

constexpr int NPH = 1 + 2 * 11;
DI void run_phase(const Params& p, int ph, LDS_AS unsigned char* smem, int dry) {
#ifdef ONLY_S
  if (ONLY_S == 99) { if (ph == 0) phase0(p, smem, dry); return; }
  if (ph == 0) return;
  const int l = (ph - 1) / 11, s = ONLY_S;
#else
  if (ph == 0) { phase0(p, smem, dry); return; }
  const int l = (ph - 1) / 11, s = (ph - 1) % 11;
#endif
  switch (s) {
    case 0: norm_phase(p, l, 0, dry); break;
    case 1: phase_gemm_in(p, l, smem, dry); break;
    case 2: phase_prep_a(p, l, dry); break;
    case 3: phase_gemm_mla(p, l, smem, dry); break;
    case 4: phase_prep_c(p, l, dry); break;
    case 5: phase_attention(p, l, smem, dry); break;
    case 6: phase_merge(p, l, smem, dry); break;
    case 7: phase_residual_gemm(p, l, 0, smem, dry); break;
    case 8: norm_phase(p, l, 1, dry); break;
    case 9: phase_mlp_in(p, l, smem, dry); break;
    default: phase_residual_gemm(p, l, 1, smem, dry); break;
  }
}

__global__ void __launch_bounds__(512, 2) mega_kernel(Params p) {
  __shared__ __attribute__((aligned(16))) unsigned char smem_raw[3 * GST];
  LDS_AS unsigned char* smem = (LDS_AS unsigned char*)smem_raw;
  __shared__ uint4 xb_words;
  cg::grid_group grid = cg::this_grid();
  if (threadIdx.x == 0) xb_words = make_uint4(0u, 0u, 0u, 0u);
  __syncthreads();
  const XcdBarrier xb = xcd_barrier_post(p.bar, (volatile LDS_AS unsigned*)&xb_words);
#pragma unroll 1
  for (int ph = 0; ph < NPH; ++ph) {
    const int st = (ph == 0) ? 31 : (ph - 1) % 11;
    const int nrep = (((unsigned)p.probe >> st) & 1u) ? 2 : 1;
    for (int rep = 0; rep < nrep; ++rep) run_phase(p, ph, smem, rep + 1 < nrep);
    if (ph + 1 < NPH) { if (ph == 0) grid.sync(); else xcd_barrier(xb); }
  }
}
#ifdef MK_MULTI
__global__ void __launch_bounds__(512, 2) phase_kernel(Params p, int ph) {
  __shared__ __attribute__((aligned(16))) unsigned char smem_raw[3 * GST];
  run_phase(p, ph, (LDS_AS unsigned char*)smem_raw, 0);
}
#endif

extern "C" void kernel_launch(void* const* d_in, const int* in_sizes, int n_in, void* d_out, int out_size, void* d_ws, size_t ws_size,
                              hipStream_t stream) {
  Params p{};
  const float* const* in = (const float* const*)d_in;
  p.x = in[0]; p.c = in[1]; p.ctx = in[2]; p.c_ctx = in[3]; p.w_mod = in[4]; p.b_mod = in[5]; p.g_norm_attn = in[6]; p.g_norm_mlp = in[7];
  p.w_in = in[8]; p.g_q_lora = in[9]; p.w_uq = in[10]; p.g_kv_lora = in[11]; p.w_ukv = in[12]; p.g_mla_q = in[13]; p.g_mla_k = in[14];
  p.w_up_mla = in[15]; p.g_swa_q = in[16]; p.g_swa_k = in[17]; p.swa_sink = in[18]; p.w_up_swa = in[19]; p.g_diff_q = in[20]; p.g_diff_k = in[21];
  p.lambda_q1 = in[22]; p.lambda_k1 = in[23]; p.lambda_q2 = in[24]; p.lambda_k2 = in[25]; p.g_diff_sub = in[26]; p.w_up_diff = in[27];
  p.w_o = in[28]; p.w_mlp_in = in[29]; p.w_mlp_out = in[30];
#ifndef PROBE_MASK
#define PROBE_MASK 0
#endif
  p.probe = PROBE_MASK; p.pad_ = 0;
  p.out = (float*)d_out;
  unsigned char* ws = (unsigned char*)d_ws;
  size_t off = 0;
  auto take = [&](size_t bytes) { unsigned char* r = ws + off; off += (bytes + 255) & ~(size_t)255; return r; };
  p.modtab = (float*)take(2 * 5 * 6144 * 4);
  p.consts = (float*)take(256);
  p.bar = (unsigned*)take(XCD_BAR_WORDS * 4);
  p.WB = (bf16_t*)take(2 * W_LAYER * 2);
  p.H = (bf16_t*)take((size_t)T * 1024 * 2);
  p.PROJ = (bf16_t*)take((size_t)T * PN * 2);
  p.MQ = (bf16_t*)take((size_t)T * 768 * 2);
  p.KV = (bf16_t*)take((size_t)T * 1024 * 2);
  p.KM = (bf16_t*)take((size_t)T * 768 * 2);
  p.CX = (float*)take((size_t)TC * 1024 * 4);
  p.YD0 = (bf16_t*)take((size_t)T * 512 * 2);
  if (off > ws_size) { fprintf(stderr, "workspace too small: need %zu have %zu\n", off, ws_size); return; }
  (void)hipMemsetAsync(p.modtab, 0, (size_t)((unsigned char*)p.bar - (unsigned char*)p.modtab) + XCD_BAR_WORDS * 4, stream);
#ifdef MK_MULTI
  for (int ph = 0; ph < NPH; ++ph) phase_kernel<<<256, 512, 0, stream>>>(p, ph);
#else
  static int grid_blocks = 0;
  if (!grid_blocks) {
    int dev = 0, cus = 0, per_cu = 0;
    hipGetDevice(&dev);
    hipDeviceGetAttribute(&cus, hipDeviceAttributeMultiprocessorCount, dev);
    hipOccupancyMaxActiveBlocksPerMultiprocessor(&per_cu, mega_kernel, 512, 0);
    if (per_cu > 1) per_cu = 1;
    grid_blocks = cus * per_cu;
    if (grid_blocks <= 0) grid_blocks = 256;
  }
  void* args[] = {&p};
  hipError_t e = hipLaunchCooperativeKernel((void*)mega_kernel, dim3(grid_blocks), dim3(512), args, 0, stream);
  if (e != hipSuccess) fprintf(stderr, "cooperative launch failed: %s (grid %d)\n", hipGetErrorString(e), grid_blocks);
#endif
}
```

```cpp
#include <hip/hip_runtime.h>
#include <hip/hip_cooperative_groups.h>
#include <cstdio>
#include <cstdint>
namespace cg = cooperative_groups;

typedef unsigned short bf16_t;
typedef short bf16x8 __attribute__((ext_vector_type(8)));
typedef short s16x4 __attribute__((ext_vector_type(4)));
typedef float f32x16 __attribute__((ext_vector_type(16)));
typedef float f32x4 __attribute__((ext_vector_type(4)));
typedef float f32x2 __attribute__((ext_vector_type(2)));
typedef __bf16 bf16x2_t __attribute__((ext_vector_type(2)));
typedef unsigned u32x2 __attribute__((ext_vector_type(2)));
typedef unsigned u32x4 __attribute__((ext_vector_type(4)));
#define LDS_AS __attribute__((address_space(3)))
#define DI __device__ __forceinline__

constexpr int D = 1024, NB = 4, SEQ = 8192, NCTX = 256;
constexpr int TL = NB * SEQ;
constexpr int TC = NB * NCTX;
constexpr int T = TL + TC;
constexpr int PN = 2720;
constexpr int C_QLAT = 0, C_KVLAT = 256, C_KPE = 384, C_SQ = 416, C_SK = 928, C_SV = 1056, C_DQ = 1184, C_DK = 1696, C_DV = 2208;
constexpr float EPS = 1e-6f;
constexpr float LOG2E = 1.4426950408889634f;
constexpr size_t W_IN = 0;
constexpr size_t W_UQ = W_IN + (size_t)5888 * 1024;
constexpr size_t W_UKV = W_UQ + 768 * 256;
constexpr size_t W_UPM = W_UKV + 1024 * 128;
constexpr size_t W_UPS = W_UPM + 1024 * 512;
constexpr size_t W_UPD = W_UPS + 1024 * 512;
constexpr size_t W_O = W_UPD + 1024 * 512;
constexpr size_t W_M1 = W_O + 1024 * 1024;
constexpr size_t W_M2 = W_M1 + (size_t)4096 * 1024;
constexpr size_t W_LAYER = W_M2 + (size_t)4096 * 1024;

struct Params {
  const float *x, *c, *ctx, *c_ctx, *w_mod, *b_mod, *g_norm_attn, *g_norm_mlp, *w_in, *g_q_lora, *w_uq, *g_kv_lora, *w_ukv,
      *g_mla_q, *g_mla_k, *w_up_mla, *g_swa_q, *g_swa_k, *swa_sink, *w_up_swa, *g_diff_q, *g_diff_k, *lambda_q1, *lambda_k1,
      *lambda_q2, *lambda_k2, *g_diff_sub, *w_up_diff, *w_o, *w_mlp_in, *w_mlp_out;
  float* out;
  float* modtab;
  float* consts;
  unsigned* bar;
  bf16_t* WB;
  bf16_t* H;
  bf16_t* PROJ;
  bf16_t* MQ;
  bf16_t* KV;
  bf16_t* KM;
  float* CX;
  bf16_t* YD0;
  int probe, pad_;
};

template <class Tp> DI Tp* opq(Tp* ptr) { asm volatile("" : "+s"(ptr)); return ptr; }
DI int tidx() { int t = threadIdx.x; asm volatile("" : "+v"(t)); return t; }
DI float bf2f(bf16_t v) { return __uint_as_float((unsigned)v << 16); }
DI unsigned pk2(float a, float b) { f32x2 v = {a, b}; bf16x2_t r = __builtin_convertvector(v, bf16x2_t); return __builtin_bit_cast(unsigned, r); }
DI bf16_t f2bf(float a) { return (bf16_t)(pk2(a, 0.f) & 0xffffu); }
DI float wave_sum(float v) {
#pragma unroll
  for (int o = 32; o; o >>= 1) v += __shfl_xor(v, o);
  return v;
}
DI float wave_max(float v) {
#pragma unroll
  for (int o = 32; o; o >>= 1) v = fmaxf(v, __shfl_xor(v, o));
  return v;
}
DI float silu(float x) { return x / (1.f + __expf(-x)); }
DI int xcd_remap(int L, int n) {
  const int q = n >> 3, r = n & 7, xcd = L & 7, off = L >> 3;
  return (xcd < r ? xcd * (q + 1) : r * (q + 1) + (xcd - r) * q) + off;
}
DI void glds16(const void* g, LDS_AS unsigned char* l) {
  __builtin_amdgcn_global_load_lds((const unsigned*)g, (LDS_AS unsigned*)l, 16, 0, 0);
}
DI void glds16a(const void* base, unsigned voff, unsigned ldsaddr) {
  unsigned keep;
  asm volatile("s_mov_b32 %0, m0\n\ts_mov_b32 m0, %3\n\ts_nop 0\n\tglobal_load_lds_dwordx4 %1, %2\n\ts_mov_b32 m0, %0"
               : "=&s"(keep) : "v"(voff), "s"(base), "s"(ldsaddr) : "memory");
}
DI unsigned lds_u32(LDS_AS unsigned char* p) { return (unsigned)(uintptr_t)p; }
DI bf16x8 lds128(LDS_AS unsigned char* p) { return *(LDS_AS bf16x8*)p; }
#define MFMA32(a, b, c) __builtin_amdgcn_mfma_f32_32x32x16_bf16((a), (b), (c), 0, 0, 0)

#define XB_TMO      128
#define XB_XCNT(j)  (256  + 64 * (j))
#define XB_XSUB(j)  (1280 + 64 * (j))
#define XB_XGEN(j)  (2304 + 64 * (j))
#define XB_TOP      3328
#define XB_TOPGEN   3392
#define XCD_BAR_WORDS 3456
#define XB_SPIN_CAP (1u << 22)
DI unsigned xb_ld(unsigned* p) { return __hip_atomic_load(p, __ATOMIC_RELAXED, __HIP_MEMORY_SCOPE_AGENT); }
DI unsigned xb_add(unsigned* p, unsigned v) { return __hip_atomic_fetch_add(p, v, __ATOMIC_RELAXED, __HIP_MEMORY_SCOPE_AGENT); }
DI unsigned xb_xcc_id() { return (unsigned)__builtin_amdgcn_s_getreg((3 << 11) | 20) & 0xFu; }
#define XB_SPIN(cond, bar) do { unsigned _sp = 0; while (cond) { __builtin_amdgcn_s_sleep(1); \
    if ((++_sp & 255u) == 0u) { if (xb_ld(&(bar)[XB_TMO])) break; if (_sp > XB_SPIN_CAP) { atomicAdd(&(bar)[XB_TMO], 1u); break; } } } } while (0)
struct XcdBarrier { unsigned* bar; unsigned x; volatile LDS_AS unsigned* st; };
DI XcdBarrier xcd_barrier_post(unsigned* bar, volatile LDS_AS unsigned* st) {
  XcdBarrier b; b.bar = bar; b.x = xb_xcc_id(); b.st = st;
  if (threadIdx.x == 0) (void)xb_add(&bar[XB_XCNT(b.x)], 1u);
  return b;
}
DI void xcd_barrier_complete(unsigned* bar, unsigned x, unsigned& nloc, unsigned& nx) {
  const unsigned G = gridDim.x * gridDim.y * gridDim.z;
  unsigned sum, cnt, mine, sp = 0u;
  for (;;) {
    sum = 0u; cnt = 0u; mine = 0u;
#pragma unroll
    for (unsigned j = 0; j < 16; ++j) { const unsigned c = xb_ld(&bar[XB_XCNT(j)]); sum += c; cnt += (c > 0u) ? 1u : 0u; mine = (j == x) ? c : mine; }
    if (sum == G) break;
    __builtin_amdgcn_s_sleep(1);
    if ((++sp & 255u) == 0u) { if (xb_ld(&bar[XB_TMO])) break; if (sp > XB_SPIN_CAP) { atomicAdd(&bar[XB_TMO], 1u); break; } }
  }
  nloc = mine > 0u ? mine : 1u; nx = cnt > 0u ? cnt : 1u;
}
DI void xcd_barrier(const XcdBarrier& b) {
  asm volatile("s_waitcnt vmcnt(0)" ::: "memory");
  __syncthreads();
  if (threadIdx.x == 0) {
    unsigned* bar = b.bar;
    __builtin_amdgcn_s_waitcnt(0);
    unsigned nloc = b.st[0], nx = b.st[1];
    if (nloc == 0u) { xcd_barrier_complete(bar, b.x, nloc, nx); b.st[0] = nloc; b.st[1] = nx; }
    const unsigned old = xb_add(&bar[XB_XSUB(b.x)], 1u);
    const unsigned gen = old / nloc;
    if (old + 1u == (gen + 1u) * nloc) {
      __builtin_amdgcn_fence(__ATOMIC_RELEASE, "agent");
      asm volatile("s_waitcnt vmcnt(0)" ::: "memory");
      const unsigned og = xb_add(&bar[XB_TOP], 1u);
      const unsigned tg = og / nx;
      if (og + 1u == (tg + 1u) * nx) xb_add(&bar[XB_TOPGEN], 1u);
      else XB_SPIN(xb_ld(&bar[XB_TOPGEN]) == tg, bar);
      __builtin_amdgcn_fence(__ATOMIC_ACQUIRE, "agent");
      xb_add(&bar[XB_XGEN(b.x)], 1u);
      asm volatile("s_waitcnt vmcnt(0)" ::: "memory");
    } else {
      XB_SPIN(xb_ld(&bar[XB_XGEN(b.x)]) == gen, bar);
      __builtin_amdgcn_fence(__ATOMIC_ACQUIRE, "agent");
      asm volatile("s_waitcnt vmcnt(0)" ::: "memory");
    }
  }
  __syncthreads();
}

DI void conv_tile(const float* src, int ld, int K, int k0, int n0, bool is_win, bf16_t* dst, LDS_AS float* tile, int dry) {
  const int tid = tidx(), ty = tid >> 4, tx = tid & 15;
  const int n = n0 + 4 * tx;
  int sc = n;
  if (is_win) sc = (n < 2720) ? n : (n < 2816 ? -1 : n - 96);
#pragma unroll
  for (int i = 0; i < 2; ++i) {
    const int k = ty + 32 * i;
    f32x4 v = {0.f, 0.f, 0.f, 0.f};
    if (sc >= 0) v = *(const f32x4*)(src + (size_t)(k0 + k) * ld + sc);
    tile[k * 65 + 4 * tx + 0] = v[0]; tile[k * 65 + 4 * tx + 1] = v[1]; tile[k * 65 + 4 * tx + 2] = v[2]; tile[k * 65 + 4 * tx + 3] = v[3];
  }
  __syncthreads();
  {
    const int r = tid >> 3, c = tid & 7;
    u32x4 w;
    w[0] = pk2(tile[(8 * c + 0) * 65 + r], tile[(8 * c + 1) * 65 + r]);
    w[1] = pk2(tile[(8 * c + 2) * 65 + r], tile[(8 * c + 3) * 65 + r]);
    w[2] = pk2(tile[(8 * c + 4) * 65 + r], tile[(8 * c + 5) * 65 + r]);
    w[3] = pk2(tile[(8 * c + 6) * 65 + r], tile[(8 * c + 7) * 65 + r]);
    if (!dry) *(u32x4*)(dst + (size_t)(n0 + r) * K + k0 + 8 * c) = w;
  }
  __syncthreads();
}

DI void phase0(const Params& p, LDS_AS unsigned char* smem, int dry) {
  const int tid_ = tidx(), lane = tid_ & 63, wave = tid_ >> 6;
  if (blockIdx.x == 0 && wave == 0) {
    for (int l = 0; l < 2; ++l) {
      const float s1 = wave_sum(p.lambda_q1[l * 64 + lane] * p.lambda_k1[l * 64 + lane]);
      const float s2 = wave_sum(p.lambda_q2[l * 64 + lane] * p.lambda_k2[l * 64 + lane]);
      const float lam_init = 0.8f - 0.6f * expf(-0.3f * (float)l);
      const float lam = expf(s1) - expf(s2) + lam_init;
      float a = fabsf(p.g_mla_q[l * 96 + lane]); if (lane < 32) a = fmaxf(a, fabsf(p.g_mla_q[l * 96 + 64 + lane]));
      float b = fabsf(p.g_mla_k[l * 96 + lane]); if (lane < 32) b = fmaxf(b, fabsf(p.g_mla_k[l * 96 + 64 + lane]));
      const float mq = wave_max(a), mk = wave_max(b);
      const float sq = wave_max(fabsf(p.g_swa_q[l * 64 + lane])), sk = wave_max(fabsf(p.g_swa_k[l * 64 + lane]));
      const float dq = wave_max(fabsf(p.g_diff_q[l * 64 + lane])), dk = wave_max(fabsf(p.g_diff_k[l * 64 + lane]));
      if (lane == 0) {
        float* cs = p.consts + l * 16;
        cs[0] = lam; cs[1] = lam_init;
        cs[2] = LOG2E * sqrtf(96.f) * mq * mk;
        cs[3] = LOG2E * 8.f * sq * sk;
        cs[4] = LOG2E * 8.f * dq * dk;
      }
    }
  }
  for (int task = blockIdx.x * 8 + wave; task < 3072; task += gridDim.x * 8) {
    const int l = task / 1536, rem = task % 1536, chunk = rem >> 4, ks = rem & 15;
    const int n = chunk * 64 + lane;
    float acc[5] = {0.f, 0.f, 0.f, 0.f, 0.f};
    const float* w = p.w_mod + ((size_t)l * 1024 + ks * 64) * 6144 + n;
#pragma unroll 8
    for (int k = 0; k < 64; ++k) {
      const float wv = w[(size_t)k * 6144];
      const int kk = ks * 64 + k;
#pragma unroll
      for (int r = 0; r < 4; ++r) acc[r] += silu(p.c[r * 1024 + kk]) * wv;
      acc[4] += silu(p.c_ctx[kk]) * wv;
    }
    const float bias = (ks == 0) ? p.b_mod[l * 6144 + n] : 0.f;
    if (!dry)
#pragma unroll
      for (int r = 0; r < 5; ++r) atomicAdd(p.modtab + (size_t)(l * 5 + r) * 6144 + n, acc[r] + bias);
  }
  LDS_AS float* tile = (LDS_AS float*)smem;
  for (int t = blockIdx.x; t < 2 * 4240; t += gridDim.x) {
    const int l = t / 4240; int u = t % 4240;
    const float* src; int ld, K; bool is_win = false; size_t doff;
    if (u < 1472) { src = p.w_in + (size_t)l * 1024 * 5792; ld = 5792; K = 1024; is_win = true; doff = W_IN; }
    else if (u < 1520) { u -= 1472; src = p.w_uq + (size_t)l * 256 * 768; ld = 768; K = 256; doff = W_UQ; }
    else if (u < 1552) { u -= 1520; src = p.w_ukv + (size_t)l * 128 * 1024; ld = 1024; K = 128; doff = W_UKV; }
    else if (u < 1680) { u -= 1552; src = p.w_up_mla + (size_t)l * 512 * 1024; ld = 1024; K = 512; doff = W_UPM; }
    else if (u < 1808) { u -= 1680; src = p.w_up_swa + (size_t)l * 512 * 1024; ld = 1024; K = 512; doff = W_UPS; }
    else if (u < 1936) { u -= 1808; src = p.w_up_diff + (size_t)l * 512 * 1024; ld = 1024; K = 512; doff = W_UPD; }
    else if (u < 2192) { u -= 1936; src = p.w_o + (size_t)l * 1024 * 1024; ld = 1024; K = 1024; doff = W_O; }
    else if (u < 3216) { u -= 2192; src = p.w_mlp_in + (size_t)l * 1024 * 4096; ld = 4096; K = 1024; doff = W_M1; }
    else { u -= 3216; src = p.w_mlp_out + (size_t)l * 4096 * 1024; ld = 1024; K = 4096; doff = W_M2; }
    const int nkt = K >> 6, kt = u % nkt, nt = u / nkt;
    conv_tile(src, ld, K, kt * 64, nt * 64, is_win, p.WB + (size_t)l * W_LAYER + doff, tile, dry);
  }
}

DI void norm_phase(const Params& p, int l, int which, int dry) {
  const int tid_ = tidx(), lane = tid_ & 63, wave = tid_ >> 6;
  const float* g = (which == 0 ? p.g_norm_attn : p.g_norm_mlp) + l * 1024;
  const int shoff = which == 0 ? 0 : 3072, scoff = shoff + 1024;
  const int nrows = (which == 1 && l == 1) ? TL : T;
  const bool first = (which == 0 && l == 0);
  const float* px = opq(p.x); const float* pctx = opq(p.ctx); const float* pout = opq((const float*)p.out); const float* pcx = opq((const float*)p.CX);
  const float* slat = first ? px : pout; const float* sctx = first ? pctx : pcx;
  for (int row = blockIdx.x * 8 + wave; row < nrows; row += gridDim.x * 8) {
    const float* xr; int bidx;
    if (row < TL) { xr = slat + (size_t)row * 1024; bidx = row >> 13; }
    else { xr = sctx + (size_t)(row - TL) * 1024; bidx = 4; }
    const float* mod = p.modtab + (size_t)(l * 5 + bidx) * 6144;
    f32x4 v[4]; float ss = 0.f;
#pragma unroll
    for (int i = 0; i < 4; ++i) { v[i] = *(const f32x4*)(xr + i * 256 + lane * 4); ss += v[i][0] * v[i][0] + v[i][1] * v[i][1] + v[i][2] * v[i][2] + v[i][3] * v[i][3]; }
    ss = wave_sum(ss);
    const float rstd = rsqrtf(ss * (1.f / 1024.f) + EPS);
#pragma unroll
    for (int i = 0; i < 4; ++i) {
      const int col = i * 256 + lane * 4;
      const f32x4 gv = *(const f32x4*)(g + col), sh = *(const f32x4*)(mod + shoff + col), sc = *(const f32x4*)(mod + scoff + col);
      float o[4];
#pragma unroll
      for (int j = 0; j < 4; ++j) o[j] = (v[i][j] * rstd * gv[j]) * (1.f + sc[j]) + sh[j];
      u32x2 w = {pk2(o[0], o[1]), pk2(o[2], o[3])};
      if (!dry) *(u32x2*)(p.H + (size_t)row * 1024 + col) = w;
    }
  }
}

constexpr int GST = 49152;
DI void gemm_kloop(const bf16_t* Ag, int lda, int a_kstep, const bf16_t* Bg, int ldb, int nkt, f32x16 (&acc)[2][2], LDS_AS unsigned char* smem) {
  const int tid_ = tidx(), lane = tid_ & 63, wave = tid_ >> 6, h = lane >> 5, wm = wave >> 1, wn = wave & 1;
  unsigned aoff[4], boff[2];
#pragma unroll
  for (int i = 0; i < 4; ++i) {
    const int r = wave * 32 + i * 8 + (lane >> 3), c = (lane & 7) ^ ((r >> 1) & 7);
    aoff[i] = (unsigned)(r * lda + c * 8) * 2u;
  }
#pragma unroll
  for (int i = 0; i < 2; ++i) {
    const int r = wave * 16 + i * 8 + (lane >> 3), c = (lane & 7) ^ ((r >> 1) & 7);
    boff[i] = (unsigned)(r * ldb + c * 8) * 2u;
  }
  const unsigned dstA = (unsigned)__builtin_amdgcn_readfirstlane((int)(lds_u32(smem) + wave * 4096));
  const unsigned dstB = (unsigned)__builtin_amdgcn_readfirstlane((int)(lds_u32(smem) + 32768 + wave * 2048));
  const int swz = (lane >> 1) & 7;
  const int arow = (wm * 64 + (lane & 31)) * 128, brow = 32768 + (wn * 64 + (lane & 31)) * 128;
  asm volatile("s_waitcnt vmcnt(0)" ::: "memory");
  __syncthreads();
  auto issue = [&](int kt, int stg) {
    const char* An = (const char*)(Ag + (size_t)kt * a_kstep); const char* Bn = (const char*)(Bg + (size_t)kt * 64);
#pragma unroll
    for (int i = 0; i < 4; ++i) glds16a(An, aoff[i], dstA + stg * GST + i * 1024);
#pragma unroll
    for (int i = 0; i < 2; ++i) glds16a(Bn, boff[i], dstB + stg * GST + i * 1024);
  };
  issue(0, 0);
  if (nkt > 1) issue(1, 1);
  int st = 0;
#pragma unroll 1
  for (int kt = 0; kt < nkt; ++kt) {
    if (kt + 1 < nkt) asm volatile("s_waitcnt vmcnt(6)" ::: "memory"); else asm volatile("s_waitcnt vmcnt(0)" ::: "memory");
    __builtin_amdgcn_s_barrier();
    asm volatile("" ::: "memory");
    if (kt + 2 < nkt) issue(kt + 2, st >= 1 ? st - 1 : 2);
    LDS_AS unsigned char* sa = smem + st * GST;
#pragma unroll
    for (int s = 0; s < 4; ++s) {
      const int co = ((2 * s + h) ^ swz) << 4;
      const bf16x8 a0 = lds128(sa + arow + co), a1 = lds128(sa + arow + 32 * 128 + co);
      const bf16x8 b0 = lds128(sa + brow + co), b1 = lds128(sa + brow + 32 * 128 + co);
      acc[0][0] = MFMA32(b0, a0, acc[0][0]); acc[0][1] = MFMA32(b1, a0, acc[0][1]);
      acc[1][0] = MFMA32(b0, a1, acc[1][0]); acc[1][1] = MFMA32(b1, a1, acc[1][1]);
    }
    st = (st == 2) ? 0 : st + 1;
  }
}
DI void zero_acc(f32x16 (&acc)[2][2]) {
#pragma unroll
  for (int a = 0; a < 2; ++a)
#pragma unroll
    for (int b = 0; b < 2; ++b)
#pragma unroll
      for (int i = 0; i < 16; ++i) acc[a][b][i] = 0.f;
}
DI void tile_decode(int id, int NT, int& mt, int& nt) { const int per = 4 * NT, g = id / per, w = id % per; mt = g * 4 + (w & 3); nt = w >> 2; }

constexpr int EPW = 17408;
template <int ACT> DI LDS_AS unsigned char* stage_tile(const f32x16 (&acc)[2][2], LDS_AS unsigned char* smem) {
  const int tid_ = tidx(), lane = tid_ & 63, wave = tid_ >> 6, h = lane >> 5;
  __syncthreads();
  LDS_AS unsigned char* reg = smem + wave * EPW;
#pragma unroll
  for (int bi = 0; bi < 2; ++bi)
#pragma unroll
    for (int bj = 0; bj < 2; ++bj)
#pragma unroll
      for (int g = 0; g < 4; ++g) {
        f32x4 v;
#pragma unroll
        for (int j = 0; j < 4; ++j) { v[j] = acc[bi][bj][4 * g + j]; if (ACT == 1) { v[j] = fmaxf(v[j], 0.f); v[j] *= v[j]; } }
        *(LDS_AS f32x4*)(reg + (bi * 32 + (lane & 31)) * 272 + (bj * 32 + 8 * g + 4 * h) * 4) = v;
      }
  return reg;
}
template <int ACT> DI void epi_store_bf16(const f32x16 (&acc)[2][2], bf16_t* dst, int ldc, int row0, int col0, int ncols, LDS_AS unsigned char* smem) {
  LDS_AS unsigned char* reg = stage_tile<ACT>(acc, smem);
  const int tid_ = tidx(), lane = tid_ & 63, wave = tid_ >> 6, wm = wave >> 1, wn = wave & 1;
  const int c = (lane & 7) * 8, col = col0 + wn * 64 + c;
#pragma unroll
  for (int i = 0; i < 8; ++i) {
    const int r = i * 8 + (lane >> 3);
    const f32x4 a = *(LDS_AS f32x4*)(reg + r * 272 + c * 4), b = *(LDS_AS f32x4*)(reg + r * 272 + c * 4 + 16);
    u32x4 w = {pk2(a[0], a[1]), pk2(a[2], a[3]), pk2(b[0], b[1]), pk2(b[2], b[3])};
    if (col < ncols) *(u32x4*)(dst + (size_t)(row0 + wm * 64 + r) * ldc + col) = w;
  }
}
DI void epi_residual(const f32x16 (&acc)[2][2], const float* xin, float* xout, const float* gate, int row0, int col0, LDS_AS unsigned char* smem) {
  LDS_AS unsigned char* reg = stage_tile<0>(acc, smem);
  const int tid_ = tidx(), lane = tid_ & 63, wave = tid_ >> 6, wm = wave >> 1, wn = wave & 1;
  const int c = (lane & 15) * 4, col = col0 + wn * 64 + c;
  const f32x4 gv = *(const f32x4*)(gate + col);
#pragma unroll
  for (int i = 0; i < 16; ++i) {
    const int r = i * 4 + (lane >> 4);
    const size_t off = (size_t)(row0 + wm * 64 + r) * 1024 + col;
    const f32x4 a = *(LDS_AS f32x4*)(reg + r * 272 + c * 4), xi = *(const f32x4*)(xin + off);
    f32x4 o;
#pragma unroll
    for (int j = 0; j < 4; ++j) o[j] = xi[j] + gv[j] * a[j];
    *(f32x4*)(xout + off) = o;
  }
}

constexpr int G2ST = 65536;
DI void gemm_kloop2(const bf16_t* Ag, int lda, const bf16_t* Bg, int ldb, int nkt  , f32x16 (&acc)[4][2], LDS_AS unsigned char* smem) {
  const int tid_ = tidx(), lane = tid_ & 63, wave = tid_ >> 6, h = lane >> 5, wm = wave >> 2, wn = wave & 3;
  unsigned aoff[4], boff[4];
#pragma unroll
  for (int i = 0; i < 4; ++i) {
    const int r = wave * 32 + i * 8 + (lane >> 3), c = (lane & 7) ^ ((r >> 1) & 7);
    aoff[i] = (unsigned)(r * lda + c * 8) * 2u; boff[i] = (unsigned)(r * ldb + c * 8) * 2u;
  }
  const unsigned dstA = (unsigned)__builtin_amdgcn_readfirstlane((int)(lds_u32(smem) + wave * 4096));
  const unsigned dstB = dstA + 32768;
  const int swz = (lane >> 1) & 7;
  const int arow = (wm * 128 + (lane & 31)) * 128, brow = 32768 + (wn * 64 + (lane & 31)) * 128;
  asm volatile("s_waitcnt vmcnt(0)" ::: "memory");
  __syncthreads();
  auto issue = [&](int kt, int stg) {
    const char* An = (const char*)(Ag + (size_t)kt * 64); const char* Bn = (const char*)(Bg + (size_t)kt * 64);
#pragma unroll
    for (int i = 0; i < 4; ++i) glds16a(An, aoff[i], dstA + stg * G2ST + i * 1024);
#pragma unroll
    for (int i = 0; i < 4; ++i) glds16a(Bn, boff[i], dstB + stg * G2ST + i * 1024);
  };
  issue(0, 0);
#pragma unroll 1
  for (int kt = 0; kt < nkt; ++kt) {
    asm volatile("s_waitcnt vmcnt(0)" ::: "memory");
    __builtin_amdgcn_s_barrier();
    asm volatile("" ::: "memory");
    if (kt + 1 < nkt) issue(kt + 1, (kt + 1) & 1);
    LDS_AS unsigned char* sa = smem + (kt & 1) * G2ST;
#pragma unroll
    for (int s = 0; s < 4; ++s) {
      const int co = ((2 * s + h) ^ swz) << 4;
      bf16x8 fa[4], fb[2];
#pragma unroll
      for (int bi = 0; bi < 4; ++bi) fa[bi] = lds128(sa + arow + bi * 32 * 128 + co);
#pragma unroll
      for (int bj = 0; bj < 2; ++bj) fb[bj] = lds128(sa + brow + bj * 32 * 128 + co);
#pragma unroll
      for (int bi = 0; bi < 4; ++bi)
#pragma unroll
        for (int bj = 0; bj < 2; ++bj) acc[bi][bj] = MFMA32(fb[bj], fa[bi], acc[bi][bj]);
    }
  }
}
DI void zero_acc2(f32x16 (&acc)[4][2]) {
#pragma unroll
  for (int a = 0; a < 4; ++a)
#pragma unroll
    for (int b = 0; b < 2; ++b)
#pragma unroll
      for (int i = 0; i < 16; ++i) acc[a][b][i] = 0.f;
}
template <int ACT, int HF> DI void stage_half(const f32x16 (&acc)[4][2], LDS_AS unsigned char* reg, int lane, int h) {
#pragma unroll
  for (int bi = 0; bi < 2; ++bi)
#pragma unroll
    for (int bj = 0; bj < 2; ++bj)
#pragma unroll
      for (int g = 0; g < 4; ++g) {
        f32x4 v;
#pragma unroll
        for (int j = 0; j < 4; ++j) { v[j] = acc[2 * HF + bi][bj][4 * g + j]; if (ACT == 1) { v[j] = fmaxf(v[j], 0.f); v[j] *= v[j]; } }
        *(LDS_AS f32x4*)(reg + (bi * 32 + (lane & 31)) * 272 + (bj * 32 + 8 * g + 4 * h) * 4) = v;
      }
}
template <int ACT, int HF> DI void epi2_half_bf16(const f32x16 (&acc)[4][2], bf16_t* dst, int ldc, int row0, int col0, int ncols, LDS_AS unsigned char* smem) {
  const int tid_ = tidx(), lane = tid_ & 63, wave = tid_ >> 6, h = lane >> 5, wm = wave >> 2, wn = wave & 3;
  LDS_AS unsigned char* reg = smem + wave * EPW;
  stage_half<ACT, HF>(acc, reg, lane, h);
  const int c = (lane & 7) * 8, col = col0 + wn * 64 + c;
#pragma unroll
  for (int i = 0; i < 8; ++i) {
    const int r = i * 8 + (lane >> 3);
    const f32x4 a = *(LDS_AS f32x4*)(reg + r * 272 + c * 4), b = *(LDS_AS f32x4*)(reg + r * 272 + c * 4 + 16);
    u32x4 w = {pk2(a[0], a[1]), pk2(a[2], a[3]), pk2(b[0], b[1]), pk2(b[2], b[3])};
    if (col < ncols) *(u32x4*)(dst + (size_t)(row0 + wm * 128 + HF * 64 + r) * ldc + col) = w;
  }
}
template <int ACT> DI void epi2_store_bf16(const f32x16 (&acc)[4][2], bf16_t* dst, int ldc, int row0, int col0, int ncols, LDS_AS unsigned char* smem) {
  __syncthreads();
  epi2_half_bf16<ACT, 0>(acc, dst, ldc, row0, col0, ncols, smem);
  epi2_half_bf16<ACT, 1>(acc, dst, ldc, row0, col0, ncols, smem);
}
template <int HF> DI void epi2_half_residual(const f32x16 (&acc)[4][2], const float* xin, float* xout, const float* gate, int row0, int col0, LDS_AS unsigned char* smem) {
  const int tid_ = tidx(), lane = tid_ & 63, wave = tid_ >> 6, h = lane >> 5, wm = wave >> 2, wn = wave & 3;
  LDS_AS unsigned char* reg = smem + wave * EPW;
  stage_half<0, HF>(acc, reg, lane, h);
  const int c = (lane & 15) * 4, col = col0 + wn * 64 + c;
  const f32x4 gv = *(const f32x4*)(gate + col);
#pragma unroll
  for (int i = 0; i < 16; ++i) {
    const int r = i * 4 + (lane >> 4);
    const size_t off = (size_t)(row0 + wm * 128 + HF * 64 + r) * 1024 + col;
    const f32x4 a = *(LDS_AS f32x4*)(reg + r * 272 + c * 4), xi = *(const f32x4*)(xin + off);
    f32x4 o;
#pragma unroll
    for (int j = 0; j < 4; ++j) o[j] = xi[j] + gv[j] * a[j];
    *(f32x4*)(xout + off) = o;
  }
}
DI void epi2_residual(const f32x16 (&acc)[4][2], const float* xin, float* xout, const float* gate, int row0, int col0, LDS_AS unsigned char* smem) {
  __syncthreads();
  epi2_half_residual<0>(acc, xin, xout, gate, row0, col0, smem);
  epi2_half_residual<1>(acc, xin, xout, gate, row0, col0, smem);
}

namespace pg8 {
typedef float f32x2v __attribute__((ext_vector_type(2)));
constexpr int BM = 256, BK = 64, HALF = 128, HTB = HALF * BK * 2, STAGE_BYTES = 8 * HTB, NXCD = 8, WGM = 8;
DI int lds_byte(int r, int c) { const int st = (r >> 4) * 2 + (c >> 5), rr = r & 15, cc = c & 31, ob = rr * 64 + cc * 2; return st * 1024 + (ob ^ (((ob >> 9) & 1) << 5)); }
DI void stage_rc(int b, int& R, int& C) { const int st = b / 1024, sb = b % 1024, swz = sb ^ (((sb >> 9) & 1) << 5); R = (st >> 1) * 16 + swz / 64; C = (st & 1) * 32 + (swz % 64) / 2; }
DI int perm32(int rho) { const int n = rho >> 4, i = rho & 15; return 8 * (i >> 2) + 4 * n + (i & 3); }
struct Unit { int pm, pn; };
struct Gemm { const bf16_t* A; const bf16_t* Bt; int M, N, K; };
struct StaticOrder {
    int nM, nN, nwg, G, c;
    DI void init(int M, int N, int G_, int c_) { nM = M / BM; nN = N / BM; nwg = nM * nN; G = G_; c = c_; }
    DI bool next(int i, Unit& u) const {
        const long L = (long)i * G + c; if (L >= nwg) return false;
        int wgid = (int)L; { const int q = nwg / NXCD, r = nwg % NXCD, xcd = wgid % NXCD, off = wgid / NXCD; wgid = (xcd < r ? xcd * (q + 1) : r * (q + 1) + (xcd - r) * q) + off; }
        const int nig = WGM * nN, gid = wgid / nig, fm = gid * WGM, gsz = (nM - fm) < WGM ? (nM - fm) : WGM;
        u.pm = fm + ((wgid % nig) % gsz); u.pn = (wgid % nig) / gsz; return true;
    }
    DI void a_ready(const Unit&) const {}
    DI void done(const Unit&) const {}
};
template <int ACT  > struct EpiBf16 {
    static constexpr bool PERM = true, AFTER_DRAIN = false;
    bf16_t* O; int ldc, ncols, dry;
    DI void operator()(const f32x4 (&acc)[2][2][4][2], const Unit& u, int wr, int wc, int fr, int fq) const {
        if (dry) return;
        const int row0 = u.pm * BM + wr * 64 + fr, col0 = u.pn * BM + wc * 32 + 8 * fq;
#pragma unroll
        for (int ai = 0; ai < 2; ++ai)
#pragma unroll
            for (int m = 0; m < 4; ++m) { bf16_t* rowp = O + (size_t)(row0 + ai * HALF + m * 16) * ldc + col0;
#pragma unroll
                for (int bj = 0; bj < 2; ++bj) { f32x4 v0 = acc[ai][bj][m][0], v1 = acc[ai][bj][m][1];
                    if (ACT == 1) {
#pragma unroll
                        for (int j = 0; j < 4; ++j) { v0[j] = fmaxf(v0[j], 0.f); v0[j] *= v0[j]; v1[j] = fmaxf(v1[j], 0.f); v1[j] *= v1[j]; } }
                    u32x4 w = {pk2(v0[0], v0[1]), pk2(v0[2], v0[3]), pk2(v1[0], v1[1]), pk2(v1[2], v1[3])};
                    if (col0 + bj * HALF < ncols) __builtin_nontemporal_store(w, (u32x4*)(rowp + bj * HALF)); } }
    }
};
struct EpiResid {
    static constexpr bool PERM = false, AFTER_DRAIN = false;
    const float* xin; float* xout; const float* gate; int dry;
    DI void operator()(const f32x4 (&acc)[2][2][4][2], const Unit& u, int wr, int wc, int fr, int fq) const {
        if (dry) return;
        const int row0 = u.pm * BM + wr * 64 + fr, col0 = u.pn * BM + wc * 32 + 4 * fq;
        const float* gv = gate + (size_t)((u.pm * BM) >> 13) * 6144 + col0;
        f32x4 g[2][2];
#pragma unroll
        for (int bj = 0; bj < 2; ++bj)
#pragma unroll
            for (int n = 0; n < 2; ++n) g[bj][n] = *(const f32x4*)(gv + bj * HALF + n * 16);
#pragma unroll
        for (int ai = 0; ai < 2; ++ai)
#pragma unroll
            for (int m = 0; m < 4; ++m) { const size_t off = (size_t)(row0 + ai * HALF + m * 16) * 1024 + col0;
#pragma unroll
                for (int bj = 0; bj < 2; ++bj)
#pragma unroll
                    for (int n = 0; n < 2; ++n) { const f32x4 xi = *(const f32x4*)(xin + off + bj * HALF + n * 16);
                        *(f32x4*)(xout + off + bj * HALF + n * 16) = xi + g[bj][n] * acc[ai][bj][m][n]; } }
    }
};
template <class Epi, class Sched, bool STAMP = false>
__device__ __forceinline__ void gemm_phase(LDS_AS unsigned char* lds, const Gemm g, const Sched& S, const Epi& E, unsigned long long* stamps) {
    const int tid = tidx(), wid = __builtin_amdgcn_readfirstlane(tid >> 6), lane = tid & 63, wr = wid >> 2, wc = wid & 3, fr = lane & 15, fq = lane >> 4;
    const int K = g.K, nt = K / BK;
    int ts_lo = 0, ts_hi = 0, nts = 0; const unsigned long long rt_entry = STAMP ? 0ull : 0ull;
#define PG8_STAMP() do { if (STAMP && wid == 0 && nts < 64) { const unsigned long long _c = (unsigned long long)clock64(); \
        ts_lo = (lane == nts) ? (int)(unsigned)_c : ts_lo; ts_hi = (lane == nts) ? (int)(unsigned)(_c >> 32) : ts_hi; ++nts; } } while (0)
    PG8_STAMP();
    unsigned voffA[2], voffB[2];
#pragma unroll
    for (int i = 0; i < 2; ++i) { int R, C; stage_rc(tid * 16 + i * 8192, R, C); const int Rb = Epi::PERM ? ((R & ~31) + perm32(R & 31)) : R;
        voffA[i] = (unsigned)(R * K + C) * 2u; voffB[i] = (unsigned)(Rb * K + C) * 2u; }
    const size_t kstep = (size_t)(BK * 2);
    const size_t hstep = (size_t)HALF * K * 2;
    const size_t tstep = 2 * hstep;
    const unsigned ldsw = (unsigned)wid * 1024u; const unsigned ldsbase = (unsigned)__builtin_amdgcn_readfirstlane((int)lds_u32(lds));
    const int aoff = lds_byte(wr * 64 + fr, fq * 8), boff = lds_byte(wc * 32 + fr, fq * 8);
#define PG8_SA(b, h) (((b) * 2 + (h)) * HTB)
#define PG8_SB(b, h) ((4 + (b) * 2 + (h)) * HTB)
#define PG8_STAGE(bufoff, gbase, voff) do { _Pragma("unroll") for (int _i = 0; _i < 2; ++_i) \
        glds16a((const void*)(gbase), (voff)[_i], ldsbase + (unsigned)(bufoff) + ldsw + (unsigned)_i * 8192u); } while (0)
#define PG8_LDA(dst, b, h) do { _Pragma("unroll") for (int m = 0; m < 4; ++m) _Pragma("unroll") for (int k = 0; k < 2; ++k) dst[m][k] = *(const LDS_AS bf16x8*)(lds + PG8_SA(b, h) + aoff + m * 2048 + k * 1024); } while (0)
#define PG8_LDB(dst, b, h) do { _Pragma("unroll") for (int n = 0; n < 2; ++n) _Pragma("unroll") for (int k = 0; k < 2; ++k) dst[n][k] = *(const LDS_AS bf16x8*)(lds + PG8_SB(b, h) + boff + n * 2048 + k * 1024); } while (0)
#define PG8_MMA(ai, bj, At, Bt) do { __builtin_amdgcn_s_setprio(1); _Pragma("unroll") for (int m = 0; m < 4; ++m) _Pragma("unroll") for (int n = 0; n < 2; ++n) _Pragma("unroll") for (int k = 0; k < 2; ++k) \
        acc[ai][bj][m][n] = __builtin_amdgcn_mfma_f32_16x16x32_bf16(Bt[n][k], At[m][k], acc[ai][bj][m][n], 0, 0, 0); __builtin_amdgcn_s_setprio(0); } while (0)
#define PG8_WAIT_V(n) asm volatile("s_waitcnt vmcnt(" #n ")" ::: "memory")
#define PG8_WAIT_L(n) asm volatile("s_waitcnt lgkmcnt(" #n ")" ::: "memory")
#define PG8_BAR __builtin_amdgcn_s_barrier()
#define PG8_SCHED __builtin_amdgcn_sched_barrier(0)
    Unit cur, nxt; int ui = 0;
    if (!S.next(0, cur)) return;
    f32x4 acc[2][2][4][2];
#pragma unroll
    for (int a = 0; a < 2; ++a)
#pragma unroll
        for (int b = 0; b < 2; ++b)
#pragma unroll
            for (int m = 0; m < 4; ++m)
#pragma unroll
                for (int n = 0; n < 2; ++n) acc[a][b][m][n] = (f32x4){0.f, 0.f, 0.f, 0.f};
    bf16x8 At[4][2], B0[2][2], B1[2][2];
    const char* cA = (const char*)g.A + (size_t)cur.pm * tstep; const char* cB = (const char*)g.Bt + (size_t)cur.pn * tstep;
    S.a_ready(cur);
    PG8_STAGE(PG8_SB(0, 0), cB, voffB); PG8_STAGE(PG8_SA(0, 0), cA, voffA); PG8_STAGE(PG8_SB(0, 1), cB + hstep, voffB); PG8_STAGE(PG8_SA(0, 1), cA + hstep, voffA);
    if (wr == 1) PG8_BAR;
    PG8_WAIT_V(4); PG8_BAR;
    PG8_STAGE(PG8_SB(1, 0), cB + kstep, voffB); PG8_STAGE(PG8_SA(1, 0), cA + kstep, voffA); PG8_STAGE(PG8_SB(1, 1), cB + hstep + kstep, voffB);
    PG8_WAIT_V(6); PG8_BAR;
    PG8_STAMP();
    for (;;) {
        const bool has_next = S.next(ui + 1, nxt);
        const char* nA = has_next ? (const char*)g.A + (size_t)nxt.pm * tstep : cA; const char* nB = has_next ? (const char*)g.Bt + (size_t)nxt.pn * tstep : cB;
        for (int t = 0; t < nt; t += 2) {
            const bool last = (t == nt - 2);
            const char* a1 = cA + (size_t)(t + 1) * kstep;
            const char* a2 = last ? nA : cA + (size_t)(t + 2) * kstep; const char* b2 = last ? nB : cB + (size_t)(t + 2) * kstep;
            const char* a3 = a2 + kstep; const char* b3 = b2 + kstep;
            if (last && has_next) S.a_ready(nxt);
            PG8_LDB(B0, 0, 0); PG8_SCHED; PG8_LDA(At, 0, 0); PG8_STAGE(PG8_SA(1, 1), a1 + hstep, voffA);
            PG8_WAIT_L(8); PG8_BAR; PG8_WAIT_L(0); PG8_MMA(0, 0, At, B0); PG8_BAR; PG8_SCHED;
            PG8_LDB(B1, 0, 1); PG8_STAGE(PG8_SB(0, 0), b2, voffB);
            PG8_BAR; PG8_WAIT_L(0); PG8_MMA(0, 1, At, B1); PG8_BAR;
            PG8_LDA(At, 0, 1); PG8_STAGE(PG8_SA(0, 0), a2, voffA);
            PG8_BAR; PG8_WAIT_L(0); PG8_MMA(1, 0, At, B0); PG8_BAR; PG8_SCHED;
            PG8_STAGE(PG8_SB(0, 1), b2 + hstep, voffB);
            PG8_WAIT_V(6); PG8_BAR; PG8_MMA(1, 1, At, B1); PG8_BAR;
            PG8_LDB(B0, 1, 0); PG8_SCHED; PG8_LDA(At, 1, 0); PG8_STAGE(PG8_SA(0, 1), a2 + hstep, voffA);
            PG8_WAIT_L(8); PG8_BAR; PG8_WAIT_L(0); PG8_MMA(0, 0, At, B0); PG8_BAR; PG8_SCHED;
            PG8_LDB(B1, 1, 1); PG8_STAGE(PG8_SB(1, 0), b3, voffB);
            PG8_BAR; PG8_WAIT_L(0); PG8_MMA(0, 1, At, B1); PG8_BAR;
            PG8_LDA(At, 1, 1); PG8_STAGE(PG8_SA(1, 0), a3, voffA);
            PG8_BAR; PG8_WAIT_L(0); PG8_MMA(1, 0, At, B0); PG8_BAR; PG8_SCHED;
            PG8_STAGE(PG8_SB(1, 1), b3 + hstep, voffB);
            PG8_WAIT_V(6); PG8_BAR; PG8_MMA(1, 1, At, B1); PG8_BAR;
        }
        PG8_STAMP();
        if constexpr (!Epi::AFTER_DRAIN) { E(acc, cur, wr, wc, fr, fq); S.done(cur); }
        PG8_STAMP();
        if (!has_next) break;
#pragma unroll
        for (int a = 0; a < 2; ++a)
#pragma unroll
            for (int b = 0; b < 2; ++b)
#pragma unroll
                for (int m = 0; m < 4; ++m)
#pragma unroll
                    for (int n = 0; n < 2; ++n) acc[a][b][m][n] = (f32x4){0.f, 0.f, 0.f, 0.f};
        cur = nxt; cA = nA; cB = nB; ++ui;
    }
    PG8_WAIT_V(0);
    if (wr == 0) PG8_BAR;
    PG8_BAR;
    if constexpr (Epi::AFTER_DRAIN) { E.fused(acc, cur, wr, wc, fr, fq, lds, wid, lane); S.done(cur); }
    PG8_STAMP();
    if (STAMP && wid == 0) { stamps[lane] = lane < nts ? (((unsigned long long)(unsigned)ts_hi << 32) | (unsigned)ts_lo) : 0ull;
        if (lane == 62) stamps[62] = rt_entry; if (lane == 63) stamps[63] = 0ull; }
#undef PG8_STAMP
#undef PG8_SA
#undef PG8_SB
#undef PG8_STAGE
#undef PG8_LDA
#undef PG8_LDB
#undef PG8_MMA
#undef PG8_WAIT_V
#undef PG8_WAIT_L
#undef PG8_BAR
#undef PG8_SCHED
}
}

DI void phase_gemm_in(const Params& p, int l, LDS_AS unsigned char* smem, int dry) {
  pg8::Gemm g; g.A = p.H; g.Bt = p.WB + (size_t)l * W_LAYER + W_IN; g.M = T; g.N = 2816; g.K = 1024;
  pg8::StaticOrder S; S.init(g.M, g.N, gridDim.x, blockIdx.x);
  pg8::EpiBf16<0> E; E.O = p.PROJ; E.ldc = PN; E.ncols = PN; E.dry = dry;
  __syncthreads();
  pg8::gemm_phase<pg8::EpiBf16<0>, pg8::StaticOrder, false>(smem, g, S, E, nullptr);
}
DI void phase_gemm_mla(const Params& p, int l, LDS_AS unsigned char* smem, int dry) {
  const bf16_t* WQ = p.WB + (size_t)l * W_LAYER + W_UQ; const bf16_t* WK = p.WB + (size_t)l * W_LAYER + W_UKV;
  const int NT = 7, ntiles = (T / 256) * NT;
  for (int i = blockIdx.x; i < ntiles; i += gridDim.x) {
    int mt, nt; tile_decode(xcd_remap(i, ntiles), NT, mt, nt);
    f32x16 acc[4][2]; zero_acc2(acc);
    if (nt < 3) {
      gemm_kloop2(p.PROJ + (size_t)mt * 256 * PN + C_QLAT, PN, WQ + (size_t)nt * 256 * 256, 256, 4, acc, smem);
      if (!dry) epi2_store_bf16<0>(acc, p.MQ, 768, mt * 256, nt * 256, 768, smem);
    } else {
      gemm_kloop2(p.PROJ + (size_t)mt * 256 * PN + C_KVLAT, PN, WK + (size_t)(nt - 3) * 256 * 128, 128, 2, acc, smem);
      if (!dry) epi2_store_bf16<0>(acc, p.KV, 1024, mt * 256, (nt - 3) * 256, 1024, smem);
    }
  }
}
DI void phase_merge(const Params& p, int l, LDS_AS unsigned char* smem, int dry) {
  const bf16_t* WL = p.WB + (size_t)l * W_LAYER;
  const int NT = 8, MT = (l == 1) ? TL / 256 : T / 256, ntiles = MT * NT;
  bf16_t* M = p.KV;
  for (int i = blockIdx.x; i < ntiles; i += gridDim.x) {
    int mt, nt; tile_decode(xcd_remap(i, ntiles), NT, mt, nt);
    unsigned tp[2][2][8];
#pragma unroll
    for (int a = 0; a < 2; ++a)
#pragma unroll
      for (int b = 0; b < 2; ++b)
#pragma unroll
        for (int e = 0; e < 8; ++e) tp[a][b][e] = 0u;
#pragma unroll 1
    for (int br = 0; br < 3; ++br) {
      unsigned gp[2][2][8];
      {
        f32x16 ag[2][2]; zero_acc(ag);
        gemm_kloop(p.H + (size_t)mt * 256 * 1024, 1024, 64, WL + W_IN + (size_t)(2816 + br * 1024 + nt * 128) * 1024, 1024, 16, ag, smem);
#pragma unroll
        for (int a = 0; a < 2; ++a)
#pragma unroll
          for (int b = 0; b < 2; ++b)
#pragma unroll
            for (int e = 0; e < 8; ++e)
              gp[a][b][e] = pk2(__builtin_amdgcn_rcpf(1.f + __builtin_amdgcn_exp2f(-LOG2E * ag[a][b][2 * e])),
                                __builtin_amdgcn_rcpf(1.f + __builtin_amdgcn_exp2f(-LOG2E * ag[a][b][2 * e + 1])));
      }
      f32x16 ay[2][2]; zero_acc(ay);
      const int lda = (br == 0) ? 768 : PN, kstep = (br == 0) ? 96 : 64;
      const size_t aofs = (br == 0) ? (size_t)T * PN : (size_t)(br == 1 ? C_SQ : C_DQ);
      __builtin_amdgcn_sched_barrier(0);
      gemm_kloop(p.PROJ + aofs + (size_t)mt * 256 * lda, lda, kstep, WL + W_UPM + (size_t)br * 1024 * 512 + (size_t)nt * 128 * 512, 512, 8, ay, smem);
#pragma unroll
      for (int a = 0; a < 2; ++a)
#pragma unroll
        for (int b = 0; b < 2; ++b)
#pragma unroll
          for (int e = 0; e < 8; ++e) {
            const float t0 = __uint_as_float(tp[a][b][e] << 16) + __uint_as_float(gp[a][b][e] << 16) * ay[a][b][2 * e];
            const float t1 = __uint_as_float(tp[a][b][e] & 0xffff0000u) + __uint_as_float(gp[a][b][e] & 0xffff0000u) * ay[a][b][2 * e + 1];
            tp[a][b][e] = pk2(t0, t1);
          }
    }
    if (!dry) {
      f32x16 tot[2][2];
#pragma unroll
      for (int a = 0; a < 2; ++a)
#pragma unroll
        for (int b = 0; b < 2; ++b)
#pragma unroll
          for (int e = 0; e < 8; ++e) { tot[a][b][2 * e] = __uint_as_float(tp[a][b][e] << 16); tot[a][b][2 * e + 1] = __uint_as_float(tp[a][b][e] & 0xffff0000u); }
      epi_store_bf16<0>(tot, M, 1024, mt * 256, nt * 128, 1024, smem);
    }
  }
}
DI void phase_residual_gemm(const Params& p, int l, int which, LDS_AS unsigned char* smem, int dry) {
  const bf16_t* WL = p.WB + (size_t)l * W_LAYER;
  const bf16_t* Abase = which == 0 ? (const bf16_t*)opq(p.KV) : (const bf16_t*)opq(p.PROJ);
  const int K = which == 0 ? 1024 : 4096;
  const bf16_t* W = WL + (which == 0 ? W_O : W_M2);
  const bool first = (which == 0 && l == 0);
  const float* px = opq(p.x); const float* pctx = opq(p.ctx); float* pout = opq(p.out); float* pcx = opq(p.CX);
  const float* slat = first ? px : (const float*)pout; const float* sctx = first ? pctx : (const float*)pcx;
  const float* gofs = p.modtab + (size_t)(l * 5) * 6144 + (which == 0 ? 2048 : 5120);
  {
    pg8::Gemm g; g.A = Abase; g.Bt = W; g.M = TL; g.N = 1024; g.K = K;
    pg8::StaticOrder S; S.init(g.M, g.N, gridDim.x, blockIdx.x);
    pg8::EpiResid E; E.xin = slat; E.xout = pout; E.gate = gofs; E.dry = dry;
    __syncthreads();
    pg8::gemm_phase<pg8::EpiResid, pg8::StaticOrder, false>(smem, g, S, E, nullptr);
  }
  if (l == 0) {
    const int i = (int)gridDim.x - 1 - (int)blockIdx.x;
    if (i < 32) {
      const int mt = TL / 256 + (i & 3), nt = i >> 2;
      f32x16 acc[2][2]; zero_acc(acc);
      gemm_kloop(Abase + (size_t)mt * 256 * K, K, 64, W + (size_t)nt * 128 * K, K, K / 64, acc, smem);
      if (!dry) epi_residual(acc, sctx, pcx, gofs + (size_t)4 * 6144, mt * 256 - TL, nt * 128, smem);
    }
  }
}
DI void phase_mlp_in(const Params& p, int l, LDS_AS unsigned char* smem, int dry) {
  pg8::Gemm g; g.A = p.H; g.Bt = p.WB + (size_t)l * W_LAYER + W_M1; g.M = (l == 1) ? TL : T; g.N = 4096; g.K = 1024;
  pg8::StaticOrder S; S.init(g.M, g.N, gridDim.x, blockIdx.x);
  pg8::EpiBf16<1> E; E.O = p.PROJ; E.ldc = 4096; E.ncols = 4096; E.dry = dry;
  __syncthreads();
  pg8::gemm_phase<pg8::EpiBf16<1>, pg8::StaticOrder, false>(smem, g, S, E, nullptr);
}

DI unsigned ld_u32(const bf16_t* p) { return *(const unsigned*)p; }
DI void unpack4(u32x2 raw, float (&v)[4]) {
  v[0] = __uint_as_float(raw[0] << 16); v[1] = __uint_as_float(raw[0] & 0xffff0000u); v[2] = __uint_as_float(raw[1] << 16); v[3] = __uint_as_float(raw[1] & 0xffff0000u);
}
DI void phase_prep_a(const Params& p, int l, int dry) {
  const int tid_ = tidx(), lane = tid_ & 63, wave = tid_ >> 6, vsel = lane >> 4, j16 = lane & 15;
  const f32x4 gsq = *(const f32x4*)(p.g_swa_q + l * 64 + 4 * j16), gsk = *(const f32x4*)(p.g_swa_k + l * 64 + 4 * j16);
  const f32x4 gdq = *(const f32x4*)(p.g_diff_q + l * 64 + 4 * j16), gdk = *(const f32x4*)(p.g_diff_k + l * 64 + 4 * j16);
  const f32x4 gql = *(const f32x4*)(p.g_q_lora + l * 256 + lane * 4);
  const f32x2 gkl = *(const f32x2*)(p.g_kv_lora + l * 128 + lane * 2);
  float freq[4];
#pragma unroll
  for (int jj = 0; jj < 4; ++jj) freq[jj] = __builtin_amdgcn_exp2f(-(float)(4 * (j16 & 3) + jj) * (13.287712379549449f / 16.f)) * 0.15915494309189535f;
  const float sgn = ((j16 >> 2) & 1) ? 1.f : -1.f;
  const int stride = gridDim.x * 8;
  for (int row0 = blockIdx.x * 8 + wave; row0 < T; row0 += 2 * stride) {
    u32x2 rq[2], rv[2][7]; unsigned rk[2];
#pragma unroll
    for (int t = 0; t < 2; ++t) {
      const int row = (row0 + t * stride < T) ? row0 + t * stride : row0;
      const bf16_t* base = p.PROJ + (size_t)row * PN;
      rq[t] = *(const u32x2*)(base + C_QLAT + lane * 4);
      rk[t] = ld_u32(base + C_KVLAT + lane * 2);
#pragma unroll
      for (int it = 0; it < 7; ++it) rv[t][it] = *(const u32x2*)(base + C_SQ + 64 * (4 * it + vsel) + 4 * j16);
    }
#pragma unroll
    for (int t = 0; t < 2; ++t) {
      const int row = row0 + t * stride;
      if (row >= T) break;
      bf16_t* base = p.PROJ + (size_t)row * PN;
      const bool islat = row < TL;
      float cs[4], sn[4];
      if (islat) {
        const int tt = row & 8191; const float pos = (float)((j16 >> 3) ? (tt & 63) : (tt >> 6));
#pragma unroll
        for (int jj = 0; jj < 4; ++jj) { const float rev = pos * freq[jj]; cs[jj] = __builtin_amdgcn_cosf(rev); sn[jj] = __builtin_amdgcn_sinf(rev); }
      } else {
#pragma unroll
        for (int jj = 0; jj < 4; ++jj) { cs[jj] = 1.f; sn[jj] = 0.f; }
      }
      {
        float v[4]; unpack4(rq[t], v);
        const float ss = wave_sum(v[0] * v[0] + v[1] * v[1] + v[2] * v[2] + v[3] * v[3]);
        const float rstd = rsqrtf(ss * (1.f / 256.f) + EPS);
        u32x2 w = {pk2(v[0] * rstd * gql[0], v[1] * rstd * gql[1]), pk2(v[2] * rstd * gql[2], v[3] * rstd * gql[3])};
        if (!dry) *(u32x2*)(base + C_QLAT + lane * 4) = w;
      }
      {
        const float v0 = __uint_as_float(rk[t] << 16), v1 = __uint_as_float(rk[t] & 0xffff0000u);
        const float ss = wave_sum(v0 * v0 + v1 * v1);
        const float rstd = rsqrtf(ss * (1.f / 128.f) + EPS);
        if (!dry) *(unsigned*)(base + C_KVLAT + lane * 2) = pk2(v0 * rstd * gkl[0], v1 * rstd * gkl[1]);
      }
#pragma unroll
      for (int it = 0; it < 7; ++it) {
        const f32x4 g = (it < 2) ? gsq : (it == 2 ? gsk : (it < 5 ? gdq : gdk));
        const float sc = (it < 2 || it == 3 || it == 4) ? 0.125f * LOG2E : 1.f;
        float v[4]; unpack4(rv[t][it], v);
        float ss = v[0] * v[0] + v[1] * v[1] + v[2] * v[2] + v[3] * v[3];
        ss += __shfl_xor(ss, 8); ss += __shfl_xor(ss, 4); ss += __shfl_xor(ss, 2); ss += __shfl_xor(ss, 1);
        const float rstd = rsqrtf(ss * (1.f / 64.f) + EPS);
        float y[4];
#pragma unroll
        for (int jj = 0; jj < 4; ++jj) {
          const float yy = v[jj] * rstd * g[jj];
          const float pr = __shfl_xor(yy, 4);
          y[jj] = (yy * cs[jj] + sgn * pr * sn[jj]) * sc;
        }
        u32x2 w = {pk2(y[0], y[1]), pk2(y[2], y[3])};
        if (!dry && (it != 2 || vsel < 2)) *(u32x2*)(base + C_SQ + 64 * (4 * it + vsel) + 4 * j16) = w;
      }
    }
  }
}
DI void phase_prep_c(const Params& p, int l, int dry) {
  const int tid_ = tidx(), lane = tid_ & 63, wave = tid_ >> 6, hd = lane >> 3, sub = lane & 7;
  f32x4 gq[3], gk[3];
#pragma unroll
  for (int i = 0; i < 3; ++i) { gq[i] = *(const f32x4*)(p.g_mla_q + l * 96 + 32 * i + 4 * sub); gk[i] = *(const f32x4*)(p.g_mla_k + l * 96 + 32 * i + 4 * sub); }
  float freq[4];
#pragma unroll
  for (int jj = 0; jj < 4; ++jj) freq[jj] = __builtin_amdgcn_exp2f(-(float)(4 * (sub & 1) + jj) * (13.287712379549449f / 8.f)) * 0.15915494309189535f;
  const float sgn = ((sub >> 1) & 1) ? 1.f : -1.f;
  const float qs = 0.10206207261596575f * LOG2E;
  const int stride = gridDim.x * 8;
  for (int row0 = blockIdx.x * 8 + wave; row0 < T; row0 += 2 * stride) {
    u32x2 rq[2][3], rkv[2][2], rpe[2];
#pragma unroll
    for (int t = 0; t < 2; ++t) {
      const int row = (row0 + t * stride < T) ? row0 + t * stride : row0;
#pragma unroll
      for (int i = 0; i < 3; ++i) rq[t][i] = *(const u32x2*)(p.MQ + (size_t)row * 768 + hd * 96 + 32 * i + 4 * sub);
#pragma unroll
      for (int i = 0; i < 2; ++i) rkv[t][i] = *(const u32x2*)(p.KV + (size_t)row * 1024 + hd * 128 + 32 * i + 4 * sub);
      rpe[t] = *(const u32x2*)(p.PROJ + (size_t)row * PN + C_KPE + 4 * sub);
    }
#pragma unroll
    for (int t = 0; t < 2; ++t) {
      const int row = row0 + t * stride;
      if (row >= T) break;
      const bool islat = row < TL;
      float cs[4], sn[4];
      if (islat) {
        const int tt = row & 8191; const float pos = (float)((sub >> 2) ? (tt & 63) : (tt >> 6));
#pragma unroll
        for (int jj = 0; jj < 4; ++jj) { const float rev = pos * freq[jj]; cs[jj] = __builtin_amdgcn_cosf(rev); sn[jj] = __builtin_amdgcn_sinf(rev); }
      } else {
#pragma unroll
        for (int jj = 0; jj < 4; ++jj) { cs[jj] = 1.f; sn[jj] = 0.f; }
      }
#pragma unroll
      for (int qk = 0; qk < 2; ++qk) {
        float v[3][4];
        if (qk == 0) { unpack4(rq[t][0], v[0]); unpack4(rq[t][1], v[1]); unpack4(rq[t][2], v[2]); }
        else { unpack4(rkv[t][0], v[0]); unpack4(rkv[t][1], v[1]); unpack4(rpe[t], v[2]); }
        float ss = 0.f;
#pragma unroll
        for (int i = 0; i < 3; ++i)
#pragma unroll
          for (int jj = 0; jj < 4; ++jj) ss += v[i][jj] * v[i][jj];
        ss += __shfl_xor(ss, 4); ss += __shfl_xor(ss, 2); ss += __shfl_xor(ss, 1);
        const float rstd = rsqrtf(ss * (1.f / 96.f) + EPS);
        const float osc = (qk == 0) ? qs : 1.f;
        u32x2 w[3];
#pragma unroll
        for (int i = 0; i < 3; ++i) {
          float y[4];
#pragma unroll
          for (int jj = 0; jj < 4; ++jj) {
            const float gg = (qk == 0) ? gq[i][jj] : gk[i][jj];
            float yy = v[i][jj] * rstd * gg;
            if (i == 2) { const float pr = __shfl_xor(yy, 2); yy = yy * cs[jj] + sgn * pr * sn[jj]; }
            y[jj] = yy * osc;
          }
          w[i][0] = pk2(y[0], y[1]); w[i][1] = pk2(y[2], y[3]);
        }
        bf16_t* dst = (qk == 0 ? p.MQ : p.KM) + (size_t)row * 768 + hd * 96 + 4 * sub;
        if (!dry) {
#pragma unroll
          for (int i = 0; i < 3; ++i) *(u32x2*)(dst + 32 * i) = w[i];
        }
      }
    }
  }
}

struct AttnArgs {
  const bf16_t* q; int qpitch;
  const bf16_t* k; int kpitch;
  const bf16_t* v; int vpitch;
  bf16_t* o; int opitch;
  int krow_ctx, krow_lat;
  int nct, lt0, lt1;
  int qrow0, qpos0;
  float mb, sinkterm;
  float lam, osc; const float* gsub;
  int dry;
  bf16_t* o0;
};

template <int QSTEPS> DI void load_q(const AttnArgs& a, int colofs, bf16x8 (&qf)[QSTEPS]) {
  const int tid_ = tidx(), lane = tid_ & 63, wave = tid_ >> 6, h = lane >> 5, l32 = lane & 31;
  const bf16_t* qr = a.q + (size_t)(a.qrow0 + wave * 32 + l32) * a.qpitch + 8 * h + colofs;
#pragma unroll
  for (int s = 0; s < QSTEPS; ++s) qf[s] = *(const bf16x8*)(qr + s * 16);
}
template <int NKA, bool KB, int DV, int EPI, bool WIN>
DI void attn_item(const AttnArgs& a, const bf16x8 (&qfr)[4 + (KB ? 2 : 0)], int kcolofs, LDS_AS unsigned char* smem) {
  const int tid_ = tidx(), lane = tid_ & 63, wave = tid_ >> 6, h = lane >> 5, l32 = lane & 31;
  constexpr int NMAP = 1;
  constexpr int QSTEPS = 4 + (KB ? 2 : 0);
  constexpr int NDB = DV / 32;
  constexpr int VP = DV * 2;
  constexpr int AST = 24576, NST = 4;
  constexpr int NLD = 1 + (KB ? 1 : 0) + (DV == 64 ? 1 : 2);
  const int ntile = a.nct + (a.lt1 - a.lt0);
  unsigned kaoff, kboff = 0, voff[DV == 64 ? 1 : 2];
  { const int r = wave * 8 + (lane >> 3), c = (lane & 7) ^ ((r >> 1) & 7); kaoff = (unsigned)(r * a.kpitch + c * 8) * 2u; }
  if (KB) { const int r = (wave & 3) * 16 + (lane >> 2), c = (lane & 3) ^ ((r >> 2) & 3); kboff = (unsigned)(r * a.kpitch + 64 + c * 8) * 2u; }
  if (DV == 64) {
    const int r = wave * 8 + (lane >> 3), c = (lane & 7) ^ (((r >> 1) & 1) << 2); voff[0] = (unsigned)(r * a.vpitch + c * 8) * 2u;
  } else {
#pragma unroll
    for (int j = 0; j < 2; ++j) { const int r = (j * 8 + wave) * 4 + (lane >> 4), c = (lane & 15) ^ ((r & 3) << 2); voff[j] = (unsigned)(r * a.vpitch + c * 8) * 2u; }
  }
  const unsigned ldst = (unsigned)__builtin_amdgcn_readfirstlane((int)(lds_u32(smem) + wave * 1024));
  const unsigned ldstb = (unsigned)__builtin_amdgcn_readfirstlane((int)(lds_u32(smem) + 16384 + (wave & 3) * 1024));
  auto issue = [&](int ti, int stg) {
    const int trow = (ti < a.nct) ? (a.krow_ctx + ti * 64) : (a.krow_lat + (a.lt0 + ti - a.nct) * 64);
    const char* kb = (const char*)(a.k + (size_t)trow * a.kpitch + kcolofs); const char* vb = (const char*)(a.v + (size_t)trow * a.vpitch);
    const unsigned d = ldst + stg * AST;
    glds16a(kb, kaoff, d);
    if (KB) glds16a(kb, kboff, ldstb + stg * AST);
#pragma unroll
    for (int j = 0; j < (DV == 64 ? 1 : 2); ++j) glds16a(vb, voff[j], d + 8192 + j * 8192);
  };
  const int kswzA = (lane >> 1) & 7, kswzB = (lane >> 2) & 3;
  const int krowA = l32 * 128, krowB = l32 * 64;
  int vbase[NDB];
  {
    const int l16 = lane & 15, qq = l16 >> 2, pp = l16 & 3, g16 = (lane >> 4) & 1;
#pragma unroll
    for (int db = 0; db < NDB; ++db) {
      const int cl = 2 * g16 + (pp >> 1);
      const int c = (DV == 64) ? (4 * (db ^ (qq >> 1)) + cl) : (4 * (db ^ qq) + cl);
      vbase[db] = (4 * h + qq) * VP + c * 16 + (pp & 1) * 8;
    }
  }
  f32x16 O[NMAP][NDB];
#pragma unroll
  for (int m = 0; m < NMAP; ++m)
#pragma unroll
    for (int db = 0; db < NDB; ++db)
#pragma unroll
      for (int i = 0; i < 16; ++i) O[m][db][i] = 0.f;
  float lsum[NMAP];
#pragma unroll
  for (int m = 0; m < NMAP; ++m) lsum[m] = 0.f;
  const float negmb = -a.mb;
  const int qpos = a.qpos0 + wave * 32 + l32;

#pragma unroll
  for (int s = 0; s < QSTEPS; ++s) asm volatile("" ::"v"(qfr[s]));
  asm volatile("s_waitcnt vmcnt(0)" ::: "memory");
  __syncthreads();
  issue(0, 0);
  if (ntile > 1) issue(1, 1);
  if (ntile > 2) issue(2, 2);
#pragma unroll 1
  for (int ti = 0; ti < ntile; ++ti) {
    const int rem = ntile - 1 - ti;
    if (rem >= 2) { if (NLD == 2) asm volatile("s_waitcnt vmcnt(4)" ::: "memory"); else asm volatile("s_waitcnt vmcnt(6)" ::: "memory"); }
    else if (rem == 1) { if (NLD == 2) asm volatile("s_waitcnt vmcnt(2)" ::: "memory"); else asm volatile("s_waitcnt vmcnt(3)" ::: "memory"); }
    else asm volatile("s_waitcnt vmcnt(0)" ::: "memory");
    __builtin_amdgcn_s_barrier();
    asm volatile("" ::: "memory");
    if (ti + 3 < ntile) issue(ti + 3, (ti + 3) & 3);
    __builtin_amdgcn_sched_barrier(0);
    LDS_AS unsigned char* st = smem + (ti & 3) * AST;
    LDS_AS unsigned char* sv = st + 8192;
    auto readK = [&](int kb, bf16x8 (&kf)[QSTEPS]) {
      LDS_AS unsigned char* ka = st + kb * 32 * 128 + krowA;
#pragma unroll
      for (int s = 0; s < 4; ++s) kf[s] = lds128(ka + (((2 * s + h) ^ kswzA) << 4));
      if (KB) {
        LDS_AS unsigned char* kbp = st + 16384 + kb * 32 * 64 + krowB;
#pragma unroll
        for (int s = 0; s < 2; ++s) kf[4 + s] = lds128(kbp + (((2 * s + h) ^ kswzB) << 4));
      }
    };
    auto readV = [&](int kb, bf16x8 (&vf)[2][NDB]) {
#pragma unroll
      for (int s = 0; s < 2; ++s)
#pragma unroll
        for (int db = 0; db < NDB; ++db) {
          const int rc = (kb * 32 + 16 * s) * VP;
          const s16x4 lo = __builtin_amdgcn_ds_read_tr16_b64_v4i16((LDS_AS s16x4*)(sv + vbase[db] + rc));
          const s16x4 hi = __builtin_amdgcn_ds_read_tr16_b64_v4i16((LDS_AS s16x4*)(sv + vbase[db] + rc + 8 * VP));
          vf[s][db] = __builtin_shufflevector(lo, hi, 0, 1, 2, 3, 4, 5, 6, 7);
        }
    };
    auto qk = [&](const bf16x8 (&kf)[QSTEPS], f32x16& S) {
#pragma unroll
      for (int i = 0; i < 16; ++i) S[i] = negmb;
#pragma unroll
      for (int s = 0; s < QSTEPS; ++s) S = MFMA32(kf[s], qfr[s], S);
    };
    auto softmax = [&](int kb, f32x16& S, bf16x8 (&pb)[2]) {
      if (WIN) {
        if (ti >= a.nct) {
          const int kp0 = (a.lt0 + ti - a.nct) * 64 + 4 * h - qpos + kb * 32;
#pragma unroll
          for (int i = 0; i < 16; ++i) {
            const int dlt = kp0 + (i & 3) + 8 * (i >> 2);
            if (dlt > 128 || dlt < -128) S[i] = -INFINITY;
          }
        }
      }
      float ls = 0.f;
#pragma unroll
      for (int i = 0; i < 16; ++i) { S[i] = __builtin_amdgcn_exp2f(S[i]); ls += S[i]; }
      lsum[0] += ls;
#pragma unroll
      for (int s = 0; s < 2; ++s) {
        u32x4 pw;
#pragma unroll
        for (int j = 0; j < 4; ++j) pw[j] = pk2(S[8 * s + 2 * j], S[8 * s + 2 * j + 1]);
        pb[s] = __builtin_bit_cast(bf16x8, pw);
      }
    };
    auto pv = [&](const bf16x8 (&vf)[2][NDB], const bf16x8 (&pb)[2]) {
#pragma unroll
      for (int s = 0; s < 2; ++s)
#pragma unroll
        for (int db = 0; db < NDB; ++db) O[0][db] = MFMA32(vf[s][db], pb[s], O[0][db]);
    };
    {
      bf16x8 kf0[QSTEPS], kf1[QSTEPS], vf0[2][NDB], vf1[2][NDB], p0[2], p1[2];
      f32x16 S0, S1;
      readK(0, kf0); readV(0, vf0);
      __builtin_amdgcn_sched_barrier(0);
      qk(kf0, S0);
      __builtin_amdgcn_sched_barrier(0);
      readK(1, kf1);
      __builtin_amdgcn_sched_barrier(0);
      qk(kf1, S1);
      __builtin_amdgcn_sched_barrier(0);
      softmax(0, S0, p0);
      __builtin_amdgcn_sched_barrier(0);
      pv(vf0, p0);
      __builtin_amdgcn_sched_barrier(0);
      readV(1, vf1);
      __builtin_amdgcn_sched_barrier(0);
      softmax(1, S1, p1);
      __builtin_amdgcn_sched_barrier(0);
      pv(vf1, p1);
      __builtin_amdgcn_sched_barrier(0);
    }
  }
  const float lt = lsum[0] + __shfl_xor(lsum[0], 32) + a.sinkterm;
  const float inv = 1.f / lt;
  bf16_t* orow = a.o + (size_t)(a.qrow0 + wave * 32 + l32) * a.opitch + 4 * h;
  if (a.dry) return;
  if (EPI == 0) {
#pragma unroll
    for (int db = 0; db < NDB; ++db)
#pragma unroll
      for (int g = 0; g < 4; ++g) {
        u32x2 w = {pk2(O[0][db][4 * g] * inv, O[0][db][4 * g + 1] * inv), pk2(O[0][db][4 * g + 2] * inv, O[0][db][4 * g + 3] * inv)};
        *(u32x2*)(orow + db * 32 + 8 * g) = w;
      }
  } else {
    const float c1 = inv * a.lam;
    float ss = 0.f;
#pragma unroll
    for (int db = 0; db < NDB; ++db)
#pragma unroll
      for (int g = 0; g < 4; ++g) {
        const u32x2 raw = *(const u32x2*)(a.o0 + (size_t)(a.qrow0 + wave * 32 + l32) * 512 + 4 * h + db * 32 + 8 * g);
        const float o0[4] = {__uint_as_float(raw[0] << 16), __uint_as_float(raw[0] & 0xffff0000u), __uint_as_float(raw[1] << 16), __uint_as_float(raw[1] & 0xffff0000u)};
#pragma unroll
        for (int j = 0; j < 4; ++j) { const float v = o0[j] - O[0][db][4 * g + j] * c1; O[0][db][4 * g + j] = v; ss += v * v; }
      }
    ss += __shfl_xor(ss, 32);
    const float rstd = rsqrtf(ss * (1.f / (float)DV) + EPS) * a.osc;
#pragma unroll
    for (int db = 0; db < NDB; ++db)
#pragma unroll
      for (int g = 0; g < 4; ++g) {
        const f32x4 gs = *(const f32x4*)(a.gsub + db * 32 + 8 * g + 4 * h);
        u32x2 w = {pk2(O[0][db][4 * g] * rstd * gs[0], O[0][db][4 * g + 1] * rstd * gs[1]), pk2(O[0][db][4 * g + 2] * rstd * gs[2], O[0][db][4 * g + 3] * rstd * gs[3])};
        *(u32x2*)(orow + db * 32 + 8 * g) = w;
      }
  }
}

DI void attn_diff_item(const AttnArgs& a, LDS_AS unsigned char* smem) {
  AttnArgs a0 = a; a0.o = a.o0; a0.opitch = 512; a0.dry = 0;
  { bf16x8 q0[4]; load_q<4>(a, 0, q0); attn_item<1, false, 128, 0, false>(a0, q0, 0, smem); }
  { bf16x8 q1[4]; load_q<4>(a, 64, q1); attn_item<1, false, 128, 1, false>(a, q1, 64, smem); }
}

DI void phase_attention(const Params& p, int l, LDS_AS unsigned char* smem, int dry) {
  const float* cs = p.consts + l * 16;
  const float lam = cs[0], lam_init = cs[1], mb_mla = cs[2], mb_swa = cs[3], mb_diff = cs[4];
  const int nc_d = (l == 0) ? 16 : 0, nc_m = (l == 0) ? 32 : 0;
#pragma unroll 1
  for (int i = blockIdx.x; i < 512 + nc_d; i += gridDim.x) {
    AttnArgs a; a.dry = dry;
    int b, hd;
    if (i < 512) {
      const int id = xcd_remap(i, 512), pair = id >> 5, qb = id & 31; b = pair >> 2; hd = pair & 3;
      a.lt0 = 0; a.lt1 = 128; a.qrow0 = b * 8192 + qb * 256;
    } else {
      const int j = i - 512; b = j >> 2; hd = j & 3;
      a.lt0 = 0; a.lt1 = 0; a.qrow0 = TL + b * 256;
    }
    a.q = p.PROJ + C_DQ + hd * 128; a.qpitch = PN; a.k = p.PROJ + C_DK + hd * 128; a.kpitch = PN; a.v = p.PROJ + C_DV + hd * 128; a.vpitch = PN;
    a.o = p.PROJ + C_DQ + hd * 128; a.opitch = PN; a.o0 = p.YD0 + hd * 128;
    a.krow_ctx = TL + b * 256; a.krow_lat = b * 8192; a.nct = 4; a.qpos0 = 0;
    a.mb = mb_diff; a.sinkterm = 0.f; a.lam = lam; a.osc = 1.f - lam_init; a.gsub = p.g_diff_sub + l * 128;
    attn_diff_item(a, smem);
  }
#pragma unroll 1
  for (int i = blockIdx.x; i < 1024 + nc_m; i += gridDim.x) {
    AttnArgs a; a.dry = dry;
    int b, hd;
    if (i < 1024) {
      const int id = xcd_remap(i, 1024), pair = id >> 5, qb = id & 31; b = pair >> 3; hd = pair & 7;
      a.lt0 = 0; a.lt1 = 128; a.qrow0 = b * 8192 + qb * 256;
    } else {
      const int j = i - 1024; b = j >> 3; hd = j & 7;
      a.lt0 = 0; a.lt1 = 0; a.qrow0 = TL + b * 256;
    }
    a.q = p.MQ + hd * 96; a.qpitch = 768; a.k = p.KM + hd * 96; a.kpitch = 768; a.v = p.KV + hd * 128 + 64; a.vpitch = 1024;
    a.o = p.MQ + hd * 96; a.opitch = 768; a.o0 = nullptr;
    a.krow_ctx = TL + b * 256; a.krow_lat = b * 8192; a.nct = 4; a.qpos0 = 0;
    a.mb = mb_mla; a.sinkterm = 0.f; a.lam = 0.f; a.osc = 0.f; a.gsub = nullptr;
    bf16x8 qf[6]; load_q<6>(a, 0, qf);
    attn_item<1, true, 64, 0, false>(a, qf, 0, smem);
  }
#pragma unroll 1
  for (int i = blockIdx.x; i < 1024 + nc_m; i += gridDim.x) {
    AttnArgs a; a.dry = dry;
    int b, hq;
    if (i < 1024) {
      const int id = xcd_remap(i, 1024), pair = id >> 5, qb = id & 31; b = pair >> 3; hq = pair & 7;
      a.lt0 = (4 * qb - 2 < 0) ? 0 : 4 * qb - 2; a.lt1 = (4 * qb + 6 > 128) ? 128 : 4 * qb + 6;
      a.qrow0 = b * 8192 + qb * 256; a.qpos0 = qb * 256;
    } else {
      const int j = i - 1024; b = j >> 3; hq = j & 7;
      a.lt0 = 0; a.lt1 = 0; a.qrow0 = TL + b * 256; a.qpos0 = 0;
    }
    const int kvh = hq >> 2;
    a.q = p.PROJ + C_SQ + hq * 64; a.qpitch = PN; a.k = p.PROJ + C_SK + kvh * 64; a.kpitch = PN; a.v = p.PROJ + C_SV + kvh * 64; a.vpitch = PN;
    a.o = p.PROJ + C_SQ + hq * 64; a.opitch = PN; a.o0 = nullptr;
    a.krow_ctx = TL + b * 256; a.krow_lat = b * 8192; a.nct = 4;
    a.mb = mb_swa; a.sinkterm = __builtin_amdgcn_exp2f(p.swa_sink[l * 8 + hq] * LOG2E - mb_swa); a.lam = 0.f; a.osc = 0.f; a.gsub = nullptr;
    bf16x8 qf[4]; load_q<4>(a, 0, qf);
    attn_item<1, false, 64, 0, true>(a, qf, 0, smem);
  }
}

constexpr int NPH = 1 + 2 * 11;
DI void run_phase(const Params& p, int ph, LDS_AS unsigned char* smem, int dry) {
#ifdef ONLY_S
  if (ONLY_S == 99) { if (ph == 0) phase0(p, smem, dry); return; }
  if (ph == 0) return;
  const int l = (ph - 1) / 11, s = ONLY_S;
#else
  if (ph == 0) { phase0(p, smem, dry); return; }
  const int l = (ph - 1) / 11, s = (ph - 1) % 11;
#endif
  switch (s) {
    case 0: norm_phase(p, l, 0, dry); break;
    case 1: phase_gemm_in(p, l, smem, dry); break;
    case 2: phase_prep_a(p, l, dry); break;
    case 3: phase_gemm_mla(p, l, smem, dry); break;
    case 4: phase_prep_c(p, l, dry); break;
    case 5: phase_attention(p, l, smem, dry); break;
    case 6: phase_merge(p, l, smem, dry); break;
    case 7: phase_residual_gemm(p, l, 0, smem, dry); break;
    case 8: norm_phase(p, l, 1, dry); break;
    case 9: phase_mlp_in(p, l, smem, dry); break;
    default: phase_residual_gemm(p, l, 1, smem, dry); break;
  }
}

__global__ void __launch_bounds__(512, 2) mega_kernel(Params p) {
  __shared__ __attribute__((aligned(16))) unsigned char smem_raw[3 * GST];
  LDS_AS unsigned char* smem = (LDS_AS unsigned char*)smem_raw;
  __shared__ uint4 xb_words;
  cg::grid_group grid = cg::this_grid();
  if (threadIdx.x == 0) xb_words = make_uint4(0u, 0u, 0u, 0u);
  __syncthreads();
  const XcdBarrier xb = xcd_barrier_post(p.bar, (volatile LDS_AS unsigned*)&xb_words);
#pragma unroll 1
  for (int ph = 0; ph < NPH; ++ph) {
    const int st = (ph == 0) ? 31 : (ph - 1) % 11;
    const int nrep = (((unsigned)p.probe >> st) & 1u) ? 2 : 1;
    for (int rep = 0; rep < nrep; ++rep) run_phase(p, ph, smem, rep + 1 < nrep);
    if (ph + 1 < NPH) { if (ph == 0) grid.sync(); else xcd_barrier(xb); }
  }
}
#ifdef MK_MULTI
__global__ void __launch_bounds__(512, 2) phase_kernel(Params p, int ph) {
  __shared__ __attribute__((aligned(16))) unsigned char smem_raw[3 * GST];
  run_phase(p, ph, (LDS_AS unsigned char*)smem_raw, 0);
}
#endif

extern "C" void kernel_launch(void* const* d_in, const int* in_sizes, int n_in, void* d_out, int out_size, void* d_ws, size_t ws_size,
                              hipStream_t stream) {
  Params p{};
  const float* const* in = (const float* const*)d_in;
  p.x = in[0]; p.c = in[1]; p.ctx = in[2]; p.c_ctx = in[3]; p.w_mod = in[4]; p.b_mod = in[5]; p.g_norm_attn = in[6]; p.g_norm_mlp = in[7];
  p.w_in = in[8]; p.g_q_lora = in[9]; p.w_uq = in[10]; p.g_kv_lora = in[11]; p.w_ukv = in[12]; p.g_mla_q = in[13]; p.g_mla_k = in[14];
  p.w_up_mla = in[15]; p.g_swa_q = in[16]; p.g_swa_k = in[17]; p.swa_sink = in[18]; p.w_up_swa = in[19]; p.g_diff_q = in[20]; p.g_diff_k = in[21];
  p.lambda_q1 = in[22]; p.lambda_k1 = in[23]; p.lambda_q2 = in[24]; p.lambda_k2 = in[25]; p.g_diff_sub = in[26]; p.w_up_diff = in[27];
  p.w_o = in[28]; p.w_mlp_in = in[29]; p.w_mlp_out = in[30];
#ifndef PROBE_MASK
#define PROBE_MASK 0
#endif
  p.probe = PROBE_MASK; p.pad_ = 0;
  p.out = (float*)d_out;
  unsigned char* ws = (unsigned char*)d_ws;
  size_t off = 0;
  auto take = [&](size_t bytes) { unsigned char* r = ws + off; off += (bytes + 255) & ~(size_t)255; return r; };
  p.modtab = (float*)take(2 * 5 * 6144 * 4);
  p.consts = (float*)take(256);
  p.bar = (unsigned*)take(XCD_BAR_WORDS * 4);
  p.WB = (bf16_t*)take(2 * W_LAYER * 2);
  p.H = (bf16_t*)take((size_t)T * 1024 * 2);
  p.PROJ = (bf16_t*)take((size_t)T * PN * 2);
  p.MQ = (bf16_t*)take((size_t)T * 768 * 2);
  p.KV = (bf16_t*)take((size_t)T * 1024 * 2);
  p.KM = (bf16_t*)take((size_t)T * 768 * 2);
  p.CX = (float*)take((size_t)TC * 1024 * 4);
  p.YD0 = (bf16_t*)take((size_t)T * 512 * 2);
  if (off > ws_size) { fprintf(stderr, "workspace too small: need %zu have %zu\n", off, ws_size); return; }
  (void)hipMemsetAsync(p.modtab, 0, (size_t)((unsigned char*)p.bar - (unsigned char*)p.modtab) + XCD_BAR_WORDS * 4, stream);
#ifdef MK_MULTI
  for (int ph = 0; ph < NPH; ++ph) phase_kernel<<<256, 512, 0, stream>>>(p, ph);
#else
  static int grid_blocks = 0;
  if (!grid_blocks) {
    int dev = 0, cus = 0, per_cu = 0;
    hipGetDevice(&dev);
    hipDeviceGetAttribute(&cus, hipDeviceAttributeMultiprocessorCount, dev);
    hipOccupancyMaxActiveBlocksPerMultiprocessor(&per_cu, mega_kernel, 512, 0);
    if (per_cu > 1) per_cu = 1;
    grid_blocks = cus * per_cu;
    if (grid_blocks <= 0) grid_blocks = 256;
  }
  void* args[] = {&p};
  hipError_t e = hipLaunchCooperativeKernel((void*)mega_kernel, dim3(grid_blocks), dim3(512), args, 0, stream);
  if (e != hipSuccess) fprintf(stderr, "cooperative launch failed: %s (grid %d)\n", hipGetErrorString(e), grid_blocks);
#endif
}
```

```cpp
#include <hip/hip_runtime.h>
#include <hip/hip_cooperative_groups.h>
#include <cstdio>
#include <cstdint>
namespace cg = cooperative_groups;

typedef unsigned short bf16_t;
typedef short bf16x8 __attribute__((ext_vector_type(8)));
typedef short s16x4 __attribute__((ext_vector_type(4)));
typedef float f32x16 __attribute__((ext_vector_type(16)));
typedef float f32x4 __attribute__((ext_vector_type(4)));
typedef float f32x2 __attribute__((ext_vector_type(2)));
typedef __bf16 bf16x2_t __attribute__((ext_vector_type(2)));
typedef unsigned u32x2 __attribute__((ext_vector_type(2)));
typedef unsigned u32x4 __attribute__((ext_vector_type(4)));
#define LDS_AS __attribute__((address_space(3)))
#define DI __device__ __forceinline__

constexpr int D = 1024, NB = 4, SEQ = 8192, NCTX = 256;
constexpr int TL = NB * SEQ;
constexpr int TC = NB * NCTX;
constexpr int T = TL + TC;
constexpr int PN = 2720;
constexpr int C_QLAT = 0, C_KVLAT = 256, C_KPE = 384, C_SQ = 416, C_SK = 928, C_SV = 1056, C_DQ = 1184, C_DK = 1696, C_DV = 2208;
constexpr float EPS = 1e-6f;
constexpr float LOG2E = 1.4426950408889634f;
constexpr size_t W_IN = 0;
constexpr size_t W_UQ = W_IN + (size_t)5888 * 1024;
constexpr size_t W_UKV = W_UQ + 768 * 256;
constexpr size_t W_UPM = W_UKV + 1024 * 128;
constexpr size_t W_UPS = W_UPM + 1024 * 512;
constexpr size_t W_UPD = W_UPS + 1024 * 512;
constexpr size_t W_O = W_UPD + 1024 * 512;
constexpr size_t W_M1 = W_O + 1024 * 1024;
constexpr size_t W_M2 = W_M1 + (size_t)4096 * 1024;
constexpr size_t W_LAYER = W_M2 + (size_t)4096 * 1024;

struct Params {
  const float *x, *c, *ctx, *c_ctx, *w_mod, *b_mod, *g_norm_attn, *g_norm_mlp, *w_in, *g_q_lora, *w_uq, *g_kv_lora, *w_ukv,
      *g_mla_q, *g_mla_k, *w_up_mla, *g_swa_q, *g_swa_k, *swa_sink, *w_up_swa, *g_diff_q, *g_diff_k, *lambda_q1, *lambda_k1,
      *lambda_q2, *lambda_k2, *g_diff_sub, *w_up_diff, *w_o, *w_mlp_in, *w_mlp_out;
  float* out;
  float* modtab;
  float* consts;
  unsigned* bar;
  bf16_t* WB;
  bf16_t* H;
  bf16_t* PROJ;
  bf16_t* MQ;
  bf16_t* KV;
  bf16_t* KM;
  float* CX;
  bf16_t* YD0;
  int probe, pad_;
};

template <class Tp> DI Tp* opq(Tp* ptr) { asm volatile("" : "+s"(ptr)); return ptr; }
DI int tidx() { int t = threadIdx.x; asm volatile("" : "+v"(t)); return t; }
DI float bf2f(bf16_t v) { return __uint_as_float((unsigned)v << 16); }
DI unsigned pk2(float a, float b) { f32x2 v = {a, b}; bf16x2_t r = __builtin_convertvector(v, bf16x2_t); return __builtin_bit_cast(unsigned, r); }
DI bf16_t f2bf(float a) { return (bf16_t)(pk2(a, 0.f) & 0xffffu); }
DI float wave_sum(float v) {
#pragma unroll
  for (int o = 32; o; o >>= 1) v += __shfl_xor(v, o);
  return v;
}
DI float wave_max(float v) {
#pragma unroll
  for (int o = 32; o; o >>= 1) v = fmaxf(v, __shfl_xor(v, o));
  return v;
}
DI float silu(float x) { return x / (1.f + __expf(-x)); }
DI int xcd_remap(int L, int n) {
  const int q = n >> 3, r = n & 7, xcd = L & 7, off = L >> 3;
  return (xcd < r ? xcd * (q + 1) : r * (q + 1) + (xcd - r) * q) + off;
}
DI void glds16(const void* g, LDS_AS unsigned char* l) {
  __builtin_amdgcn_global_load_lds((const unsigned*)g, (LDS_AS unsigned*)l, 16, 0, 0);
}
DI void glds16a(const void* base, unsigned voff, unsigned ldsaddr) {
  unsigned keep;
  asm volatile("s_mov_b32 %0, m0\n\ts_mov_b32 m0, %3\n\ts_nop 0\n\tglobal_load_lds_dwordx4 %1, %2\n\ts_mov_b32 m0, %0"
               : "=&s"(keep) : "v"(voff), "s"(base), "s"(ldsaddr) : "memory");
}
DI unsigned lds_u32(LDS_AS unsigned char* p) { return (unsigned)(uintptr_t)p; }
DI bf16x8 lds128(LDS_AS unsigned char* p) { return *(LDS_AS bf16x8*)p; }
#define MFMA32(a, b, c) __builtin_amdgcn_mfma_f32_32x32x16_bf16((a), (b), (c), 0, 0, 0)

#define XB_TMO      128
#define XB_XCNT(j)  (256  + 64 * (j))
#define XB_XSUB(j)  (1280 + 64 * (j))
#define XB_XGEN(j)  (2304 + 64 * (j))
#define XB_TOP      3328
#define XB_TOPGEN   3392
#define XCD_BAR_WORDS 3456
#define XB_SPIN_CAP (1u << 22)
DI unsigned xb_ld(unsigned* p) { return __hip_atomic_load(p, __ATOMIC_RELAXED, __HIP_MEMORY_SCOPE_AGENT); }
DI unsigned xb_add(unsigned* p, unsigned v) { return __hip_atomic_fetch_add(p, v, __ATOMIC_RELAXED, __HIP_MEMORY_SCOPE_AGENT); }
DI unsigned xb_xcc_id() { return (unsigned)__builtin_amdgcn_s_getreg((3 << 11) | 20) & 0xFu; }
#define XB_SPIN(cond, bar) do { unsigned _sp = 0; while (cond) { __builtin_amdgcn_s_sleep(1); \
    if ((++_sp & 255u) == 0u) { if (xb_ld(&(bar)[XB_TMO])) break; if (_sp > XB_SPIN_CAP) { atomicAdd(&(bar)[XB_TMO], 1u); break; } } } } while (0)
struct XcdBarrier { unsigned* bar; unsigned x; volatile LDS_AS unsigned* st; };
DI XcdBarrier xcd_barrier_post(unsigned* bar, volatile LDS_AS unsigned* st) {
  XcdBarrier b; b.bar = bar; b.x = xb_xcc_id(); b.st = st;
  if (threadIdx.x == 0) (void)xb_add(&bar[XB_XCNT(b.x)], 1u);
  return b;
}
DI void xcd_barrier_complete(unsigned* bar, unsigned x, unsigned& nloc, unsigned& nx) {
  const unsigned G = gridDim.x * gridDim.y * gridDim.z;
  unsigned sum, cnt, mine, sp = 0u;
  for (;;) {
    sum = 0u; cnt = 0u; mine = 0u;
#pragma unroll
    for (unsigned j = 0; j < 16; ++j) { const unsigned c = xb_ld(&bar[XB_XCNT(j)]); sum += c; cnt += (c > 0u) ? 1u : 0u; mine = (j == x) ? c : mine; }
    if (sum == G) break;
    __builtin_amdgcn_s_sleep(1);
    if ((++sp & 255u) == 0u) { if (xb_ld(&bar[XB_TMO])) break; if (sp > XB_SPIN_CAP) { atomicAdd(&bar[XB_TMO], 1u); break; } }
  }
  nloc = mine > 0u ? mine : 1u; nx = cnt > 0u ? cnt : 1u;
}
DI void xcd_barrier(const XcdBarrier& b) {
  asm volatile("s_waitcnt vmcnt(0)" ::: "memory");
  __syncthreads();
  if (threadIdx.x == 0) {
    unsigned* bar = b.bar;
    __builtin_amdgcn_s_waitcnt(0);
    unsigned nloc = b.st[0], nx = b.st[1];
    if (nloc == 0u) { xcd_barrier_complete(bar, b.x, nloc, nx); b.st[0] = nloc; b.st[1] = nx; }
    const unsigned old = xb_add(&bar[XB_XSUB(b.x)], 1u);
    const unsigned gen = old / nloc;
    if (old + 1u == (gen + 1u) * nloc) {
      __builtin_amdgcn_fence(__ATOMIC_RELEASE, "agent");
      asm volatile("s_waitcnt vmcnt(0)" ::: "memory");
      const unsigned og = xb_add(&bar[XB_TOP], 1u);
      const unsigned tg = og / nx;
      if (og + 1u == (tg + 1u) * nx) xb_add(&bar[XB_TOPGEN], 1u);
      else XB_SPIN(xb_ld(&bar[XB_TOPGEN]) == tg, bar);
      __builtin_amdgcn_fence(__ATOMIC_ACQUIRE, "agent");
      xb_add(&bar[XB_XGEN(b.x)], 1u);
      asm volatile("s_waitcnt vmcnt(0)" ::: "memory");
    } else {
      XB_SPIN(xb_ld(&bar[XB_XGEN(b.x)]) == gen, bar);
      __builtin_amdgcn_fence(__ATOMIC_ACQUIRE, "agent");
      asm volatile("s_waitcnt vmcnt(0)" ::: "memory");
    }
  }
  __syncthreads();
}

struct ConvT { const float* src; bf16_t* dst; int ld, K, k0, n0, is_win; };
DI void conv_load(const ConvT& d, int tid, f32x4 (&v)[2]) {
  const int ty = tid >> 4, tx = tid & 15, n = d.n0 + 4 * tx;
  int sc = n;
  if (d.is_win) sc = (n < 2720) ? n : (n < 2816 ? -1 : n - 96);
#pragma unroll
  for (int i = 0; i < 2; ++i) {
    v[i] = (f32x4){0.f, 0.f, 0.f, 0.f};
    if (sc >= 0) v[i] = *(const f32x4*)(d.src + (size_t)(d.k0 + ty + 32 * i) * d.ld + sc);
  }
}
DI void conv_finish(const ConvT& d, int tid, const f32x4 (&v)[2], LDS_AS float* tile, int dry) {
  const int ty = tid >> 4, tx = tid & 15;
#pragma unroll
  for (int i = 0; i < 2; ++i) {
    const int k = ty + 32 * i;
    tile[k * 65 + 4 * tx + 0] = v[i][0]; tile[k * 65 + 4 * tx + 1] = v[i][1]; tile[k * 65 + 4 * tx + 2] = v[i][2]; tile[k * 65 + 4 * tx + 3] = v[i][3];
  }
  __syncthreads();
  {
    const int r = tid >> 3, c = tid & 7;
    u32x4 w;
    w[0] = pk2(tile[(8 * c + 0) * 65 + r], tile[(8 * c + 1) * 65 + r]);
    w[1] = pk2(tile[(8 * c + 2) * 65 + r], tile[(8 * c + 3) * 65 + r]);
    w[2] = pk2(tile[(8 * c + 4) * 65 + r], tile[(8 * c + 5) * 65 + r]);
    w[3] = pk2(tile[(8 * c + 6) * 65 + r], tile[(8 * c + 7) * 65 + r]);
    if (!dry) *(u32x4*)(d.dst + (size_t)(d.n0 + r) * d.K + d.k0 + 8 * c) = w;
  }
}
DI ConvT conv_decode(const Params& p, int t) {
  ConvT d; d.is_win = 0;
  const int l = t / 4240; int u = t % 4240; size_t doff;
  if (u < 1472) { d.src = p.w_in + (size_t)l * 1024 * 5792; d.ld = 5792; d.K = 1024; d.is_win = 1; doff = W_IN; }
  else if (u < 1520) { u -= 1472; d.src = p.w_uq + (size_t)l * 256 * 768; d.ld = 768; d.K = 256; doff = W_UQ; }
  else if (u < 1552) { u -= 1520; d.src = p.w_ukv + (size_t)l * 128 * 1024; d.ld = 1024; d.K = 128; doff = W_UKV; }
  else if (u < 1680) { u -= 1552; d.src = p.w_up_mla + (size_t)l * 512 * 1024; d.ld = 1024; d.K = 512; doff = W_UPM; }
  else if (u < 1808) { u -= 1680; d.src = p.w_up_swa + (size_t)l * 512 * 1024; d.ld = 1024; d.K = 512; doff = W_UPS; }
  else if (u < 1936) { u -= 1808; d.src = p.w_up_diff + (size_t)l * 512 * 1024; d.ld = 1024; d.K = 512; doff = W_UPD; }
  else if (u < 2192) { u -= 1936; d.src = p.w_o + (size_t)l * 1024 * 1024; d.ld = 1024; d.K = 1024; doff = W_O; }
  else if (u < 3216) { u -= 2192; d.src = p.w_mlp_in + (size_t)l * 1024 * 4096; d.ld = 4096; d.K = 1024; doff = W_M1; }
  else { u -= 3216; d.src = p.w_mlp_out + (size_t)l * 4096 * 1024; d.ld = 1024; d.K = 4096; doff = W_M2; }
  const int nkt = d.K >> 6;
  d.k0 = (u % nkt) * 64; d.n0 = (u / nkt) * 64; d.dst = p.WB + (size_t)l * W_LAYER + doff;
  return d;
}

DI void phase0(const Params& p, LDS_AS unsigned char* smem, int dry) {
  const int tid_ = tidx(), lane = tid_ & 63, wave = tid_ >> 6;
  if (blockIdx.x == 0 && wave == 0) {
    for (int l = 0; l < 2; ++l) {
      const float s1 = wave_sum(p.lambda_q1[l * 64 + lane] * p.lambda_k1[l * 64 + lane]);
      const float s2 = wave_sum(p.lambda_q2[l * 64 + lane] * p.lambda_k2[l * 64 + lane]);
      const float lam_init = 0.8f - 0.6f * expf(-0.3f * (float)l);
      const float lam = expf(s1) - expf(s2) + lam_init;
      float a = fabsf(p.g_mla_q[l * 96 + lane]); if (lane < 32) a = fmaxf(a, fabsf(p.g_mla_q[l * 96 + 64 + lane]));
      float b = fabsf(p.g_mla_k[l * 96 + lane]); if (lane < 32) b = fmaxf(b, fabsf(p.g_mla_k[l * 96 + 64 + lane]));
      const float mq = wave_max(a), mk = wave_max(b);
      const float sq = wave_max(fabsf(p.g_swa_q[l * 64 + lane])), sk = wave_max(fabsf(p.g_swa_k[l * 64 + lane]));
      const float dq = wave_max(fabsf(p.g_diff_q[l * 64 + lane])), dk = wave_max(fabsf(p.g_diff_k[l * 64 + lane]));
      if (lane == 0) {
        float* cs = p.consts + l * 16;
        cs[0] = lam; cs[1] = lam_init;
        cs[2] = LOG2E * sqrtf(96.f) * mq * mk;
        cs[3] = LOG2E * 8.f * sq * sk;
        cs[4] = LOG2E * 8.f * dq * dk;
      }
    }
  }
  for (int task = blockIdx.x * 8 + wave; task < 3072; task += gridDim.x * 8) {
    const int l = task / 1536, rem = task % 1536, chunk = rem >> 4, ks = rem & 15;
    const int n = chunk * 64 + lane;
    float acc[5] = {0.f, 0.f, 0.f, 0.f, 0.f};
    const float* w = p.w_mod + ((size_t)l * 1024 + ks * 64) * 6144 + n;
#pragma unroll 8
    for (int k = 0; k < 64; ++k) {
      const float wv = w[(size_t)k * 6144];
      const int kk = ks * 64 + k;
#pragma unroll
      for (int r = 0; r < 4; ++r) acc[r] += silu(p.c[r * 1024 + kk]) * wv;
      acc[4] += silu(p.c_ctx[kk]) * wv;
    }
    const float bias = (ks == 0) ? p.b_mod[l * 6144 + n] : 0.f;
    if (!dry)
#pragma unroll
      for (int r = 0; r < 5; ++r) atomicAdd(p.modtab + (size_t)(l * 5 + r) * 6144 + n, acc[r] + bias);
  }
  {
    constexpr int NTI = 4, TBUF = 64 * 65 + 16;
    LDS_AS float* tile0 = (LDS_AS float*)smem;
    const int tid = tidx(), G = gridDim.x, NTOT = 2 * 4240;
    for (int t = blockIdx.x; t < NTOT; t += NTI * G) {
      ConvT d[NTI]; f32x4 v[NTI][2];
#pragma unroll
      for (int q = 0; q < NTI; ++q) { d[q] = conv_decode(p, (t + q * G < NTOT) ? t + q * G : t); conv_load(d[q], tid, v[q]); }
      __syncthreads();
#pragma unroll
      for (int q = 0; q < NTI; ++q)
        if (t + q * G < NTOT) conv_finish(d[q], tid, v[q], tile0 + q * TBUF, dry);
    }
    __syncthreads();
  }
}

DI void norm_phase(const Params& p, int l, int which, int dry) {
  const int tid_ = tidx(), lane = tid_ & 63, wave = tid_ >> 6;
  const float* g = (which == 0 ? p.g_norm_attn : p.g_norm_mlp) + l * 1024;
  const int shoff = which == 0 ? 0 : 3072, scoff = shoff + 1024;
  const int nrows = (which == 1 && l == 1) ? TL : T;
  const bool first = (which == 0 && l == 0);
  const float* px = opq(p.x); const float* pctx = opq(p.ctx); const float* pout = opq((const float*)p.out); const float* pcx = opq((const float*)p.CX);
  const float* slat = first ? px : pout; const float* sctx = first ? pctx : pcx;
  for (int row = blockIdx.x * 8 + wave; row < nrows; row += gridDim.x * 8) {
    const float* xr; int bidx;
    if (row < TL) { xr = slat + (size_t)row * 1024; bidx = row >> 13; }
    else { xr = sctx + (size_t)(row - TL) * 1024; bidx = 4; }
    const float* mod = p.modtab + (size_t)(l * 5 + bidx) * 6144;
    f32x4 v[4]; float ss = 0.f;
#pragma unroll
    for (int i = 0; i < 4; ++i) { v[i] = *(const f32x4*)(xr + i * 256 + lane * 4); ss += v[i][0] * v[i][0] + v[i][1] * v[i][1] + v[i][2] * v[i][2] + v[i][3] * v[i][3]; }
    ss = wave_sum(ss);
    const float rstd = rsqrtf(ss * (1.f / 1024.f) + EPS);
#pragma unroll
    for (int i = 0; i < 4; ++i) {
      const int col = i * 256 + lane * 4;
      const f32x4 gv = *(const f32x4*)(g + col), sh = *(const f32x4*)(mod + shoff + col), sc = *(const f32x4*)(mod + scoff + col);
      float o[4];
#pragma unroll
      for (int j = 0; j < 4; ++j) o[j] = (v[i][j] * rstd * gv[j]) * (1.f + sc[j]) + sh[j];
      u32x2 w = {pk2(o[0], o[1]), pk2(o[2], o[3])};
      if (!dry) *(u32x2*)(p.H + (size_t)row * 1024 + col) = w;
    }
  }
}

constexpr int GST = 49152;
DI void gemm_kloop(const bf16_t* Ag, int lda, int a_kstep, const bf16_t* Bg, int ldb, int nkt, f32x16 (&acc)[2][2], LDS_AS unsigned char* smem) {
  const int tid_ = tidx(), lane = tid_ & 63, wave = tid_ >> 6, h = lane >> 5, wm = wave >> 1, wn = wave & 1;
  unsigned aoff[4], boff[2];
#pragma unroll
  for (int i = 0; i < 4; ++i) {
    const int r = wave * 32 + i * 8 + (lane >> 3), c = (lane & 7) ^ ((r >> 1) & 7);
    aoff[i] = (unsigned)(r * lda + c * 8) * 2u;
  }
#pragma unroll
  for (int i = 0; i < 2; ++i) {
    const int r = wave * 16 + i * 8 + (lane >> 3), c = (lane & 7) ^ ((r >> 1) & 7);
    boff[i] = (unsigned)(r * ldb + c * 8) * 2u;
  }
  const unsigned dstA = (unsigned)__builtin_amdgcn_readfirstlane((int)(lds_u32(smem) + wave * 4096));
  const unsigned dstB = (unsigned)__builtin_amdgcn_readfirstlane((int)(lds_u32(smem) + 32768 + wave * 2048));
  const int swz = (lane >> 1) & 7;
  const int arow = (wm * 64 + (lane & 31)) * 128, brow = 32768 + (wn * 64 + (lane & 31)) * 128;
  asm volatile("s_waitcnt vmcnt(0)" ::: "memory");
  __syncthreads();
  auto issue = [&](int kt, int stg) {
    const char* An = (const char*)(Ag + (size_t)kt * a_kstep); const char* Bn = (const char*)(Bg + (size_t)kt * 64);
#pragma unroll
    for (int i = 0; i < 4; ++i) glds16a(An, aoff[i], dstA + stg * GST + i * 1024);
#pragma unroll
    for (int i = 0; i < 2; ++i) glds16a(Bn, boff[i], dstB + stg * GST + i * 1024);
  };
  issue(0, 0);
  if (nkt > 1) issue(1, 1);
  int st = 0;
#pragma unroll 1
  for (int kt = 0; kt < nkt; ++kt) {
    if (kt + 1 < nkt) asm volatile("s_waitcnt vmcnt(6)" ::: "memory"); else asm volatile("s_waitcnt vmcnt(0)" ::: "memory");
    __builtin_amdgcn_s_barrier();
    asm volatile("" ::: "memory");
    if (kt + 2 < nkt) issue(kt + 2, st >= 1 ? st - 1 : 2);
    LDS_AS unsigned char* sa = smem + st * GST;
#pragma unroll
    for (int s = 0; s < 4; ++s) {
      const int co = ((2 * s + h) ^ swz) << 4;
      const bf16x8 a0 = lds128(sa + arow + co), a1 = lds128(sa + arow + 32 * 128 + co);
      const bf16x8 b0 = lds128(sa + brow + co), b1 = lds128(sa + brow + 32 * 128 + co);
      acc[0][0] = MFMA32(b0, a0, acc[0][0]); acc[0][1] = MFMA32(b1, a0, acc[0][1]);
      acc[1][0] = MFMA32(b0, a1, acc[1][0]); acc[1][1] = MFMA32(b1, a1, acc[1][1]);
    }
    st = (st == 2) ? 0 : st + 1;
  }
}
DI void zero_acc(f32x16 (&acc)[2][2]) {
#pragma unroll
  for (int a = 0; a < 2; ++a)
#pragma unroll
    for (int b = 0; b < 2; ++b)
#pragma unroll
      for (int i = 0; i < 16; ++i) acc[a][b][i] = 0.f;
}
DI void tile_decode(int id, int NT, int& mt, int& nt) { const int per = 4 * NT, g = id / per, w = id % per; mt = g * 4 + (w & 3); nt = w >> 2; }

constexpr int EPW = 17408;
template <int ACT> DI LDS_AS unsigned char* stage_tile(const f32x16 (&acc)[2][2], LDS_AS unsigned char* smem) {
  const int tid_ = tidx(), lane = tid_ & 63, wave = tid_ >> 6, h = lane >> 5;
  __syncthreads();
  LDS_AS unsigned char* reg = smem + wave * EPW;
#pragma unroll
  for (int bi = 0; bi < 2; ++bi)
#pragma unroll
    for (int bj = 0; bj < 2; ++bj)
#pragma unroll
      for (int g = 0; g < 4; ++g) {
        f32x4 v;
#pragma unroll
        for (int j = 0; j < 4; ++j) { v[j] = acc[bi][bj][4 * g + j]; if (ACT == 1) { v[j] = fmaxf(v[j], 0.f); v[j] *= v[j]; } }
        *(LDS_AS f32x4*)(reg + (bi * 32 + (lane & 31)) * 272 + (bj * 32 + 8 * g + 4 * h) * 4) = v;
      }
  return reg;
}
template <int ACT> DI void epi_store_bf16(const f32x16 (&acc)[2][2], bf16_t* dst, int ldc, int row0, int col0, int ncols, LDS_AS unsigned char* smem) {
  LDS_AS unsigned char* reg = stage_tile<ACT>(acc, smem);
  const int tid_ = tidx(), lane = tid_ & 63, wave = tid_ >> 6, wm = wave >> 1, wn = wave & 1;
  const int c = (lane & 7) * 8, col = col0 + wn * 64 + c;
#pragma unroll
  for (int i = 0; i < 8; ++i) {
    const int r = i * 8 + (lane >> 3);
    const f32x4 a = *(LDS_AS f32x4*)(reg + r * 272 + c * 4), b = *(LDS_AS f32x4*)(reg + r * 272 + c * 4 + 16);
    u32x4 w = {pk2(a[0], a[1]), pk2(a[2], a[3]), pk2(b[0], b[1]), pk2(b[2], b[3])};
    if (col < ncols) *(u32x4*)(dst + (size_t)(row0 + wm * 64 + r) * ldc + col) = w;
  }
}
DI void epi_residual(const f32x16 (&acc)[2][2], const float* xin, float* xout, const float* gate, int row0, int col0, LDS_AS unsigned char* smem) {
  LDS_AS unsigned char* reg = stage_tile<0>(acc, smem);
  const int tid_ = tidx(), lane = tid_ & 63, wave = tid_ >> 6, wm = wave >> 1, wn = wave & 1;
  const int c = (lane & 15) * 4, col = col0 + wn * 64 + c;
  const f32x4 gv = *(const f32x4*)(gate + col);
#pragma unroll
  for (int i = 0; i < 16; ++i) {
    const int r = i * 4 + (lane >> 4);
    const size_t off = (size_t)(row0 + wm * 64 + r) * 1024 + col;
    const f32x4 a = *(LDS_AS f32x4*)(reg + r * 272 + c * 4), xi = *(const f32x4*)(xin + off);
    f32x4 o;
#pragma unroll
    for (int j = 0; j < 4; ++j) o[j] = xi[j] + gv[j] * a[j];
    *(f32x4*)(xout + off) = o;
  }
}

constexpr int G2ST = 65536;
DI void gemm_kloop2(const bf16_t* Ag, int lda, const bf16_t* Bg, int ldb, int nkt  , f32x16 (&acc)[4][2], LDS_AS unsigned char* smem) {
  const int tid_ = tidx(), lane = tid_ & 63, wave = tid_ >> 6, h = lane >> 5, wm = wave >> 2, wn = wave & 3;
  unsigned aoff[4], boff[4];
#pragma unroll
  for (int i = 0; i < 4; ++i) {
    const int r = wave * 32 + i * 8 + (lane >> 3), c = (lane & 7) ^ ((r >> 1) & 7);
    aoff[i] = (unsigned)(r * lda + c * 8) * 2u; boff[i] = (unsigned)(r * ldb + c * 8) * 2u;
  }
  const unsigned dstA = (unsigned)__builtin_amdgcn_readfirstlane((int)(lds_u32(smem) + wave * 4096));
  const unsigned dstB = dstA + 32768;
  const int swz = (lane >> 1) & 7;
  const int arow = (wm * 128 + (lane & 31)) * 128, brow = 32768 + (wn * 64 + (lane & 31)) * 128;
  asm volatile("s_waitcnt vmcnt(0)" ::: "memory");
  __syncthreads();
  auto issue = [&](int kt, int stg) {
    const char* An = (const char*)(Ag + (size_t)kt * 64); const char* Bn = (const char*)(Bg + (size_t)kt * 64);
#pragma unroll
    for (int i = 0; i < 4; ++i) glds16a(An, aoff[i], dstA + stg * G2ST + i * 1024);
#pragma unroll
    for (int i = 0; i < 4; ++i) glds16a(Bn, boff[i], dstB + stg * G2ST + i * 1024);
  };
  issue(0, 0);
#pragma unroll 1
  for (int kt = 0; kt < nkt; ++kt) {
    asm volatile("s_waitcnt vmcnt(0)" ::: "memory");
    __builtin_amdgcn_s_barrier();
    asm volatile("" ::: "memory");
    if (kt + 1 < nkt) issue(kt + 1, (kt + 1) & 1);
    LDS_AS unsigned char* sa = smem + (kt & 1) * G2ST;
#pragma unroll
    for (int s = 0; s < 4; ++s) {
      const int co = ((2 * s + h) ^ swz) << 4;
      bf16x8 fa[4], fb[2];
#pragma unroll
      for (int bi = 0; bi < 4; ++bi) fa[bi] = lds128(sa + arow + bi * 32 * 128 + co);
#pragma unroll
      for (int bj = 0; bj < 2; ++bj) fb[bj] = lds128(sa + brow + bj * 32 * 128 + co);
#pragma unroll
      for (int bi = 0; bi < 4; ++bi)
#pragma unroll
        for (int bj = 0; bj < 2; ++bj) acc[bi][bj] = MFMA32(fb[bj], fa[bi], acc[bi][bj]);
    }
  }
}
DI void zero_acc2(f32x16 (&acc)[4][2]) {
#pragma unroll
  for (int a = 0; a < 4; ++a)
#pragma unroll
    for (int b = 0; b < 2; ++b)
#pragma unroll
      for (int i = 0; i < 16; ++i) acc[a][b][i] = 0.f;
}
template <int ACT, int HF> DI void stage_half(const f32x16 (&acc)[4][2], LDS_AS unsigned char* reg, int lane, int h) {
#pragma unroll
  for (int bi = 0; bi < 2; ++bi)
#pragma unroll
    for (int bj = 0; bj < 2; ++bj)
#pragma unroll
      for (int g = 0; g < 4; ++g) {
        f32x4 v;
#pragma unroll
        for (int j = 0; j < 4; ++j) { v[j] = acc[2 * HF + bi][bj][4 * g + j]; if (ACT == 1) { v[j] = fmaxf(v[j], 0.f); v[j] *= v[j]; } }
        *(LDS_AS f32x4*)(reg + (bi * 32 + (lane & 31)) * 272 + (bj * 32 + 8 * g + 4 * h) * 4) = v;
      }
}
template <int ACT, int HF> DI void epi2_half_bf16(const f32x16 (&acc)[4][2], bf16_t* dst, int ldc, int row0, int col0, int ncols, LDS_AS unsigned char* smem) {
  const int tid_ = tidx(), lane = tid_ & 63, wave = tid_ >> 6, h = lane >> 5, wm = wave >> 2, wn = wave & 3;
  LDS_AS unsigned char* reg = smem + wave * EPW;
  stage_half<ACT, HF>(acc, reg, lane, h);
  const int c = (lane & 7) * 8, col = col0 + wn * 64 + c;
#pragma unroll
  for (int i = 0; i < 8; ++i) {
    const int r = i * 8 + (lane >> 3);
    const f32x4 a = *(LDS_AS f32x4*)(reg + r * 272 + c * 4), b = *(LDS_AS f32x4*)(reg + r * 272 + c * 4 + 16);
    u32x4 w = {pk2(a[0], a[1]), pk2(a[2], a[3]), pk2(b[0], b[1]), pk2(b[2], b[3])};
    if (col < ncols) *(u32x4*)(dst + (size_t)(row0 + wm * 128 + HF * 64 + r) * ldc + col) = w;
  }
}
template <int ACT> DI void epi2_store_bf16(const f32x16 (&acc)[4][2], bf16_t* dst, int ldc, int row0, int col0, int ncols, LDS_AS unsigned char* smem) {
  __syncthreads();
  epi2_half_bf16<ACT, 0>(acc, dst, ldc, row0, col0, ncols, smem);
  epi2_half_bf16<ACT, 1>(acc, dst, ldc, row0, col0, ncols, smem);
}
template <int HF> DI void epi2_half_residual(const f32x16 (&acc)[4][2], const float* xin, float* xout, const float* gate, int row0, int col0, LDS_AS unsigned char* smem) {
  const int tid_ = tidx(), lane = tid_ & 63, wave = tid_ >> 6, h = lane >> 5, wm = wave >> 2, wn = wave & 3;
  LDS_AS unsigned char* reg = smem + wave * EPW;
  stage_half<0, HF>(acc, reg, lane, h);
  const int c = (lane & 15) * 4, col = col0 + wn * 64 + c;
  const f32x4 gv = *(const f32x4*)(gate + col);
#pragma unroll
  for (int i = 0; i < 16; ++i) {
    const int r = i * 4 + (lane >> 4);
    const size_t off = (size_t)(row0 + wm * 128 + HF * 64 + r) * 1024 + col;
    const f32x4 a = *(LDS_AS f32x4*)(reg + r * 272 + c * 4), xi = *(const f32x4*)(xin + off);
    f32x4 o;
#pragma unroll
    for (int j = 0; j < 4; ++j) o[j] = xi[j] + gv[j] * a[j];
    *(f32x4*)(xout + off) = o;
  }
}
DI void epi2_residual(const f32x16 (&acc)[4][2], const float* xin, float* xout, const float* gate, int row0, int col0, LDS_AS unsigned char* smem) {
  __syncthreads();
  epi2_half_residual<0>(acc, xin, xout, gate, row0, col0, smem);
  epi2_half_residual<1>(acc, xin, xout, gate, row0, col0, smem);
}

namespace pg8 {
typedef float f32x2v __attribute__((ext_vector_type(2)));
constexpr int BM = 256, BK = 64, HALF = 128, HTB = HALF * BK * 2, STAGE_BYTES = 8 * HTB, NXCD = 8, WGM = 8;
DI int lds_byte(int r, int c) { const int st = (r >> 4) * 2 + (c >> 5), rr = r & 15, cc = c & 31, ob = rr * 64 + cc * 2; return st * 1024 + (ob ^ (((ob >> 9) & 1) << 5)); }
DI void stage_rc(int b, int& R, int& C) { const int st = b / 1024, sb = b % 1024, swz = sb ^ (((sb >> 9) & 1) << 5); R = (st >> 1) * 16 + swz / 64; C = (st & 1) * 32 + (swz % 64) / 2; }
DI int perm32(int rho) { const int n = rho >> 4, i = rho & 15; return 8 * (i >> 2) + 4 * n + (i & 3); }
struct Unit { int pm, pn; };
struct Gemm { const bf16_t* A; const bf16_t* Bt; int M, N, K; };
struct StaticOrder {
    int nM, nN, nwg, G, c;
    DI void init(int M, int N, int G_, int c_) { nM = M / BM; nN = N / BM; nwg = nM * nN; G = G_; c = c_; }
    DI bool next(int i, Unit& u) const {
        const long L = (long)i * G + c; if (L >= nwg) return false;
        int wgid = (int)L; { const int q = nwg / NXCD, r = nwg % NXCD, xcd = wgid % NXCD, off = wgid / NXCD; wgid = (xcd < r ? xcd * (q + 1) : r * (q + 1) + (xcd - r) * q) + off; }
        const int nig = WGM * nN, gid = wgid / nig, fm = gid * WGM, gsz = (nM - fm) < WGM ? (nM - fm) : WGM;
        u.pm = fm + ((wgid % nig) % gsz); u.pn = (wgid % nig) / gsz; return true;
    }
    DI void a_ready(const Unit&) const {}
    DI void done(const Unit&) const {}
};
template <int ACT  > struct EpiBf16 {
    static constexpr bool PERM = true, AFTER_DRAIN = false;
    bf16_t* O; int ldc, ncols, dry;
    DI void operator()(const f32x4 (&acc)[2][2][4][2], const Unit& u, int wr, int wc, int fr, int fq) const {
        if (dry) return;
        const int row0 = u.pm * BM + wr * 64 + fr, col0 = u.pn * BM + wc * 32 + 8 * fq;
#pragma unroll
        for (int ai = 0; ai < 2; ++ai)
#pragma unroll
            for (int m = 0; m < 4; ++m) { bf16_t* rowp = O + (size_t)(row0 + ai * HALF + m * 16) * ldc + col0;
#pragma unroll
                for (int bj = 0; bj < 2; ++bj) { f32x4 v0 = acc[ai][bj][m][0], v1 = acc[ai][bj][m][1];
                    if (ACT == 1) {
#pragma unroll
                        for (int j = 0; j < 4; ++j) { v0[j] = fmaxf(v0[j], 0.f); v0[j] *= v0[j]; v1[j] = fmaxf(v1[j], 0.f); v1[j] *= v1[j]; } }
                    u32x4 w = {pk2(v0[0], v0[1]), pk2(v0[2], v0[3]), pk2(v1[0], v1[1]), pk2(v1[2], v1[3])};
                    if (col0 + bj * HALF < ncols) *(u32x4*)(rowp + bj * HALF) = w; } }
    }
};
struct EpiResid {
    static constexpr bool PERM = false, AFTER_DRAIN = false;
    const float* xin; float* xout; const float* gate; int dry;
    DI void operator()(const f32x4 (&acc)[2][2][4][2], const Unit& u, int wr, int wc, int fr, int fq) const {
        if (dry) return;
        const int row0 = u.pm * BM + wr * 64 + fr, col0 = u.pn * BM + wc * 32 + 4 * fq;
        const float* gv = gate + (size_t)((u.pm * BM) >> 13) * 6144 + col0;
        f32x4 g[2][2];
#pragma unroll
        for (int bj = 0; bj < 2; ++bj)
#pragma unroll
            for (int n = 0; n < 2; ++n) g[bj][n] = *(const f32x4*)(gv + bj * HALF + n * 16);
#pragma unroll
        for (int ai = 0; ai < 2; ++ai)
#pragma unroll
            for (int m = 0; m < 4; ++m) { const size_t off = (size_t)(row0 + ai * HALF + m * 16) * 1024 + col0;
#pragma unroll
                for (int bj = 0; bj < 2; ++bj)
#pragma unroll
                    for (int n = 0; n < 2; ++n) { const f32x4 xi = *(const f32x4*)(xin + off + bj * HALF + n * 16);
                        *(f32x4*)(xout + off + bj * HALF + n * 16) = xi + g[bj][n] * acc[ai][bj][m][n]; } }
    }
};
template <class Epi, class Sched, bool STAMP = false>
__device__ __forceinline__ void gemm_phase(LDS_AS unsigned char* lds, const Gemm g, const Sched& S, const Epi& E, unsigned long long* stamps) {
    const int tid = tidx(), wid = __builtin_amdgcn_readfirstlane(tid >> 6), lane = tid & 63, wr = wid >> 2, wc = wid & 3, fr = lane & 15, fq = lane >> 4;
    const int K = g.K, nt = K / BK;
    int ts_lo = 0, ts_hi = 0, nts = 0; const unsigned long long rt_entry = STAMP ? 0ull : 0ull;
#define PG8_STAMP() do { if (STAMP && wid == 0 && nts < 64) { const unsigned long long _c = (unsigned long long)clock64(); \
        ts_lo = (lane == nts) ? (int)(unsigned)_c : ts_lo; ts_hi = (lane == nts) ? (int)(unsigned)(_c >> 32) : ts_hi; ++nts; } } while (0)
    PG8_STAMP();
    unsigned voffA[2], voffB[2];
#pragma unroll
    for (int i = 0; i < 2; ++i) { int R, C; stage_rc(tid * 16 + i * 8192, R, C); const int Rb = Epi::PERM ? ((R & ~31) + perm32(R & 31)) : R;
        voffA[i] = (unsigned)(R * K + C) * 2u; voffB[i] = (unsigned)(Rb * K + C) * 2u; }
    const size_t kstep = (size_t)(BK * 2);
    const size_t hstep = (size_t)HALF * K * 2;
    const size_t tstep = 2 * hstep;
    const unsigned ldsw = (unsigned)wid * 1024u; const unsigned ldsbase = (unsigned)__builtin_amdgcn_readfirstlane((int)lds_u32(lds));
    const int aoff = lds_byte(wr * 64 + fr, fq * 8), boff = lds_byte(wc * 32 + fr, fq * 8);
#define PG8_SA(b, h) (((b) * 2 + (h)) * HTB)
#define PG8_SB(b, h) ((4 + (b) * 2 + (h)) * HTB)
#define PG8_STAGE(bufoff, gbase, voff) do { _Pragma("unroll") for (int _i = 0; _i < 2; ++_i) \
        glds16a((const void*)(gbase), (voff)[_i], ldsbase + (unsigned)(bufoff) + ldsw + (unsigned)_i * 8192u); } while (0)
#define PG8_LDA(dst, b, h) do { _Pragma("unroll") for (int m = 0; m < 4; ++m) _Pragma("unroll") for (int k = 0; k < 2; ++k) dst[m][k] = *(const LDS_AS bf16x8*)(lds + PG8_SA(b, h) + aoff + m * 2048 + k * 1024); } while (0)
#define PG8_LDB(dst, b, h) do { _Pragma("unroll") for (int n = 0; n < 2; ++n) _Pragma("unroll") for (int k = 0; k < 2; ++k) dst[n][k] = *(const LDS_AS bf16x8*)(lds + PG8_SB(b, h) + boff + n * 2048 + k * 1024); } while (0)
#define PG8_MMA(ai, bj, At, Bt) do { __builtin_amdgcn_s_setprio(1); _Pragma("unroll") for (int m = 0; m < 4; ++m) _Pragma("unroll") for (int n = 0; n < 2; ++n) _Pragma("unroll") for (int k = 0; k < 2; ++k) \
        acc[ai][bj][m][n] = __builtin_amdgcn_mfma_f32_16x16x32_bf16(Bt[n][k], At[m][k], acc[ai][bj][m][n], 0, 0, 0); __builtin_amdgcn_s_setprio(0); } while (0)
#define PG8_WAIT_V(n) asm volatile("s_waitcnt vmcnt(" #n ")" ::: "memory")
#define PG8_WAIT_L(n) asm volatile("s_waitcnt lgkmcnt(" #n ")" ::: "memory")
#define PG8_BAR __builtin_amdgcn_s_barrier()
#define PG8_SCHED __builtin_amdgcn_sched_barrier(0)
    Unit cur, nxt; int ui = 0;
    if (!S.next(0, cur)) return;
    f32x4 acc[2][2][4][2];
#pragma unroll
    for (int a = 0; a < 2; ++a)
#pragma unroll
        for (int b = 0; b < 2; ++b)
#pragma unroll
            for (int m = 0; m < 4; ++m)
#pragma unroll
                for (int n = 0; n < 2; ++n) acc[a][b][m][n] = (f32x4){0.f, 0.f, 0.f, 0.f};
    bf16x8 At[4][2], B0[2][2], B1[2][2];
    const char* cA = (const char*)g.A + (size_t)cur.pm * tstep; const char* cB = (const char*)g.Bt + (size_t)cur.pn * tstep;
    S.a_ready(cur);
    PG8_STAGE(PG8_SB(0, 0), cB, voffB); PG8_STAGE(PG8_SA(0, 0), cA, voffA); PG8_STAGE(PG8_SB(0, 1), cB + hstep, voffB); PG8_STAGE(PG8_SA(0, 1), cA + hstep, voffA);
    if (wr == 1) PG8_BAR;
    PG8_WAIT_V(4); PG8_BAR;
    PG8_STAGE(PG8_SB(1, 0), cB + kstep, voffB); PG8_STAGE(PG8_SA(1, 0), cA + kstep, voffA); PG8_STAGE(PG8_SB(1, 1), cB + hstep + kstep, voffB);
    PG8_WAIT_V(6); PG8_BAR;
    PG8_STAMP();
    for (;;) {
        const bool has_next = S.next(ui + 1, nxt);
        const char* nA = has_next ? (const char*)g.A + (size_t)nxt.pm * tstep : cA; const char* nB = has_next ? (const char*)g.Bt + (size_t)nxt.pn * tstep : cB;
        for (int t = 0; t < nt; t += 2) {
            const bool last = (t == nt - 2);
            const char* a1 = cA + (size_t)(t + 1) * kstep;
            const char* a2 = last ? nA : cA + (size_t)(t + 2) * kstep; const char* b2 = last ? nB : cB + (size_t)(t + 2) * kstep;
            const char* a3 = a2 + kstep; const char* b3 = b2 + kstep;
            if (last && has_next) S.a_ready(nxt);
            PG8_LDB(B0, 0, 0); PG8_SCHED; PG8_LDA(At, 0, 0); PG8_STAGE(PG8_SA(1, 1), a1 + hstep, voffA);
            PG8_WAIT_L(8); PG8_BAR; PG8_WAIT_L(0); PG8_MMA(0, 0, At, B0); PG8_BAR; PG8_SCHED;
            PG8_LDB(B1, 0, 1); PG8_STAGE(PG8_SB(0, 0), b2, voffB);
            PG8_BAR; PG8_WAIT_L(0); PG8_MMA(0, 1, At, B1); PG8_BAR;
            PG8_LDA(At, 0, 1); PG8_STAGE(PG8_SA(0, 0), a2, voffA);
            PG8_BAR; PG8_WAIT_L(0); PG8_MMA(1, 0, At, B0); PG8_BAR; PG8_SCHED;
            PG8_STAGE(PG8_SB(0, 1), b2 + hstep, voffB);
            PG8_WAIT_V(6); PG8_BAR; PG8_MMA(1, 1, At, B1); PG8_BAR;
            PG8_LDB(B0, 1, 0); PG8_SCHED; PG8_LDA(At, 1, 0); PG8_STAGE(PG8_SA(0, 1), a2 + hstep, voffA);
            PG8_WAIT_L(8); PG8_BAR; PG8_WAIT_L(0); PG8_MMA(0, 0, At, B0); PG8_BAR; PG8_SCHED;
            PG8_LDB(B1, 1, 1); PG8_STAGE(PG8_SB(1, 0), b3, voffB);
            PG8_BAR; PG8_WAIT_L(0); PG8_MMA(0, 1, At, B1); PG8_BAR;
            PG8_LDA(At, 1, 1); PG8_STAGE(PG8_SA(1, 0), a3, voffA);
            PG8_BAR; PG8_WAIT_L(0); PG8_MMA(1, 0, At, B0); PG8_BAR; PG8_SCHED;
            PG8_STAGE(PG8_SB(1, 1), b3 + hstep, voffB);
            PG8_WAIT_V(6); PG8_BAR; PG8_MMA(1, 1, At, B1); PG8_BAR;
        }
        PG8_STAMP();
        if constexpr (!Epi::AFTER_DRAIN) { E(acc, cur, wr, wc, fr, fq); S.done(cur); }
        PG8_STAMP();
        if (!has_next) break;
#pragma unroll
        for (int a = 0; a < 2; ++a)
#pragma unroll
            for (int b = 0; b < 2; ++b)
#pragma unroll
                for (int m = 0; m < 4; ++m)
#pragma unroll
                    for (int n = 0; n < 2; ++n) acc[a][b][m][n] = (f32x4){0.f, 0.f, 0.f, 0.f};
        cur = nxt; cA = nA; cB = nB; ++ui;
    }
    PG8_WAIT_V(0);
    if (wr == 0) PG8_BAR;
    PG8_BAR;
    if constexpr (Epi::AFTER_DRAIN) { E.fused(acc, cur, wr, wc, fr, fq, lds, wid, lane); S.done(cur); }
    PG8_STAMP();
    if (STAMP && wid == 0) { stamps[lane] = lane < nts ? (((unsigned long long)(unsigned)ts_hi << 32) | (unsigned)ts_lo) : 0ull;
        if (lane == 62) stamps[62] = rt_entry; if (lane == 63) stamps[63] = 0ull; }
#undef PG8_STAMP
#undef PG8_SA
#undef PG8_SB
#undef PG8_STAGE
#undef PG8_LDA
#undef PG8_LDB
#undef PG8_MMA
#undef PG8_WAIT_V
#undef PG8_WAIT_L
#undef PG8_BAR
#undef PG8_SCHED
}
}

DI void phase_gemm_in(const Params& p, int l, LDS_AS unsigned char* smem, int dry) {
  pg8::Gemm g; g.A = p.H; g.Bt = p.WB + (size_t)l * W_LAYER + W_IN; g.M = T; g.N = 2816; g.K = 1024;
  pg8::StaticOrder S; S.init(g.M, g.N, gridDim.x, blockIdx.x);
  pg8::EpiBf16<0> E; E.O = p.PROJ; E.ldc = PN; E.ncols = PN; E.dry = dry;
  __syncthreads();
  pg8::gemm_phase<pg8::EpiBf16<0>, pg8::StaticOrder, false>(smem, g, S, E, nullptr);
}
DI void phase_gemm_mla(const Params& p, int l, LDS_AS unsigned char* smem, int dry) {
  const bf16_t* WQ = p.WB + (size_t)l * W_LAYER + W_UQ; const bf16_t* WK = p.WB + (size_t)l * W_LAYER + W_UKV;
  const int NT = 7, ntiles = (T / 256) * NT;
  for (int i = blockIdx.x; i < ntiles; i += gridDim.x) {
    int mt, nt; tile_decode(xcd_remap(i, ntiles), NT, mt, nt);
    f32x16 acc[4][2]; zero_acc2(acc);
    if (nt < 3) {
      gemm_kloop2(p.PROJ + (size_t)mt * 256 * PN + C_QLAT, PN, WQ + (size_t)nt * 256 * 256, 256, 4, acc, smem);
      if (!dry) epi2_store_bf16<0>(acc, p.MQ, 768, mt * 256, nt * 256, 768, smem);
    } else {
      gemm_kloop2(p.PROJ + (size_t)mt * 256 * PN + C_KVLAT, PN, WK + (size_t)(nt - 3) * 256 * 128, 128, 2, acc, smem);
      if (!dry) epi2_store_bf16<0>(acc, p.KV, 1024, mt * 256, (nt - 3) * 256, 1024, smem);
    }
  }
}
DI void phase_merge(const Params& p, int l, LDS_AS unsigned char* smem, int dry) {
  const bf16_t* WL = p.WB + (size_t)l * W_LAYER;
  const int NT = 8, MT = (l == 1) ? TL / 256 : T / 256, ntiles = MT * NT;
  bf16_t* M = p.KV;
  for (int i = blockIdx.x; i < ntiles; i += gridDim.x) {
    int mt, nt; tile_decode(xcd_remap(i, ntiles), NT, mt, nt);
    unsigned tp[2][2][8];
#pragma unroll
    for (int a = 0; a < 2; ++a)
#pragma unroll
      for (int b = 0; b < 2; ++b)
#pragma unroll
        for (int e = 0; e < 8; ++e) tp[a][b][e] = 0u;
#pragma unroll 1
    for (int br = 0; br < 3; ++br) {
      unsigned gp[2][2][8];
      {
        f32x16 ag[2][2]; zero_acc(ag);
        gemm_kloop(p.H + (size_t)mt * 256 * 1024, 1024, 64, WL + W_IN + (size_t)(2816 + br * 1024 + nt * 128) * 1024, 1024, 16, ag, smem);
#pragma unroll
        for (int a = 0; a < 2; ++a)
#pragma unroll
          for (int b = 0; b < 2; ++b)
#pragma unroll
            for (int e = 0; e < 8; ++e)
              gp[a][b][e] = pk2(__builtin_amdgcn_rcpf(1.f + __builtin_amdgcn_exp2f(-LOG2E * ag[a][b][2 * e])),
                                __builtin_amdgcn_rcpf(1.f + __builtin_amdgcn_exp2f(-LOG2E * ag[a][b][2 * e + 1])));
      }
      f32x16 ay[2][2]; zero_acc(ay);
      const int lda = (br == 0) ? 768 : PN, kstep = (br == 0) ? 96 : 64;
      const size_t aofs = (br == 0) ? (size_t)T * PN : (size_t)(br == 1 ? C_SQ : C_DQ);
      __builtin_amdgcn_sched_barrier(0);
      gemm_kloop(p.PROJ + aofs + (size_t)mt * 256 * lda, lda, kstep, WL + W_UPM + (size_t)br * 1024 * 512 + (size_t)nt * 128 * 512, 512, 8, ay, smem);
#pragma unroll
      for (int a = 0; a < 2; ++a)
#pragma unroll
        for (int b = 0; b < 2; ++b)
#pragma unroll
          for (int e = 0; e < 8; ++e) {
            const float t0 = __uint_as_float(tp[a][b][e] << 16) + __uint_as_float(gp[a][b][e] << 16) * ay[a][b][2 * e];
            const float t1 = __uint_as_float(tp[a][b][e] & 0xffff0000u) + __uint_as_float(gp[a][b][e] & 0xffff0000u) * ay[a][b][2 * e + 1];
            tp[a][b][e] = pk2(t0, t1);
          }
    }
    if (!dry) {
      f32x16 tot[2][2];
#pragma unroll
      for (int a = 0; a < 2; ++a)
#pragma unroll
        for (int b = 0; b < 2; ++b)
#pragma unroll
          for (int e = 0; e < 8; ++e) { tot[a][b][2 * e] = __uint_as_float(tp[a][b][e] << 16); tot[a][b][2 * e + 1] = __uint_as_float(tp[a][b][e] & 0xffff0000u); }
      epi_store_bf16<0>(tot, M, 1024, mt * 256, nt * 128, 1024, smem);
    }
  }
}
DI void phase_residual_gemm(const Params& p, int l, int which, LDS_AS unsigned char* smem, int dry) {
  const bf16_t* WL = p.WB + (size_t)l * W_LAYER;
  const bf16_t* Abase = which == 0 ? (const bf16_t*)opq(p.KV) : (const bf16_t*)opq(p.PROJ);
  const int K = which == 0 ? 1024 : 4096;
  const bf16_t* W = WL + (which == 0 ? W_O : W_M2);
  const bool first = (which == 0 && l == 0);
  const float* px = opq(p.x); const float* pctx = opq(p.ctx); float* pout = opq(p.out); float* pcx = opq(p.CX);
  const float* slat = first ? px : (const float*)pout; const float* sctx = first ? pctx : (const float*)pcx;
  const float* gofs = p.modtab + (size_t)(l * 5) * 6144 + (which == 0 ? 2048 : 5120);
  {
    pg8::Gemm g; g.A = Abase; g.Bt = W; g.M = TL; g.N = 1024; g.K = K;
    pg8::StaticOrder S; S.init(g.M, g.N, gridDim.x, blockIdx.x);
    pg8::EpiResid E; E.xin = slat; E.xout = pout; E.gate = gofs; E.dry = dry;
    __syncthreads();
    pg8::gemm_phase<pg8::EpiResid, pg8::StaticOrder, false>(smem, g, S, E, nullptr);
  }
  if (l == 0) {
    const int i = (int)gridDim.x - 1 - (int)blockIdx.x;
    if (i < 32) {
      const int mt = TL / 256 + (i & 3), nt = i >> 2;
      f32x16 acc[2][2]; zero_acc(acc);
      gemm_kloop(Abase + (size_t)mt * 256 * K, K, 64, W + (size_t)nt * 128 * K, K, K / 64, acc, smem);
      if (!dry) epi_residual(acc, sctx, pcx, gofs + (size_t)4 * 6144, mt * 256 - TL, nt * 128, smem);
    }
  }
}
DI void phase_mlp_in(const Params& p, int l, LDS_AS unsigned char* smem, int dry) {
  pg8::Gemm g; g.A = p.H; g.Bt = p.WB + (size_t)l * W_LAYER + W_M1; g.M = (l == 1) ? TL : T; g.N = 4096; g.K = 1024;
  pg8::StaticOrder S; S.init(g.M, g.N, gridDim.x, blockIdx.x);
  pg8::EpiBf16<1> E; E.O = p.PROJ; E.ldc = 4096; E.ncols = 4096; E.dry = dry;
  __syncthreads();
  pg8::gemm_phase<pg8::EpiBf16<1>, pg8::StaticOrder, false>(smem, g, S, E, nullptr);
}

DI unsigned ld_u32(const bf16_t* p) { return *(const unsigned*)p; }
DI void unpack4(u32x2 raw, float (&v)[4]) {
  v[0] = __uint_as_float(raw[0] << 16); v[1] = __uint_as_float(raw[0] & 0xffff0000u); v[2] = __uint_as_float(raw[1] << 16); v[3] = __uint_as_float(raw[1] & 0xffff0000u);
}
DI void phase_prep_a(const Params& p, int l, int dry) {
  const int tid_ = tidx(), lane = tid_ & 63, wave = tid_ >> 6, vsel = lane >> 4, j16 = lane & 15;
  const f32x4 gsq = *(const f32x4*)(p.g_swa_q + l * 64 + 4 * j16), gsk = *(const f32x4*)(p.g_swa_k + l * 64 + 4 * j16);
  const f32x4 gdq = *(const f32x4*)(p.g_diff_q + l * 64 + 4 * j16), gdk = *(const f32x4*)(p.g_diff_k + l * 64 + 4 * j16);
  const f32x4 gql = *(const f32x4*)(p.g_q_lora + l * 256 + lane * 4);
  const f32x2 gkl = *(const f32x2*)(p.g_kv_lora + l * 128 + lane * 2);
  float freq[4];
#pragma unroll
  for (int jj = 0; jj < 4; ++jj) freq[jj] = __builtin_amdgcn_exp2f(-(float)(4 * (j16 & 3) + jj) * (13.287712379549449f / 16.f)) * 0.15915494309189535f;
  const float sgn = ((j16 >> 2) & 1) ? 1.f : -1.f;
  const int stride = gridDim.x * 8;
  for (int row0 = blockIdx.x * 8 + wave; row0 < T; row0 += 2 * stride) {
    u32x2 rq[2], rv[2][7]; unsigned rk[2];
#pragma unroll
    for (int t = 0; t < 2; ++t) {
      const int row = (row0 + t * stride < T) ? row0 + t * stride : row0;
      const bf16_t* base = p.PROJ + (size_t)row * PN;
      rq[t] = *(const u32x2*)(base + C_QLAT + lane * 4);
      rk[t] = ld_u32(base + C_KVLAT + lane * 2);
#pragma unroll
      for (int it = 0; it < 7; ++it) rv[t][it] = *(const u32x2*)(base + C_SQ + 64 * (4 * it + vsel) + 4 * j16);
    }
#pragma unroll
    for (int t = 0; t < 2; ++t) {
      const int row = row0 + t * stride;
      if (row >= T) break;
      bf16_t* base = p.PROJ + (size_t)row * PN;
      const bool islat = row < TL;
      float cs[4], sn[4];
      if (islat) {
        const int tt = row & 8191; const float pos = (float)((j16 >> 3) ? (tt & 63) : (tt >> 6));
#pragma unroll
        for (int jj = 0; jj < 4; ++jj) { const float rev = pos * freq[jj]; cs[jj] = __builtin_amdgcn_cosf(rev); sn[jj] = __builtin_amdgcn_sinf(rev); }
      } else {
#pragma unroll
        for (int jj = 0; jj < 4; ++jj) { cs[jj] = 1.f; sn[jj] = 0.f; }
      }
      {
        float v[4]; unpack4(rq[t], v);
        const float ss = wave_sum(v[0] * v[0] + v[1] * v[1] + v[2] * v[2] + v[3] * v[3]);
        const float rstd = rsqrtf(ss * (1.f / 256.f) + EPS);
        u32x2 w = {pk2(v[0] * rstd * gql[0], v[1] * rstd * gql[1]), pk2(v[2] * rstd * gql[2], v[3] * rstd * gql[3])};
        if (!dry) *(u32x2*)(base + C_QLAT + lane * 4) = w;
      }
      {
        const float v0 = __uint_as_float(rk[t] << 16), v1 = __uint_as_float(rk[t] & 0xffff0000u);
        const float ss = wave_sum(v0 * v0 + v1 * v1);
        const float rstd = rsqrtf(ss * (1.f / 128.f) + EPS);
        if (!dry) *(unsigned*)(base + C_KVLAT + lane * 2) = pk2(v0 * rstd * gkl[0], v1 * rstd * gkl[1]);
      }
#pragma unroll
      for (int it = 0; it < 7; ++it) {
        const f32x4 g = (it < 2) ? gsq : (it == 2 ? gsk : (it < 5 ? gdq : gdk));
        const float sc = (it < 2 || it == 3 || it == 4) ? 0.125f * LOG2E : 1.f;
        float v[4]; unpack4(rv[t][it], v);
        float ss = v[0] * v[0] + v[1] * v[1] + v[2] * v[2] + v[3] * v[3];
        ss += __shfl_xor(ss, 8); ss += __shfl_xor(ss, 4); ss += __shfl_xor(ss, 2); ss += __shfl_xor(ss, 1);
        const float rstd = rsqrtf(ss * (1.f / 64.f) + EPS);
        float y[4];
#pragma unroll
        for (int jj = 0; jj < 4; ++jj) {
          const float yy = v[jj] * rstd * g[jj];
          const float pr = __shfl_xor(yy, 4);
          y[jj] = (yy * cs[jj] + sgn * pr * sn[jj]) * sc;
        }
        u32x2 w = {pk2(y[0], y[1]), pk2(y[2], y[3])};
        if (!dry && (it != 2 || vsel < 2)) *(u32x2*)(base + C_SQ + 64 * (4 * it + vsel) + 4 * j16) = w;
      }
    }
  }
}
DI void phase_prep_c(const Params& p, int l, int dry) {
  const int tid_ = tidx(), lane = tid_ & 63, wave = tid_ >> 6, hd = lane >> 3, sub = lane & 7;
  f32x4 gq[3], gk[3];
#pragma unroll
  for (int i = 0; i < 3; ++i) { gq[i] = *(const f32x4*)(p.g_mla_q + l * 96 + 32 * i + 4 * sub); gk[i] = *(const f32x4*)(p.g_mla_k + l * 96 + 32 * i + 4 * sub); }
  float freq[4];
#pragma unroll
  for (int jj = 0; jj < 4; ++jj) freq[jj] = __builtin_amdgcn_exp2f(-(float)(4 * (sub & 1) + jj) * (13.287712379549449f / 8.f)) * 0.15915494309189535f;
  const float sgn = ((sub >> 1) & 1) ? 1.f : -1.f;
  const float qs = 0.10206207261596575f * LOG2E;
  const int stride = gridDim.x * 8;
  for (int row0 = blockIdx.x * 8 + wave; row0 < T; row0 += 2 * stride) {
    u32x2 rq[2][3], rkv[2][2], rpe[2];
#pragma unroll
    for (int t = 0; t < 2; ++t) {
      const int row = (row0 + t * stride < T) ? row0 + t * stride : row0;
#pragma unroll
      for (int i = 0; i < 3; ++i) rq[t][i] = *(const u32x2*)(p.MQ + (size_t)row * 768 + hd * 96 + 32 * i + 4 * sub);
#pragma unroll
      for (int i = 0; i < 2; ++i) rkv[t][i] = *(const u32x2*)(p.KV + (size_t)row * 1024 + hd * 128 + 32 * i + 4 * sub);
      rpe[t] = *(const u32x2*)(p.PROJ + (size_t)row * PN + C_KPE + 4 * sub);
    }
#pragma unroll
    for (int t = 0; t < 2; ++t) {
      const int row = row0 + t * stride;
      if (row >= T) break;
      const bool islat = row < TL;
      float cs[4], sn[4];
      if (islat) {
        const int tt = row & 8191; const float pos = (float)((sub >> 2) ? (tt & 63) : (tt >> 6));
#pragma unroll
        for (int jj = 0; jj < 4; ++jj) { const float rev = pos * freq[jj]; cs[jj] = __builtin_amdgcn_cosf(rev); sn[jj] = __builtin_amdgcn_sinf(rev); }
      } else {
#pragma unroll
        for (int jj = 0; jj < 4; ++jj) { cs[jj] = 1.f; sn[jj] = 0.f; }
      }
#pragma unroll
      for (int qk = 0; qk < 2; ++qk) {
        float v[3][4];
        if (qk == 0) { unpack4(rq[t][0], v[0]); unpack4(rq[t][1], v[1]); unpack4(rq[t][2], v[2]); }
        else { unpack4(rkv[t][0], v[0]); unpack4(rkv[t][1], v[1]); unpack4(rpe[t], v[2]); }
        float ss = 0.f;
#pragma unroll
        for (int i = 0; i < 3; ++i)
#pragma unroll
          for (int jj = 0; jj < 4; ++jj) ss += v[i][jj] * v[i][jj];
        ss += __shfl_xor(ss, 4); ss += __shfl_xor(ss, 2); ss += __shfl_xor(ss, 1);
        const float rstd = rsqrtf(ss * (1.f / 96.f) + EPS);
        const float osc = (qk == 0) ? qs : 1.f;
        u32x2 w[3];
#pragma unroll
        for (int i = 0; i < 3; ++i) {
          float y[4];
#pragma unroll
          for (int jj = 0; jj < 4; ++jj) {
            const float gg = (qk == 0) ? gq[i][jj] : gk[i][jj];
            float yy = v[i][jj] * rstd * gg;
            if (i == 2) { const float pr = __shfl_xor(yy, 2); yy = yy * cs[jj] + sgn * pr * sn[jj]; }
            y[jj] = yy * osc;
          }
          w[i][0] = pk2(y[0], y[1]); w[i][1] = pk2(y[2], y[3]);
        }
        bf16_t* dst = (qk == 0 ? p.MQ : p.KM) + (size_t)row * 768 + hd * 96 + 4 * sub;
        if (!dry) {
#pragma unroll
          for (int i = 0; i < 3; ++i) *(u32x2*)(dst + 32 * i) = w[i];
        }
      }
    }
  }
}

struct AttnArgs {
  const bf16_t* q; int qpitch;
  const bf16_t* k; int kpitch;
  const bf16_t* v; int vpitch;
  bf16_t* o; int opitch;
  int krow_ctx, krow_lat;
  int nct, lt0, lt1;
  int qrow0, qpos0;
  float mb, sinkterm;
  float lam, osc; const float* gsub;
  int dry;
  bf16_t* o0;
};

template <int QSTEPS> DI void load_q(const AttnArgs& a, int colofs, bf16x8 (&qf)[QSTEPS]) {
  const int tid_ = tidx(), lane = tid_ & 63, wave = tid_ >> 6, h = lane >> 5, l32 = lane & 31;
  const bf16_t* qr = a.q + (size_t)(a.qrow0 + wave * 32 + l32) * a.qpitch + 8 * h + colofs;
#pragma unroll
  for (int s = 0; s < QSTEPS; ++s) qf[s] = *(const bf16x8*)(qr + s * 16);
}
template <int NKA, bool KB, int DV, int EPI, bool WIN>
DI void attn_item(const AttnArgs& a, const bf16x8 (&qfr)[4 + (KB ? 2 : 0)], int kcolofs, LDS_AS unsigned char* smem) {
  const int tid_ = tidx(), lane = tid_ & 63, wave = tid_ >> 6, h = lane >> 5, l32 = lane & 31;
  constexpr int NMAP = 1;
  constexpr int QSTEPS = 4 + (KB ? 2 : 0);
  constexpr int NDB = DV / 32;
  constexpr int VP = DV * 2;
  constexpr int AST = 24576, NST = 4;
  constexpr int NLD = 1 + (KB ? 1 : 0) + (DV == 64 ? 1 : 2);
  const int ntile = a.nct + (a.lt1 - a.lt0);
  unsigned kaoff, kboff = 0, voff[DV == 64 ? 1 : 2];
  { const int r = wave * 8 + (lane >> 3), c = (lane & 7) ^ ((r >> 1) & 7); kaoff = (unsigned)(r * a.kpitch + c * 8) * 2u; }
  if (KB) { const int r = (wave & 3) * 16 + (lane >> 2), c = (lane & 3) ^ ((r >> 2) & 3); kboff = (unsigned)(r * a.kpitch + 64 + c * 8) * 2u; }
  if (DV == 64) {
    const int r = wave * 8 + (lane >> 3), c = (lane & 7) ^ (((r >> 1) & 1) << 2); voff[0] = (unsigned)(r * a.vpitch + c * 8) * 2u;
  } else {
#pragma unroll
    for (int j = 0; j < 2; ++j) { const int r = (j * 8 + wave) * 4 + (lane >> 4), c = (lane & 15) ^ ((r & 3) << 2); voff[j] = (unsigned)(r * a.vpitch + c * 8) * 2u; }
  }
  const unsigned ldst = (unsigned)__builtin_amdgcn_readfirstlane((int)(lds_u32(smem) + wave * 1024));
  const unsigned ldstb = (unsigned)__builtin_amdgcn_readfirstlane((int)(lds_u32(smem) + 16384 + (wave & 3) * 1024));
  auto issue = [&](int ti, int stg) {
    const int trow = (ti < a.nct) ? (a.krow_ctx + ti * 64) : (a.krow_lat + (a.lt0 + ti - a.nct) * 64);
    const char* kb = (const char*)(a.k + (size_t)trow * a.kpitch + kcolofs); const char* vb = (const char*)(a.v + (size_t)trow * a.vpitch);
    const unsigned d = ldst + stg * AST;
    glds16a(kb, kaoff, d);
    if (KB) glds16a(kb, kboff, ldstb + stg * AST);
#pragma unroll
    for (int j = 0; j < (DV == 64 ? 1 : 2); ++j) glds16a(vb, voff[j], d + 8192 + j * 8192);
  };
  const int kswzA = (lane >> 1) & 7, kswzB = (lane >> 2) & 3;
  const int krowA = l32 * 128, krowB = l32 * 64;
  int vbase[NDB];
  {
    const int l16 = lane & 15, qq = l16 >> 2, pp = l16 & 3, g16 = (lane >> 4) & 1;
#pragma unroll
    for (int db = 0; db < NDB; ++db) {
      const int cl = 2 * g16 + (pp >> 1);
      const int c = (DV == 64) ? (4 * (db ^ (qq >> 1)) + cl) : (4 * (db ^ qq) + cl);
      vbase[db] = (4 * h + qq) * VP + c * 16 + (pp & 1) * 8;
    }
  }
  f32x16 O[NMAP][NDB];
#pragma unroll
  for (int m = 0; m < NMAP; ++m)
#pragma unroll
    for (int db = 0; db < NDB; ++db)
#pragma unroll
      for (int i = 0; i < 16; ++i) O[m][db][i] = 0.f;
  float lsum[NMAP];
#pragma unroll
  for (int m = 0; m < NMAP; ++m) lsum[m] = 0.f;
  const float negmb = -a.mb;
  const int qpos = a.qpos0 + wave * 32 + l32;

#pragma unroll
  for (int s = 0; s < QSTEPS; ++s) asm volatile("" ::"v"(qfr[s]));
  asm volatile("s_waitcnt vmcnt(0)" ::: "memory");
  __syncthreads();
  issue(0, 0);
  if (ntile > 1) issue(1, 1);
  if (ntile > 2) issue(2, 2);
#pragma unroll 1
  for (int ti = 0; ti < ntile; ++ti) {
    const int rem = ntile - 1 - ti;
    if (rem >= 2) { if (NLD == 2) asm volatile("s_waitcnt vmcnt(4)" ::: "memory"); else asm volatile("s_waitcnt vmcnt(6)" ::: "memory"); }
    else if (rem == 1) { if (NLD == 2) asm volatile("s_waitcnt vmcnt(2)" ::: "memory"); else asm volatile("s_waitcnt vmcnt(3)" ::: "memory"); }
    else asm volatile("s_waitcnt vmcnt(0)" ::: "memory");
    __builtin_amdgcn_s_barrier();
    asm volatile("" ::: "memory");
    if (ti + 3 < ntile) issue(ti + 3, (ti + 3) & 3);
    __builtin_amdgcn_sched_barrier(0);
    LDS_AS unsigned char* st = smem + (ti & 3) * AST;
    LDS_AS unsigned char* sv = st + 8192;
    auto readK = [&](int kb, bf16x8 (&kf)[QSTEPS]) {
      LDS_AS unsigned char* ka = st + kb * 32 * 128 + krowA;
#pragma unroll
      for (int s = 0; s < 4; ++s) kf[s] = lds128(ka + (((2 * s + h) ^ kswzA) << 4));
      if (KB) {
        LDS_AS unsigned char* kbp = st + 16384 + kb * 32 * 64 + krowB;
#pragma unroll
        for (int s = 0; s < 2; ++s) kf[4 + s] = lds128(kbp + (((2 * s + h) ^ kswzB) << 4));
      }
    };
    auto readV = [&](int kb, bf16x8 (&vf)[2][NDB]) {
#pragma unroll
      for (int s = 0; s < 2; ++s)
#pragma unroll
        for (int db = 0; db < NDB; ++db) {
          const int rc = (kb * 32 + 16 * s) * VP;
          const s16x4 lo = __builtin_amdgcn_ds_read_tr16_b64_v4i16((LDS_AS s16x4*)(sv + vbase[db] + rc));
          const s16x4 hi = __builtin_amdgcn_ds_read_tr16_b64_v4i16((LDS_AS s16x4*)(sv + vbase[db] + rc + 8 * VP));
          vf[s][db] = __builtin_shufflevector(lo, hi, 0, 1, 2, 3, 4, 5, 6, 7);
        }
    };
    auto qk = [&](const bf16x8 (&kf)[QSTEPS], f32x16& S) {
#pragma unroll
      for (int i = 0; i < 16; ++i) S[i] = negmb;
#pragma unroll
      for (int s = 0; s < QSTEPS; ++s) S = MFMA32(kf[s], qfr[s], S);
    };
    auto softmax = [&](int kb, f32x16& S, bf16x8 (&pb)[2]) {
      if (WIN) {
        if (ti >= a.nct) {
          const int kp0 = (a.lt0 + ti - a.nct) * 64 + 4 * h - qpos + kb * 32;
#pragma unroll
          for (int i = 0; i < 16; ++i) {
            const int dlt = kp0 + (i & 3) + 8 * (i >> 2);
            if (dlt > 128 || dlt < -128) S[i] = -INFINITY;
          }
        }
      }
      float ls = 0.f;
#pragma unroll
      for (int i = 0; i < 16; ++i) { S[i] = __builtin_amdgcn_exp2f(S[i]); ls += S[i]; }
      lsum[0] += ls;
#pragma unroll
      for (int s = 0; s < 2; ++s) {
        u32x4 pw;
#pragma unroll
        for (int j = 0; j < 4; ++j) pw[j] = pk2(S[8 * s + 2 * j], S[8 * s + 2 * j + 1]);
        pb[s] = __builtin_bit_cast(bf16x8, pw);
      }
    };
    auto pv = [&](const bf16x8 (&vf)[2][NDB], const bf16x8 (&pb)[2]) {
#pragma unroll
      for (int s = 0; s < 2; ++s)
#pragma unroll
        for (int db = 0; db < NDB; ++db) O[0][db] = MFMA32(vf[s][db], pb[s], O[0][db]);
    };
    {
      bf16x8 kf0[QSTEPS], kf1[QSTEPS], vf0[2][NDB], vf1[2][NDB], p0[2], p1[2];
      f32x16 S0, S1;
      readK(0, kf0); readV(0, vf0);
      __builtin_amdgcn_sched_barrier(0);
      qk(kf0, S0);
      __builtin_amdgcn_sched_barrier(0);
      readK(1, kf1);
      __builtin_amdgcn_sched_barrier(0);
      qk(kf1, S1);
      __builtin_amdgcn_sched_barrier(0);
      softmax(0, S0, p0);
      __builtin_amdgcn_sched_barrier(0);
      pv(vf0, p0);
      __builtin_amdgcn_sched_barrier(0);
      readV(1, vf1);
      __builtin_amdgcn_sched_barrier(0);
      softmax(1, S1, p1);
      __builtin_amdgcn_sched_barrier(0);
      pv(vf1, p1);
      __builtin_amdgcn_sched_barrier(0);
    }
  }
  const float lt = lsum[0] + __shfl_xor(lsum[0], 32) + a.sinkterm;
  const float inv = 1.f / lt;
  bf16_t* orow = a.o + (size_t)(a.qrow0 + wave * 32 + l32) * a.opitch + 4 * h;
  if (a.dry) return;
  if (EPI == 0) {
#pragma unroll
    for (int db = 0; db < NDB; ++db)
#pragma unroll
      for (int g = 0; g < 4; ++g) {
        u32x2 w = {pk2(O[0][db][4 * g] * inv, O[0][db][4 * g + 1] * inv), pk2(O[0][db][4 * g + 2] * inv, O[0][db][4 * g + 3] * inv)};
        *(u32x2*)(orow + db * 32 + 8 * g) = w;
      }
  } else {
    const float c1 = inv * a.lam;
    float ss = 0.f;
#pragma unroll
    for (int db = 0; db < NDB; ++db)
#pragma unroll
      for (int g = 0; g < 4; ++g) {
        const u32x2 raw = *(const u32x2*)(a.o0 + (size_t)(a.qrow0 + wave * 32 + l32) * 512 + 4 * h + db * 32 + 8 * g);
        const float o0[4] = {__uint_as_float(raw[0] << 16), __uint_as_float(raw[0] & 0xffff0000u), __uint_as_float(raw[1] << 16), __uint_as_float(raw[1] & 0xffff0000u)};
#pragma unroll
        for (int j = 0; j < 4; ++j) { const float v = o0[j] - O[0][db][4 * g + j] * c1; O[0][db][4 * g + j] = v; ss += v * v; }
      }
    ss += __shfl_xor(ss, 32);
    const float rstd = rsqrtf(ss * (1.f / (float)DV) + EPS) * a.osc;
#pragma unroll
    for (int db = 0; db < NDB; ++db)
#pragma unroll
      for (int g = 0; g < 4; ++g) {
        const f32x4 gs = *(const f32x4*)(a.gsub + db * 32 + 8 * g + 4 * h);
        u32x2 w = {pk2(O[0][db][4 * g] * rstd * gs[0], O[0][db][4 * g + 1] * rstd * gs[1]), pk2(O[0][db][4 * g + 2] * rstd * gs[2], O[0][db][4 * g + 3] * rstd * gs[3])};
        *(u32x2*)(orow + db * 32 + 8 * g) = w;
      }
  }
}

DI void attn_diff_item(const AttnArgs& a, LDS_AS unsigned char* smem) {
  AttnArgs a0 = a; a0.o = a.o0; a0.opitch = 512; a0.dry = 0;
  { bf16x8 q0[4]; load_q<4>(a, 0, q0); attn_item<1, false, 128, 0, false>(a0, q0, 0, smem); }
  { bf16x8 q1[4]; load_q<4>(a, 64, q1); attn_item<1, false, 128, 1, false>(a, q1, 64, smem); }
}

DI void phase_attention(const Params& p, int l, LDS_AS unsigned char* smem, int dry) {
  const float* cs = p.consts + l * 16;
  const float lam = cs[0], lam_init = cs[1], mb_mla = cs[2], mb_swa = cs[3], mb_diff = cs[4];
  const int nc_d = (l == 0) ? 16 : 0, nc_m = (l == 0) ? 32 : 0;
#pragma unroll 1
  for (int i = blockIdx.x; i < 512 + nc_d; i += gridDim.x) {
    AttnArgs a; a.dry = dry;
    int b, hd;
    if (i < 512) {
      const int id = xcd_remap(i, 512), pair = id >> 5, qb = id & 31; b = pair >> 2; hd = pair & 3;
      a.lt0 = 0; a.lt1 = 128; a.qrow0 = b * 8192 + qb * 256;
    } else {
      const int j = i - 512; b = j >> 2; hd = j & 3;
      a.lt0 = 0; a.lt1 = 0; a.qrow0 = TL + b * 256;
    }
    a.q = p.PROJ + C_DQ + hd * 128; a.qpitch = PN; a.k = p.PROJ + C_DK + hd * 128; a.kpitch = PN; a.v = p.PROJ + C_DV + hd * 128; a.vpitch = PN;
    a.o = p.PROJ + C_DQ + hd * 128; a.opitch = PN; a.o0 = p.YD0 + hd * 128;
    a.krow_ctx = TL + b * 256; a.krow_lat = b * 8192; a.nct = 4; a.qpos0 = 0;
    a.mb = mb_diff; a.sinkterm = 0.f; a.lam = lam; a.osc = 1.f - lam_init; a.gsub = p.g_diff_sub + l * 128;
    attn_diff_item(a, smem);
  }
#pragma unroll 1
  for (int i = blockIdx.x; i < 1024 + nc_m; i += gridDim.x) {
    AttnArgs a; a.dry = dry;
    int b, hd;
    if (i < 1024) {
      const int id = xcd_remap(i, 1024), pair = id >> 5, qb = id & 31; b = pair >> 3; hd = pair & 7;
      a.lt0 = 0; a.lt1 = 128; a.qrow0 = b * 8192 + qb * 256;
    } else {
      const int j = i - 1024; b = j >> 3; hd = j & 7;
      a.lt0 = 0; a.lt1 = 0; a.qrow0 = TL + b * 256;
    }
    a.q = p.MQ + hd * 96; a.qpitch = 768; a.k = p.KM + hd * 96; a.kpitch = 768; a.v = p.KV + hd * 128 + 64; a.vpitch = 1024;
    a.o = p.MQ + hd * 96; a.opitch = 768; a.o0 = nullptr;
    a.krow_ctx = TL + b * 256; a.krow_lat = b * 8192; a.nct = 4; a.qpos0 = 0;
    a.mb = mb_mla; a.sinkterm = 0.f; a.lam = 0.f; a.osc = 0.f; a.gsub = nullptr;
    bf16x8 qf[6]; load_q<6>(a, 0, qf);
    attn_item<1, true, 64, 0, false>(a, qf, 0, smem);
  }
#pragma unroll 1
  for (int i = blockIdx.x; i < 1024 + nc_m; i += gridDim.x) {
    AttnArgs a; a.dry = dry;
    int b, hq;
    if (i < 1024) {
      const int id = xcd_remap(i, 1024), pair = id >> 5, qb = id & 31; b = pair >> 3; hq = pair & 7;
      a.lt0 = (4 * qb - 2 < 0) ? 0 : 4 * qb - 2; a.lt1 = (4 * qb + 6 > 128) ? 128 : 4 * qb + 6;
      a.qrow0 = b * 8192 + qb * 256; a.qpos0 = qb * 256;
    } else {
      const int j = i - 1024; b = j >> 3; hq = j & 7;
      a.lt0 = 0; a.lt1 = 0; a.qrow0 = TL + b * 256; a.qpos0 = 0;
    }
    const int kvh = hq >> 2;
    a.q = p.PROJ + C_SQ + hq * 64; a.qpitch = PN; a.k = p.PROJ + C_SK + kvh * 64; a.kpitch = PN; a.v = p.PROJ + C_SV + kvh * 64; a.vpitch = PN;
    a.o = p.PROJ + C_SQ + hq * 64; a.opitch = PN; a.o0 = nullptr;
    a.krow_ctx = TL + b * 256; a.krow_lat = b * 8192; a.nct = 4;
    a.mb = mb_swa; a.sinkterm = __builtin_amdgcn_exp2f(p.swa_sink[l * 8 + hq] * LOG2E - mb_swa); a.lam = 0.f; a.osc = 0.f; a.gsub = nullptr;
    bf16x8 qf[4]; load_q<4>(a, 0, qf);
    attn_item<1, false, 64, 0, true>(a, qf, 0, smem);
  }
}

constexpr int NPH = 1 + 2 * 11;
DI void run_phase(const Params& p, int ph, LDS_AS unsigned char* smem, int dry) {
#ifdef ONLY_S
  if (ONLY_S == 99) { if (ph == 0) phase0(p, smem, dry); return; }
  if (ph == 0) return;
  const int l = (ph - 1) / 11, s = ONLY_S;
#else
  if (ph == 0) { phase0(p, smem, dry); return; }
  const int l = (ph - 1) / 11, s = (ph - 1) % 11;
#endif
  switch (s) {
    case 0: norm_phase(p, l, 0, dry); break;
    case 1: phase_gemm_in(p, l, smem, dry); break;
    case 2: phase_prep_a(p, l, dry); break;
    case 3: phase_gemm_mla(p, l, smem, dry); break;
    case 4: phase_prep_c(p, l, dry); break;
    case 5: phase_attention(p, l, smem, dry); break;
    case 6: phase_merge(p, l, smem, dry); break;
    case 7: phase_residual_gemm(p, l, 0, smem, dry); break;
    case 8: norm_phase(p, l, 1, dry); break;
    case 9: phase_mlp_in(p, l, smem, dry); break;
    default: phase_residual_gemm(p, l, 1, smem, dry); break;
  }
}

__global__ void __launch_bounds__(512, 2) mega_kernel(Params p) {
  __shared__ __attribute__((aligned(16))) unsigned char smem_raw[3 * GST];
  LDS_AS unsigned char* smem = (LDS_AS unsigned char*)smem_raw;
  __shared__ uint4 xb_words;
  cg::grid_group grid = cg::this_grid();
  if (threadIdx.x == 0) xb_words = make_uint4(0u, 0u, 0u, 0u);
  __syncthreads();
  const XcdBarrier xb = xcd_barrier_post(p.bar, (volatile LDS_AS unsigned*)&xb_words);
#pragma unroll 1
  for (int ph = 0; ph < NPH; ++ph) {
    const int st = (ph == 0) ? 31 : (ph - 1) % 11;
    const int nrep = (((unsigned)p.probe >> st) & 1u) ? 2 : 1;
    for (int rep = 0; rep < nrep; ++rep) run_phase(p, ph, smem, rep + 1 < nrep);
    if (ph + 1 < NPH) { if (ph == 0) grid.sync(); else xcd_barrier(xb); }
  }
}
#ifdef MK_MULTI
__global__ void __launch_bounds__(512, 2) phase_kernel(Params p, int ph) {
  __shared__ __attribute__((aligned(16))) unsigned char smem_raw[3 * GST];
  run_phase(p, ph, (LDS_AS unsigned char*)smem_raw, 0);
}
#endif

extern "C" void kernel_launch(void* const* d_in, const int* in_sizes, int n_in, void* d_out, int out_size, void* d_ws, size_t ws_size,
                              hipStream_t stream) {
  Params p{};
  const float* const* in = (const float* const*)d_in;
  p.x = in[0]; p.c = in[1]; p.ctx = in[2]; p.c_ctx = in[3]; p.w_mod = in[4]; p.b_mod = in[5]; p.g_norm_attn = in[6]; p.g_norm_mlp = in[7];
  p.w_in = in[8]; p.g_q_lora = in[9]; p.w_uq = in[10]; p.g_kv_lora = in[11]; p.w_ukv = in[12]; p.g_mla_q = in[13]; p.g_mla_k = in[14];
  p.w_up_mla = in[15]; p.g_swa_q = in[16]; p.g_swa_k = in[17]; p.swa_sink = in[18]; p.w_up_swa = in[19]; p.g_diff_q = in[20]; p.g_diff_k = in[21];
  p.lambda_q1 = in[22]; p.lambda_k1 = in[23]; p.lambda_q2 = in[24]; p.lambda_k2 = in[25]; p.g_diff_sub = in[26]; p.w_up_diff = in[27];
  p.w_o = in[28]; p.w_mlp_in = in[29]; p.w_mlp_out = in[30];
#ifndef PROBE_MASK
#define PROBE_MASK 0
#endif
  p.probe = PROBE_MASK; p.pad_ = 0;
  p.out = (float*)d_out;
  unsigned char* ws = (unsigned char*)d_ws;
  size_t off = 0;
  auto take = [&](size_t bytes) { unsigned char* r = ws + off; off += (bytes + 255) & ~(size_t)255; return r; };
  p.modtab = (float*)take(2 * 5 * 6144 * 4);
  p.consts = (float*)take(256);
  p.bar = (unsigned*)take(XCD_BAR_WORDS * 4);
  p.WB = (bf16_t*)take(2 * W_LAYER * 2);
  p.H = (bf16_t*)take((size_t)T * 1024 * 2);
  p.PROJ = (bf16_t*)take((size_t)T * PN * 2);
  p.MQ = (bf16_t*)take((size_t)T * 768 * 2);
  p.KV = (bf16_t*)take((size_t)T * 1024 * 2);
  p.KM = (bf16_t*)take((size_t)T * 768 * 2);
  p.CX = (float*)take((size_t)TC * 1024 * 4);
  p.YD0 = (bf16_t*)take((size_t)T * 512 * 2);
  if (off > ws_size) { fprintf(stderr, "workspace too small: need %zu have %zu\n", off, ws_size); return; }
  (void)hipMemsetAsync(p.modtab, 0, (size_t)((unsigned char*)p.bar - (unsigned char*)p.modtab) + XCD_BAR_WORDS * 4, stream);
#ifdef MK_MULTI
  for (int ph = 0; ph < NPH; ++ph) phase_kernel<<<256, 512, 0, stream>>>(p, ph);
#else
  static int grid_blocks = 0;
  if (!grid_blocks) {
    int dev = 0, cus = 0, per_cu = 0;
    hipGetDevice(&dev);
    hipDeviceGetAttribute(&cus, hipDeviceAttributeMultiprocessorCount, dev);
    hipOccupancyMaxActiveBlocksPerMultiprocessor(&per_cu, mega_kernel, 512, 0);
    if (per_cu > 1) per_cu = 1;
    grid_blocks = cus * per_cu;
    if (grid_blocks <= 0) grid_blocks = 256;
  }
  void* args[] = {&p};
  hipError_t e = hipLaunchCooperativeKernel((void*)mega_kernel, dim3(grid_blocks), dim3(512), args, 0, stream);
  if (e != hipSuccess) fprintf(stderr, "cooperative launch failed: %s (grid %d)\n", hipGetErrorString(e), grid_blocks);
#endif
}
```

```cpp
#include <hip/hip_runtime.h>
#include <hip/hip_cooperative_groups.h>
#include <cstdio>
#include <cstdint>
namespace cg = cooperative_groups;

typedef unsigned short bf16_t;
typedef short bf16x8 __attribute__((ext_vector_type(8)));
typedef short s16x4 __attribute__((ext_vector_type(4)));
typedef float f32x16 __attribute__((ext_vector_type(16)));
typedef float f32x4 __attribute__((ext_vector_type(4)));
typedef float f32x2 __attribute__((ext_vector_type(2)));
typedef __bf16 bf16x2_t __attribute__((ext_vector_type(2)));
typedef unsigned u32x2 __attribute__((ext_vector_type(2)));
typedef unsigned u32x4 __attribute__((ext_vector_type(4)));
#define LDS_AS __attribute__((address_space(3)))
#define DI __device__ __forceinline__

constexpr int D = 1024, NB = 4, SEQ = 8192, NCTX = 256;
constexpr int TL = NB * SEQ;
constexpr int TC = NB * NCTX;
constexpr int T = TL + TC;
constexpr int PN = 2720;
constexpr int C_QLAT = 0, C_KVLAT = 256, C_KPE = 384, C_SQ = 416, C_SK = 928, C_SV = 1056, C_DQ = 1184, C_DK = 1696, C_DV = 2208;
constexpr float EPS = 1e-6f;
constexpr float LOG2E = 1.4426950408889634f;
constexpr size_t W_IN = 0;
constexpr size_t W_UQ = W_IN + (size_t)5888 * 1024;
constexpr size_t W_UKV = W_UQ + 768 * 256;
constexpr size_t W_UPM = W_UKV + 1024 * 128;
constexpr size_t W_UPS = W_UPM + 1024 * 512;
constexpr size_t W_UPD = W_UPS + 1024 * 512;
constexpr size_t W_O = W_UPD + 1024 * 512;
constexpr size_t W_M1 = W_O + 1024 * 1024;
constexpr size_t W_M2 = W_M1 + (size_t)4096 * 1024;
constexpr size_t W_LAYER = W_M2 + (size_t)4096 * 1024;

struct Params {
  const float *x, *c, *ctx, *c_ctx, *w_mod, *b_mod, *g_norm_attn, *g_norm_mlp, *w_in, *g_q_lora, *w_uq, *g_kv_lora, *w_ukv,
      *g_mla_q, *g_mla_k, *w_up_mla, *g_swa_q, *g_swa_k, *swa_sink, *w_up_swa, *g_diff_q, *g_diff_k, *lambda_q1, *lambda_k1,
      *lambda_q2, *lambda_k2, *g_diff_sub, *w_up_diff, *w_o, *w_mlp_in, *w_mlp_out;
  float* out;
  float* modtab;
  float* consts;
  unsigned* bar;
  bf16_t* WB;
  bf16_t* H;
  bf16_t* PROJ;
  bf16_t* MQ;
  bf16_t* KV;
  bf16_t* KM;
  float* CX;
  bf16_t* YD0;
  int probe, pad_;
};

template <class Tp> DI Tp* opq(Tp* ptr) { asm volatile("" : "+s"(ptr)); return ptr; }
DI int tidx() { int t = threadIdx.x; asm volatile("" : "+v"(t)); return t; }
DI float bf2f(bf16_t v) { return __uint_as_float((unsigned)v << 16); }
DI unsigned pk2(float a, float b) { f32x2 v = {a, b}; bf16x2_t r = __builtin_convertvector(v, bf16x2_t); return __builtin_bit_cast(unsigned, r); }
DI bf16_t f2bf(float a) { return (bf16_t)(pk2(a, 0.f) & 0xffffu); }
DI float wave_sum(float v) {
#pragma unroll
  for (int o = 32; o; o >>= 1) v += __shfl_xor(v, o);
  return v;
}
DI float wave_max(float v) {
#pragma unroll
  for (int o = 32; o; o >>= 1) v = fmaxf(v, __shfl_xor(v, o));
  return v;
}
DI float silu(float x) { return x / (1.f + __expf(-x)); }
DI int xcd_remap(int L, int n) {
  const int q = n >> 3, r = n & 7, xcd = L & 7, off = L >> 3;
  return (xcd < r ? xcd * (q + 1) : r * (q + 1) + (xcd - r) * q) + off;
}
DI void glds16(const void* g, LDS_AS unsigned char* l) {
  __builtin_amdgcn_global_load_lds((const unsigned*)g, (LDS_AS unsigned*)l, 16, 0, 0);
}
DI void glds16a(const void* base, unsigned voff, unsigned ldsaddr) {
  unsigned keep;
  asm volatile("s_mov_b32 %0, m0\n\ts_mov_b32 m0, %3\n\ts_nop 0\n\tglobal_load_lds_dwordx4 %1, %2\n\ts_mov_b32 m0, %0"
               : "=&s"(keep) : "v"(voff), "s"(base), "s"(ldsaddr) : "memory");
}
DI unsigned lds_u32(LDS_AS unsigned char* p) { return (unsigned)(uintptr_t)p; }
DI bf16x8 lds128(LDS_AS unsigned char* p) { return *(LDS_AS bf16x8*)p; }
#define MFMA32(a, b, c) __builtin_amdgcn_mfma_f32_32x32x16_bf16((a), (b), (c), 0, 0, 0)

#define XB_TMO      128
#define XB_XCNT(j)  (256  + 64 * (j))
#define XB_XSUB(j)  (1280 + 64 * (j))
#define XB_XGEN(j)  (2304 + 64 * (j))
#define XB_TOP      3328
#define XB_TOPGEN   3392
#define XCD_BAR_WORDS 3456
#define XB_SPIN_CAP (1u << 22)
DI unsigned xb_ld(unsigned* p) { return __hip_atomic_load(p, __ATOMIC_RELAXED, __HIP_MEMORY_SCOPE_AGENT); }
DI unsigned xb_add(unsigned* p, unsigned v) { return __hip_atomic_fetch_add(p, v, __ATOMIC_RELAXED, __HIP_MEMORY_SCOPE_AGENT); }
DI unsigned xb_xcc_id() { return (unsigned)__builtin_amdgcn_s_getreg((3 << 11) | 20) & 0xFu; }
#define XB_SPIN(cond, bar) do { unsigned _sp = 0; while (cond) { __builtin_amdgcn_s_sleep(1); \
    if ((++_sp & 255u) == 0u) { if (xb_ld(&(bar)[XB_TMO])) break; if (_sp > XB_SPIN_CAP) { atomicAdd(&(bar)[XB_TMO], 1u); break; } } } } while (0)
struct XcdBarrier { unsigned* bar; unsigned x; volatile LDS_AS unsigned* st; };
DI XcdBarrier xcd_barrier_post(unsigned* bar, volatile LDS_AS unsigned* st) {
  XcdBarrier b; b.bar = bar; b.x = xb_xcc_id(); b.st = st;
  if (threadIdx.x == 0) (void)xb_add(&bar[XB_XCNT(b.x)], 1u);
  return b;
}
DI void xcd_barrier_complete(unsigned* bar, unsigned x, unsigned& nloc, unsigned& nx) {
  const unsigned G = gridDim.x * gridDim.y * gridDim.z;
  unsigned sum, cnt, mine, sp = 0u;
  for (;;) {
    sum = 0u; cnt = 0u; mine = 0u;
#pragma unroll
    for (unsigned j = 0; j < 16; ++j) { const unsigned c = xb_ld(&bar[XB_XCNT(j)]); sum += c; cnt += (c > 0u) ? 1u : 0u; mine = (j == x) ? c : mine; }
    if (sum == G) break;
    __builtin_amdgcn_s_sleep(1);
    if ((++sp & 255u) == 0u) { if (xb_ld(&bar[XB_TMO])) break; if (sp > XB_SPIN_CAP) { atomicAdd(&bar[XB_TMO], 1u); break; } }
  }
  nloc = mine > 0u ? mine : 1u; nx = cnt > 0u ? cnt : 1u;
}
DI void xcd_barrier(const XcdBarrier& b) {
  asm volatile("s_waitcnt vmcnt(0)" ::: "memory");
  __syncthreads();
  if (threadIdx.x == 0) {
    unsigned* bar = b.bar;
    __builtin_amdgcn_s_waitcnt(0);
    unsigned nloc = b.st[0], nx = b.st[1];
    if (nloc == 0u) { xcd_barrier_complete(bar, b.x, nloc, nx); b.st[0] = nloc; b.st[1] = nx; }
    const unsigned old = xb_add(&bar[XB_XSUB(b.x)], 1u);
    const unsigned gen = old / nloc;
    if (old + 1u == (gen + 1u) * nloc) {
      __builtin_amdgcn_fence(__ATOMIC_RELEASE, "agent");
      asm volatile("s_waitcnt vmcnt(0)" ::: "memory");
      const unsigned og = xb_add(&bar[XB_TOP], 1u);
      const unsigned tg = og / nx;
      if (og + 1u == (tg + 1u) * nx) xb_add(&bar[XB_TOPGEN], 1u);
      else XB_SPIN(xb_ld(&bar[XB_TOPGEN]) == tg, bar);
      __builtin_amdgcn_fence(__ATOMIC_ACQUIRE, "agent");
      xb_add(&bar[XB_XGEN(b.x)], 1u);
      asm volatile("s_waitcnt vmcnt(0)" ::: "memory");
    } else {
      XB_SPIN(xb_ld(&bar[XB_XGEN(b.x)]) == gen, bar);
      __builtin_amdgcn_fence(__ATOMIC_ACQUIRE, "agent");
      asm volatile("s_waitcnt vmcnt(0)" ::: "memory");
    }
  }
  __syncthreads();
}

struct ConvT { const float* src; bf16_t* dst; int ld, K, k0, n0, is_win; };
DI void conv_load(const ConvT& d, int tid, f32x4 (&v)[2]) {
  const int ty = tid >> 4, tx = tid & 15, n = d.n0 + 4 * tx;
  int sc = n;
  if (d.is_win) sc = (n < 2720) ? n : (n < 2816 ? -1 : n - 96);
#pragma unroll
  for (int i = 0; i < 2; ++i) {
    v[i] = (f32x4){0.f, 0.f, 0.f, 0.f};
    if (sc >= 0) v[i] = *(const f32x4*)(d.src + (size_t)(d.k0 + ty + 32 * i) * d.ld + sc);
  }
}
DI void conv_finish(const ConvT& d, int tid, const f32x4 (&v)[2], LDS_AS float* tile, int dry) {
  const int ty = tid >> 4, tx = tid & 15;
#pragma unroll
  for (int i = 0; i < 2; ++i) {
    const int k = ty + 32 * i;
    tile[k * 65 + 4 * tx + 0] = v[i][0]; tile[k * 65 + 4 * tx + 1] = v[i][1]; tile[k * 65 + 4 * tx + 2] = v[i][2]; tile[k * 65 + 4 * tx + 3] = v[i][3];
  }
  __syncthreads();
  {
    const int r = tid >> 3, c = tid & 7;
    u32x4 w;
    w[0] = pk2(tile[(8 * c + 0) * 65 + r], tile[(8 * c + 1) * 65 + r]);
    w[1] = pk2(tile[(8 * c + 2) * 65 + r], tile[(8 * c + 3) * 65 + r]);
    w[2] = pk2(tile[(8 * c + 4) * 65 + r], tile[(8 * c + 5) * 65 + r]);
    w[3] = pk2(tile[(8 * c + 6) * 65 + r], tile[(8 * c + 7) * 65 + r]);
    if (!dry) *(u32x4*)(d.dst + (size_t)(d.n0 + r) * d.K + d.k0 + 8 * c) = w;
  }
}
DI ConvT conv_decode(const Params& p, int t) {
  ConvT d; d.is_win = 0;
  const int l = t / 4240; int u = t % 4240; size_t doff;
  if (u < 1472) { d.src = p.w_in + (size_t)l * 1024 * 5792; d.ld = 5792; d.K = 1024; d.is_win = 1; doff = W_IN; }
  else if (u < 1520) { u -= 1472; d.src = p.w_uq + (size_t)l * 256 * 768; d.ld = 768; d.K = 256; doff = W_UQ; }
  else if (u < 1552) { u -= 1520; d.src = p.w_ukv + (size_t)l * 128 * 1024; d.ld = 1024; d.K = 128; doff = W_UKV; }
  else if (u < 1680) { u -= 1552; d.src = p.w_up_mla + (size_t)l * 512 * 1024; d.ld = 1024; d.K = 512; doff = W_UPM; }
  else if (u < 1808) { u -= 1680; d.src = p.w_up_swa + (size_t)l * 512 * 1024; d.ld = 1024; d.K = 512; doff = W_UPS; }
  else if (u < 1936) { u -= 1808; d.src = p.w_up_diff + (size_t)l * 512 * 1024; d.ld = 1024; d.K = 512; doff = W_UPD; }
  else if (u < 2192) { u -= 1936; d.src = p.w_o + (size_t)l * 1024 * 1024; d.ld = 1024; d.K = 1024; doff = W_O; }
  else if (u < 3216) { u -= 2192; d.src = p.w_mlp_in + (size_t)l * 1024 * 4096; d.ld = 4096; d.K = 1024; doff = W_M1; }
  else { u -= 3216; d.src = p.w_mlp_out + (size_t)l * 4096 * 1024; d.ld = 1024; d.K = 4096; doff = W_M2; }
  const int nkt = d.K >> 6;
  d.k0 = (u % nkt) * 64; d.n0 = (u / nkt) * 64; d.dst = p.WB + (size_t)l * W_LAYER + doff;
  return d;
}

DI void phase0(const Params& p, LDS_AS unsigned char* smem, int dry) {
  const int tid_ = tidx(), lane = tid_ & 63, wave = tid_ >> 6;
  if (blockIdx.x == 0 && wave == 0) {
    for (int l = 0; l < 2; ++l) {
      const float s1 = wave_sum(p.lambda_q1[l * 64 + lane] * p.lambda_k1[l * 64 + lane]);
      const float s2 = wave_sum(p.lambda_q2[l * 64 + lane] * p.lambda_k2[l * 64 + lane]);
      const float lam_init = 0.8f - 0.6f * expf(-0.3f * (float)l);
      const float lam = expf(s1) - expf(s2) + lam_init;
      float a = fabsf(p.g_mla_q[l * 96 + lane]); if (lane < 32) a = fmaxf(a, fabsf(p.g_mla_q[l * 96 + 64 + lane]));
      float b = fabsf(p.g_mla_k[l * 96 + lane]); if (lane < 32) b = fmaxf(b, fabsf(p.g_mla_k[l * 96 + 64 + lane]));
      const float mq = wave_max(a), mk = wave_max(b);
      const float sq = wave_max(fabsf(p.g_swa_q[l * 64 + lane])), sk = wave_max(fabsf(p.g_swa_k[l * 64 + lane]));
      const float dq = wave_max(fabsf(p.g_diff_q[l * 64 + lane])), dk = wave_max(fabsf(p.g_diff_k[l * 64 + lane]));
      if (lane == 0) {
        float* cs = p.consts + l * 16;
        cs[0] = lam; cs[1] = lam_init;
        cs[2] = LOG2E * sqrtf(96.f) * mq * mk;
        cs[3] = LOG2E * 8.f * sq * sk;
        cs[4] = LOG2E * 8.f * dq * dk;
      }
    }
  }
  for (int task = blockIdx.x * 8 + wave; task < 3072; task += gridDim.x * 8) {
    const int l = task / 1536, rem = task % 1536, chunk = rem >> 4, ks = rem & 15;
    const int n = chunk * 64 + lane;
    float acc[5] = {0.f, 0.f, 0.f, 0.f, 0.f};
    const float* w = p.w_mod + ((size_t)l * 1024 + ks * 64) * 6144 + n;
#pragma unroll 8
    for (int k = 0; k < 64; ++k) {
      const float wv = w[(size_t)k * 6144];
      const int kk = ks * 64 + k;
#pragma unroll
      for (int r = 0; r < 4; ++r) acc[r] += silu(p.c[r * 1024 + kk]) * wv;
      acc[4] += silu(p.c_ctx[kk]) * wv;
    }
    const float bias = (ks == 0) ? p.b_mod[l * 6144 + n] : 0.f;
    if (!dry)
#pragma unroll
      for (int r = 0; r < 5; ++r) atomicAdd(p.modtab + (size_t)(l * 5 + r) * 6144 + n, acc[r] + bias);
  }
  {
    constexpr int NTI = 4, TBUF = 64 * 65 + 16;
    LDS_AS float* tile0 = (LDS_AS float*)smem;
    const int tid = tidx(), G = gridDim.x, NTOT = 2 * 4240;
    for (int t = blockIdx.x; t < NTOT; t += NTI * G) {
      ConvT d[NTI]; f32x4 v[NTI][2];
#pragma unroll
      for (int q = 0; q < NTI; ++q) { d[q] = conv_decode(p, (t + q * G < NTOT) ? t + q * G : t); conv_load(d[q], tid, v[q]); }
      __syncthreads();
#pragma unroll
      for (int q = 0; q < NTI; ++q)
        if (t + q * G < NTOT) conv_finish(d[q], tid, v[q], tile0 + q * TBUF, dry);
    }
    __syncthreads();
  }
}

DI void norm_phase(const Params& p, int l, int which, int dry) {
  const int tid_ = tidx(), lane = tid_ & 63, wave = tid_ >> 6;
  const float* g = (which == 0 ? p.g_norm_attn : p.g_norm_mlp) + l * 1024;
  const int shoff = which == 0 ? 0 : 3072, scoff = shoff + 1024;
  const int nrows = (which == 1 && l == 1) ? TL : T;
  const bool first = (which == 0 && l == 0);
  const float* px = opq(p.x); const float* pctx = opq(p.ctx); const float* pout = opq((const float*)p.out); const float* pcx = opq((const float*)p.CX);
  const float* slat = first ? px : pout; const float* sctx = first ? pctx : pcx;
  for (int row = blockIdx.x * 8 + wave; row < nrows; row += gridDim.x * 8) {
    const float* xr; int bidx;
    if (row < TL) { xr = slat + (size_t)row * 1024; bidx = row >> 13; }
    else { xr = sctx + (size_t)(row - TL) * 1024; bidx = 4; }
    const float* mod = p.modtab + (size_t)(l * 5 + bidx) * 6144;
    f32x4 v[4]; float ss = 0.f;
#pragma unroll
    for (int i = 0; i < 4; ++i) { v[i] = *(const f32x4*)(xr + i * 256 + lane * 4); ss += v[i][0] * v[i][0] + v[i][1] * v[i][1] + v[i][2] * v[i][2] + v[i][3] * v[i][3]; }
    ss = wave_sum(ss);
    const float rstd = rsqrtf(ss * (1.f / 1024.f) + EPS);
#pragma unroll
    for (int i = 0; i < 4; ++i) {
      const int col = i * 256 + lane * 4;
      const f32x4 gv = *(const f32x4*)(g + col), sh = *(const f32x4*)(mod + shoff + col), sc = *(const f32x4*)(mod + scoff + col);
      float o[4];
#pragma unroll
      for (int j = 0; j < 4; ++j) o[j] = (v[i][j] * rstd * gv[j]) * (1.f + sc[j]) + sh[j];
      u32x2 w = {pk2(o[0], o[1]), pk2(o[2], o[3])};
      if (!dry) *(u32x2*)(p.H + (size_t)row * 1024 + col) = w;
    }
  }
}

constexpr int GST = 49152;
DI void gemm_kloop(const bf16_t* Ag, int lda, int a_kstep, const bf16_t* Bg, int ldb, int nkt, f32x16 (&acc)[2][2], LDS_AS unsigned char* smem) {
  const int tid_ = tidx(), lane = tid_ & 63, wave = tid_ >> 6, h = lane >> 5, wm = wave >> 1, wn = wave & 1;
  unsigned aoff[4], boff[2];
#pragma unroll
  for (int i = 0; i < 4; ++i) {
    const int r = wave * 32 + i * 8 + (lane >> 3), c = (lane & 7) ^ ((r >> 1) & 7);
    aoff[i] = (unsigned)(r * lda + c * 8) * 2u;
  }
#pragma unroll
  for (int i = 0; i < 2; ++i) {
    const int r = wave * 16 + i * 8 + (lane >> 3), c = (lane & 7) ^ ((r >> 1) & 7);
    boff[i] = (unsigned)(r * ldb + c * 8) * 2u;
  }
  const unsigned dstA = (unsigned)__builtin_amdgcn_readfirstlane((int)(lds_u32(smem) + wave * 4096));
  const unsigned dstB = (unsigned)__builtin_amdgcn_readfirstlane((int)(lds_u32(smem) + 32768 + wave * 2048));
  const int swz = (lane >> 1) & 7;
  const int arow = (wm * 64 + (lane & 31)) * 128, brow = 32768 + (wn * 64 + (lane & 31)) * 128;
  asm volatile("s_waitcnt vmcnt(0)" ::: "memory");
  __syncthreads();
  auto issue = [&](int kt, int stg) {
    const char* An = (const char*)(Ag + (size_t)kt * a_kstep); const char* Bn = (const char*)(Bg + (size_t)kt * 64);
#pragma unroll
    for (int i = 0; i < 4; ++i) glds16a(An, aoff[i], dstA + stg * GST + i * 1024);
#pragma unroll
    for (int i = 0; i < 2; ++i) glds16a(Bn, boff[i], dstB + stg * GST + i * 1024);
  };
  issue(0, 0);
  if (nkt > 1) issue(1, 1);
  int st = 0;
#pragma unroll 1
  for (int kt = 0; kt < nkt; ++kt) {
    if (kt + 1 < nkt) asm volatile("s_waitcnt vmcnt(6)" ::: "memory"); else asm volatile("s_waitcnt vmcnt(0)" ::: "memory");
    __builtin_amdgcn_s_barrier();
    asm volatile("" ::: "memory");
    if (kt + 2 < nkt) issue(kt + 2, st >= 1 ? st - 1 : 2);
    LDS_AS unsigned char* sa = smem + st * GST;
#pragma unroll
    for (int s = 0; s < 4; ++s) {
      const int co = ((2 * s + h) ^ swz) << 4;
      const bf16x8 a0 = lds128(sa + arow + co), a1 = lds128(sa + arow + 32 * 128 + co);
      const bf16x8 b0 = lds128(sa + brow + co), b1 = lds128(sa + brow + 32 * 128 + co);
      acc[0][0] = MFMA32(b0, a0, acc[0][0]); acc[0][1] = MFMA32(b1, a0, acc[0][1]);
      acc[1][0] = MFMA32(b0, a1, acc[1][0]); acc[1][1] = MFMA32(b1, a1, acc[1][1]);
    }
    st = (st == 2) ? 0 : st + 1;
  }
}
DI void zero_acc(f32x16 (&acc)[2][2]) {
#pragma unroll
  for (int a = 0; a < 2; ++a)
#pragma unroll
    for (int b = 0; b < 2; ++b)
#pragma unroll
      for (int i = 0; i < 16; ++i) acc[a][b][i] = 0.f;
}
DI void tile_decode(int id, int NT, int& mt, int& nt) { const int per = 4 * NT, g = id / per, w = id % per; mt = g * 4 + (w & 3); nt = w >> 2; }

constexpr int EPW = 17408;
template <int ACT> DI LDS_AS unsigned char* stage_tile(const f32x16 (&acc)[2][2], LDS_AS unsigned char* smem) {
  const int tid_ = tidx(), lane = tid_ & 63, wave = tid_ >> 6, h = lane >> 5;
  __syncthreads();
  LDS_AS unsigned char* reg = smem + wave * EPW;
#pragma unroll
  for (int bi = 0; bi < 2; ++bi)
#pragma unroll
    for (int bj = 0; bj < 2; ++bj)
#pragma unroll
      for (int g = 0; g < 4; ++g) {
        f32x4 v;
#pragma unroll
        for (int j = 0; j < 4; ++j) { v[j] = acc[bi][bj][4 * g + j]; if (ACT == 1) { v[j] = fmaxf(v[j], 0.f); v[j] *= v[j]; } }
        *(LDS_AS f32x4*)(reg + (bi * 32 + (lane & 31)) * 272 + (bj * 32 + 8 * g + 4 * h) * 4) = v;
      }
  return reg;
}
template <int ACT> DI void epi_store_bf16(const f32x16 (&acc)[2][2], bf16_t* dst, int ldc, int row0, int col0, int ncols, LDS_AS unsigned char* smem) {
  LDS_AS unsigned char* reg = stage_tile<ACT>(acc, smem);
  const int tid_ = tidx(), lane = tid_ & 63, wave = tid_ >> 6, wm = wave >> 1, wn = wave & 1;
  const int c = (lane & 7) * 8, col = col0 + wn * 64 + c;
#pragma unroll
  for (int i = 0; i < 8; ++i) {
    const int r = i * 8 + (lane >> 3);
    const f32x4 a = *(LDS_AS f32x4*)(reg + r * 272 + c * 4), b = *(LDS_AS f32x4*)(reg + r * 272 + c * 4 + 16);
    u32x4 w = {pk2(a[0], a[1]), pk2(a[2], a[3]), pk2(b[0], b[1]), pk2(b[2], b[3])};
    if (col < ncols) *(u32x4*)(dst + (size_t)(row0 + wm * 64 + r) * ldc + col) = w;
  }
}
DI void epi_residual(const f32x16 (&acc)[2][2], const float* xin, float* xout, const float* gate, int row0, int col0, LDS_AS unsigned char* smem) {
  LDS_AS unsigned char* reg = stage_tile<0>(acc, smem);
  const int tid_ = tidx(), lane = tid_ & 63, wave = tid_ >> 6, wm = wave >> 1, wn = wave & 1;
  const int c = (lane & 15) * 4, col = col0 + wn * 64 + c;
  const f32x4 gv = *(const f32x4*)(gate + col);
#pragma unroll
  for (int i = 0; i < 16; ++i) {
    const int r = i * 4 + (lane >> 4);
    const size_t off = (size_t)(row0 + wm * 64 + r) * 1024 + col;
    const f32x4 a = *(LDS_AS f32x4*)(reg + r * 272 + c * 4), xi = *(const f32x4*)(xin + off);
    f32x4 o;
#pragma unroll
    for (int j = 0; j < 4; ++j) o[j] = xi[j] + gv[j] * a[j];
    *(f32x4*)(xout + off) = o;
  }
}

constexpr int G2ST = 65536;
DI void gemm_kloop2(const bf16_t* Ag, int lda, const bf16_t* Bg, int ldb, int nkt  , f32x16 (&acc)[4][2], LDS_AS unsigned char* smem) {
  const int tid_ = tidx(), lane = tid_ & 63, wave = tid_ >> 6, h = lane >> 5, wm = wave >> 2, wn = wave & 3;
  unsigned aoff[4], boff[4];
#pragma unroll
  for (int i = 0; i < 4; ++i) {
    const int r = wave * 32 + i * 8 + (lane >> 3), c = (lane & 7) ^ ((r >> 1) & 7);
    aoff[i] = (unsigned)(r * lda + c * 8) * 2u; boff[i] = (unsigned)(r * ldb + c * 8) * 2u;
  }
  const unsigned dstA = (unsigned)__builtin_amdgcn_readfirstlane((int)(lds_u32(smem) + wave * 4096));
  const unsigned dstB = dstA + 32768;
  const int swz = (lane >> 1) & 7;
  const int arow = (wm * 128 + (lane & 31)) * 128, brow = 32768 + (wn * 64 + (lane & 31)) * 128;
  asm volatile("s_waitcnt vmcnt(0)" ::: "memory");
  __syncthreads();
  auto issue = [&](int kt, int stg) {
    const char* An = (const char*)(Ag + (size_t)kt * 64); const char* Bn = (const char*)(Bg + (size_t)kt * 64);
#pragma unroll
    for (int i = 0; i < 4; ++i) glds16a(An, aoff[i], dstA + stg * G2ST + i * 1024);
#pragma unroll
    for (int i = 0; i < 4; ++i) glds16a(Bn, boff[i], dstB + stg * G2ST + i * 1024);
  };
  issue(0, 0);
#pragma unroll 1
  for (int kt = 0; kt < nkt; ++kt) {
    asm volatile("s_waitcnt vmcnt(0)" ::: "memory");
    __builtin_amdgcn_s_barrier();
    asm volatile("" ::: "memory");
    if (kt + 1 < nkt) issue(kt + 1, (kt + 1) & 1);
    LDS_AS unsigned char* sa = smem + (kt & 1) * G2ST;
#pragma unroll
    for (int s = 0; s < 4; ++s) {
      const int co = ((2 * s + h) ^ swz) << 4;
      bf16x8 fa[4], fb[2];
#pragma unroll
      for (int bi = 0; bi < 4; ++bi) fa[bi] = lds128(sa + arow + bi * 32 * 128 + co);
#pragma unroll
      for (int bj = 0; bj < 2; ++bj) fb[bj] = lds128(sa + brow + bj * 32 * 128 + co);
#pragma unroll
      for (int bi = 0; bi < 4; ++bi)
#pragma unroll
        for (int bj = 0; bj < 2; ++bj) acc[bi][bj] = MFMA32(fb[bj], fa[bi], acc[bi][bj]);
    }
  }
}
DI void zero_acc2(f32x16 (&acc)[4][2]) {
#pragma unroll
  for (int a = 0; a < 4; ++a)
#pragma unroll
    for (int b = 0; b < 2; ++b)
#pragma unroll
      for (int i = 0; i < 16; ++i) acc[a][b][i] = 0.f;
}
template <int ACT, int HF> DI void stage_half(const f32x16 (&acc)[4][2], LDS_AS unsigned char* reg, int lane, int h) {
#pragma unroll
  for (int bi = 0; bi < 2; ++bi)
#pragma unroll
    for (int bj = 0; bj < 2; ++bj)
#pragma unroll
      for (int g = 0; g < 4; ++g) {
        f32x4 v;
#pragma unroll
        for (int j = 0; j < 4; ++j) { v[j] = acc[2 * HF + bi][bj][4 * g + j]; if (ACT == 1) { v[j] = fmaxf(v[j], 0.f); v[j] *= v[j]; } }
        *(LDS_AS f32x4*)(reg + (bi * 32 + (lane & 31)) * 272 + (bj * 32 + 8 * g + 4 * h) * 4) = v;
      }
}
template <int ACT, int HF> DI void epi2_half_bf16(const f32x16 (&acc)[4][2], bf16_t* dst, int ldc, int row0, int col0, int ncols, LDS_AS unsigned char* smem) {
  const int tid_ = tidx(), lane = tid_ & 63, wave = tid_ >> 6, h = lane >> 5, wm = wave >> 2, wn = wave & 3;
  LDS_AS unsigned char* reg = smem + wave * EPW;
  stage_half<ACT, HF>(acc, reg, lane, h);
  const int c = (lane & 7) * 8, col = col0 + wn * 64 + c;
#pragma unroll
  for (int i = 0; i < 8; ++i) {
    const int r = i * 8 + (lane >> 3);
    const f32x4 a = *(LDS_AS f32x4*)(reg + r * 272 + c * 4), b = *(LDS_AS f32x4*)(reg + r * 272 + c * 4 + 16);
    u32x4 w = {pk2(a[0], a[1]), pk2(a[2], a[3]), pk2(b[0], b[1]), pk2(b[2], b[3])};
    if (col < ncols) *(u32x4*)(dst + (size_t)(row0 + wm * 128 + HF * 64 + r) * ldc + col) = w;
  }
}
template <int ACT> DI void epi2_store_bf16(const f32x16 (&acc)[4][2], bf16_t* dst, int ldc, int row0, int col0, int ncols, LDS_AS unsigned char* smem) {
  __syncthreads();
  epi2_half_bf16<ACT, 0>(acc, dst, ldc, row0, col0, ncols, smem);
  epi2_half_bf16<ACT, 1>(acc, dst, ldc, row0, col0, ncols, smem);
}
template <int HF> DI void epi2_half_residual(const f32x16 (&acc)[4][2], const float* xin, float* xout, const float* gate, int row0, int col0, LDS_AS unsigned char* smem) {
  const int tid_ = tidx(), lane = tid_ & 63, wave = tid_ >> 6, h = lane >> 5, wm = wave >> 2, wn = wave & 3;
  LDS_AS unsigned char* reg = smem + wave * EPW;
  stage_half<0, HF>(acc, reg, lane, h);
  const int c = (lane & 15) * 4, col = col0 + wn * 64 + c;
  const f32x4 gv = *(const f32x4*)(gate + col);
#pragma unroll
  for (int i = 0; i < 16; ++i) {
    const int r = i * 4 + (lane >> 4);
    const size_t off = (size_t)(row0 + wm * 128 + HF * 64 + r) * 1024 + col;
    const f32x4 a = *(LDS_AS f32x4*)(reg + r * 272 + c * 4), xi = *(const f32x4*)(xin + off);
    f32x4 o;
#pragma unroll
    for (int j = 0; j < 4; ++j) o[j] = xi[j] + gv[j] * a[j];
    *(f32x4*)(xout + off) = o;
  }
}
DI void epi2_residual(const f32x16 (&acc)[4][2], const float* xin, float* xout, const float* gate, int row0, int col0, LDS_AS unsigned char* smem) {
  __syncthreads();
  epi2_half_residual<0>(acc, xin, xout, gate, row0, col0, smem);
  epi2_half_residual<1>(acc, xin, xout, gate, row0, col0, smem);
}

namespace pg8 {
typedef float f32x2v __attribute__((ext_vector_type(2)));
constexpr int BM = 256, BK = 64, HALF = 128, HTB = HALF * BK * 2, STAGE_BYTES = 8 * HTB, NXCD = 8, WGM = 8;
DI int lds_byte(int r, int c) { const int st = (r >> 4) * 2 + (c >> 5), rr = r & 15, cc = c & 31, ob = rr * 64 + cc * 2; return st * 1024 + (ob ^ (((ob >> 9) & 1) << 5)); }
DI void stage_rc(int b, int& R, int& C) { const int st = b / 1024, sb = b % 1024, swz = sb ^ (((sb >> 9) & 1) << 5); R = (st >> 1) * 16 + swz / 64; C = (st & 1) * 32 + (swz % 64) / 2; }
DI int perm32(int rho) { const int n = rho >> 4, i = rho & 15; return 8 * (i >> 2) + 4 * n + (i & 3); }
struct Unit { int pm, pn; };
struct Gemm { const bf16_t* A; const bf16_t* Bt; int M, N, K; };
struct StaticOrder {
    int nM, nN, nwg, G, c;
    DI void init(int M, int N, int G_, int c_) { nM = M / BM; nN = N / BM; nwg = nM * nN; G = G_; c = c_; }
    DI bool next(int i, Unit& u) const {
        const long L = (long)i * G + c; if (L >= nwg) return false;
        int wgid = (int)L; { const int q = nwg / NXCD, r = nwg % NXCD, xcd = wgid % NXCD, off = wgid / NXCD; wgid = (xcd < r ? xcd * (q + 1) : r * (q + 1) + (xcd - r) * q) + off; }
        const int nig = WGM * nN, gid = wgid / nig, fm = gid * WGM, gsz = (nM - fm) < WGM ? (nM - fm) : WGM;
        u.pm = fm + ((wgid % nig) % gsz); u.pn = (wgid % nig) / gsz; return true;
    }
    DI void a_ready(const Unit&) const {}
    DI void done(const Unit&) const {}
};
template <int ACT  > struct EpiBf16 {
    static constexpr bool PERM = true, AFTER_DRAIN = false;
    bf16_t* O; int ldc, ncols, dry;
    DI void operator()(const f32x4 (&acc)[2][2][4][2], const Unit& u, int wr, int wc, int fr, int fq) const {
        if (dry) return;
        const int row0 = u.pm * BM + wr * 64 + fr, col0 = u.pn * BM + wc * 32 + 8 * fq;
#pragma unroll
        for (int ai = 0; ai < 2; ++ai)
#pragma unroll
            for (int m = 0; m < 4; ++m) { bf16_t* rowp = O + (size_t)(row0 + ai * HALF + m * 16) * ldc + col0;
#pragma unroll
                for (int bj = 0; bj < 2; ++bj) { f32x4 v0 = acc[ai][bj][m][0], v1 = acc[ai][bj][m][1];
                    if (ACT == 1) {
#pragma unroll
                        for (int j = 0; j < 4; ++j) { v0[j] = fmaxf(v0[j], 0.f); v0[j] *= v0[j]; v1[j] = fmaxf(v1[j], 0.f); v1[j] *= v1[j]; } }
                    u32x4 w = {pk2(v0[0], v0[1]), pk2(v0[2], v0[3]), pk2(v1[0], v1[1]), pk2(v1[2], v1[3])};
                    if (col0 + bj * HALF < ncols) *(u32x4*)(rowp + bj * HALF) = w; } }
    }
};
struct EpiResid {
    static constexpr bool PERM = false, AFTER_DRAIN = false;
    const float* xin; float* xout; const float* gate; int dry;
    DI void operator()(const f32x4 (&acc)[2][2][4][2], const Unit& u, int wr, int wc, int fr, int fq) const {
        if (dry) return;
        const int row0 = u.pm * BM + wr * 64 + fr, col0 = u.pn * BM + wc * 32 + 4 * fq;
        const float* gv = gate + (size_t)((u.pm * BM) >> 13) * 6144 + col0;
        f32x4 g[2][2];
#pragma unroll
        for (int bj = 0; bj < 2; ++bj)
#pragma unroll
            for (int n = 0; n < 2; ++n) g[bj][n] = *(const f32x4*)(gv + bj * HALF + n * 16);
#pragma unroll
        for (int ai = 0; ai < 2; ++ai)
#pragma unroll
            for (int m = 0; m < 4; ++m) { const size_t off = (size_t)(row0 + ai * HALF + m * 16) * 1024 + col0;
#pragma unroll
                for (int bj = 0; bj < 2; ++bj)
#pragma unroll
                    for (int n = 0; n < 2; ++n) { const f32x4 xi = *(const f32x4*)(xin + off + bj * HALF + n * 16);
                        *(f32x4*)(xout + off + bj * HALF + n * 16) = xi + g[bj][n] * acc[ai][bj][m][n]; } }
    }
};
template <class Epi, class Sched, bool STAMP = false>
__device__ __forceinline__ void gemm_phase(LDS_AS unsigned char* lds, const Gemm g, const Sched& S, const Epi& E, unsigned long long* stamps) {
    const int tid = tidx(), wid = __builtin_amdgcn_readfirstlane(tid >> 6), lane = tid & 63, wr = wid >> 2, wc = wid & 3, fr = lane & 15, fq = lane >> 4;
    const int K = g.K, nt = K / BK;
    int ts_lo = 0, ts_hi = 0, nts = 0; const unsigned long long rt_entry = STAMP ? 0ull : 0ull;
#define PG8_STAMP() do { if (STAMP && wid == 0 && nts < 64) { const unsigned long long _c = (unsigned long long)clock64(); \
        ts_lo = (lane == nts) ? (int)(unsigned)_c : ts_lo; ts_hi = (lane == nts) ? (int)(unsigned)(_c >> 32) : ts_hi; ++nts; } } while (0)
    PG8_STAMP();
    unsigned voffA[2], voffB[2];
#pragma unroll
    for (int i = 0; i < 2; ++i) { int R, C; stage_rc(tid * 16 + i * 8192, R, C); const int Rb = Epi::PERM ? ((R & ~31) + perm32(R & 31)) : R;
        voffA[i] = (unsigned)(R * K + C) * 2u; voffB[i] = (unsigned)(Rb * K + C) * 2u; }
    const size_t kstep = (size_t)(BK * 2);
    const size_t hstep = (size_t)HALF * K * 2;
    const size_t tstep = 2 * hstep;
    const unsigned ldsw = (unsigned)wid * 1024u; const unsigned ldsbase = (unsigned)__builtin_amdgcn_readfirstlane((int)lds_u32(lds));
    const int aoff = lds_byte(wr * 64 + fr, fq * 8), boff = lds_byte(wc * 32 + fr, fq * 8);
#define PG8_SA(b, h) (((b) * 2 + (h)) * HTB)
#define PG8_SB(b, h) ((4 + (b) * 2 + (h)) * HTB)
#define PG8_STAGE(bufoff, gbase, voff) do { _Pragma("unroll") for (int _i = 0; _i < 2; ++_i) \
        glds16a((const void*)(gbase), (voff)[_i], ldsbase + (unsigned)(bufoff) + ldsw + (unsigned)_i * 8192u); } while (0)
#define PG8_LDA(dst, b, h) do { _Pragma("unroll") for (int m = 0; m < 4; ++m) _Pragma("unroll") for (int k = 0; k < 2; ++k) dst[m][k] = *(const LDS_AS bf16x8*)(lds + PG8_SA(b, h) + aoff + m * 2048 + k * 1024); } while (0)
#define PG8_LDB(dst, b, h) do { _Pragma("unroll") for (int n = 0; n < 2; ++n) _Pragma("unroll") for (int k = 0; k < 2; ++k) dst[n][k] = *(const LDS_AS bf16x8*)(lds + PG8_SB(b, h) + boff + n * 2048 + k * 1024); } while (0)
#define PG8_MMA(ai, bj, At, Bt) do { __builtin_amdgcn_s_setprio(1); _Pragma("unroll") for (int m = 0; m < 4; ++m) _Pragma("unroll") for (int n = 0; n < 2; ++n) _Pragma("unroll") for (int k = 0; k < 2; ++k) \
        acc[ai][bj][m][n] = __builtin_amdgcn_mfma_f32_16x16x32_bf16(Bt[n][k], At[m][k], acc[ai][bj][m][n], 0, 0, 0); __builtin_amdgcn_s_setprio(0); } while (0)
#define PG8_WAIT_V(n) asm volatile("s_waitcnt vmcnt(" #n ")" ::: "memory")
#define PG8_WAIT_L(n) asm volatile("s_waitcnt lgkmcnt(" #n ")" ::: "memory")
#define PG8_BAR __builtin_amdgcn_s_barrier()
#define PG8_SCHED __builtin_amdgcn_sched_barrier(0)
    Unit cur, nxt; int ui = 0;
    if (!S.next(0, cur)) return;
    f32x4 acc[2][2][4][2];
#pragma unroll
    for (int a = 0; a < 2; ++a)
#pragma unroll
        for (int b = 0; b < 2; ++b)
#pragma unroll
            for (int m = 0; m < 4; ++m)
#pragma unroll
                for (int n = 0; n < 2; ++n) acc[a][b][m][n] = (f32x4){0.f, 0.f, 0.f, 0.f};
    bf16x8 At[4][2], B0[2][2], B1[2][2];
    const char* cA = (const char*)g.A + (size_t)cur.pm * tstep; const char* cB = (const char*)g.Bt + (size_t)cur.pn * tstep;
    S.a_ready(cur);
    PG8_STAGE(PG8_SB(0, 0), cB, voffB); PG8_STAGE(PG8_SA(0, 0), cA, voffA); PG8_STAGE(PG8_SB(0, 1), cB + hstep, voffB); PG8_STAGE(PG8_SA(0, 1), cA + hstep, voffA);
    if (wr == 1) PG8_BAR;
    PG8_WAIT_V(4); PG8_BAR;
    PG8_STAGE(PG8_SB(1, 0), cB + kstep, voffB); PG8_STAGE(PG8_SA(1, 0), cA + kstep, voffA); PG8_STAGE(PG8_SB(1, 1), cB + hstep + kstep, voffB);
    PG8_WAIT_V(6); PG8_BAR;
    PG8_STAMP();
    for (;;) {
        const bool has_next = S.next(ui + 1, nxt);
        const char* nA = has_next ? (const char*)g.A + (size_t)nxt.pm * tstep : cA; const char* nB = has_next ? (const char*)g.Bt + (size_t)nxt.pn * tstep : cB;
        for (int t = 0; t < nt; t += 2) {
            const bool last = (t == nt - 2);
            const char* a1 = cA + (size_t)(t + 1) * kstep;
            const char* a2 = last ? nA : cA + (size_t)(t + 2) * kstep; const char* b2 = last ? nB : cB + (size_t)(t + 2) * kstep;
            const char* a3 = a2 + kstep; const char* b3 = b2 + kstep;
            if (last && has_next) S.a_ready(nxt);
            PG8_LDB(B0, 0, 0); PG8_SCHED; PG8_LDA(At, 0, 0); PG8_STAGE(PG8_SA(1, 1), a1 + hstep, voffA);
            PG8_WAIT_L(8); PG8_BAR; PG8_WAIT_L(0); PG8_MMA(0, 0, At, B0); PG8_BAR; PG8_SCHED;
            PG8_LDB(B1, 0, 1); PG8_STAGE(PG8_SB(0, 0), b2, voffB);
            PG8_BAR; PG8_WAIT_L(0); PG8_MMA(0, 1, At, B1); PG8_BAR;
            PG8_LDA(At, 0, 1); PG8_STAGE(PG8_SA(0, 0), a2, voffA);
            PG8_BAR; PG8_WAIT_L(0); PG8_MMA(1, 0, At, B0); PG8_BAR; PG8_SCHED;
            PG8_STAGE(PG8_SB(0, 1), b2 + hstep, voffB);
            PG8_WAIT_V(6); PG8_BAR; PG8_MMA(1, 1, At, B1); PG8_BAR;
            PG8_LDB(B0, 1, 0); PG8_SCHED; PG8_LDA(At, 1, 0); PG8_STAGE(PG8_SA(0, 1), a2 + hstep, voffA);
            PG8_WAIT_L(8); PG8_BAR; PG8_WAIT_L(0); PG8_MMA(0, 0, At, B0); PG8_BAR; PG8_SCHED;
            PG8_LDB(B1, 1, 1); PG8_STAGE(PG8_SB(1, 0), b3, voffB);
            PG8_BAR; PG8_WAIT_L(0); PG8_MMA(0, 1, At, B1); PG8_BAR;
            PG8_LDA(At, 1, 1); PG8_STAGE(PG8_SA(1, 0), a3, voffA);
            PG8_BAR; PG8_WAIT_L(0); PG8_MMA(1, 0, At, B0); PG8_BAR; PG8_SCHED;
            PG8_STAGE(PG8_SB(1, 1), b3 + hstep, voffB);
            PG8_WAIT_V(6); PG8_BAR; PG8_MMA(1, 1, At, B1); PG8_BAR;
        }
        PG8_STAMP();
        if constexpr (!Epi::AFTER_DRAIN) { E(acc, cur, wr, wc, fr, fq); S.done(cur); }
        PG8_STAMP();
        if (!has_next) break;
#pragma unroll
        for (int a = 0; a < 2; ++a)
#pragma unroll
            for (int b = 0; b < 2; ++b)
#pragma unroll
                for (int m = 0; m < 4; ++m)
#pragma unroll
                    for (int n = 0; n < 2; ++n) acc[a][b][m][n] = (f32x4){0.f, 0.f, 0.f, 0.f};
        cur = nxt; cA = nA; cB = nB; ++ui;
    }
    PG8_WAIT_V(0);
    if (wr == 0) PG8_BAR;
    PG8_BAR;
    if constexpr (Epi::AFTER_DRAIN) { E.fused(acc, cur, wr, wc, fr, fq, lds, wid, lane); S.done(cur); }
    PG8_STAMP();
    if (STAMP && wid == 0) { stamps[lane] = lane < nts ? (((unsigned long long)(unsigned)ts_hi << 32) | (unsigned)ts_lo) : 0ull;
        if (lane == 62) stamps[62] = rt_entry; if (lane == 63) stamps[63] = 0ull; }
#undef PG8_STAMP
#undef PG8_SA
#undef PG8_SB
#undef PG8_STAGE
#undef PG8_LDA
#undef PG8_LDB
#undef PG8_MMA
#undef PG8_WAIT_V
#undef PG8_WAIT_L
#undef PG8_BAR
#undef PG8_SCHED
}
}

DI void phase_gemm_in(const Params& p, int l, LDS_AS unsigned char* smem, int dry) {
  pg8::Gemm g; g.A = p.H; g.Bt = p.WB + (size_t)l * W_LAYER + W_IN; g.M = T; g.N = 2816; g.K = 1024;
  pg8::StaticOrder S; S.init(g.M, g.N, gridDim.x, blockIdx.x);
  pg8::EpiBf16<0> E; E.O = p.PROJ; E.ldc = PN; E.ncols = PN; E.dry = dry;
  __syncthreads();
  pg8::gemm_phase<pg8::EpiBf16<0>, pg8::StaticOrder, false>(smem, g, S, E, nullptr);
}
DI void phase_gemm_mla(const Params& p, int l, LDS_AS unsigned char* smem, int dry) {
  const bf16_t* WQ = p.WB + (size_t)l * W_LAYER + W_UQ; const bf16_t* WK = p.WB + (size_t)l * W_LAYER + W_UKV;
  const int NT = 7, ntiles = (T / 256) * NT;
  for (int i = blockIdx.x; i < ntiles; i += gridDim.x) {
    int mt, nt; tile_decode(xcd_remap(i, ntiles), NT, mt, nt);
    f32x16 acc[4][2]; zero_acc2(acc);
    if (nt < 3) {
      gemm_kloop2(p.PROJ + (size_t)mt * 256 * PN + C_QLAT, PN, WQ + (size_t)nt * 256 * 256, 256, 4, acc, smem);
      if (!dry) epi2_store_bf16<0>(acc, p.MQ, 768, mt * 256, nt * 256, 768, smem);
    } else {
      gemm_kloop2(p.PROJ + (size_t)mt * 256 * PN + C_KVLAT, PN, WK + (size_t)(nt - 3) * 256 * 128, 128, 2, acc, smem);
      if (!dry) epi2_store_bf16<0>(acc, p.KV, 1024, mt * 256, (nt - 3) * 256, 1024, smem);
    }
  }
}
DI void phase_merge(const Params& p, int l, LDS_AS unsigned char* smem, int dry) {
  const bf16_t* WL = p.WB + (size_t)l * W_LAYER;
  const int NT = 8, MT = (l == 1) ? TL / 256 : T / 256, ntiles = MT * NT;
  bf16_t* M = p.KV;
  for (int i = blockIdx.x; i < ntiles; i += gridDim.x) {
    int mt, nt; tile_decode(xcd_remap(i, ntiles), NT, mt, nt);
    unsigned tp[2][2][8];
#pragma unroll
    for (int a = 0; a < 2; ++a)
#pragma unroll
      for (int b = 0; b < 2; ++b)
#pragma unroll
        for (int e = 0; e < 8; ++e) tp[a][b][e] = 0u;
#pragma unroll 1
    for (int br = 0; br < 3; ++br) {
      unsigned gp[2][2][8];
      {
        f32x16 ag[2][2]; zero_acc(ag);
        gemm_kloop(p.H + (size_t)mt * 256 * 1024, 1024, 64, WL + W_IN + (size_t)(2816 + br * 1024 + nt * 128) * 1024, 1024, 16, ag, smem);
#pragma unroll
        for (int a = 0; a < 2; ++a)
#pragma unroll
          for (int b = 0; b < 2; ++b)
#pragma unroll
            for (int e = 0; e < 8; ++e)
              gp[a][b][e] = pk2(__builtin_amdgcn_rcpf(1.f + __builtin_amdgcn_exp2f(-LOG2E * ag[a][b][2 * e])),
                                __builtin_amdgcn_rcpf(1.f + __builtin_amdgcn_exp2f(-LOG2E * ag[a][b][2 * e + 1])));
      }
      f32x16 ay[2][2]; zero_acc(ay);
      const int lda = (br == 0) ? 768 : PN, kstep = (br == 0) ? 96 : 64;
      const size_t aofs = (br == 0) ? (size_t)T * PN : (size_t)(br == 1 ? C_SQ : C_DQ);
      __builtin_amdgcn_sched_barrier(0);
      gemm_kloop(p.PROJ + aofs + (size_t)mt * 256 * lda, lda, kstep, WL + W_UPM + (size_t)br * 1024 * 512 + (size_t)nt * 128 * 512, 512, 8, ay, smem);
#pragma unroll
      for (int a = 0; a < 2; ++a)
#pragma unroll
        for (int b = 0; b < 2; ++b)
#pragma unroll
          for (int e = 0; e < 8; ++e) {
            const float t0 = __uint_as_float(tp[a][b][e] << 16) + __uint_as_float(gp[a][b][e] << 16) * ay[a][b][2 * e];
            const float t1 = __uint_as_float(tp[a][b][e] & 0xffff0000u) + __uint_as_float(gp[a][b][e] & 0xffff0000u) * ay[a][b][2 * e + 1];
            tp[a][b][e] = pk2(t0, t1);
          }
    }
    if (!dry) {
      f32x16 tot[2][2];
#pragma unroll
      for (int a = 0; a < 2; ++a)
#pragma unroll
        for (int b = 0; b < 2; ++b)
#pragma unroll
          for (int e = 0; e < 8; ++e) { tot[a][b][2 * e] = __uint_as_float(tp[a][b][e] << 16); tot[a][b][2 * e + 1] = __uint_as_float(tp[a][b][e] & 0xffff0000u); }
      epi_store_bf16<0>(tot, M, 1024, mt * 256, nt * 128, 1024, smem);
    }
  }
}
DI void phase_residual_gemm(const Params& p, int l, int which, LDS_AS unsigned char* smem, int dry) {
  const bf16_t* WL = p.WB + (size_t)l * W_LAYER;
  const bf16_t* Abase = which == 0 ? (const bf16_t*)opq(p.KV) : (const bf16_t*)opq(p.PROJ);
  const int K = which == 0 ? 1024 : 4096;
  const bf16_t* W = WL + (which == 0 ? W_O : W_M2);
  const bool first = (which == 0 && l == 0);
  const float* px = opq(p.x); const float* pctx = opq(p.ctx); float* pout = opq(p.out); float* pcx = opq(p.CX);
  const float* slat = first ? px : (const float*)pout; const float* sctx = first ? pctx : (const float*)pcx;
  const float* gofs = p.modtab + (size_t)(l * 5) * 6144 + (which == 0 ? 2048 : 5120);
  {
    pg8::Gemm g; g.A = Abase; g.Bt = W; g.M = TL; g.N = 1024; g.K = K;
    pg8::StaticOrder S; S.init(g.M, g.N, gridDim.x, blockIdx.x);
    pg8::EpiResid E; E.xin = slat; E.xout = pout; E.gate = gofs; E.dry = dry;
    __syncthreads();
    pg8::gemm_phase<pg8::EpiResid, pg8::StaticOrder, false>(smem, g, S, E, nullptr);
  }
  if (l == 0) {
    const int i = (int)gridDim.x - 1 - (int)blockIdx.x;
    if (i < 32) {
      const int mt = TL / 256 + (i & 3), nt = i >> 2;
      f32x16 acc[2][2]; zero_acc(acc);
      gemm_kloop(Abase + (size_t)mt * 256 * K, K, 64, W + (size_t)nt * 128 * K, K, K / 64, acc, smem);
      if (!dry) epi_residual(acc, sctx, pcx, gofs + (size_t)4 * 6144, mt * 256 - TL, nt * 128, smem);
    }
  }
}
DI void phase_mlp_in(const Params& p, int l, LDS_AS unsigned char* smem, int dry) {
  pg8::Gemm g; g.A = p.H; g.Bt = p.WB + (size_t)l * W_LAYER + W_M1; g.M = (l == 1) ? TL : T; g.N = 4096; g.K = 1024;
  pg8::StaticOrder S; S.init(g.M, g.N, gridDim.x, blockIdx.x);
  pg8::EpiBf16<1> E; E.O = p.PROJ; E.ldc = 4096; E.ncols = 4096; E.dry = dry;
  __syncthreads();
  pg8::gemm_phase<pg8::EpiBf16<1>, pg8::StaticOrder, false>(smem, g, S, E, nullptr);
}

DI unsigned ld_u32(const bf16_t* p) { return *(const unsigned*)p; }
DI void unpack4(u32x2 raw, float (&v)[4]) {
  v[0] = __uint_as_float(raw[0] << 16); v[1] = __uint_as_float(raw[0] & 0xffff0000u); v[2] = __uint_as_float(raw[1] << 16); v[3] = __uint_as_float(raw[1] & 0xffff0000u);
}
DI void phase_prep_a(const Params& p, int l, int dry) {
  const int tid_ = tidx(), lane = tid_ & 63, wave = tid_ >> 6, vsel = lane >> 4, j16 = lane & 15;
  const f32x4 gsq = *(const f32x4*)(p.g_swa_q + l * 64 + 4 * j16), gsk = *(const f32x4*)(p.g_swa_k + l * 64 + 4 * j16);
  const f32x4 gdq = *(const f32x4*)(p.g_diff_q + l * 64 + 4 * j16), gdk = *(const f32x4*)(p.g_diff_k + l * 64 + 4 * j16);
  const f32x4 gql = *(const f32x4*)(p.g_q_lora + l * 256 + lane * 4);
  const f32x2 gkl = *(const f32x2*)(p.g_kv_lora + l * 128 + lane * 2);
  float freq[4];
#pragma unroll
  for (int jj = 0; jj < 4; ++jj) freq[jj] = __builtin_amdgcn_exp2f(-(float)(4 * (j16 & 3) + jj) * (13.287712379549449f / 16.f)) * 0.15915494309189535f;
  const float sgn = ((j16 >> 2) & 1) ? 1.f : -1.f;
  const int stride = gridDim.x * 8;
  for (int row0 = blockIdx.x * 8 + wave; row0 < T; row0 += 2 * stride) {
    u32x2 rq[2], rv[2][7]; unsigned rk[2];
#pragma unroll
    for (int t = 0; t < 2; ++t) {
      const int row = (row0 + t * stride < T) ? row0 + t * stride : row0;
      const bf16_t* base = p.PROJ + (size_t)row * PN;
      rq[t] = *(const u32x2*)(base + C_QLAT + lane * 4);
      rk[t] = ld_u32(base + C_KVLAT + lane * 2);
#pragma unroll
      for (int it = 0; it < 7; ++it) rv[t][it] = *(const u32x2*)(base + C_SQ + 64 * (4 * it + vsel) + 4 * j16);
    }
#pragma unroll
    for (int t = 0; t < 2; ++t) {
      const int row = row0 + t * stride;
      if (row >= T) break;
      bf16_t* base = p.PROJ + (size_t)row * PN;
      const bool islat = row < TL;
      float cs[4], sn[4];
      if (islat) {
        const int tt = row & 8191; const float pos = (float)((j16 >> 3) ? (tt & 63) : (tt >> 6));
#pragma unroll
        for (int jj = 0; jj < 4; ++jj) { const float rev = pos * freq[jj]; cs[jj] = __builtin_amdgcn_cosf(rev); sn[jj] = __builtin_amdgcn_sinf(rev); }
      } else {
#pragma unroll
        for (int jj = 0; jj < 4; ++jj) { cs[jj] = 1.f; sn[jj] = 0.f; }
      }
      {
        float v[4]; unpack4(rq[t], v);
        const float ss = wave_sum(v[0] * v[0] + v[1] * v[1] + v[2] * v[2] + v[3] * v[3]);
        const float rstd = rsqrtf(ss * (1.f / 256.f) + EPS);
        u32x2 w = {pk2(v[0] * rstd * gql[0], v[1] * rstd * gql[1]), pk2(v[2] * rstd * gql[2], v[3] * rstd * gql[3])};
        if (!dry) *(u32x2*)(base + C_QLAT + lane * 4) = w;
      }
      {
        const float v0 = __uint_as_float(rk[t] << 16), v1 = __uint_as_float(rk[t] & 0xffff0000u);
        const float ss = wave_sum(v0 * v0 + v1 * v1);
        const float rstd = rsqrtf(ss * (1.f / 128.f) + EPS);
        if (!dry) *(unsigned*)(base + C_KVLAT + lane * 2) = pk2(v0 * rstd * gkl[0], v1 * rstd * gkl[1]);
      }
#pragma unroll
      for (int it = 0; it < 7; ++it) {
        const f32x4 g = (it < 2) ? gsq : (it == 2 ? gsk : (it < 5 ? gdq : gdk));
        const float sc = (it < 2 || it == 3 || it == 4) ? 0.125f * LOG2E : 1.f;
        float v[4]; unpack4(rv[t][it], v);
        float ss = v[0] * v[0] + v[1] * v[1] + v[2] * v[2] + v[3] * v[3];
        ss += __shfl_xor(ss, 8); ss += __shfl_xor(ss, 4); ss += __shfl_xor(ss, 2); ss += __shfl_xor(ss, 1);
        const float rstd = rsqrtf(ss * (1.f / 64.f) + EPS);
        float y[4];
#pragma unroll
        for (int jj = 0; jj < 4; ++jj) {
          const float yy = v[jj] * rstd * g[jj];
          const float pr = __shfl_xor(yy, 4);
          y[jj] = (yy * cs[jj] + sgn * pr * sn[jj]) * sc;
        }
        u32x2 w = {pk2(y[0], y[1]), pk2(y[2], y[3])};
        if (!dry && (it != 2 || vsel < 2)) *(u32x2*)(base + C_SQ + 64 * (4 * it + vsel) + 4 * j16) = w;
      }
    }
  }
}
DI void phase_prep_c(const Params& p, int l, int dry) {
  const int tid_ = tidx(), lane = tid_ & 63, wave = tid_ >> 6, hd = lane >> 3, sub = lane & 7;
  f32x4 gq[3], gk[3];
#pragma unroll
  for (int i = 0; i < 3; ++i) { gq[i] = *(const f32x4*)(p.g_mla_q + l * 96 + 32 * i + 4 * sub); gk[i] = *(const f32x4*)(p.g_mla_k + l * 96 + 32 * i + 4 * sub); }
  float freq[4];
#pragma unroll
  for (int jj = 0; jj < 4; ++jj) freq[jj] = __builtin_amdgcn_exp2f(-(float)(4 * (sub & 1) + jj) * (13.287712379549449f / 8.f)) * 0.15915494309189535f;
  const float sgn = ((sub >> 1) & 1) ? 1.f : -1.f;
  const float qs = 0.10206207261596575f * LOG2E;
  const int stride = gridDim.x * 8;
  for (int row0 = blockIdx.x * 8 + wave; row0 < T; row0 += 2 * stride) {
    u32x2 rq[2][3], rkv[2][2], rpe[2];
#pragma unroll
    for (int t = 0; t < 2; ++t) {
      const int row = (row0 + t * stride < T) ? row0 + t * stride : row0;
#pragma unroll
      for (int i = 0; i < 3; ++i) rq[t][i] = *(const u32x2*)(p.MQ + (size_t)row * 768 + hd * 96 + 32 * i + 4 * sub);
#pragma unroll
      for (int i = 0; i < 2; ++i) rkv[t][i] = *(const u32x2*)(p.KV + (size_t)row * 1024 + hd * 128 + 32 * i + 4 * sub);
      rpe[t] = *(const u32x2*)(p.PROJ + (size_t)row * PN + C_KPE + 4 * sub);
    }
#pragma unroll
    for (int t = 0; t < 2; ++t) {
      const int row = row0 + t * stride;
      if (row >= T) break;
      const bool islat = row < TL;
      float cs[4], sn[4];
      if (islat) {
        const int tt = row & 8191; const float pos = (float)((sub >> 2) ? (tt & 63) : (tt >> 6));
#pragma unroll
        for (int jj = 0; jj < 4; ++jj) { const float rev = pos * freq[jj]; cs[jj] = __builtin_amdgcn_cosf(rev); sn[jj] = __builtin_amdgcn_sinf(rev); }
      } else {
#pragma unroll
        for (int jj = 0; jj < 4; ++jj) { cs[jj] = 1.f; sn[jj] = 0.f; }
      }
#pragma unroll
      for (int qk = 0; qk < 2; ++qk) {
        float v[3][4];
        if (qk == 0) { unpack4(rq[t][0], v[0]); unpack4(rq[t][1], v[1]); unpack4(rq[t][2], v[2]); }
        else { unpack4(rkv[t][0], v[0]); unpack4(rkv[t][1], v[1]); unpack4(rpe[t], v[2]); }
        float ss = 0.f;
#pragma unroll
        for (int i = 0; i < 3; ++i)
#pragma unroll
          for (int jj = 0; jj < 4; ++jj) ss += v[i][jj] * v[i][jj];
        ss += __shfl_xor(ss, 4); ss += __shfl_xor(ss, 2); ss += __shfl_xor(ss, 1);
        const float rstd = rsqrtf(ss * (1.f / 96.f) + EPS);
        const float osc = (qk == 0) ? qs : 1.f;
        u32x2 w[3];
#pragma unroll
        for (int i = 0; i < 3; ++i) {
          float y[4];
#pragma unroll
          for (int jj = 0; jj < 4; ++jj) {
            const float gg = (qk == 0) ? gq[i][jj] : gk[i][jj];
            float yy = v[i][jj] * rstd * gg;
            if (i == 2) { const float pr = __shfl_xor(yy, 2); yy = yy * cs[jj] + sgn * pr * sn[jj]; }
            y[jj] = yy * osc;
          }
          w[i][0] = pk2(y[0], y[1]); w[i][1] = pk2(y[2], y[3]);
        }
        bf16_t* dst = (qk == 0 ? p.MQ : p.KM) + (size_t)row * 768 + hd * 96 + 4 * sub;
        if (!dry) {
#pragma unroll
          for (int i = 0; i < 3; ++i) *(u32x2*)(dst + 32 * i) = w[i];
        }
      }
    }
  }
}

struct AttnArgs {
  const bf16_t* q; int qpitch;
  const bf16_t* k; int kpitch;
  const bf16_t* v; int vpitch;
  bf16_t* o; int opitch;
  int krow_ctx, krow_lat;
  int nct, lt0, lt1;
  int qrow0, qpos0;
  float mb, sinkterm;
  float lam, osc; const float* gsub;
  int dry;
  bf16_t* o0;
};

template <int QSTEPS> DI void load_q(const AttnArgs& a, int colofs, bf16x8 (&qf)[QSTEPS]) {
  const int tid_ = tidx(), lane = tid_ & 63, wave = tid_ >> 6, h = lane >> 5, l32 = lane & 31;
  const bf16_t* qr = a.q + (size_t)(a.qrow0 + wave * 32 + l32) * a.qpitch + 8 * h + colofs;
#pragma unroll
  for (int s = 0; s < QSTEPS; ++s) qf[s] = *(const bf16x8*)(qr + s * 16);
}
template <int NKA, bool KB, int DV, int EPI, bool WIN>
DI void attn_item(const AttnArgs& a, const bf16x8 (&qfr)[4 + (KB ? 2 : 0)], int kcolofs, LDS_AS unsigned char* smem) {
  const int tid_ = tidx(), lane = tid_ & 63, wave = tid_ >> 6, h = lane >> 5, l32 = lane & 31;
  constexpr int NMAP = 1;
  constexpr int QSTEPS = 4 + (KB ? 2 : 0);
  constexpr int NDB = DV / 32;
  constexpr int VP = DV * 2;
  constexpr int AST = 24576, NST = 4;
  constexpr int NLD = 1 + (KB ? 1 : 0) + (DV == 64 ? 1 : 2);
  const int ntile = a.nct + (a.lt1 - a.lt0);
  unsigned kaoff, kboff = 0, voff[DV == 64 ? 1 : 2];
  { const int r = wave * 8 + (lane >> 3), c = (lane & 7) ^ ((r >> 1) & 7); kaoff = (unsigned)(r * a.kpitch + c * 8) * 2u; }
  if (KB) { const int r = (wave & 3) * 16 + (lane >> 2), c = (lane & 3) ^ ((r >> 2) & 3); kboff = (unsigned)(r * a.kpitch + 64 + c * 8) * 2u; }
  if (DV == 64) {
    const int r = wave * 8 + (lane >> 3), c = (lane & 7) ^ (((r >> 1) & 1) << 2); voff[0] = (unsigned)(r * a.vpitch + c * 8) * 2u;
  } else {
#pragma unroll
    for (int j = 0; j < 2; ++j) { const int r = (j * 8 + wave) * 4 + (lane >> 4), c = (lane & 15) ^ ((r & 3) << 2); voff[j] = (unsigned)(r * a.vpitch + c * 8) * 2u; }
  }
  const unsigned ldst = (unsigned)__builtin_amdgcn_readfirstlane((int)(lds_u32(smem) + wave * 1024));
  const unsigned ldstb = (unsigned)__builtin_amdgcn_readfirstlane((int)(lds_u32(smem) + 16384 + (wave & 3) * 1024));
  auto issue = [&](int ti, int stg) {
    const int trow = (ti < a.nct) ? (a.krow_ctx + ti * 64) : (a.krow_lat + (a.lt0 + ti - a.nct) * 64);
    const char* kb = (const char*)(a.k + (size_t)trow * a.kpitch + kcolofs); const char* vb = (const char*)(a.v + (size_t)trow * a.vpitch);
    const unsigned d = ldst + stg * AST;
    glds16a(kb, kaoff, d);
    if (KB) glds16a(kb, kboff, ldstb + stg * AST);
#pragma unroll
    for (int j = 0; j < (DV == 64 ? 1 : 2); ++j) glds16a(vb, voff[j], d + 8192 + j * 8192);
  };
  const int kswzA = (lane >> 1) & 7, kswzB = (lane >> 2) & 3;
  const int krowA = l32 * 128, krowB = l32 * 64;
  int vbase[NDB];
  {
    const int l16 = lane & 15, qq = l16 >> 2, pp = l16 & 3, g16 = (lane >> 4) & 1;
#pragma unroll
    for (int db = 0; db < NDB; ++db) {
      const int cl = 2 * g16 + (pp >> 1);
      const int c = (DV == 64) ? (4 * (db ^ (qq >> 1)) + cl) : (4 * (db ^ qq) + cl);
      vbase[db] = (4 * h + qq) * VP + c * 16 + (pp & 1) * 8;
    }
  }
  f32x16 O[NMAP][NDB];
#pragma unroll
  for (int m = 0; m < NMAP; ++m)
#pragma unroll
    for (int db = 0; db < NDB; ++db)
#pragma unroll
      for (int i = 0; i < 16; ++i) O[m][db][i] = 0.f;
  float lsum[NMAP];
#pragma unroll
  for (int m = 0; m < NMAP; ++m) lsum[m] = 0.f;
  const float negmb = -a.mb;
  const int qpos = a.qpos0 + wave * 32 + l32;

#pragma unroll
  for (int s = 0; s < QSTEPS; ++s) asm volatile("" ::"v"(qfr[s]));
  asm volatile("s_waitcnt vmcnt(0)" ::: "memory");
  __syncthreads();
  issue(0, 0);
  if (ntile > 1) issue(1, 1);
  if (ntile > 2) issue(2, 2);
#pragma unroll 1
  for (int ti = 0; ti < ntile; ++ti) {
    const int rem = ntile - 1 - ti;
    if (rem >= 2) { if (NLD == 2) asm volatile("s_waitcnt vmcnt(4)" ::: "memory"); else asm volatile("s_waitcnt vmcnt(6)" ::: "memory"); }
    else if (rem == 1) { if (NLD == 2) asm volatile("s_waitcnt vmcnt(2)" ::: "memory"); else asm volatile("s_waitcnt vmcnt(3)" ::: "memory"); }
    else asm volatile("s_waitcnt vmcnt(0)" ::: "memory");
    __builtin_amdgcn_s_barrier();
    asm volatile("" ::: "memory");
    if (ti + 3 < ntile) issue(ti + 3, (ti + 3) & 3);
    __builtin_amdgcn_sched_barrier(0);
    LDS_AS unsigned char* st = smem + (ti & 3) * AST;
    LDS_AS unsigned char* sv = st + 8192;
    auto readK = [&](int kb, bf16x8 (&kf)[QSTEPS]) {
      LDS_AS unsigned char* ka = st + kb * 32 * 128 + krowA;
#pragma unroll
      for (int s = 0; s < 4; ++s) kf[s] = lds128(ka + (((2 * s + h) ^ kswzA) << 4));
      if (KB) {
        LDS_AS unsigned char* kbp = st + 16384 + kb * 32 * 64 + krowB;
#pragma unroll
        for (int s = 0; s < 2; ++s) kf[4 + s] = lds128(kbp + (((2 * s + h) ^ kswzB) << 4));
      }
    };
    auto readV = [&](int kb, bf16x8 (&vf)[2][NDB]) {
#pragma unroll
      for (int s = 0; s < 2; ++s)
#pragma unroll
        for (int db = 0; db < NDB; ++db) {
          const int rc = (kb * 32 + 16 * s) * VP;
          const s16x4 lo = __builtin_amdgcn_ds_read_tr16_b64_v4i16((LDS_AS s16x4*)(sv + vbase[db] + rc));
          const s16x4 hi = __builtin_amdgcn_ds_read_tr16_b64_v4i16((LDS_AS s16x4*)(sv + vbase[db] + rc + 8 * VP));
          vf[s][db] = __builtin_shufflevector(lo, hi, 0, 1, 2, 3, 4, 5, 6, 7);
        }
    };
    auto qk = [&](const bf16x8 (&kf)[QSTEPS], f32x16& S) {
#pragma unroll
      for (int i = 0; i < 16; ++i) S[i] = negmb;
#pragma unroll
      for (int s = 0; s < QSTEPS; ++s) S = MFMA32(kf[s], qfr[s], S);
    };
    auto softmax = [&](int kb, f32x16& S, bf16x8 (&pb)[2]) {
      if (WIN) {
        if (ti >= a.nct) {
          const int kp0 = (a.lt0 + ti - a.nct) * 64 + 4 * h - qpos + kb * 32;
#pragma unroll
          for (int i = 0; i < 16; ++i) {
            const int dlt = kp0 + (i & 3) + 8 * (i >> 2);
            if (dlt > 128 || dlt < -128) S[i] = -INFINITY;
          }
        }
      }
      float ls = 0.f;
#pragma unroll
      for (int i = 0; i < 16; ++i) { S[i] = __builtin_amdgcn_exp2f(S[i]); ls += S[i]; }
      lsum[0] += ls;
#pragma unroll
      for (int s = 0; s < 2; ++s) {
        u32x4 pw;
#pragma unroll
        for (int j = 0; j < 4; ++j) pw[j] = pk2(S[8 * s + 2 * j], S[8 * s + 2 * j + 1]);
        pb[s] = __builtin_bit_cast(bf16x8, pw);
      }
    };
    auto pv = [&](const bf16x8 (&vf)[2][NDB], const bf16x8 (&pb)[2]) {
#pragma unroll
      for (int s = 0; s < 2; ++s)
#pragma unroll
        for (int db = 0; db < NDB; ++db) O[0][db] = MFMA32(vf[s][db], pb[s], O[0][db]);
    };
    bool skip = false;
    if (WIN) {
      if (ti >= a.nct) {
        const int kp = (a.lt0 + ti - a.nct) * 64, r0 = a.qpos0 + __builtin_amdgcn_readfirstlane(wave) * 32;
        skip = (kp + 63 < r0 - 128) || (kp > r0 + 31 + 128);
      }
    }
    if (!skip) {
      bf16x8 kf0[QSTEPS], kf1[QSTEPS], vf0[2][NDB], vf1[2][NDB], p0[2], p1[2];
      f32x16 S0, S1;
      readK(0, kf0); readV(0, vf0);
      __builtin_amdgcn_sched_barrier(0);
      qk(kf0, S0);
      __builtin_amdgcn_sched_barrier(0);
      readK(1, kf1);
      __builtin_amdgcn_sched_barrier(0);
      qk(kf1, S1);
      __builtin_amdgcn_sched_barrier(0);
      softmax(0, S0, p0);
      __builtin_amdgcn_sched_barrier(0);
      pv(vf0, p0);
      __builtin_amdgcn_sched_barrier(0);
      readV(1, vf1);
      __builtin_amdgcn_sched_barrier(0);
      softmax(1, S1, p1);
      __builtin_amdgcn_sched_barrier(0);
      pv(vf1, p1);
      __builtin_amdgcn_sched_barrier(0);
    }
  }
  const float lt = lsum[0] + __shfl_xor(lsum[0], 32) + a.sinkterm;
  const float inv = 1.f / lt;
  bf16_t* orow = a.o + (size_t)(a.qrow0 + wave * 32 + l32) * a.opitch + 4 * h;
  if (a.dry) return;
  if (EPI == 0) {
#pragma unroll
    for (int db = 0; db < NDB; ++db)
#pragma unroll
      for (int g = 0; g < 4; ++g) {
        u32x2 w = {pk2(O[0][db][4 * g] * inv, O[0][db][4 * g + 1] * inv), pk2(O[0][db][4 * g + 2] * inv, O[0][db][4 * g + 3] * inv)};
        *(u32x2*)(orow + db * 32 + 8 * g) = w;
      }
  } else {
    const float c1 = inv * a.lam;
    float ss = 0.f;
#pragma unroll
    for (int db = 0; db < NDB; ++db)
#pragma unroll
      for (int g = 0; g < 4; ++g) {
        const u32x2 raw = *(const u32x2*)(a.o0 + (size_t)(a.qrow0 + wave * 32 + l32) * 512 + 4 * h + db * 32 + 8 * g);
        const float o0[4] = {__uint_as_float(raw[0] << 16), __uint_as_float(raw[0] & 0xffff0000u), __uint_as_float(raw[1] << 16), __uint_as_float(raw[1] & 0xffff0000u)};
#pragma unroll
        for (int j = 0; j < 4; ++j) { const float v = o0[j] - O[0][db][4 * g + j] * c1; O[0][db][4 * g + j] = v; ss += v * v; }
      }
    ss += __shfl_xor(ss, 32);
    const float rstd = rsqrtf(ss * (1.f / (float)DV) + EPS) * a.osc;
#pragma unroll
    for (int db = 0; db < NDB; ++db)
#pragma unroll
      for (int g = 0; g < 4; ++g) {
        const f32x4 gs = *(const f32x4*)(a.gsub + db * 32 + 8 * g + 4 * h);
        u32x2 w = {pk2(O[0][db][4 * g] * rstd * gs[0], O[0][db][4 * g + 1] * rstd * gs[1]), pk2(O[0][db][4 * g + 2] * rstd * gs[2], O[0][db][4 * g + 3] * rstd * gs[3])};
        *(u32x2*)(orow + db * 32 + 8 * g) = w;
      }
  }
}

DI void attn_diff_item(const AttnArgs& a, LDS_AS unsigned char* smem) {
  AttnArgs a0 = a; a0.o = a.o0; a0.opitch = 512; a0.dry = 0;
  { bf16x8 q0[4]; load_q<4>(a, 0, q0); attn_item<1, false, 128, 0, false>(a0, q0, 0, smem); }
  { bf16x8 q1[4]; load_q<4>(a, 64, q1); attn_item<1, false, 128, 1, false>(a, q1, 64, smem); }
}

DI void phase_attention(const Params& p, int l, LDS_AS unsigned char* smem, int dry) {
  const float* cs = p.consts + l * 16;
  const float lam = cs[0], lam_init = cs[1], mb_mla = cs[2], mb_swa = cs[3], mb_diff = cs[4];
  const int nc_d = (l == 0) ? 16 : 0, nc_m = (l == 0) ? 32 : 0;
#pragma unroll 1
  for (int i = blockIdx.x; i < 512 + nc_d; i += gridDim.x) {
    AttnArgs a; a.dry = dry;
    int b, hd;
    if (i < 512) {
      const int id = xcd_remap(i, 512), pair = id >> 5, qb = id & 31; b = pair >> 2; hd = pair & 3;
      a.lt0 = 0; a.lt1 = 128; a.qrow0 = b * 8192 + qb * 256;
    } else {
      const int j = i - 512; b = j >> 2; hd = j & 3;
      a.lt0 = 0; a.lt1 = 0; a.qrow0 = TL + b * 256;
    }
    a.q = p.PROJ + C_DQ + hd * 128; a.qpitch = PN; a.k = p.PROJ + C_DK + hd * 128; a.kpitch = PN; a.v = p.PROJ + C_DV + hd * 128; a.vpitch = PN;
    a.o = p.PROJ + C_DQ + hd * 128; a.opitch = PN; a.o0 = p.YD0 + hd * 128;
    a.krow_ctx = TL + b * 256; a.krow_lat = b * 8192; a.nct = 4; a.qpos0 = 0;
    a.mb = mb_diff; a.sinkterm = 0.f; a.lam = lam; a.osc = 1.f - lam_init; a.gsub = p.g_diff_sub + l * 128;
    attn_diff_item(a, smem);
  }
#pragma unroll 1
  for (int i = blockIdx.x; i < 1024 + nc_m; i += gridDim.x) {
    AttnArgs a; a.dry = dry;
    int b, hd;
    if (i < 1024) {
      const int id = xcd_remap(i, 1024), pair = id >> 5, qb = id & 31; b = pair >> 3; hd = pair & 7;
      a.lt0 = 0; a.lt1 = 128; a.qrow0 = b * 8192 + qb * 256;
    } else {
      const int j = i - 1024; b = j >> 3; hd = j & 7;
      a.lt0 = 0; a.lt1 = 0; a.qrow0 = TL + b * 256;
    }
    a.q = p.MQ + hd * 96; a.qpitch = 768; a.k = p.KM + hd * 96; a.kpitch = 768; a.v = p.KV + hd * 128 + 64; a.vpitch = 1024;
    a.o = p.MQ + hd * 96; a.opitch = 768; a.o0 = nullptr;
    a.krow_ctx = TL + b * 256; a.krow_lat = b * 8192; a.nct = 4; a.qpos0 = 0;
    a.mb = mb_mla; a.sinkterm = 0.f; a.lam = 0.f; a.osc = 0.f; a.gsub = nullptr;
    bf16x8 qf[6]; load_q<6>(a, 0, qf);
    attn_item<1, true, 64, 0, false>(a, qf, 0, smem);
  }
#pragma unroll 1
  for (int i = blockIdx.x; i < 1024 + nc_m; i += gridDim.x) {
    AttnArgs a; a.dry = dry;
    int b, hq;
    if (i < 1024) {
      const int id = xcd_remap(i, 1024), pair = id >> 5, qb = id & 31; b = pair >> 3; hq = pair & 7;
      a.lt0 = (4 * qb - 2 < 0) ? 0 : 4 * qb - 2; a.lt1 = (4 * qb + 6 > 128) ? 128 : 4 * qb + 6;
      a.qrow0 = b * 8192 + qb * 256; a.qpos0 = qb * 256;
    } else {
      const int j = i - 1024; b = j >> 3; hq = j & 7;
      a.lt0 = 0; a.lt1 = 0; a.qrow0 = TL + b * 256; a.qpos0 = 0;
    }
    const int kvh = hq >> 2;
    a.q = p.PROJ + C_SQ + hq * 64; a.qpitch = PN; a.k = p.PROJ + C_SK + kvh * 64; a.kpitch = PN; a.v = p.PROJ + C_SV + kvh * 64; a.vpitch = PN;
    a.o = p.PROJ + C_SQ + hq * 64; a.opitch = PN; a.o0 = nullptr;
    a.krow_ctx = TL + b * 256; a.krow_lat = b * 8192; a.nct = 4;
    a.mb = mb_swa; a.sinkterm = __builtin_amdgcn_exp2f(p.swa_sink[l * 8 + hq] * LOG2E - mb_swa); a.lam = 0.f; a.osc = 0.f; a.gsub = nullptr;
    bf16x8 qf[4]; load_q<4>(a, 0, qf);
    attn_item<1, false, 64, 0, true>(a, qf, 0, smem);
  }
}

constexpr int NPH = 1 + 2 * 11;
DI void run_phase(const Params& p, int ph, LDS_AS unsigned char* smem, int dry) {
#ifdef ONLY_S
  if (ONLY_S == 99) { if (ph == 0) phase0(p, smem, dry); return; }
  if (ph == 0) return;
  const int l = (ph - 1) / 11, s = ONLY_S;
#else
  if (ph == 0) { phase0(p, smem, dry); return; }
  const int l = (ph - 1) / 11, s = (ph - 1) % 11;
#endif
  switch (s) {
    case 0: norm_phase(p, l, 0, dry); break;
    case 1: phase_gemm_in(p, l, smem, dry); break;
    case 2: phase_prep_a(p, l, dry); break;
    case 3: phase_gemm_mla(p, l, smem, dry); break;
    case 4: phase_prep_c(p, l, dry); break;
    case 5: phase_attention(p, l, smem, dry); break;
    case 6: phase_merge(p, l, smem, dry); break;
    case 7: phase_residual_gemm(p, l, 0, smem, dry); break;
    case 8: norm_phase(p, l, 1, dry); break;
    case 9: phase_mlp_in(p, l, smem, dry); break;
    default: phase_residual_gemm(p, l, 1, smem, dry); break;
  }
}

__global__ void __launch_bounds__(512, 2) mega_kernel(Params p) {
  __shared__ __attribute__((aligned(16))) unsigned char smem_raw[3 * GST];
  LDS_AS unsigned char* smem = (LDS_AS unsigned char*)smem_raw;
  __shared__ uint4 xb_words;
  cg::grid_group grid = cg::this_grid();
  if (threadIdx.x == 0) xb_words = make_uint4(0u, 0u, 0u, 0u);
  __syncthreads();
  const XcdBarrier xb = xcd_barrier_post(p.bar, (volatile LDS_AS unsigned*)&xb_words);
#pragma unroll 1
  for (int ph = 0; ph < NPH; ++ph) {
    const int st = (ph == 0) ? 31 : (ph - 1) % 11;
    const int nrep = (((unsigned)p.probe >> st) & 1u) ? 2 : 1;
    for (int rep = 0; rep < nrep; ++rep) run_phase(p, ph, smem, rep + 1 < nrep);
    if (ph + 1 < NPH) { if (ph == 0) grid.sync(); else xcd_barrier(xb); }
  }
}
#ifdef MK_MULTI
__global__ void __launch_bounds__(512, 2) phase_kernel(Params p, int ph) {
  __shared__ __attribute__((aligned(16))) unsigned char smem_raw[3 * GST];
  run_phase(p, ph, (LDS_AS unsigned char*)smem_raw, 0);
}
#endif

extern "C" void kernel_launch(void* const* d_in, const int* in_sizes, int n_in, void* d_out, int out_size, void* d_ws, size_t ws_size,
                              hipStream_t stream) {
  Params p{};
  const float* const* in = (const float* const*)d_in;
  p.x = in[0]; p.c = in[1]; p.ctx = in[2]; p.c_ctx = in[3]; p.w_mod = in[4]; p.b_mod = in[5]; p.g_norm_attn = in[6]; p.g_norm_mlp = in[7];
  p.w_in = in[8]; p.g_q_lora = in[9]; p.w_uq = in[10]; p.g_kv_lora = in[11]; p.w_ukv = in[12]; p.g_mla_q = in[13]; p.g_mla_k = in[14];
  p.w_up_mla = in[15]; p.g_swa_q = in[16]; p.g_swa_k = in[17]; p.swa_sink = in[18]; p.w_up_swa = in[19]; p.g_diff_q = in[20]; p.g_diff_k = in[21];
  p.lambda_q1 = in[22]; p.lambda_k1 = in[23]; p.lambda_q2 = in[24]; p.lambda_k2 = in[25]; p.g_diff_sub = in[26]; p.w_up_diff = in[27];
  p.w_o = in[28]; p.w_mlp_in = in[29]; p.w_mlp_out = in[30];
#ifndef PROBE_MASK
#define PROBE_MASK 0
#endif
  p.probe = PROBE_MASK; p.pad_ = 0;
  p.out = (float*)d_out;
  unsigned char* ws = (unsigned char*)d_ws;
  size_t off = 0;
  auto take = [&](size_t bytes) { unsigned char* r = ws + off; off += (bytes + 255) & ~(size_t)255; return r; };
  p.modtab = (float*)take(2 * 5 * 6144 * 4);
  p.consts = (float*)take(256);
  p.bar = (unsigned*)take(XCD_BAR_WORDS * 4);
  p.WB = (bf16_t*)take(2 * W_LAYER * 2);
  p.H = (bf16_t*)take((size_t)T * 1024 * 2);
  p.PROJ = (bf16_t*)take((size_t)T * PN * 2);
  p.MQ = (bf16_t*)take((size_t)T * 768 * 2);
  p.KV = (bf16_t*)take((size_t)T * 1024 * 2);
  p.KM = (bf16_t*)take((size_t)T * 768 * 2);
  p.CX = (float*)take((size_t)TC * 1024 * 4);
  p.YD0 = (bf16_t*)take((size_t)T * 512 * 2);
  if (off > ws_size) { fprintf(stderr, "workspace too small: need %zu have %zu\n", off, ws_size); return; }
  (void)hipMemsetAsync(p.modtab, 0, (size_t)((unsigned char*)p.bar - (unsigned char*)p.modtab) + XCD_BAR_WORDS * 4, stream);
#ifdef MK_MULTI
  for (int ph = 0; ph < NPH; ++ph) phase_kernel<<<256, 512, 0, stream>>>(p, ph);
#else
  static int grid_blocks = 0;
  if (!grid_blocks) {
    int dev = 0, cus = 0, per_cu = 0;
    hipGetDevice(&dev);
    hipDeviceGetAttribute(&cus, hipDeviceAttributeMultiprocessorCount, dev);
    hipOccupancyMaxActiveBlocksPerMultiprocessor(&per_cu, mega_kernel, 512, 0);
    if (per_cu > 1) per_cu = 1;
    grid_blocks = cus * per_cu;
    if (grid_blocks <= 0) grid_blocks = 256;
  }
  void* args[] = {&p};
  hipError_t e = hipLaunchCooperativeKernel((void*)mega_kernel, dim3(grid_blocks), dim3(512), args, 0, stream);
  if (e != hipSuccess) fprintf(stderr, "cooperative launch failed: %s (grid %d)\n", hipGetErrorString(e), grid_blocks);
#endif
}
```

```cpp
#include <hip/hip_runtime.h>
#include <hip/hip_cooperative_groups.h>
#include <cstdio>
#include <cstdint>
namespace cg = cooperative_groups;

typedef unsigned short bf16_t;
typedef short bf16x8 __attribute__((ext_vector_type(8)));
typedef short s16x4 __attribute__((ext_vector_type(4)));
typedef float f32x16 __attribute__((ext_vector_type(16)));
typedef float f32x4 __attribute__((ext_vector_type(4)));
typedef float f32x2 __attribute__((ext_vector_type(2)));
typedef __bf16 bf16x2_t __attribute__((ext_vector_type(2)));
typedef unsigned u32x2 __attribute__((ext_vector_type(2)));
typedef unsigned u32x4 __attribute__((ext_vector_type(4)));
#define LDS_AS __attribute__((address_space(3)))
#define DI __device__ __forceinline__

constexpr int D = 1024, NB = 4, SEQ = 8192, NCTX = 256;
constexpr int TL = NB * SEQ;
constexpr int TC = NB * NCTX;
constexpr int T = TL + TC;
constexpr int PN = 2720;
constexpr int C_QLAT = 0, C_KVLAT = 256, C_KPE = 384, C_SQ = 416, C_SK = 928, C_SV = 1056, C_DQ = 1184, C_DK = 1696, C_DV = 2208;
constexpr float EPS = 1e-6f;
constexpr float LOG2E = 1.4426950408889634f;
constexpr size_t W_IN = 0;
constexpr size_t W_UQ = W_IN + (size_t)5888 * 1024;
constexpr size_t W_UKV = W_UQ + 768 * 256;
constexpr size_t W_UPM = W_UKV + 1024 * 128;
constexpr size_t W_UPS = W_UPM + 1024 * 512;
constexpr size_t W_UPD = W_UPS + 1024 * 512;
constexpr size_t W_O = W_UPD + 1024 * 512;
constexpr size_t W_M1 = W_O + 1024 * 1024;
constexpr size_t W_M2 = W_M1 + (size_t)4096 * 1024;
constexpr size_t W_LAYER = W_M2 + (size_t)4096 * 1024;

struct Params {
  const float *x, *c, *ctx, *c_ctx, *w_mod, *b_mod, *g_norm_attn, *g_norm_mlp, *w_in, *g_q_lora, *w_uq, *g_kv_lora, *w_ukv,
      *g_mla_q, *g_mla_k, *w_up_mla, *g_swa_q, *g_swa_k, *swa_sink, *w_up_swa, *g_diff_q, *g_diff_k, *lambda_q1, *lambda_k1,
      *lambda_q2, *lambda_k2, *g_diff_sub, *w_up_diff, *w_o, *w_mlp_in, *w_mlp_out;
  float* out;
  float* modtab;
  float* consts;
  unsigned* bar;
  bf16_t* WB;
  bf16_t* H;
  bf16_t* PROJ;
  bf16_t* MQ;
  bf16_t* KV;
  bf16_t* KM;
  float* CX;
  bf16_t* YD0;
  int probe, pad_;
};

template <class Tp> DI Tp* opq(Tp* ptr) { asm volatile("" : "+s"(ptr)); return ptr; }
DI int tidx() { int t = threadIdx.x; asm volatile("" : "+v"(t)); return t; }
DI float bf2f(bf16_t v) { return __uint_as_float((unsigned)v << 16); }
DI unsigned pk2(float a, float b) { f32x2 v = {a, b}; bf16x2_t r = __builtin_convertvector(v, bf16x2_t); return __builtin_bit_cast(unsigned, r); }
DI bf16_t f2bf(float a) { return (bf16_t)(pk2(a, 0.f) & 0xffffu); }
DI float wave_sum(float v) {
#pragma unroll
  for (int o = 32; o; o >>= 1) v += __shfl_xor(v, o);
  return v;
}
DI float wave_max(float v) {
#pragma unroll
  for (int o = 32; o; o >>= 1) v = fmaxf(v, __shfl_xor(v, o));
  return v;
}
DI float silu(float x) { return x / (1.f + __expf(-x)); }
DI int xcd_remap(int L, int n) {
  const int q = n >> 3, r = n & 7, xcd = L & 7, off = L >> 3;
  return (xcd < r ? xcd * (q + 1) : r * (q + 1) + (xcd - r) * q) + off;
}
DI void glds16(const void* g, LDS_AS unsigned char* l) {
  __builtin_amdgcn_global_load_lds((const unsigned*)g, (LDS_AS unsigned*)l, 16, 0, 0);
}
DI void glds16a(const void* base, unsigned voff, unsigned ldsaddr) {
  unsigned keep;
  asm volatile("s_mov_b32 %0, m0\n\ts_mov_b32 m0, %3\n\ts_nop 0\n\tglobal_load_lds_dwordx4 %1, %2\n\ts_mov_b32 m0, %0"
               : "=&s"(keep) : "v"(voff), "s"(base), "s"(ldsaddr) : "memory");
}
DI unsigned lds_u32(LDS_AS unsigned char* p) { return (unsigned)(uintptr_t)p; }
DI bf16x8 lds128(LDS_AS unsigned char* p) { return *(LDS_AS bf16x8*)p; }
#define MFMA32(a, b, c) __builtin_amdgcn_mfma_f32_32x32x16_bf16((a), (b), (c), 0, 0, 0)

#define XB_TMO      128
#define XB_XCNT(j)  (256  + 64 * (j))
#define XB_XSUB(j)  (1280 + 64 * (j))
#define XB_XGEN(j)  (2304 + 64 * (j))
#define XB_TOP      3328
#define XB_TOPGEN   3392
#define XCD_BAR_WORDS 3456
#define XB_SPIN_CAP (1u << 22)
DI unsigned xb_ld(unsigned* p) { return __hip_atomic_load(p, __ATOMIC_RELAXED, __HIP_MEMORY_SCOPE_AGENT); }
DI unsigned xb_add(unsigned* p, unsigned v) { return __hip_atomic_fetch_add(p, v, __ATOMIC_RELAXED, __HIP_MEMORY_SCOPE_AGENT); }
DI unsigned xb_xcc_id() { return (unsigned)__builtin_amdgcn_s_getreg((3 << 11) | 20) & 0xFu; }
#define XB_SPIN(cond, bar) do { unsigned _sp = 0; while (cond) { __builtin_amdgcn_s_sleep(1); \
    if ((++_sp & 255u) == 0u) { if (xb_ld(&(bar)[XB_TMO])) break; if (_sp > XB_SPIN_CAP) { atomicAdd(&(bar)[XB_TMO], 1u); break; } } } } while (0)
struct XcdBarrier { unsigned* bar; unsigned x; volatile LDS_AS unsigned* st; };
DI XcdBarrier xcd_barrier_post(unsigned* bar, volatile LDS_AS unsigned* st) {
  XcdBarrier b; b.bar = bar; b.x = xb_xcc_id(); b.st = st;
  if (threadIdx.x == 0) (void)xb_add(&bar[XB_XCNT(b.x)], 1u);
  return b;
}
DI void xcd_barrier_complete(unsigned* bar, unsigned x, unsigned& nloc, unsigned& nx) {
  const unsigned G = gridDim.x * gridDim.y * gridDim.z;
  unsigned sum, cnt, mine, sp = 0u;
  for (;;) {
    sum = 0u; cnt = 0u; mine = 0u;
#pragma unroll
    for (unsigned j = 0; j < 16; ++j) { const unsigned c = xb_ld(&bar[XB_XCNT(j)]); sum += c; cnt += (c > 0u) ? 1u : 0u; mine = (j == x) ? c : mine; }
    if (sum == G) break;
    __builtin_amdgcn_s_sleep(1);
    if ((++sp & 255u) == 0u) { if (xb_ld(&bar[XB_TMO])) break; if (sp > XB_SPIN_CAP) { atomicAdd(&bar[XB_TMO], 1u); break; } }
  }
  nloc = mine > 0u ? mine : 1u; nx = cnt > 0u ? cnt : 1u;
}
DI void xcd_barrier(const XcdBarrier& b) {
  asm volatile("s_waitcnt vmcnt(0)" ::: "memory");
  __syncthreads();
  if (threadIdx.x == 0) {
    unsigned* bar = b.bar;
    __builtin_amdgcn_s_waitcnt(0);
    unsigned nloc = b.st[0], nx = b.st[1];
    if (nloc == 0u) { xcd_barrier_complete(bar, b.x, nloc, nx); b.st[0] = nloc; b.st[1] = nx; }
    const unsigned old = xb_add(&bar[XB_XSUB(b.x)], 1u);
    const unsigned gen = old / nloc;
    if (old + 1u == (gen + 1u) * nloc) {
      __builtin_amdgcn_fence(__ATOMIC_RELEASE, "agent");
      asm volatile("s_waitcnt vmcnt(0)" ::: "memory");
      const unsigned og = xb_add(&bar[XB_TOP], 1u);
      const unsigned tg = og / nx;
      if (og + 1u == (tg + 1u) * nx) xb_add(&bar[XB_TOPGEN], 1u);
      else XB_SPIN(xb_ld(&bar[XB_TOPGEN]) == tg, bar);
      __builtin_amdgcn_fence(__ATOMIC_ACQUIRE, "agent");
      xb_add(&bar[XB_XGEN(b.x)], 1u);
      asm volatile("s_waitcnt vmcnt(0)" ::: "memory");
    } else {
      XB_SPIN(xb_ld(&bar[XB_XGEN(b.x)]) == gen, bar);
      __builtin_amdgcn_fence(__ATOMIC_ACQUIRE, "agent");
      asm volatile("s_waitcnt vmcnt(0)" ::: "memory");
    }
  }
  __syncthreads();
}

struct ConvT { const float* src; bf16_t* dst; int ld, K, k0, n0, is_win; };
DI void conv_load(const ConvT& d, int tid, f32x4 (&v)[2]) {
  const int ty = tid >> 4, tx = tid & 15, n = d.n0 + 4 * tx;
  int sc = n;
  if (d.is_win) sc = (n < 2720) ? n : (n < 2816 ? -1 : n - 96);
#pragma unroll
  for (int i = 0; i < 2; ++i) {
    v[i] = (f32x4){0.f, 0.f, 0.f, 0.f};
    if (sc >= 0) v[i] = *(const f32x4*)(d.src + (size_t)(d.k0 + ty + 32 * i) * d.ld + sc);
  }
}
DI void conv_finish(const ConvT& d, int tid, const f32x4 (&v)[2], LDS_AS float* tile, int dry) {
  const int ty = tid >> 4, tx = tid & 15;
#pragma unroll
  for (int i = 0; i < 2; ++i) {
    const int k = ty + 32 * i;
    tile[k * 65 + 4 * tx + 0] = v[i][0]; tile[k * 65 + 4 * tx + 1] = v[i][1]; tile[k * 65 + 4 * tx + 2] = v[i][2]; tile[k * 65 + 4 * tx + 3] = v[i][3];
  }
  __syncthreads();
  {
    const int r = tid >> 3, c = tid & 7;
    u32x4 w;
    w[0] = pk2(tile[(8 * c + 0) * 65 + r], tile[(8 * c + 1) * 65 + r]);
    w[1] = pk2(tile[(8 * c + 2) * 65 + r], tile[(8 * c + 3) * 65 + r]);
    w[2] = pk2(tile[(8 * c + 4) * 65 + r], tile[(8 * c + 5) * 65 + r]);
    w[3] = pk2(tile[(8 * c + 6) * 65 + r], tile[(8 * c + 7) * 65 + r]);
    if (!dry) *(u32x4*)(d.dst + (size_t)(d.n0 + r) * d.K + d.k0 + 8 * c) = w;
  }
}
DI ConvT conv_decode(const Params& p, int t) {
  ConvT d; d.is_win = 0;
  const int l = t / 4240; int u = t % 4240; size_t doff;
  if (u < 1472) { d.src = p.w_in + (size_t)l * 1024 * 5792; d.ld = 5792; d.K = 1024; d.is_win = 1; doff = W_IN; }
  else if (u < 1520) { u -= 1472; d.src = p.w_uq + (size_t)l * 256 * 768; d.ld = 768; d.K = 256; doff = W_UQ; }
  else if (u < 1552) { u -= 1520; d.src = p.w_ukv + (size_t)l * 128 * 1024; d.ld = 1024; d.K = 128; doff = W_UKV; }
  else if (u < 1680) { u -= 1552; d.src = p.w_up_mla + (size_t)l * 512 * 1024; d.ld = 1024; d.K = 512; doff = W_UPM; }
  else if (u < 1808) { u -= 1680; d.src = p.w_up_swa + (size_t)l * 512 * 1024; d.ld = 1024; d.K = 512; doff = W_UPS; }
  else if (u < 1936) { u -= 1808; d.src = p.w_up_diff + (size_t)l * 512 * 1024; d.ld = 1024; d.K = 512; doff = W_UPD; }
  else if (u < 2192) { u -= 1936; d.src = p.w_o + (size_t)l * 1024 * 1024; d.ld = 1024; d.K = 1024; doff = W_O; }
  else if (u < 3216) { u -= 2192; d.src = p.w_mlp_in + (size_t)l * 1024 * 4096; d.ld = 4096; d.K = 1024; doff = W_M1; }
  else { u -= 3216; d.src = p.w_mlp_out + (size_t)l * 4096 * 1024; d.ld = 1024; d.K = 4096; doff = W_M2; }
  const int nkt = d.K >> 6;
  d.k0 = (u % nkt) * 64; d.n0 = (u / nkt) * 64; d.dst = p.WB + (size_t)l * W_LAYER + doff;
  return d;
}

DI void phase0(const Params& p, LDS_AS unsigned char* smem, int dry) {
  const int tid_ = tidx(), lane = tid_ & 63, wave = tid_ >> 6;
  if (blockIdx.x == 0 && wave == 0) {
    for (int l = 0; l < 2; ++l) {
      const float s1 = wave_sum(p.lambda_q1[l * 64 + lane] * p.lambda_k1[l * 64 + lane]);
      const float s2 = wave_sum(p.lambda_q2[l * 64 + lane] * p.lambda_k2[l * 64 + lane]);
      const float lam_init = 0.8f - 0.6f * expf(-0.3f * (float)l);
      const float lam = expf(s1) - expf(s2) + lam_init;
      float a = fabsf(p.g_mla_q[l * 96 + lane]); if (lane < 32) a = fmaxf(a, fabsf(p.g_mla_q[l * 96 + 64 + lane]));
      float b = fabsf(p.g_mla_k[l * 96 + lane]); if (lane < 32) b = fmaxf(b, fabsf(p.g_mla_k[l * 96 + 64 + lane]));
      const float mq = wave_max(a), mk = wave_max(b);
      const float sq = wave_max(fabsf(p.g_swa_q[l * 64 + lane])), sk = wave_max(fabsf(p.g_swa_k[l * 64 + lane]));
      const float dq = wave_max(fabsf(p.g_diff_q[l * 64 + lane])), dk = wave_max(fabsf(p.g_diff_k[l * 64 + lane]));
      if (lane == 0) {
        float* cs = p.consts + l * 16;
        cs[0] = lam; cs[1] = lam_init;
        cs[2] = LOG2E * sqrtf(96.f) * mq * mk;
        cs[3] = LOG2E * 8.f * sq * sk;
        cs[4] = LOG2E * 8.f * dq * dk;
      }
    }
  }
  for (int task = blockIdx.x * 8 + wave; task < 3072; task += gridDim.x * 8) {
    const int l = task / 1536, rem = task % 1536, chunk = rem >> 4, ks = rem & 15;
    const int n = chunk * 64 + lane;
    float acc[5] = {0.f, 0.f, 0.f, 0.f, 0.f};
    const float* w = p.w_mod + ((size_t)l * 1024 + ks * 64) * 6144 + n;
    float sil[5];
#pragma unroll
    for (int r = 0; r < 4; ++r) sil[r] = silu(p.c[r * 1024 + ks * 64 + lane]);
    sil[4] = silu(p.c_ctx[ks * 64 + lane]);
#pragma unroll 16
    for (int k = 0; k < 64; ++k) {
      const float wv = w[(size_t)k * 6144];
#pragma unroll
      for (int r = 0; r < 5; ++r) acc[r] += __int_as_float(__builtin_amdgcn_readlane(__float_as_int(sil[r]), k)) * wv;
    }
    const float bias = (ks == 0) ? p.b_mod[l * 6144 + n] : 0.f;
    if (!dry)
#pragma unroll
      for (int r = 0; r < 5; ++r) atomicAdd(p.modtab + (size_t)(l * 5 + r) * 6144 + n, acc[r] + bias);
  }
  {
    constexpr int NTI = 4, TBUF = 64 * 65 + 16;
    LDS_AS float* tile0 = (LDS_AS float*)smem;
    const int tid = tidx(), G = gridDim.x, NTOT = 2 * 4240;
    for (int t = blockIdx.x; t < NTOT; t += NTI * G) {
      ConvT d[NTI]; f32x4 v[NTI][2];
#pragma unroll
      for (int q = 0; q < NTI; ++q) { d[q] = conv_decode(p, (t + q * G < NTOT) ? t + q * G : t); conv_load(d[q], tid, v[q]); }
      __syncthreads();
#pragma unroll
      for (int q = 0; q < NTI; ++q)
        if (t + q * G < NTOT) conv_finish(d[q], tid, v[q], tile0 + q * TBUF, dry);
    }
    __syncthreads();
  }
}

DI void norm_phase(const Params& p, int l, int which, int dry) {
  const int tid_ = tidx(), lane = tid_ & 63, wave = tid_ >> 6;
  const float* g = (which == 0 ? p.g_norm_attn : p.g_norm_mlp) + l * 1024;
  const int shoff = which == 0 ? 0 : 3072, scoff = shoff + 1024;
  const int nrows = (which == 1 && l == 1) ? TL : T;
  const bool first = (which == 0 && l == 0);
  const float* px = opq(p.x); const float* pctx = opq(p.ctx); const float* pout = opq((const float*)p.out); const float* pcx = opq((const float*)p.CX);
  const float* slat = first ? px : pout; const float* sctx = first ? pctx : pcx;
  for (int row = blockIdx.x * 8 + wave; row < nrows; row += gridDim.x * 8) {
    const float* xr; int bidx;
    if (row < TL) { xr = slat + (size_t)row * 1024; bidx = row >> 13; }
    else { xr = sctx + (size_t)(row - TL) * 1024; bidx = 4; }
    const float* mod = p.modtab + (size_t)(l * 5 + bidx) * 6144;
    f32x4 v[4]; float ss = 0.f;
#pragma unroll
    for (int i = 0; i < 4; ++i) { v[i] = *(const f32x4*)(xr + i * 256 + lane * 4); ss += v[i][0] * v[i][0] + v[i][1] * v[i][1] + v[i][2] * v[i][2] + v[i][3] * v[i][3]; }
    ss = wave_sum(ss);
    const float rstd = rsqrtf(ss * (1.f / 1024.f) + EPS);
#pragma unroll
    for (int i = 0; i < 4; ++i) {
      const int col = i * 256 + lane * 4;
      const f32x4 gv = *(const f32x4*)(g + col), sh = *(const f32x4*)(mod + shoff + col), sc = *(const f32x4*)(mod + scoff + col);
      float o[4];
#pragma unroll
      for (int j = 0; j < 4; ++j) o[j] = (v[i][j] * rstd * gv[j]) * (1.f + sc[j]) + sh[j];
      u32x2 w = {pk2(o[0], o[1]), pk2(o[2], o[3])};
      if (!dry) *(u32x2*)(p.H + (size_t)row * 1024 + col) = w;
    }
  }
}

constexpr int GST = 49152;
DI void gemm_kloop(const bf16_t* Ag, int lda, int a_kstep, const bf16_t* Bg, int ldb, int nkt, f32x16 (&acc)[2][2], LDS_AS unsigned char* smem) {
  const int tid_ = tidx(), lane = tid_ & 63, wave = tid_ >> 6, h = lane >> 5, wm = wave >> 1, wn = wave & 1;
  unsigned aoff[4], boff[2];
#pragma unroll
  for (int i = 0; i < 4; ++i) {
    const int r = wave * 32 + i * 8 + (lane >> 3), c = (lane & 7) ^ ((r >> 1) & 7);
    aoff[i] = (unsigned)(r * lda + c * 8) * 2u;
  }
#pragma unroll
  for (int i = 0; i < 2; ++i) {
    const int r = wave * 16 + i * 8 + (lane >> 3), c = (lane & 7) ^ ((r >> 1) & 7);
    boff[i] = (unsigned)(r * ldb + c * 8) * 2u;
  }
  const unsigned dstA = (unsigned)__builtin_amdgcn_readfirstlane((int)(lds_u32(smem) + wave * 4096));
  const unsigned dstB = (unsigned)__builtin_amdgcn_readfirstlane((int)(lds_u32(smem) + 32768 + wave * 2048));
  const int swz = (lane >> 1) & 7;
  const int arow = (wm * 64 + (lane & 31)) * 128, brow = 32768 + (wn * 64 + (lane & 31)) * 128;
  asm volatile("s_waitcnt vmcnt(0)" ::: "memory");
  __syncthreads();
  auto issue = [&](int kt, int stg) {
    const char* An = (const char*)(Ag + (size_t)kt * a_kstep); const char* Bn = (const char*)(Bg + (size_t)kt * 64);
#pragma unroll
    for (int i = 0; i < 4; ++i) glds16a(An, aoff[i], dstA + stg * GST + i * 1024);
#pragma unroll
    for (int i = 0; i < 2; ++i) glds16a(Bn, boff[i], dstB + stg * GST + i * 1024);
  };
  issue(0, 0);
  if (nkt > 1) issue(1, 1);
  int st = 0;
#pragma unroll 1
  for (int kt = 0; kt < nkt; ++kt) {
    if (kt + 1 < nkt) asm volatile("s_waitcnt vmcnt(6)" ::: "memory"); else asm volatile("s_waitcnt vmcnt(0)" ::: "memory");
    __builtin_amdgcn_s_barrier();
    asm volatile("" ::: "memory");
    if (kt + 2 < nkt) issue(kt + 2, st >= 1 ? st - 1 : 2);
    LDS_AS unsigned char* sa = smem + st * GST;
#pragma unroll
    for (int s = 0; s < 4; ++s) {
      const int co = ((2 * s + h) ^ swz) << 4;
      const bf16x8 a0 = lds128(sa + arow + co), a1 = lds128(sa + arow + 32 * 128 + co);
      const bf16x8 b0 = lds128(sa + brow + co), b1 = lds128(sa + brow + 32 * 128 + co);
      acc[0][0] = MFMA32(b0, a0, acc[0][0]); acc[0][1] = MFMA32(b1, a0, acc[0][1]);
      acc[1][0] = MFMA32(b0, a1, acc[1][0]); acc[1][1] = MFMA32(b1, a1, acc[1][1]);
    }
    st = (st == 2) ? 0 : st + 1;
  }
}
DI void zero_acc(f32x16 (&acc)[2][2]) {
#pragma unroll
  for (int a = 0; a < 2; ++a)
#pragma unroll
    for (int b = 0; b < 2; ++b)
#pragma unroll
      for (int i = 0; i < 16; ++i) acc[a][b][i] = 0.f;
}
DI void tile_decode(int id, int NT, int& mt, int& nt) { const int per = 4 * NT, g = id / per, w = id % per; mt = g * 4 + (w & 3); nt = w >> 2; }

constexpr int EPW = 17408;
template <int ACT> DI LDS_AS unsigned char* stage_tile(const f32x16 (&acc)[2][2], LDS_AS unsigned char* smem) {
  const int tid_ = tidx(), lane = tid_ & 63, wave = tid_ >> 6, h = lane >> 5;
  __syncthreads();
  LDS_AS unsigned char* reg = smem + wave * EPW;
#pragma unroll
  for (int bi = 0; bi < 2; ++bi)
#pragma unroll
    for (int bj = 0; bj < 2; ++bj)
#pragma unroll
      for (int g = 0; g < 4; ++g) {
        f32x4 v;
#pragma unroll
        for (int j = 0; j < 4; ++j) { v[j] = acc[bi][bj][4 * g + j]; if (ACT == 1) { v[j] = fmaxf(v[j], 0.f); v[j] *= v[j]; } }
        *(LDS_AS f32x4*)(reg + (bi * 32 + (lane & 31)) * 272 + (bj * 32 + 8 * g + 4 * h) * 4) = v;
      }
  return reg;
}
template <int ACT> DI void epi_store_bf16(const f32x16 (&acc)[2][2], bf16_t* dst, int ldc, int row0, int col0, int ncols, LDS_AS unsigned char* smem) {
  LDS_AS unsigned char* reg = stage_tile<ACT>(acc, smem);
  const int tid_ = tidx(), lane = tid_ & 63, wave = tid_ >> 6, wm = wave >> 1, wn = wave & 1;
  const int c = (lane & 7) * 8, col = col0 + wn * 64 + c;
#pragma unroll
  for (int i = 0; i < 8; ++i) {
    const int r = i * 8 + (lane >> 3);
    const f32x4 a = *(LDS_AS f32x4*)(reg + r * 272 + c * 4), b = *(LDS_AS f32x4*)(reg + r * 272 + c * 4 + 16);
    u32x4 w = {pk2(a[0], a[1]), pk2(a[2], a[3]), pk2(b[0], b[1]), pk2(b[2], b[3])};
    if (col < ncols) *(u32x4*)(dst + (size_t)(row0 + wm * 64 + r) * ldc + col) = w;
  }
}
DI void epi_residual(const f32x16 (&acc)[2][2], const float* xin, float* xout, const float* gate, int row0, int col0, LDS_AS unsigned char* smem) {
  LDS_AS unsigned char* reg = stage_tile<0>(acc, smem);
  const int tid_ = tidx(), lane = tid_ & 63, wave = tid_ >> 6, wm = wave >> 1, wn = wave & 1;
  const int c = (lane & 15) * 4, col = col0 + wn * 64 + c;
  const f32x4 gv = *(const f32x4*)(gate + col);
#pragma unroll
  for (int i = 0; i < 16; ++i) {
    const int r = i * 4 + (lane >> 4);
    const size_t off = (size_t)(row0 + wm * 64 + r) * 1024 + col;
    const f32x4 a = *(LDS_AS f32x4*)(reg + r * 272 + c * 4), xi = *(const f32x4*)(xin + off);
    f32x4 o;
#pragma unroll
    for (int j = 0; j < 4; ++j) o[j] = xi[j] + gv[j] * a[j];
    *(f32x4*)(xout + off) = o;
  }
}

constexpr int G2ST = 65536;
DI void gemm_kloop2(const bf16_t* Ag, int lda, const bf16_t* Bg, int ldb, int nkt  , f32x16 (&acc)[4][2], LDS_AS unsigned char* smem) {
  const int tid_ = tidx(), lane = tid_ & 63, wave = tid_ >> 6, h = lane >> 5, wm = wave >> 2, wn = wave & 3;
  unsigned aoff[4], boff[4];
#pragma unroll
  for (int i = 0; i < 4; ++i) {
    const int r = wave * 32 + i * 8 + (lane >> 3), c = (lane & 7) ^ ((r >> 1) & 7);
    aoff[i] = (unsigned)(r * lda + c * 8) * 2u; boff[i] = (unsigned)(r * ldb + c * 8) * 2u;
  }
  const unsigned dstA = (unsigned)__builtin_amdgcn_readfirstlane((int)(lds_u32(smem) + wave * 4096));
  const unsigned dstB = dstA + 32768;
  const int swz = (lane >> 1) & 7;
  const int arow = (wm * 128 + (lane & 31)) * 128, brow = 32768 + (wn * 64 + (lane & 31)) * 128;
  asm volatile("s_waitcnt vmcnt(0)" ::: "memory");
  __syncthreads();
  auto issue = [&](int kt, int stg) {
    const char* An = (const char*)(Ag + (size_t)kt * 64); const char* Bn = (const char*)(Bg + (size_t)kt * 64);
#pragma unroll
    for (int i = 0; i < 4; ++i) glds16a(An, aoff[i], dstA + stg * G2ST + i * 1024);
#pragma unroll
    for (int i = 0; i < 4; ++i) glds16a(Bn, boff[i], dstB + stg * G2ST + i * 1024);
  };
  issue(0, 0);
#pragma unroll 1
  for (int kt = 0; kt < nkt; ++kt) {
    asm volatile("s_waitcnt vmcnt(0)" ::: "memory");
    __builtin_amdgcn_s_barrier();
    asm volatile("" ::: "memory");
    if (kt + 1 < nkt) issue(kt + 1, (kt + 1) & 1);
    LDS_AS unsigned char* sa = smem + (kt & 1) * G2ST;
#pragma unroll
    for (int s = 0; s < 4; ++s) {
      const int co = ((2 * s + h) ^ swz) << 4;
      bf16x8 fa[4], fb[2];
#pragma unroll
      for (int bi = 0; bi < 4; ++bi) fa[bi] = lds128(sa + arow + bi * 32 * 128 + co);
#pragma unroll
      for (int bj = 0; bj < 2; ++bj) fb[bj] = lds128(sa + brow + bj * 32 * 128 + co);
#pragma unroll
      for (int bi = 0; bi < 4; ++bi)
#pragma unroll
        for (int bj = 0; bj < 2; ++bj) acc[bi][bj] = MFMA32(fb[bj], fa[bi], acc[bi][bj]);
    }
  }
}
DI void zero_acc2(f32x16 (&acc)[4][2]) {
#pragma unroll
  for (int a = 0; a < 4; ++a)
#pragma unroll
    for (int b = 0; b < 2; ++b)
#pragma unroll
      for (int i = 0; i < 16; ++i) acc[a][b][i] = 0.f;
}
template <int ACT, int HF> DI void stage_half(const f32x16 (&acc)[4][2], LDS_AS unsigned char* reg, int lane, int h) {
#pragma unroll
  for (int bi = 0; bi < 2; ++bi)
#pragma unroll
    for (int bj = 0; bj < 2; ++bj)
#pragma unroll
      for (int g = 0; g < 4; ++g) {
        f32x4 v;
#pragma unroll
        for (int j = 0; j < 4; ++j) { v[j] = acc[2 * HF + bi][bj][4 * g + j]; if (ACT == 1) { v[j] = fmaxf(v[j], 0.f); v[j] *= v[j]; } }
        *(LDS_AS f32x4*)(reg + (bi * 32 + (lane & 31)) * 272 + (bj * 32 + 8 * g + 4 * h) * 4) = v;
      }
}
template <int ACT, int HF> DI void epi2_half_bf16(const f32x16 (&acc)[4][2], bf16_t* dst, int ldc, int row0, int col0, int ncols, LDS_AS unsigned char* smem) {
  const int tid_ = tidx(), lane = tid_ & 63, wave = tid_ >> 6, h = lane >> 5, wm = wave >> 2, wn = wave & 3;
  LDS_AS unsigned char* reg = smem + wave * EPW;
  stage_half<ACT, HF>(acc, reg, lane, h);
  const int c = (lane & 7) * 8, col = col0 + wn * 64 + c;
#pragma unroll
  for (int i = 0; i < 8; ++i) {
    const int r = i * 8 + (lane >> 3);
    const f32x4 a = *(LDS_AS f32x4*)(reg + r * 272 + c * 4), b = *(LDS_AS f32x4*)(reg + r * 272 + c * 4 + 16);
    u32x4 w = {pk2(a[0], a[1]), pk2(a[2], a[3]), pk2(b[0], b[1]), pk2(b[2], b[3])};
    if (col < ncols) *(u32x4*)(dst + (size_t)(row0 + wm * 128 + HF * 64 + r) * ldc + col) = w;
  }
}
template <int ACT> DI void epi2_store_bf16(const f32x16 (&acc)[4][2], bf16_t* dst, int ldc, int row0, int col0, int ncols, LDS_AS unsigned char* smem) {
  __syncthreads();
  epi2_half_bf16<ACT, 0>(acc, dst, ldc, row0, col0, ncols, smem);
  epi2_half_bf16<ACT, 1>(acc, dst, ldc, row0, col0, ncols, smem);
}
template <int HF> DI void epi2_half_residual(const f32x16 (&acc)[4][2], const float* xin, float* xout, const float* gate, int row0, int col0, LDS_AS unsigned char* smem) {
  const int tid_ = tidx(), lane = tid_ & 63, wave = tid_ >> 6, h = lane >> 5, wm = wave >> 2, wn = wave & 3;
  LDS_AS unsigned char* reg = smem + wave * EPW;
  stage_half<0, HF>(acc, reg, lane, h);
  const int c = (lane & 15) * 4, col = col0 + wn * 64 + c;
  const f32x4 gv = *(const f32x4*)(gate + col);
#pragma unroll
  for (int i = 0; i < 16; ++i) {
    const int r = i * 4 + (lane >> 4);
    const size_t off = (size_t)(row0 + wm * 128 + HF * 64 + r) * 1024 + col;
    const f32x4 a = *(LDS_AS f32x4*)(reg + r * 272 + c * 4), xi = *(const f32x4*)(xin + off);
    f32x4 o;
#pragma unroll
    for (int j = 0; j < 4; ++j) o[j] = xi[j] + gv[j] * a[j];
    *(f32x4*)(xout + off) = o;
  }
}
DI void epi2_residual(const f32x16 (&acc)[4][2], const float* xin, float* xout, const float* gate, int row0, int col0, LDS_AS unsigned char* smem) {
  __syncthreads();
  epi2_half_residual<0>(acc, xin, xout, gate, row0, col0, smem);
  epi2_half_residual<1>(acc, xin, xout, gate, row0, col0, smem);
}

namespace pg8 {
typedef float f32x2v __attribute__((ext_vector_type(2)));
constexpr int BM = 256, BK = 64, HALF = 128, HTB = HALF * BK * 2, STAGE_BYTES = 8 * HTB, NXCD = 8, WGM = 8;
DI int lds_byte(int r, int c) { const int st = (r >> 4) * 2 + (c >> 5), rr = r & 15, cc = c & 31, ob = rr * 64 + cc * 2; return st * 1024 + (ob ^ (((ob >> 9) & 1) << 5)); }
DI void stage_rc(int b, int& R, int& C) { const int st = b / 1024, sb = b % 1024, swz = sb ^ (((sb >> 9) & 1) << 5); R = (st >> 1) * 16 + swz / 64; C = (st & 1) * 32 + (swz % 64) / 2; }
DI int perm32(int rho) { const int n = rho >> 4, i = rho & 15; return 8 * (i >> 2) + 4 * n + (i & 3); }
struct Unit { int pm, pn; };
struct Gemm { const bf16_t* A; const bf16_t* Bt; int M, N, K; };
struct StaticOrder {
    int nM, nN, nwg, G, c;
    DI void init(int M, int N, int G_, int c_) { nM = M / BM; nN = N / BM; nwg = nM * nN; G = G_; c = c_; }
    DI bool next(int i, Unit& u) const {
        const long L = (long)i * G + c; if (L >= nwg) return false;
        int wgid = (int)L; { const int q = nwg / NXCD, r = nwg % NXCD, xcd = wgid % NXCD, off = wgid / NXCD; wgid = (xcd < r ? xcd * (q + 1) : r * (q + 1) + (xcd - r) * q) + off; }
        const int nig = WGM * nN, gid = wgid / nig, fm = gid * WGM, gsz = (nM - fm) < WGM ? (nM - fm) : WGM;
        u.pm = fm + ((wgid % nig) % gsz); u.pn = (wgid % nig) / gsz; return true;
    }
    DI void a_ready(const Unit&) const {}
    DI void done(const Unit&) const {}
};
template <int ACT  > struct EpiBf16 {
    static constexpr bool PERM = true, AFTER_DRAIN = false;
    bf16_t* O; int ldc, ncols, dry;
    DI void operator()(const f32x4 (&acc)[2][2][4][2], const Unit& u, int wr, int wc, int fr, int fq) const {
        if (dry) return;
        const int row0 = u.pm * BM + wr * 64 + fr, col0 = u.pn * BM + wc * 32 + 8 * fq;
#pragma unroll
        for (int ai = 0; ai < 2; ++ai)
#pragma unroll
            for (int m = 0; m < 4; ++m) { bf16_t* rowp = O + (size_t)(row0 + ai * HALF + m * 16) * ldc + col0;
#pragma unroll
                for (int bj = 0; bj < 2; ++bj) { f32x4 v0 = acc[ai][bj][m][0], v1 = acc[ai][bj][m][1];
                    if (ACT == 1) {
#pragma unroll
                        for (int j = 0; j < 4; ++j) { v0[j] = fmaxf(v0[j], 0.f); v0[j] *= v0[j]; v1[j] = fmaxf(v1[j], 0.f); v1[j] *= v1[j]; } }
                    u32x4 w = {pk2(v0[0], v0[1]), pk2(v0[2], v0[3]), pk2(v1[0], v1[1]), pk2(v1[2], v1[3])};
                    if (col0 + bj * HALF < ncols) *(u32x4*)(rowp + bj * HALF) = w; } }
    }
};
struct EpiResid {
    static constexpr bool PERM = false, AFTER_DRAIN = false;
    const float* xin; float* xout; const float* gate; int dry;
    DI void operator()(const f32x4 (&acc)[2][2][4][2], const Unit& u, int wr, int wc, int fr, int fq) const {
        if (dry) return;
        const int row0 = u.pm * BM + wr * 64 + fr, col0 = u.pn * BM + wc * 32 + 4 * fq;
        const float* gv = gate + (size_t)((u.pm * BM) >> 13) * 6144 + col0;
        f32x4 g[2][2];
#pragma unroll
        for (int bj = 0; bj < 2; ++bj)
#pragma unroll
            for (int n = 0; n < 2; ++n) g[bj][n] = *(const f32x4*)(gv + bj * HALF + n * 16);
#pragma unroll
        for (int ai = 0; ai < 2; ++ai)
#pragma unroll
            for (int m = 0; m < 4; ++m) { const size_t off = (size_t)(row0 + ai * HALF + m * 16) * 1024 + col0;
#pragma unroll
                for (int bj = 0; bj < 2; ++bj)
#pragma unroll
                    for (int n = 0; n < 2; ++n) { const f32x4 xi = *(const f32x4*)(xin + off + bj * HALF + n * 16);
                        *(f32x4*)(xout + off + bj * HALF + n * 16) = xi + g[bj][n] * acc[ai][bj][m][n]; } }
    }
};
template <class Epi, class Sched, bool STAMP = false>
__device__ __forceinline__ void gemm_phase(LDS_AS unsigned char* lds, const Gemm g, const Sched& S, const Epi& E, unsigned long long* stamps) {
    const int tid = tidx(), wid = __builtin_amdgcn_readfirstlane(tid >> 6), lane = tid & 63, wr = wid >> 2, wc = wid & 3, fr = lane & 15, fq = lane >> 4;
    const int K = g.K, nt = K / BK;
    int ts_lo = 0, ts_hi = 0, nts = 0; const unsigned long long rt_entry = STAMP ? 0ull : 0ull;
#define PG8_STAMP() do { if (STAMP && wid == 0 && nts < 64) { const unsigned long long _c = (unsigned long long)clock64(); \
        ts_lo = (lane == nts) ? (int)(unsigned)_c : ts_lo; ts_hi = (lane == nts) ? (int)(unsigned)(_c >> 32) : ts_hi; ++nts; } } while (0)
    PG8_STAMP();
    unsigned voffA[2], voffB[2];
#pragma unroll
    for (int i = 0; i < 2; ++i) { int R, C; stage_rc(tid * 16 + i * 8192, R, C); const int Rb = Epi::PERM ? ((R & ~31) + perm32(R & 31)) : R;
        voffA[i] = (unsigned)(R * K + C) * 2u; voffB[i] = (unsigned)(Rb * K + C) * 2u; }
    const size_t kstep = (size_t)(BK * 2);
    const size_t hstep = (size_t)HALF * K * 2;
    const size_t tstep = 2 * hstep;
    const unsigned ldsw = (unsigned)wid * 1024u; const unsigned ldsbase = (unsigned)__builtin_amdgcn_readfirstlane((int)lds_u32(lds));
    const int aoff = lds_byte(wr * 64 + fr, fq * 8), boff = lds_byte(wc * 32 + fr, fq * 8);
#define PG8_SA(b, h) (((b) * 2 + (h)) * HTB)
#define PG8_SB(b, h) ((4 + (b) * 2 + (h)) * HTB)
#define PG8_STAGE(bufoff, gbase, voff) do { _Pragma("unroll") for (int _i = 0; _i < 2; ++_i) \
        glds16a((const void*)(gbase), (voff)[_i], ldsbase + (unsigned)(bufoff) + ldsw + (unsigned)_i * 8192u); } while (0)
#define PG8_LDA(dst, b, h) do { _Pragma("unroll") for (int m = 0; m < 4; ++m) _Pragma("unroll") for (int k = 0; k < 2; ++k) dst[m][k] = *(const LDS_AS bf16x8*)(lds + PG8_SA(b, h) + aoff + m * 2048 + k * 1024); } while (0)
#define PG8_LDB(dst, b, h) do { _Pragma("unroll") for (int n = 0; n < 2; ++n) _Pragma("unroll") for (int k = 0; k < 2; ++k) dst[n][k] = *(const LDS_AS bf16x8*)(lds + PG8_SB(b, h) + boff + n * 2048 + k * 1024); } while (0)
#define PG8_MMA(ai, bj, At, Bt) do { __builtin_amdgcn_s_setprio(1); _Pragma("unroll") for (int m = 0; m < 4; ++m) _Pragma("unroll") for (int n = 0; n < 2; ++n) _Pragma("unroll") for (int k = 0; k < 2; ++k) \
        acc[ai][bj][m][n] = __builtin_amdgcn_mfma_f32_16x16x32_bf16(Bt[n][k], At[m][k], acc[ai][bj][m][n], 0, 0, 0); __builtin_amdgcn_s_setprio(0); } while (0)
#define PG8_WAIT_V(n) asm volatile("s_waitcnt vmcnt(" #n ")" ::: "memory")
#define PG8_WAIT_L(n) asm volatile("s_waitcnt lgkmcnt(" #n ")" ::: "memory")
#define PG8_BAR __builtin_amdgcn_s_barrier()
#define PG8_SCHED __builtin_amdgcn_sched_barrier(0)
    Unit cur, nxt; int ui = 0;
    if (!S.next(0, cur)) return;
    f32x4 acc[2][2][4][2];
#pragma unroll
    for (int a = 0; a < 2; ++a)
#pragma unroll
        for (int b = 0; b < 2; ++b)
#pragma unroll
            for (int m = 0; m < 4; ++m)
#pragma unroll
                for (int n = 0; n < 2; ++n) acc[a][b][m][n] = (f32x4){0.f, 0.f, 0.f, 0.f};
    bf16x8 At[4][2], B0[2][2], B1[2][2];
    const char* cA = (const char*)g.A + (size_t)cur.pm * tstep; const char* cB = (const char*)g.Bt + (size_t)cur.pn * tstep;
    S.a_ready(cur);
    PG8_STAGE(PG8_SB(0, 0), cB, voffB); PG8_STAGE(PG8_SA(0, 0), cA, voffA); PG8_STAGE(PG8_SB(0, 1), cB + hstep, voffB); PG8_STAGE(PG8_SA(0, 1), cA + hstep, voffA);
    if (wr == 1) PG8_BAR;
    PG8_WAIT_V(4); PG8_BAR;
    PG8_STAGE(PG8_SB(1, 0), cB + kstep, voffB); PG8_STAGE(PG8_SA(1, 0), cA + kstep, voffA); PG8_STAGE(PG8_SB(1, 1), cB + hstep + kstep, voffB);
    PG8_WAIT_V(6); PG8_BAR;
    PG8_STAMP();
    for (;;) {
        const bool has_next = S.next(ui + 1, nxt);
        const char* nA = has_next ? (const char*)g.A + (size_t)nxt.pm * tstep : cA; const char* nB = has_next ? (const char*)g.Bt + (size_t)nxt.pn * tstep : cB;
        for (int t = 0; t < nt; t += 2) {
            const bool last = (t == nt - 2);
            const char* a1 = cA + (size_t)(t + 1) * kstep;
            const char* a2 = last ? nA : cA + (size_t)(t + 2) * kstep; const char* b2 = last ? nB : cB + (size_t)(t + 2) * kstep;
            const char* a3 = a2 + kstep; const char* b3 = b2 + kstep;
            if (last && has_next) S.a_ready(nxt);
            PG8_LDB(B0, 0, 0); PG8_SCHED; PG8_LDA(At, 0, 0); PG8_STAGE(PG8_SA(1, 1), a1 + hstep, voffA);
            PG8_WAIT_L(8); PG8_BAR; PG8_WAIT_L(0); PG8_MMA(0, 0, At, B0); PG8_BAR; PG8_SCHED;
            PG8_LDB(B1, 0, 1); PG8_STAGE(PG8_SB(0, 0), b2, voffB);
            PG8_BAR; PG8_WAIT_L(0); PG8_MMA(0, 1, At, B1); PG8_BAR;
            PG8_LDA(At, 0, 1); PG8_STAGE(PG8_SA(0, 0), a2, voffA);
            PG8_BAR; PG8_WAIT_L(0); PG8_MMA(1, 0, At, B0); PG8_BAR; PG8_SCHED;
            PG8_STAGE(PG8_SB(0, 1), b2 + hstep, voffB);
            PG8_WAIT_V(6); PG8_BAR; PG8_MMA(1, 1, At, B1); PG8_BAR;
            PG8_LDB(B0, 1, 0); PG8_SCHED; PG8_LDA(At, 1, 0); PG8_STAGE(PG8_SA(0, 1), a2 + hstep, voffA);
            PG8_WAIT_L(8); PG8_BAR; PG8_WAIT_L(0); PG8_MMA(0, 0, At, B0); PG8_BAR; PG8_SCHED;
            PG8_LDB(B1, 1, 1); PG8_STAGE(PG8_SB(1, 0), b3, voffB);
            PG8_BAR; PG8_WAIT_L(0); PG8_MMA(0, 1, At, B1); PG8_BAR;
            PG8_LDA(At, 1, 1); PG8_STAGE(PG8_SA(1, 0), a3, voffA);
            PG8_BAR; PG8_WAIT_L(0); PG8_MMA(1, 0, At, B0); PG8_BAR; PG8_SCHED;
            PG8_STAGE(PG8_SB(1, 1), b3 + hstep, voffB);
            PG8_WAIT_V(6); PG8_BAR; PG8_MMA(1, 1, At, B1); PG8_BAR;
        }
        PG8_STAMP();
        if constexpr (!Epi::AFTER_DRAIN) { E(acc, cur, wr, wc, fr, fq); S.done(cur); }
        PG8_STAMP();
        if (!has_next) break;
#pragma unroll
        for (int a = 0; a < 2; ++a)
#pragma unroll
            for (int b = 0; b < 2; ++b)
#pragma unroll
                for (int m = 0; m < 4; ++m)
#pragma unroll
                    for (int n = 0; n < 2; ++n) acc[a][b][m][n] = (f32x4){0.f, 0.f, 0.f, 0.f};
        cur = nxt; cA = nA; cB = nB; ++ui;
    }
    PG8_WAIT_V(0);
    if (wr == 0) PG8_BAR;
    PG8_BAR;
    if constexpr (Epi::AFTER_DRAIN) { E.fused(acc, cur, wr, wc, fr, fq, lds, wid, lane); S.done(cur); }
    PG8_STAMP();
    if (STAMP && wid == 0) { stamps[lane] = lane < nts ? (((unsigned long long)(unsigned)ts_hi << 32) | (unsigned)ts_lo) : 0ull;
        if (lane == 62) stamps[62] = rt_entry; if (lane == 63) stamps[63] = 0ull; }
#undef PG8_STAMP
#undef PG8_SA
#undef PG8_SB
#undef PG8_STAGE
#undef PG8_LDA
#undef PG8_LDB
#undef PG8_MMA
#undef PG8_WAIT_V
#undef PG8_WAIT_L
#undef PG8_BAR
#undef PG8_SCHED
}
}

DI void phase_gemm_in(const Params& p, int l, LDS_AS unsigned char* smem, int dry) {
  pg8::Gemm g; g.A = p.H; g.Bt = p.WB + (size_t)l * W_LAYER + W_IN; g.M = T; g.N = 2816; g.K = 1024;
  pg8::StaticOrder S; S.init(g.M, g.N, gridDim.x, blockIdx.x);
  pg8::EpiBf16<0> E; E.O = p.PROJ; E.ldc = PN; E.ncols = PN; E.dry = dry;
  __syncthreads();
  pg8::gemm_phase<pg8::EpiBf16<0>, pg8::StaticOrder, false>(smem, g, S, E, nullptr);
}
DI void phase_gemm_mla(const Params& p, int l, LDS_AS unsigned char* smem, int dry) {
  const bf16_t* WQ = p.WB + (size_t)l * W_LAYER + W_UQ; const bf16_t* WK = p.WB + (size_t)l * W_LAYER + W_UKV;
  const int NT = 7, ntiles = (T / 256) * NT;
  for (int i = blockIdx.x; i < ntiles; i += gridDim.x) {
    int mt, nt; tile_decode(xcd_remap(i, ntiles), NT, mt, nt);
    f32x16 acc[4][2]; zero_acc2(acc);
    if (nt < 3) {
      gemm_kloop2(p.PROJ + (size_t)mt * 256 * PN + C_QLAT, PN, WQ + (size_t)nt * 256 * 256, 256, 4, acc, smem);
      if (!dry) epi2_store_bf16<0>(acc, p.MQ, 768, mt * 256, nt * 256, 768, smem);
    } else {
      gemm_kloop2(p.PROJ + (size_t)mt * 256 * PN + C_KVLAT, PN, WK + (size_t)(nt - 3) * 256 * 128, 128, 2, acc, smem);
      if (!dry) epi2_store_bf16<0>(acc, p.KV, 1024, mt * 256, (nt - 3) * 256, 1024, smem);
    }
  }
}
DI void phase_merge(const Params& p, int l, LDS_AS unsigned char* smem, int dry) {
  const bf16_t* WL = p.WB + (size_t)l * W_LAYER;
  const int NT = 8, MT = (l == 1) ? TL / 256 : T / 256, ntiles = MT * NT;
  bf16_t* M = p.KV;
  for (int i = blockIdx.x; i < ntiles; i += gridDim.x) {
    int mt, nt; tile_decode(xcd_remap(i, ntiles), NT, mt, nt);
    unsigned tp[2][2][8];
#pragma unroll
    for (int a = 0; a < 2; ++a)
#pragma unroll
      for (int b = 0; b < 2; ++b)
#pragma unroll
        for (int e = 0; e < 8; ++e) tp[a][b][e] = 0u;
#pragma unroll 1
    for (int br = 0; br < 3; ++br) {
      unsigned gp[2][2][8];
      {
        f32x16 ag[2][2]; zero_acc(ag);
        gemm_kloop(p.H + (size_t)mt * 256 * 1024, 1024, 64, WL + W_IN + (size_t)(2816 + br * 1024 + nt * 128) * 1024, 1024, 16, ag, smem);
#pragma unroll
        for (int a = 0; a < 2; ++a)
#pragma unroll
          for (int b = 0; b < 2; ++b)
#pragma unroll
            for (int e = 0; e < 8; ++e)
              gp[a][b][e] = pk2(__builtin_amdgcn_rcpf(1.f + __builtin_amdgcn_exp2f(-LOG2E * ag[a][b][2 * e])),
                                __builtin_amdgcn_rcpf(1.f + __builtin_amdgcn_exp2f(-LOG2E * ag[a][b][2 * e + 1])));
      }
      f32x16 ay[2][2]; zero_acc(ay);
      const int lda = (br == 0) ? 768 : PN, kstep = (br == 0) ? 96 : 64;
      const size_t aofs = (br == 0) ? (size_t)T * PN : (size_t)(br == 1 ? C_SQ : C_DQ);
      __builtin_amdgcn_sched_barrier(0);
      gemm_kloop(p.PROJ + aofs + (size_t)mt * 256 * lda, lda, kstep, WL + W_UPM + (size_t)br * 1024 * 512 + (size_t)nt * 128 * 512, 512, 8, ay, smem);
#pragma unroll
      for (int a = 0; a < 2; ++a)
#pragma unroll
        for (int b = 0; b < 2; ++b)
#pragma unroll
          for (int e = 0; e < 8; ++e) {
            const float t0 = __uint_as_float(tp[a][b][e] << 16) + __uint_as_float(gp[a][b][e] << 16) * ay[a][b][2 * e];
            const float t1 = __uint_as_float(tp[a][b][e] & 0xffff0000u) + __uint_as_float(gp[a][b][e] & 0xffff0000u) * ay[a][b][2 * e + 1];
            tp[a][b][e] = pk2(t0, t1);
          }
    }
    if (!dry) {
      f32x16 tot[2][2];
#pragma unroll
      for (int a = 0; a < 2; ++a)
#pragma unroll
        for (int b = 0; b < 2; ++b)
#pragma unroll
          for (int e = 0; e < 8; ++e) { tot[a][b][2 * e] = __uint_as_float(tp[a][b][e] << 16); tot[a][b][2 * e + 1] = __uint_as_float(tp[a][b][e] & 0xffff0000u); }
      epi_store_bf16<0>(tot, M, 1024, mt * 256, nt * 128, 1024, smem);
    }
  }
}
DI void phase_residual_gemm(const Params& p, int l, int which, LDS_AS unsigned char* smem, int dry) {
  const bf16_t* WL = p.WB + (size_t)l * W_LAYER;
  const bf16_t* Abase = which == 0 ? (const bf16_t*)opq(p.KV) : (const bf16_t*)opq(p.PROJ);
  const int K = which == 0 ? 1024 : 4096;
  const bf16_t* W = WL + (which == 0 ? W_O : W_M2);
  const bool first = (which == 0 && l == 0);
  const float* px = opq(p.x); const float* pctx = opq(p.ctx); float* pout = opq(p.out); float* pcx = opq(p.CX);
  const float* slat = first ? px : (const float*)pout; const float* sctx = first ? pctx : (const float*)pcx;
  const float* gofs = p.modtab + (size_t)(l * 5) * 6144 + (which == 0 ? 2048 : 5120);
  {
    pg8::Gemm g; g.A = Abase; g.Bt = W; g.M = TL; g.N = 1024; g.K = K;
    pg8::StaticOrder S; S.init(g.M, g.N, gridDim.x, blockIdx.x);
    pg8::EpiResid E; E.xin = slat; E.xout = pout; E.gate = gofs; E.dry = dry;
    __syncthreads();
    pg8::gemm_phase<pg8::EpiResid, pg8::StaticOrder, false>(smem, g, S, E, nullptr);
  }
  if (l == 0) {
    const int i = (int)gridDim.x - 1 - (int)blockIdx.x;
    if (i < 32) {
      const int mt = TL / 256 + (i & 3), nt = i >> 2;
      f32x16 acc[2][2]; zero_acc(acc);
      gemm_kloop(Abase + (size_t)mt * 256 * K, K, 64, W + (size_t)nt * 128 * K, K, K / 64, acc, smem);
      if (!dry) epi_residual(acc, sctx, pcx, gofs + (size_t)4 * 6144, mt * 256 - TL, nt * 128, smem);
    }
  }
}
DI void phase_mlp_in(const Params& p, int l, LDS_AS unsigned char* smem, int dry) {
  pg8::Gemm g; g.A = p.H; g.Bt = p.WB + (size_t)l * W_LAYER + W_M1; g.M = (l == 1) ? TL : T; g.N = 4096; g.K = 1024;
  pg8::StaticOrder S; S.init(g.M, g.N, gridDim.x, blockIdx.x);
  pg8::EpiBf16<1> E; E.O = p.PROJ; E.ldc = 4096; E.ncols = 4096; E.dry = dry;
  __syncthreads();
  pg8::gemm_phase<pg8::EpiBf16<1>, pg8::StaticOrder, false>(smem, g, S, E, nullptr);
}

DI unsigned ld_u32(const bf16_t* p) { return *(const unsigned*)p; }
DI void unpack4(u32x2 raw, float (&v)[4]) {
  v[0] = __uint_as_float(raw[0] << 16); v[1] = __uint_as_float(raw[0] & 0xffff0000u); v[2] = __uint_as_float(raw[1] << 16); v[3] = __uint_as_float(raw[1] & 0xffff0000u);
}
DI void phase_prep_a(const Params& p, int l, int dry) {
  const int tid_ = tidx(), lane = tid_ & 63, wave = tid_ >> 6, vsel = lane >> 4, j16 = lane & 15;
  const f32x4 gsq = *(const f32x4*)(p.g_swa_q + l * 64 + 4 * j16), gsk = *(const f32x4*)(p.g_swa_k + l * 64 + 4 * j16);
  const f32x4 gdq = *(const f32x4*)(p.g_diff_q + l * 64 + 4 * j16), gdk = *(const f32x4*)(p.g_diff_k + l * 64 + 4 * j16);
  const f32x4 gql = *(const f32x4*)(p.g_q_lora + l * 256 + lane * 4);
  const f32x2 gkl = *(const f32x2*)(p.g_kv_lora + l * 128 + lane * 2);
  float freq[4];
#pragma unroll
  for (int jj = 0; jj < 4; ++jj) freq[jj] = __builtin_amdgcn_exp2f(-(float)(4 * (j16 & 3) + jj) * (13.287712379549449f / 16.f)) * 0.15915494309189535f;
  const float sgn = ((j16 >> 2) & 1) ? 1.f : -1.f;
  const int stride = gridDim.x * 8;
  for (int row0 = blockIdx.x * 8 + wave; row0 < T; row0 += 2 * stride) {
    u32x2 rq[2], rv[2][7]; unsigned rk[2];
#pragma unroll
    for (int t = 0; t < 2; ++t) {
      const int row = (row0 + t * stride < T) ? row0 + t * stride : row0;
      const bf16_t* base = p.PROJ + (size_t)row * PN;
      rq[t] = *(const u32x2*)(base + C_QLAT + lane * 4);
      rk[t] = ld_u32(base + C_KVLAT + lane * 2);
#pragma unroll
      for (int it = 0; it < 7; ++it) rv[t][it] = *(const u32x2*)(base + C_SQ + 64 * (4 * it + vsel) + 4 * j16);
    }
#pragma unroll
    for (int t = 0; t < 2; ++t) {
      const int row = row0 + t * stride;
      if (row >= T) break;
      bf16_t* base = p.PROJ + (size_t)row * PN;
      const bool islat = row < TL;
      float cs[4], sn[4];
      if (islat) {
        const int tt = row & 8191; const float pos = (float)((j16 >> 3) ? (tt & 63) : (tt >> 6));
#pragma unroll
        for (int jj = 0; jj < 4; ++jj) { const float rev = pos * freq[jj]; cs[jj] = __builtin_amdgcn_cosf(rev); sn[jj] = __builtin_amdgcn_sinf(rev); }
      } else {
#pragma unroll
        for (int jj = 0; jj < 4; ++jj) { cs[jj] = 1.f; sn[jj] = 0.f; }
      }
      {
        float v[4]; unpack4(rq[t], v);
        const float ss = wave_sum(v[0] * v[0] + v[1] * v[1] + v[2] * v[2] + v[3] * v[3]);
        const float rstd = rsqrtf(ss * (1.f / 256.f) + EPS);
        u32x2 w = {pk2(v[0] * rstd * gql[0], v[1] * rstd * gql[1]), pk2(v[2] * rstd * gql[2], v[3] * rstd * gql[3])};
        if (!dry) *(u32x2*)(base + C_QLAT + lane * 4) = w;
      }
      {
        const float v0 = __uint_as_float(rk[t] << 16), v1 = __uint_as_float(rk[t] & 0xffff0000u);
        const float ss = wave_sum(v0 * v0 + v1 * v1);
        const float rstd = rsqrtf(ss * (1.f / 128.f) + EPS);
        if (!dry) *(unsigned*)(base + C_KVLAT + lane * 2) = pk2(v0 * rstd * gkl[0], v1 * rstd * gkl[1]);
      }
#pragma unroll
      for (int it = 0; it < 7; ++it) {
        const f32x4 g = (it < 2) ? gsq : (it == 2 ? gsk : (it < 5 ? gdq : gdk));
        const float sc = (it < 2 || it == 3 || it == 4) ? 0.125f * LOG2E : 1.f;
        float v[4]; unpack4(rv[t][it], v);
        float ss = v[0] * v[0] + v[1] * v[1] + v[2] * v[2] + v[3] * v[3];
        ss += __shfl_xor(ss, 8); ss += __shfl_xor(ss, 4); ss += __shfl_xor(ss, 2); ss += __shfl_xor(ss, 1);
        const float rstd = rsqrtf(ss * (1.f / 64.f) + EPS);
        float y[4];
#pragma unroll
        for (int jj = 0; jj < 4; ++jj) {
          const float yy = v[jj] * rstd * g[jj];
          const float pr = __shfl_xor(yy, 4);
          y[jj] = (yy * cs[jj] + sgn * pr * sn[jj]) * sc;
        }
        u32x2 w = {pk2(y[0], y[1]), pk2(y[2], y[3])};
        if (!dry && (it != 2 || vsel < 2)) *(u32x2*)(base + C_SQ + 64 * (4 * it + vsel) + 4 * j16) = w;
      }
    }
  }
}
DI void phase_prep_c(const Params& p, int l, int dry) {
  const int tid_ = tidx(), lane = tid_ & 63, wave = tid_ >> 6, hd = lane >> 3, sub = lane & 7;
  f32x4 gq[3], gk[3];
#pragma unroll
  for (int i = 0; i < 3; ++i) { gq[i] = *(const f32x4*)(p.g_mla_q + l * 96 + 32 * i + 4 * sub); gk[i] = *(const f32x4*)(p.g_mla_k + l * 96 + 32 * i + 4 * sub); }
  float freq[4];
#pragma unroll
  for (int jj = 0; jj < 4; ++jj) freq[jj] = __builtin_amdgcn_exp2f(-(float)(4 * (sub & 1) + jj) * (13.287712379549449f / 8.f)) * 0.15915494309189535f;
  const float sgn = ((sub >> 1) & 1) ? 1.f : -1.f;
  const float qs = 0.10206207261596575f * LOG2E;
  const int stride = gridDim.x * 8;
  for (int row0 = blockIdx.x * 8 + wave; row0 < T; row0 += 2 * stride) {
    u32x2 rq[2][3], rkv[2][2], rpe[2];
#pragma unroll
    for (int t = 0; t < 2; ++t) {
      const int row = (row0 + t * stride < T) ? row0 + t * stride : row0;
#pragma unroll
      for (int i = 0; i < 3; ++i) rq[t][i] = *(const u32x2*)(p.MQ + (size_t)row * 768 + hd * 96 + 32 * i + 4 * sub);
#pragma unroll
      for (int i = 0; i < 2; ++i) rkv[t][i] = *(const u32x2*)(p.KV + (size_t)row * 1024 + hd * 128 + 32 * i + 4 * sub);
      rpe[t] = *(const u32x2*)(p.PROJ + (size_t)row * PN + C_KPE + 4 * sub);
    }
#pragma unroll
    for (int t = 0; t < 2; ++t) {
      const int row = row0 + t * stride;
      if (row >= T) break;
      const bool islat = row < TL;
      float cs[4], sn[4];
      if (islat) {
        const int tt = row & 8191; const float pos = (float)((sub >> 2) ? (tt & 63) : (tt >> 6));
#pragma unroll
        for (int jj = 0; jj < 4; ++jj) { const float rev = pos * freq[jj]; cs[jj] = __builtin_amdgcn_cosf(rev); sn[jj] = __builtin_amdgcn_sinf(rev); }
      } else {
#pragma unroll
        for (int jj = 0; jj < 4; ++jj) { cs[jj] = 1.f; sn[jj] = 0.f; }
      }
#pragma unroll
      for (int qk = 0; qk < 2; ++qk) {
        float v[3][4];
        if (qk == 0) { unpack4(rq[t][0], v[0]); unpack4(rq[t][1], v[1]); unpack4(rq[t][2], v[2]); }
        else { unpack4(rkv[t][0], v[0]); unpack4(rkv[t][1], v[1]); unpack4(rpe[t], v[2]); }
        float ss = 0.f;
#pragma unroll
        for (int i = 0; i < 3; ++i)
#pragma unroll
          for (int jj = 0; jj < 4; ++jj) ss += v[i][jj] * v[i][jj];
        ss += __shfl_xor(ss, 4); ss += __shfl_xor(ss, 2); ss += __shfl_xor(ss, 1);
        const float rstd = rsqrtf(ss * (1.f / 96.f) + EPS);
        const float osc = (qk == 0) ? qs : 1.f;
        u32x2 w[3];
#pragma unroll
        for (int i = 0; i < 3; ++i) {
          float y[4];
#pragma unroll
          for (int jj = 0; jj < 4; ++jj) {
            const float gg = (qk == 0) ? gq[i][jj] : gk[i][jj];
            float yy = v[i][jj] * rstd * gg;
            if (i == 2) { const float pr = __shfl_xor(yy, 2); yy = yy * cs[jj] + sgn * pr * sn[jj]; }
            y[jj] = yy * osc;
          }
          w[i][0] = pk2(y[0], y[1]); w[i][1] = pk2(y[2], y[3]);
        }
        bf16_t* dst = (qk == 0 ? p.MQ : p.KM) + (size_t)row * 768 + hd * 96 + 4 * sub;
        if (!dry) {
#pragma unroll
          for (int i = 0; i < 3; ++i) *(u32x2*)(dst + 32 * i) = w[i];
        }
      }
    }
  }
}

struct AttnArgs {
  const bf16_t* q; int qpitch;
  const bf16_t* k; int kpitch;
  const bf16_t* v; int vpitch;
  bf16_t* o; int opitch;
  int krow_ctx, krow_lat;
  int nct, lt0, lt1;
  int qrow0, qpos0;
  float mb, sinkterm;
  float lam, osc; const float* gsub;
  int dry;
  bf16_t* o0;
};

template <int QSTEPS> DI void load_q(const AttnArgs& a, int colofs, bf16x8 (&qf)[QSTEPS]) {
  const int tid_ = tidx(), lane = tid_ & 63, wave = tid_ >> 6, h = lane >> 5, l32 = lane & 31;
  const bf16_t* qr = a.q + (size_t)(a.qrow0 + wave * 32 + l32) * a.qpitch + 8 * h + colofs;
#pragma unroll
  for (int s = 0; s < QSTEPS; ++s) qf[s] = *(const bf16x8*)(qr + s * 16);
}
template <int NKA, bool KB, int DV, int EPI, bool WIN>
DI void attn_item(const AttnArgs& a, const bf16x8 (&qfr)[4 + (KB ? 2 : 0)], int kcolofs, LDS_AS unsigned char* smem) {
  const int tid_ = tidx(), lane = tid_ & 63, wave = tid_ >> 6, h = lane >> 5, l32 = lane & 31;
  constexpr int NMAP = 1;
  constexpr int QSTEPS = 4 + (KB ? 2 : 0);
  constexpr int NDB = DV / 32;
  constexpr int VP = DV * 2;
  constexpr int AST = 24576, NST = 4;
  constexpr int NLD = 1 + (KB ? 1 : 0) + (DV == 64 ? 1 : 2);
  const int ntile = a.nct + (a.lt1 - a.lt0);
  unsigned kaoff, kboff = 0, voff[DV == 64 ? 1 : 2];
  { const int r = wave * 8 + (lane >> 3), c = (lane & 7) ^ ((r >> 1) & 7); kaoff = (unsigned)(r * a.kpitch + c * 8) * 2u; }
  if (KB) { const int r = (wave & 3) * 16 + (lane >> 2), c = (lane & 3) ^ ((r >> 2) & 3); kboff = (unsigned)(r * a.kpitch + 64 + c * 8) * 2u; }
  if (DV == 64) {
    const int r = wave * 8 + (lane >> 3), c = (lane & 7) ^ (((r >> 1) & 1) << 2); voff[0] = (unsigned)(r * a.vpitch + c * 8) * 2u;
  } else {
#pragma unroll
    for (int j = 0; j < 2; ++j) { const int r = (j * 8 + wave) * 4 + (lane >> 4), c = (lane & 15) ^ ((r & 3) << 2); voff[j] = (unsigned)(r * a.vpitch + c * 8) * 2u; }
  }
  const unsigned ldst = (unsigned)__builtin_amdgcn_readfirstlane((int)(lds_u32(smem) + wave * 1024));
  const unsigned ldstb = (unsigned)__builtin_amdgcn_readfirstlane((int)(lds_u32(smem) + 16384 + (wave & 3) * 1024));
  auto issue = [&](int ti, int stg) {
    const int trow = (ti < a.nct) ? (a.krow_ctx + ti * 64) : (a.krow_lat + (a.lt0 + ti - a.nct) * 64);
    const char* kb = (const char*)(a.k + (size_t)trow * a.kpitch + kcolofs); const char* vb = (const char*)(a.v + (size_t)trow * a.vpitch);
    const unsigned d = ldst + stg * AST;
    glds16a(kb, kaoff, d);
    if (KB) glds16a(kb, kboff, ldstb + stg * AST);
#pragma unroll
    for (int j = 0; j < (DV == 64 ? 1 : 2); ++j) glds16a(vb, voff[j], d + 8192 + j * 8192);
  };
  const int kswzA = (lane >> 1) & 7, kswzB = (lane >> 2) & 3;
  const int krowA = l32 * 128, krowB = l32 * 64;
  int vbase[NDB];
  {
    const int l16 = lane & 15, qq = l16 >> 2, pp = l16 & 3, g16 = (lane >> 4) & 1;
#pragma unroll
    for (int db = 0; db < NDB; ++db) {
      const int cl = 2 * g16 + (pp >> 1);
      const int c = (DV == 64) ? (4 * (db ^ (qq >> 1)) + cl) : (4 * (db ^ qq) + cl);
      vbase[db] = (4 * h + qq) * VP + c * 16 + (pp & 1) * 8;
    }
  }
  f32x16 O[NMAP][NDB];
#pragma unroll
  for (int m = 0; m < NMAP; ++m)
#pragma unroll
    for (int db = 0; db < NDB; ++db)
#pragma unroll
      for (int i = 0; i < 16; ++i) O[m][db][i] = 0.f;
  float lsum[NMAP];
#pragma unroll
  for (int m = 0; m < NMAP; ++m) lsum[m] = 0.f;
  const float negmb = -a.mb;
  const int qpos = a.qpos0 + wave * 32 + l32;

#pragma unroll
  for (int s = 0; s < QSTEPS; ++s) asm volatile("" ::"v"(qfr[s]));
  asm volatile("s_waitcnt vmcnt(0)" ::: "memory");
  __syncthreads();
  issue(0, 0);
  if (ntile > 1) issue(1, 1);
  if (ntile > 2) issue(2, 2);
#pragma unroll 1
  for (int ti = 0; ti < ntile; ++ti) {
    const int rem = ntile - 1 - ti;
    if (rem >= 2) { if (NLD == 2) asm volatile("s_waitcnt vmcnt(4)" ::: "memory"); else asm volatile("s_waitcnt vmcnt(6)" ::: "memory"); }
    else if (rem == 1) { if (NLD == 2) asm volatile("s_waitcnt vmcnt(2)" ::: "memory"); else asm volatile("s_waitcnt vmcnt(3)" ::: "memory"); }
    else asm volatile("s_waitcnt vmcnt(0)" ::: "memory");
    __builtin_amdgcn_s_barrier();
    asm volatile("" ::: "memory");
    if (ti + 3 < ntile) issue(ti + 3, (ti + 3) & 3);
    __builtin_amdgcn_sched_barrier(0);
    LDS_AS unsigned char* st = smem + (ti & 3) * AST;
    LDS_AS unsigned char* sv = st + 8192;
    auto readK = [&](int kb, bf16x8 (&kf)[QSTEPS]) {
      LDS_AS unsigned char* ka = st + kb * 32 * 128 + krowA;
#pragma unroll
      for (int s = 0; s < 4; ++s) kf[s] = lds128(ka + (((2 * s + h) ^ kswzA) << 4));
      if (KB) {
        LDS_AS unsigned char* kbp = st + 16384 + kb * 32 * 64 + krowB;
#pragma unroll
        for (int s = 0; s < 2; ++s) kf[4 + s] = lds128(kbp + (((2 * s + h) ^ kswzB) << 4));
      }
    };
    auto readV = [&](int kb, bf16x8 (&vf)[2][NDB]) {
#pragma unroll
      for (int s = 0; s < 2; ++s)
#pragma unroll
        for (int db = 0; db < NDB; ++db) {
          const int rc = (kb * 32 + 16 * s) * VP;
          const s16x4 lo = __builtin_amdgcn_ds_read_tr16_b64_v4i16((LDS_AS s16x4*)(sv + vbase[db] + rc));
          const s16x4 hi = __builtin_amdgcn_ds_read_tr16_b64_v4i16((LDS_AS s16x4*)(sv + vbase[db] + rc + 8 * VP));
          vf[s][db] = __builtin_shufflevector(lo, hi, 0, 1, 2, 3, 4, 5, 6, 7);
        }
    };
    auto qk = [&](const bf16x8 (&kf)[QSTEPS], f32x16& S) {
#pragma unroll
      for (int i = 0; i < 16; ++i) S[i] = negmb;
#pragma unroll
      for (int s = 0; s < QSTEPS; ++s) S = MFMA32(kf[s], qfr[s], S);
    };
    auto softmax = [&](int kb, f32x16& S, bf16x8 (&pb)[2]) {
      if (WIN) {
        if (ti >= a.nct) {
          const int kp0 = (a.lt0 + ti - a.nct) * 64 + 4 * h - qpos + kb * 32;
#pragma unroll
          for (int i = 0; i < 16; ++i) {
            const int dlt = kp0 + (i & 3) + 8 * (i >> 2);
            if (dlt > 128 || dlt < -128) S[i] = -INFINITY;
          }
        }
      }
      float ls = 0.f;
#pragma unroll
      for (int i = 0; i < 16; ++i) { S[i] = __builtin_amdgcn_exp2f(S[i]); ls += S[i]; }
      lsum[0] += ls;
#pragma unroll
      for (int s = 0; s < 2; ++s) {
        u32x4 pw;
#pragma unroll
        for (int j = 0; j < 4; ++j) pw[j] = pk2(S[8 * s + 2 * j], S[8 * s + 2 * j + 1]);
        pb[s] = __builtin_bit_cast(bf16x8, pw);
      }
    };
    auto pv = [&](const bf16x8 (&vf)[2][NDB], const bf16x8 (&pb)[2]) {
#pragma unroll
      for (int s = 0; s < 2; ++s)
#pragma unroll
        for (int db = 0; db < NDB; ++db) O[0][db] = MFMA32(vf[s][db], pb[s], O[0][db]);
    };
    bool skip = false;
    if (WIN) {
      if (ti >= a.nct) {
        const int kp = (a.lt0 + ti - a.nct) * 64, r0 = a.qpos0 + __builtin_amdgcn_readfirstlane(wave) * 32;
        skip = (kp + 63 < r0 - 128) || (kp > r0 + 31 + 128);
      }
    }
    if (!skip) {
      bf16x8 kf0[QSTEPS], kf1[QSTEPS], vf0[2][NDB], vf1[2][NDB], p0[2], p1[2];
      f32x16 S0, S1;
      readK(0, kf0); readV(0, vf0);
      __builtin_amdgcn_sched_barrier(0);
      qk(kf0, S0);
      __builtin_amdgcn_sched_barrier(0);
      readK(1, kf1);
      __builtin_amdgcn_sched_barrier(0);
      qk(kf1, S1);
      __builtin_amdgcn_sched_barrier(0);
      softmax(0, S0, p0);
      __builtin_amdgcn_sched_barrier(0);
      pv(vf0, p0);
      __builtin_amdgcn_sched_barrier(0);
      readV(1, vf1);
      __builtin_amdgcn_sched_barrier(0);
      softmax(1, S1, p1);
      __builtin_amdgcn_sched_barrier(0);
      pv(vf1, p1);
      __builtin_amdgcn_sched_barrier(0);
    }
  }
  const float lt = lsum[0] + __shfl_xor(lsum[0], 32) + a.sinkterm;
  const float inv = 1.f / lt;
  bf16_t* orow = a.o + (size_t)(a.qrow0 + wave * 32 + l32) * a.opitch + 4 * h;
  if (a.dry) return;
  if (EPI == 0) {
#pragma unroll
    for (int db = 0; db < NDB; ++db)
#pragma unroll
      for (int g = 0; g < 4; ++g) {
        u32x2 w = {pk2(O[0][db][4 * g] * inv, O[0][db][4 * g + 1] * inv), pk2(O[0][db][4 * g + 2] * inv, O[0][db][4 * g + 3] * inv)};
        *(u32x2*)(orow + db * 32 + 8 * g) = w;
      }
  } else {
    const float c1 = inv * a.lam;
    float ss = 0.f;
#pragma unroll
    for (int db = 0; db < NDB; ++db)
#pragma unroll
      for (int g = 0; g < 4; ++g) {
        const u32x2 raw = *(const u32x2*)(a.o0 + (size_t)(a.qrow0 + wave * 32 + l32) * 512 + 4 * h + db * 32 + 8 * g);
        const float o0[4] = {__uint_as_float(raw[0] << 16), __uint_as_float(raw[0] & 0xffff0000u), __uint_as_float(raw[1] << 16), __uint_as_float(raw[1] & 0xffff0000u)};
#pragma unroll
        for (int j = 0; j < 4; ++j) { const float v = o0[j] - O[0][db][4 * g + j] * c1; O[0][db][4 * g + j] = v; ss += v * v; }
      }
    ss += __shfl_xor(ss, 32);
    const float rstd = rsqrtf(ss * (1.f / (float)DV) + EPS) * a.osc;
#pragma unroll
    for (int db = 0; db < NDB; ++db)
#pragma unroll
      for (int g = 0; g < 4; ++g) {
        const f32x4 gs = *(const f32x4*)(a.gsub + db * 32 + 8 * g + 4 * h);
        u32x2 w = {pk2(O[0][db][4 * g] * rstd * gs[0], O[0][db][4 * g + 1] * rstd * gs[1]), pk2(O[0][db][4 * g + 2] * rstd * gs[2], O[0][db][4 * g + 3] * rstd * gs[3])};
        *(u32x2*)(orow + db * 32 + 8 * g) = w;
      }
  }
}

DI void attn_diff_item(const AttnArgs& a, LDS_AS unsigned char* smem) {
  AttnArgs a0 = a; a0.o = a.o0; a0.opitch = 512; a0.dry = 0;
  { bf16x8 q0[4]; load_q<4>(a, 0, q0); attn_item<1, false, 128, 0, false>(a0, q0, 0, smem); }
  { bf16x8 q1[4]; load_q<4>(a, 64, q1); attn_item<1, false, 128, 1, false>(a, q1, 64, smem); }
}

DI void phase_attention(const Params& p, int l, LDS_AS unsigned char* smem, int dry) {
  const float* cs = p.consts + l * 16;
  const float lam = cs[0], lam_init = cs[1], mb_mla = cs[2], mb_swa = cs[3], mb_diff = cs[4];
  const int nc_d = (l == 0) ? 16 : 0, nc_m = (l == 0) ? 32 : 0;
#pragma unroll 1
  for (int i = blockIdx.x; i < 512 + nc_d; i += gridDim.x) {
    AttnArgs a; a.dry = dry;
    int b, hd;
    if (i < 512) {
      const int id = xcd_remap(i, 512), pair = id >> 5, qb = id & 31; b = pair >> 2; hd = pair & 3;
      a.lt0 = 0; a.lt1 = 128; a.qrow0 = b * 8192 + qb * 256;
    } else {
      const int j = i - 512; b = j >> 2; hd = j & 3;
      a.lt0 = 0; a.lt1 = 0; a.qrow0 = TL + b * 256;
    }
    a.q = p.PROJ + C_DQ + hd * 128; a.qpitch = PN; a.k = p.PROJ + C_DK + hd * 128; a.kpitch = PN; a.v = p.PROJ + C_DV + hd * 128; a.vpitch = PN;
    a.o = p.PROJ + C_DQ + hd * 128; a.opitch = PN; a.o0 = p.YD0 + hd * 128;
    a.krow_ctx = TL + b * 256; a.krow_lat = b * 8192; a.nct = 4; a.qpos0 = 0;
    a.mb = mb_diff; a.sinkterm = 0.f; a.lam = lam; a.osc = 1.f - lam_init; a.gsub = p.g_diff_sub + l * 128;
    attn_diff_item(a, smem);
  }
#pragma unroll 1
  for (int i = blockIdx.x; i < 1024 + nc_m; i += gridDim.x) {
    AttnArgs a; a.dry = dry;
    int b, hd;
    if (i < 1024) {
      const int id = xcd_remap(i, 1024), pair = id >> 5, qb = id & 31; b = pair >> 3; hd = pair & 7;
      a.lt0 = 0; a.lt1 = 128; a.qrow0 = b * 8192 + qb * 256;
    } else {
      const int j = i - 1024; b = j >> 3; hd = j & 7;
      a.lt0 = 0; a.lt1 = 0; a.qrow0 = TL + b * 256;
    }
    a.q = p.MQ + hd * 96; a.qpitch = 768; a.k = p.KM + hd * 96; a.kpitch = 768; a.v = p.KV + hd * 128 + 64; a.vpitch = 1024;
    a.o = p.MQ + hd * 96; a.opitch = 768; a.o0 = nullptr;
    a.krow_ctx = TL + b * 256; a.krow_lat = b * 8192; a.nct = 4; a.qpos0 = 0;
    a.mb = mb_mla; a.sinkterm = 0.f; a.lam = 0.f; a.osc = 0.f; a.gsub = nullptr;
    bf16x8 qf[6]; load_q<6>(a, 0, qf);
    attn_item<1, true, 64, 0, false>(a, qf, 0, smem);
  }
#pragma unroll 1
  for (int i = blockIdx.x; i < 1024 + nc_m; i += gridDim.x) {
    AttnArgs a; a.dry = dry;
    int b, hq;
    if (i < 1024) {
      const int id = xcd_remap(i, 1024), pair = id >> 5, qb = id & 31; b = pair >> 3; hq = pair & 7;
      a.lt0 = (4 * qb - 2 < 0) ? 0 : 4 * qb - 2; a.lt1 = (4 * qb + 6 > 128) ? 128 : 4 * qb + 6;
      a.qrow0 = b * 8192 + qb * 256; a.qpos0 = qb * 256;
    } else {
      const int j = i - 1024; b = j >> 3; hq = j & 7;
      a.lt0 = 0; a.lt1 = 0; a.qrow0 = TL + b * 256; a.qpos0 = 0;
    }
    const int kvh = hq >> 2;
    a.q = p.PROJ + C_SQ + hq * 64; a.qpitch = PN; a.k = p.PROJ + C_SK + kvh * 64; a.kpitch = PN; a.v = p.PROJ + C_SV + kvh * 64; a.vpitch = PN;
    a.o = p.PROJ + C_SQ + hq * 64; a.opitch = PN; a.o0 = nullptr;
    a.krow_ctx = TL + b * 256; a.krow_lat = b * 8192; a.nct = 4;
    a.mb = mb_swa; a.sinkterm = __builtin_amdgcn_exp2f(p.swa_sink[l * 8 + hq] * LOG2E - mb_swa); a.lam = 0.f; a.osc = 0.f; a.gsub = nullptr;
    bf16x8 qf[4]; load_q<4>(a, 0, qf);
    attn_item<1, false, 64, 0, true>(a, qf, 0, smem);
  }
}

constexpr int NPH = 1 + 2 * 11;
DI void run_phase(const Params& p, int ph, LDS_AS unsigned char* smem, int dry) {
#ifdef ONLY_S
  if (ONLY_S == 99) { if (ph == 0) phase0(p, smem, dry); return; }
  if (ph == 0) return;
  const int l = (ph - 1) / 11, s = ONLY_S;
#else
  if (ph == 0) { phase0(p, smem, dry); return; }
  const int l = (ph - 1) / 11, s = (ph - 1) % 11;
#endif
  switch (s) {
    case 0: norm_phase(p, l, 0, dry); break;
    case 1: phase_gemm_in(p, l, smem, dry); break;
    case 2: phase_prep_a(p, l, dry); break;
    case 3: phase_gemm_mla(p, l, smem, dry); break;
    case 4: phase_prep_c(p, l, dry); break;
    case 5: phase_attention(p, l, smem, dry); break;
    case 6: phase_merge(p, l, smem, dry); break;
    case 7: phase_residual_gemm(p, l, 0, smem, dry); break;
    case 8: norm_phase(p, l, 1, dry); break;
    case 9: phase_mlp_in(p, l, smem, dry); break;
    default: phase_residual_gemm(p, l, 1, smem, dry); break;
  }
}

__global__ void __launch_bounds__(512, 2) mega_kernel(Params p) {
  __shared__ __attribute__((aligned(16))) unsigned char smem_raw[3 * GST];
  LDS_AS unsigned char* smem = (LDS_AS unsigned char*)smem_raw;
  __shared__ uint4 xb_words;
  cg::grid_group grid = cg::this_grid();
  if (threadIdx.x == 0) xb_words = make_uint4(0u, 0u, 0u, 0u);
  __syncthreads();
  const XcdBarrier xb = xcd_barrier_post(p.bar, (volatile LDS_AS unsigned*)&xb_words);
#pragma unroll 1
  for (int ph = 0; ph < NPH; ++ph) {
    const int st = (ph == 0) ? 31 : (ph - 1) % 11;
    const int nrep = (((unsigned)p.probe >> st) & 1u) ? 2 : 1;
    for (int rep = 0; rep < nrep; ++rep) run_phase(p, ph, smem, rep + 1 < nrep);
    if (ph + 1 < NPH) { if (ph == 0) grid.sync(); else xcd_barrier(xb); }
  }
}
#ifdef MK_MULTI
__global__ void __launch_bounds__(512, 2) phase_kernel(Params p, int ph) {
  __shared__ __attribute__((aligned(16))) unsigned char smem_raw[3 * GST];
  run_phase(p, ph, (LDS_AS unsigned char*)smem_raw, 0);
}
#endif

extern "C" void kernel_launch(void* const* d_in, const int* in_sizes, int n_in, void* d_out, int out_size, void* d_ws, size_t ws_size,
                              hipStream_t stream) {
  Params p{};
  const float* const* in = (const float* const*)d_in;
  p.x = in[0]; p.c = in[1]; p.ctx = in[2]; p.c_ctx = in[3]; p.w_mod = in[4]; p.b_mod = in[5]; p.g_norm_attn = in[6]; p.g_norm_mlp = in[7];
  p.w_in = in[8]; p.g_q_lora = in[9]; p.w_uq = in[10]; p.g_kv_lora = in[11]; p.w_ukv = in[12]; p.g_mla_q = in[13]; p.g_mla_k = in[14];
  p.w_up_mla = in[15]; p.g_swa_q = in[16]; p.g_swa_k = in[17]; p.swa_sink = in[18]; p.w_up_swa = in[19]; p.g_diff_q = in[20]; p.g_diff_k = in[21];
  p.lambda_q1 = in[22]; p.lambda_k1 = in[23]; p.lambda_q2 = in[24]; p.lambda_k2 = in[25]; p.g_diff_sub = in[26]; p.w_up_diff = in[27];
  p.w_o = in[28]; p.w_mlp_in = in[29]; p.w_mlp_out = in[30];
#ifndef PROBE_MASK
#define PROBE_MASK 0
#endif
  p.probe = PROBE_MASK; p.pad_ = 0;
  p.out = (float*)d_out;
  unsigned char* ws = (unsigned char*)d_ws;
  size_t off = 0;
  auto take = [&](size_t bytes) { unsigned char* r = ws + off; off += (bytes + 255) & ~(size_t)255; return r; };
  p.modtab = (float*)take(2 * 5 * 6144 * 4);
  p.consts = (float*)take(256);
  p.bar = (unsigned*)take(XCD_BAR_WORDS * 4);
  p.WB = (bf16_t*)take(2 * W_LAYER * 2);
  p.H = (bf16_t*)take((size_t)T * 1024 * 2);
  p.PROJ = (bf16_t*)take((size_t)T * PN * 2);
  p.MQ = (bf16_t*)take((size_t)T * 768 * 2);
  p.KV = (bf16_t*)take((size_t)T * 1024 * 2);
  p.KM = (bf16_t*)take((size_t)T * 768 * 2);
  p.CX = (float*)take((size_t)TC * 1024 * 4);
  p.YD0 = (bf16_t*)take((size_t)T * 512 * 2);
  if (off > ws_size) { fprintf(stderr, "workspace too small: need %zu have %zu\n", off, ws_size); return; }
  (void)hipMemsetAsync(p.modtab, 0, (size_t)((unsigned char*)p.bar - (unsigned char*)p.modtab) + XCD_BAR_WORDS * 4, stream);
#ifdef MK_MULTI
  for (int ph = 0; ph < NPH; ++ph) phase_kernel<<<256, 512, 0, stream>>>(p, ph);
#else
  static int grid_blocks = 0;
  if (!grid_blocks) {
    int dev = 0, cus = 0, per_cu = 0;
    hipGetDevice(&dev);
    hipDeviceGetAttribute(&cus, hipDeviceAttributeMultiprocessorCount, dev);
    hipOccupancyMaxActiveBlocksPerMultiprocessor(&per_cu, mega_kernel, 512, 0);
    if (per_cu > 1) per_cu = 1;
    grid_blocks = cus * per_cu;
    if (grid_blocks <= 0) grid_blocks = 256;
  }
  void* args[] = {&p};
  hipError_t e = hipLaunchCooperativeKernel((void*)mega_kernel, dim3(grid_blocks), dim3(512), args, 0, stream);
  if (e != hipSuccess) fprintf(stderr, "cooperative launch failed: %s (grid %d)\n", hipGetErrorString(e), grid_blocks);
#endif
}
```

```cpp
#include <hip/hip_runtime.h>
#include <hip/hip_cooperative_groups.h>
#include <cstdio>
#include <cstdint>
namespace cg = cooperative_groups;

typedef unsigned short bf16_t;
typedef short bf16x8 __attribute__((ext_vector_type(8)));
typedef short s16x4 __attribute__((ext_vector_type(4)));
typedef float f32x16 __attribute__((ext_vector_type(16)));
typedef float f32x4 __attribute__((ext_vector_type(4)));
typedef float f32x2 __attribute__((ext_vector_type(2)));
typedef __bf16 bf16x2_t __attribute__((ext_vector_type(2)));
typedef unsigned u32x2 __attribute__((ext_vector_type(2)));
typedef unsigned u32x4 __attribute__((ext_vector_type(4)));
#define LDS_AS __attribute__((address_space(3)))
#define DI __device__ __forceinline__

constexpr int D = 1024, NB = 4, SEQ = 8192, NCTX = 256;
constexpr int TL = NB * SEQ;
constexpr int TC = NB * NCTX;
constexpr int T = TL + TC;
constexpr int PN = 2720;
constexpr int C_QLAT = 0, C_KVLAT = 256, C_KPE = 384, C_SQ = 416, C_SK = 928, C_SV = 1056, C_DQ = 1184, C_DK = 1696, C_DV = 2208;
constexpr float EPS = 1e-6f;
constexpr float LOG2E = 1.4426950408889634f;
constexpr size_t W_IN = 0;
constexpr size_t W_UQ = W_IN + (size_t)5888 * 1024;
constexpr size_t W_UKV = W_UQ + 768 * 256;
constexpr size_t W_UPM = W_UKV + 1024 * 128;
constexpr size_t W_UPS = W_UPM + 1024 * 512;
constexpr size_t W_UPD = W_UPS + 1024 * 512;
constexpr size_t W_O = W_UPD + 1024 * 512;
constexpr size_t W_M1 = W_O + 1024 * 1024;
constexpr size_t W_M2 = W_M1 + (size_t)4096 * 1024;
constexpr size_t W_LAYER = W_M2 + (size_t)4096 * 1024;

struct Params {
  const float *x, *c, *ctx, *c_ctx, *w_mod, *b_mod, *g_norm_attn, *g_norm_mlp, *w_in, *g_q_lora, *w_uq, *g_kv_lora, *w_ukv,
      *g_mla_q, *g_mla_k, *w_up_mla, *g_swa_q, *g_swa_k, *swa_sink, *w_up_swa, *g_diff_q, *g_diff_k, *lambda_q1, *lambda_k1,
      *lambda_q2, *lambda_k2, *g_diff_sub, *w_up_diff, *w_o, *w_mlp_in, *w_mlp_out;
  float* out;
  float* modtab;
  float* consts;
  unsigned* bar;
  bf16_t* WB;
  bf16_t* H;
  bf16_t* PROJ;
  bf16_t* MQ;
  bf16_t* KV;
  bf16_t* KM;
  float* CX;
  bf16_t* YD0;
  int probe, pad_;
};

template <class Tp> DI Tp* opq(Tp* ptr) { asm volatile("" : "+s"(ptr)); return ptr; }
DI int tidx() { int t = threadIdx.x; asm volatile("" : "+v"(t)); return t; }
DI float bf2f(bf16_t v) { return __uint_as_float((unsigned)v << 16); }
DI unsigned pk2(float a, float b) { f32x2 v = {a, b}; bf16x2_t r = __builtin_convertvector(v, bf16x2_t); return __builtin_bit_cast(unsigned, r); }
DI bf16_t f2bf(float a) { return (bf16_t)(pk2(a, 0.f) & 0xffffu); }
DI float wave_sum(float v) {
#pragma unroll
  for (int o = 32; o; o >>= 1) v += __shfl_xor(v, o);
  return v;
}
DI float wave_max(float v) {
#pragma unroll
  for (int o = 32; o; o >>= 1) v = fmaxf(v, __shfl_xor(v, o));
  return v;
}
DI float silu(float x) { return x / (1.f + __expf(-x)); }
DI int xcd_remap(int L, int n) {
  const int q = n >> 3, r = n & 7, xcd = L & 7, off = L >> 3;
  return (xcd < r ? xcd * (q + 1) : r * (q + 1) + (xcd - r) * q) + off;
}
DI void glds16(const void* g, LDS_AS unsigned char* l) {
  __builtin_amdgcn_global_load_lds((const unsigned*)g, (LDS_AS unsigned*)l, 16, 0, 0);
}
DI void glds16a(const void* base, unsigned voff, unsigned ldsaddr) {
  unsigned keep;
  asm volatile("s_mov_b32 %0, m0\n\ts_mov_b32 m0, %3\n\ts_nop 0\n\tglobal_load_lds_dwordx4 %1, %2\n\ts_mov_b32 m0, %0"
               : "=&s"(keep) : "v"(voff), "s"(base), "s"(ldsaddr) : "memory");
}
DI unsigned lds_u32(LDS_AS unsigned char* p) { return (unsigned)(uintptr_t)p; }
DI bf16x8 lds128(LDS_AS unsigned char* p) { return *(LDS_AS bf16x8*)p; }
#define MFMA32(a, b, c) __builtin_amdgcn_mfma_f32_32x32x16_bf16((a), (b), (c), 0, 0, 0)

#define XB_TMO      128
#define XB_XCNT(j)  (256  + 64 * (j))
#define XB_XSUB(j)  (1280 + 64 * (j))
#define XB_XGEN(j)  (2304 + 64 * (j))
#define XB_TOP      3328
#define XB_TOPGEN   3392
#define XCD_BAR_WORDS 3456
#define XB_SPIN_CAP (1u << 22)
DI unsigned xb_ld(unsigned* p) { return __hip_atomic_load(p, __ATOMIC_RELAXED, __HIP_MEMORY_SCOPE_AGENT); }
DI unsigned xb_add(unsigned* p, unsigned v) { return __hip_atomic_fetch_add(p, v, __ATOMIC_RELAXED, __HIP_MEMORY_SCOPE_AGENT); }
DI unsigned xb_xcc_id() { return (unsigned)__builtin_amdgcn_s_getreg((3 << 11) | 20) & 0xFu; }
#define XB_SPIN(cond, bar) do { unsigned _sp = 0; while (cond) { __builtin_amdgcn_s_sleep(1); \
    if ((++_sp & 255u) == 0u) { if (xb_ld(&(bar)[XB_TMO])) break; if (_sp > XB_SPIN_CAP) { atomicAdd(&(bar)[XB_TMO], 1u); break; } } } } while (0)
struct XcdBarrier { unsigned* bar; unsigned x; volatile LDS_AS unsigned* st; };
DI XcdBarrier xcd_barrier_post(unsigned* bar, volatile LDS_AS unsigned* st) {
  XcdBarrier b; b.bar = bar; b.x = xb_xcc_id(); b.st = st;
  if (threadIdx.x == 0) (void)xb_add(&bar[XB_XCNT(b.x)], 1u);
  return b;
}
DI void xcd_barrier_complete(unsigned* bar, unsigned x, unsigned& nloc, unsigned& nx) {
  const unsigned G = gridDim.x * gridDim.y * gridDim.z;
  unsigned sum, cnt, mine, sp = 0u;
  for (;;) {
    sum = 0u; cnt = 0u; mine = 0u;
#pragma unroll
    for (unsigned j = 0; j < 16; ++j) { const unsigned c = xb_ld(&bar[XB_XCNT(j)]); sum += c; cnt += (c > 0u) ? 1u : 0u; mine = (j == x) ? c : mine; }
    if (sum == G) break;
    __builtin_amdgcn_s_sleep(1);
    if ((++sp & 255u) == 0u) { if (xb_ld(&bar[XB_TMO])) break; if (sp > XB_SPIN_CAP) { atomicAdd(&bar[XB_TMO], 1u); break; } }
  }
  nloc = mine > 0u ? mine : 1u; nx = cnt > 0u ? cnt : 1u;
}
DI void xcd_barrier(const XcdBarrier& b) {
  asm volatile("s_waitcnt vmcnt(0)" ::: "memory");
  __syncthreads();
  if (threadIdx.x == 0) {
    unsigned* bar = b.bar;
    __builtin_amdgcn_s_waitcnt(0);
    unsigned nloc = b.st[0], nx = b.st[1];
    if (nloc == 0u) { xcd_barrier_complete(bar, b.x, nloc, nx); b.st[0] = nloc; b.st[1] = nx; }
    const unsigned old = xb_add(&bar[XB_XSUB(b.x)], 1u);
    const unsigned gen = old / nloc;
    if (old + 1u == (gen + 1u) * nloc) {
      __builtin_amdgcn_fence(__ATOMIC_RELEASE, "agent");
      asm volatile("s_waitcnt vmcnt(0)" ::: "memory");
      const unsigned og = xb_add(&bar[XB_TOP], 1u);
      const unsigned tg = og / nx;
      if (og + 1u == (tg + 1u) * nx) xb_add(&bar[XB_TOPGEN], 1u);
      else XB_SPIN(xb_ld(&bar[XB_TOPGEN]) == tg, bar);
      __builtin_amdgcn_fence(__ATOMIC_ACQUIRE, "agent");
      xb_add(&bar[XB_XGEN(b.x)], 1u);
      asm volatile("s_waitcnt vmcnt(0)" ::: "memory");
    } else {
      XB_SPIN(xb_ld(&bar[XB_XGEN(b.x)]) == gen, bar);
      __builtin_amdgcn_fence(__ATOMIC_ACQUIRE, "agent");
      asm volatile("s_waitcnt vmcnt(0)" ::: "memory");
    }
  }
  __syncthreads();
}

struct ConvT { const float* src; bf16_t* dst; int ld, K, k0, n0, is_win; };
DI void conv_load(const ConvT& d, int tid, f32x4 (&v)[2]) {
  const int ty = tid >> 4, tx = tid & 15, n = d.n0 + 4 * tx;
  int sc = n;
  if (d.is_win) sc = (n < 2720) ? n : (n < 2816 ? -1 : n - 96);
#pragma unroll
  for (int i = 0; i < 2; ++i) {
    v[i] = (f32x4){0.f, 0.f, 0.f, 0.f};
    if (sc >= 0) v[i] = *(const f32x4*)(d.src + (size_t)(d.k0 + ty + 32 * i) * d.ld + sc);
  }
}
DI void conv_finish(const ConvT& d, int tid, const f32x4 (&v)[2], LDS_AS float* tile, int dry) {
  const int ty = tid >> 4, tx = tid & 15;
#pragma unroll
  for (int i = 0; i < 2; ++i) {
    const int k = ty + 32 * i;
    tile[k * 65 + 4 * tx + 0] = v[i][0]; tile[k * 65 + 4 * tx + 1] = v[i][1]; tile[k * 65 + 4 * tx + 2] = v[i][2]; tile[k * 65 + 4 * tx + 3] = v[i][3];
  }
  __syncthreads();
  {
    const int r = tid >> 3, c = tid & 7;
    u32x4 w;
    w[0] = pk2(tile[(8 * c + 0) * 65 + r], tile[(8 * c + 1) * 65 + r]);
    w[1] = pk2(tile[(8 * c + 2) * 65 + r], tile[(8 * c + 3) * 65 + r]);
    w[2] = pk2(tile[(8 * c + 4) * 65 + r], tile[(8 * c + 5) * 65 + r]);
    w[3] = pk2(tile[(8 * c + 6) * 65 + r], tile[(8 * c + 7) * 65 + r]);
    if (!dry) *(u32x4*)(d.dst + (size_t)(d.n0 + r) * d.K + d.k0 + 8 * c) = w;
  }
}
DI ConvT conv_decode(const Params& p, int t) {
  ConvT d; d.is_win = 0;
  const int l = t / 4240; int u = t % 4240; size_t doff;
  if (u < 1472) { d.src = p.w_in + (size_t)l * 1024 * 5792; d.ld = 5792; d.K = 1024; d.is_win = 1; doff = W_IN; }
  else if (u < 1520) { u -= 1472; d.src = p.w_uq + (size_t)l * 256 * 768; d.ld = 768; d.K = 256; doff = W_UQ; }
  else if (u < 1552) { u -= 1520; d.src = p.w_ukv + (size_t)l * 128 * 1024; d.ld = 1024; d.K = 128; doff = W_UKV; }
  else if (u < 1680) { u -= 1552; d.src = p.w_up_mla + (size_t)l * 512 * 1024; d.ld = 1024; d.K = 512; doff = W_UPM; }
  else if (u < 1808) { u -= 1680; d.src = p.w_up_swa + (size_t)l * 512 * 1024; d.ld = 1024; d.K = 512; doff = W_UPS; }
  else if (u < 1936) { u -= 1808; d.src = p.w_up_diff + (size_t)l * 512 * 1024; d.ld = 1024; d.K = 512; doff = W_UPD; }
  else if (u < 2192) { u -= 1936; d.src = p.w_o + (size_t)l * 1024 * 1024; d.ld = 1024; d.K = 1024; doff = W_O; }
  else if (u < 3216) { u -= 2192; d.src = p.w_mlp_in + (size_t)l * 1024 * 4096; d.ld = 4096; d.K = 1024; doff = W_M1; }
  else { u -= 3216; d.src = p.w_mlp_out + (size_t)l * 4096 * 1024; d.ld = 1024; d.K = 4096; doff = W_M2; }
  const int nkt = d.K >> 6;
  d.k0 = (u % nkt) * 64; d.n0 = (u / nkt) * 64; d.dst = p.WB + (size_t)l * W_LAYER + doff;
  return d;
}

DI void phase0(const Params& p, LDS_AS unsigned char* smem, int dry) {
  const int tid_ = tidx(), lane = tid_ & 63, wave = tid_ >> 6;
  if (blockIdx.x == 0 && wave == 0) {
    for (int l = 0; l < 2; ++l) {
      const float s1 = wave_sum(p.lambda_q1[l * 64 + lane] * p.lambda_k1[l * 64 + lane]);
      const float s2 = wave_sum(p.lambda_q2[l * 64 + lane] * p.lambda_k2[l * 64 + lane]);
      const float lam_init = 0.8f - 0.6f * expf(-0.3f * (float)l);
      const float lam = expf(s1) - expf(s2) + lam_init;
      float a = fabsf(p.g_mla_q[l * 96 + lane]); if (lane < 32) a = fmaxf(a, fabsf(p.g_mla_q[l * 96 + 64 + lane]));
      float b = fabsf(p.g_mla_k[l * 96 + lane]); if (lane < 32) b = fmaxf(b, fabsf(p.g_mla_k[l * 96 + 64 + lane]));
      const float mq = wave_max(a), mk = wave_max(b);
      const float sq = wave_max(fabsf(p.g_swa_q[l * 64 + lane])), sk = wave_max(fabsf(p.g_swa_k[l * 64 + lane]));
      const float dq = wave_max(fabsf(p.g_diff_q[l * 64 + lane])), dk = wave_max(fabsf(p.g_diff_k[l * 64 + lane]));
      if (lane == 0) {
        float* cs = p.consts + l * 16;
        cs[0] = lam; cs[1] = lam_init;
        cs[2] = LOG2E * sqrtf(96.f) * mq * mk;
        cs[3] = LOG2E * 8.f * sq * sk;
        cs[4] = LOG2E * 8.f * dq * dk;
      }
    }
  }
  for (int task = blockIdx.x * 8 + wave; task < 3072; task += gridDim.x * 8) {
    const int l = task / 1536, rem = task % 1536, chunk = rem >> 4, ks = rem & 15;
    const int n = chunk * 64 + lane;
    float acc[5] = {0.f, 0.f, 0.f, 0.f, 0.f};
    const float* w = p.w_mod + ((size_t)l * 1024 + ks * 64) * 6144 + n;
    float sil[5];
#pragma unroll
    for (int r = 0; r < 4; ++r) sil[r] = silu(p.c[r * 1024 + ks * 64 + lane]);
    sil[4] = silu(p.c_ctx[ks * 64 + lane]);
#pragma unroll 16
    for (int k = 0; k < 64; ++k) {
      const float wv = w[(size_t)k * 6144];
#pragma unroll
      for (int r = 0; r < 5; ++r) acc[r] += __int_as_float(__builtin_amdgcn_readlane(__float_as_int(sil[r]), k)) * wv;
    }
    const float bias = (ks == 0) ? p.b_mod[l * 6144 + n] : 0.f;
    if (!dry)
#pragma unroll
      for (int r = 0; r < 5; ++r) atomicAdd(p.modtab + (size_t)(l * 5 + r) * 6144 + n, acc[r] + bias);
  }
  {
    constexpr int NTI = 4, TBUF = 64 * 65 + 16;
    LDS_AS float* tile0 = (LDS_AS float*)smem;
    const int tid = tidx(), G = gridDim.x, NTOT = 2 * 4240;
    for (int t = blockIdx.x; t < NTOT; t += NTI * G) {
      ConvT d[NTI]; f32x4 v[NTI][2];
#pragma unroll
      for (int q = 0; q < NTI; ++q) { d[q] = conv_decode(p, (t + q * G < NTOT) ? t + q * G : t); conv_load(d[q], tid, v[q]); }
      __syncthreads();
#pragma unroll
      for (int q = 0; q < NTI; ++q)
        if (t + q * G < NTOT) conv_finish(d[q], tid, v[q], tile0 + q * TBUF, dry);
    }
    __syncthreads();
  }
}

DI void norm_phase(const Params& p, int l, int which, int dry) {
  const int tid_ = tidx(), lane = tid_ & 63, wave = tid_ >> 6;
  const float* g = (which == 0 ? p.g_norm_attn : p.g_norm_mlp) + l * 1024;
  const int shoff = which == 0 ? 0 : 3072, scoff = shoff + 1024;
  const int nrows = (which == 1 && l == 1) ? TL : T;
  const bool first = (which == 0 && l == 0);
  const float* px = opq(p.x); const float* pctx = opq(p.ctx); const float* pout = opq((const float*)p.out); const float* pcx = opq((const float*)p.CX);
  const float* slat = first ? px : pout; const float* sctx = first ? pctx : pcx;
  for (int row = blockIdx.x * 8 + wave; row < nrows; row += gridDim.x * 8) {
    const float* xr; int bidx;
    if (row < TL) { xr = slat + (size_t)row * 1024; bidx = row >> 13; }
    else { xr = sctx + (size_t)(row - TL) * 1024; bidx = 4; }
    const float* mod = p.modtab + (size_t)(l * 5 + bidx) * 6144;
    f32x4 v[4]; float ss = 0.f;
#pragma unroll
    for (int i = 0; i < 4; ++i) { v[i] = *(const f32x4*)(xr + i * 256 + lane * 4); ss += v[i][0] * v[i][0] + v[i][1] * v[i][1] + v[i][2] * v[i][2] + v[i][3] * v[i][3]; }
    ss = wave_sum(ss);
    const float rstd = rsqrtf(ss * (1.f / 1024.f) + EPS);
#pragma unroll
    for (int i = 0; i < 4; ++i) {
      const int col = i * 256 + lane * 4;
      const f32x4 gv = *(const f32x4*)(g + col), sh = *(const f32x4*)(mod + shoff + col), sc = *(const f32x4*)(mod + scoff + col);
      float o[4];
#pragma unroll
      for (int j = 0; j < 4; ++j) o[j] = (v[i][j] * rstd * gv[j]) * (1.f + sc[j]) + sh[j];
      u32x2 w = {pk2(o[0], o[1]), pk2(o[2], o[3])};
      if (!dry) *(u32x2*)(p.H + (size_t)row * 1024 + col) = w;
    }
  }
}

constexpr int GST = 49152;
DI void gemm_kloop(const bf16_t* Ag, int lda, int a_kstep, const bf16_t* Bg, int ldb, int nkt, f32x16 (&acc)[2][2], LDS_AS unsigned char* smem) {
  const int tid_ = tidx(), lane = tid_ & 63, wave = tid_ >> 6, h = lane >> 5, wm = wave >> 1, wn = wave & 1;
  unsigned aoff[4], boff[2];
#pragma unroll
  for (int i = 0; i < 4; ++i) {
    const int r = wave * 32 + i * 8 + (lane >> 3), c = (lane & 7) ^ ((r >> 1) & 7);
    aoff[i] = (unsigned)(r * lda + c * 8) * 2u;
  }
#pragma unroll
  for (int i = 0; i < 2; ++i) {
    const int r = wave * 16 + i * 8 + (lane >> 3), c = (lane & 7) ^ ((r >> 1) & 7);
    boff[i] = (unsigned)(r * ldb + c * 8) * 2u;
  }
  const unsigned dstA = (unsigned)__builtin_amdgcn_readfirstlane((int)(lds_u32(smem) + wave * 4096));
  const unsigned dstB = (unsigned)__builtin_amdgcn_readfirstlane((int)(lds_u32(smem) + 32768 + wave * 2048));
  const int swz = (lane >> 1) & 7;
  const int arow = (wm * 64 + (lane & 31)) * 128, brow = 32768 + (wn * 64 + (lane & 31)) * 128;
  asm volatile("s_waitcnt vmcnt(0)" ::: "memory");
  __syncthreads();
  auto issue = [&](int kt, int stg) {
    const char* An = (const char*)(Ag + (size_t)kt * a_kstep); const char* Bn = (const char*)(Bg + (size_t)kt * 64);
#pragma unroll
    for (int i = 0; i < 4; ++i) glds16a(An, aoff[i], dstA + stg * GST + i * 1024);
#pragma unroll
    for (int i = 0; i < 2; ++i) glds16a(Bn, boff[i], dstB + stg * GST + i * 1024);
  };
  issue(0, 0);
  if (nkt > 1) issue(1, 1);
  int st = 0;
#pragma unroll 1
  for (int kt = 0; kt < nkt; ++kt) {
    if (kt + 1 < nkt) asm volatile("s_waitcnt vmcnt(6)" ::: "memory"); else asm volatile("s_waitcnt vmcnt(0)" ::: "memory");
    __builtin_amdgcn_s_barrier();
    asm volatile("" ::: "memory");
    if (kt + 2 < nkt) issue(kt + 2, st >= 1 ? st - 1 : 2);
    LDS_AS unsigned char* sa = smem + st * GST;
#pragma unroll
    for (int s = 0; s < 4; ++s) {
      const int co = ((2 * s + h) ^ swz) << 4;
      const bf16x8 a0 = lds128(sa + arow + co), a1 = lds128(sa + arow + 32 * 128 + co);
      const bf16x8 b0 = lds128(sa + brow + co), b1 = lds128(sa + brow + 32 * 128 + co);
      acc[0][0] = MFMA32(b0, a0, acc[0][0]); acc[0][1] = MFMA32(b1, a0, acc[0][1]);
      acc[1][0] = MFMA32(b0, a1, acc[1][0]); acc[1][1] = MFMA32(b1, a1, acc[1][1]);
    }
    st = (st == 2) ? 0 : st + 1;
  }
}
DI void zero_acc(f32x16 (&acc)[2][2]) {
#pragma unroll
  for (int a = 0; a < 2; ++a)
#pragma unroll
    for (int b = 0; b < 2; ++b)
#pragma unroll
      for (int i = 0; i < 16; ++i) acc[a][b][i] = 0.f;
}
DI void tile_decode(int id, int NT, int& mt, int& nt) { const int per = 4 * NT, g = id / per, w = id % per; mt = g * 4 + (w & 3); nt = w >> 2; }

constexpr int EPW = 17408;
template <int ACT> DI LDS_AS unsigned char* stage_tile(const f32x16 (&acc)[2][2], LDS_AS unsigned char* smem) {
  const int tid_ = tidx(), lane = tid_ & 63, wave = tid_ >> 6, h = lane >> 5;
  __syncthreads();
  LDS_AS unsigned char* reg = smem + wave * EPW;
#pragma unroll
  for (int bi = 0; bi < 2; ++bi)
#pragma unroll
    for (int bj = 0; bj < 2; ++bj)
#pragma unroll
      for (int g = 0; g < 4; ++g) {
        f32x4 v;
#pragma unroll
        for (int j = 0; j < 4; ++j) { v[j] = acc[bi][bj][4 * g + j]; if (ACT == 1) { v[j] = fmaxf(v[j], 0.f); v[j] *= v[j]; } }
        *(LDS_AS f32x4*)(reg + (bi * 32 + (lane & 31)) * 272 + (bj * 32 + 8 * g + 4 * h) * 4) = v;
      }
  return reg;
}
template <int ACT> DI void epi_store_bf16(const f32x16 (&acc)[2][2], bf16_t* dst, int ldc, int row0, int col0, int ncols, LDS_AS unsigned char* smem) {
  LDS_AS unsigned char* reg = stage_tile<ACT>(acc, smem);
  const int tid_ = tidx(), lane = tid_ & 63, wave = tid_ >> 6, wm = wave >> 1, wn = wave & 1;
  const int c = (lane & 7) * 8, col = col0 + wn * 64 + c;
#pragma unroll
  for (int i = 0; i < 8; ++i) {
    const int r = i * 8 + (lane >> 3);
    const f32x4 a = *(LDS_AS f32x4*)(reg + r * 272 + c * 4), b = *(LDS_AS f32x4*)(reg + r * 272 + c * 4 + 16);
    u32x4 w = {pk2(a[0], a[1]), pk2(a[2], a[3]), pk2(b[0], b[1]), pk2(b[2], b[3])};
    if (col < ncols) *(u32x4*)(dst + (size_t)(row0 + wm * 64 + r) * ldc + col) = w;
  }
}
DI void epi_residual(const f32x16 (&acc)[2][2], const float* xin, float* xout, const float* gate, int row0, int col0, LDS_AS unsigned char* smem) {
  LDS_AS unsigned char* reg = stage_tile<0>(acc, smem);
  const int tid_ = tidx(), lane = tid_ & 63, wave = tid_ >> 6, wm = wave >> 1, wn = wave & 1;
  const int c = (lane & 15) * 4, col = col0 + wn * 64 + c;
  const f32x4 gv = *(const f32x4*)(gate + col);
#pragma unroll
  for (int i = 0; i < 16; ++i) {
    const int r = i * 4 + (lane >> 4);
    const size_t off = (size_t)(row0 + wm * 64 + r) * 1024 + col;
    const f32x4 a = *(LDS_AS f32x4*)(reg + r * 272 + c * 4), xi = *(const f32x4*)(xin + off);
    f32x4 o;
#pragma unroll
    for (int j = 0; j < 4; ++j) o[j] = xi[j] + gv[j] * a[j];
    *(f32x4*)(xout + off) = o;
  }
}

constexpr int G2ST = 65536;
DI void gemm_kloop2(const bf16_t* Ag, int lda, const bf16_t* Bg, int ldb, int nkt  , f32x16 (&acc)[4][2], LDS_AS unsigned char* smem) {
  const int tid_ = tidx(), lane = tid_ & 63, wave = tid_ >> 6, h = lane >> 5, wm = wave >> 2, wn = wave & 3;
  unsigned aoff[4], boff[4];
#pragma unroll
  for (int i = 0; i < 4; ++i) {
    const int r = wave * 32 + i * 8 + (lane >> 3), c = (lane & 7) ^ ((r >> 1) & 7);
    aoff[i] = (unsigned)(r * lda + c * 8) * 2u; boff[i] = (unsigned)(r * ldb + c * 8) * 2u;
  }
  const unsigned dstA = (unsigned)__builtin_amdgcn_readfirstlane((int)(lds_u32(smem) + wave * 4096));
  const unsigned dstB = dstA + 32768;
  const int swz = (lane >> 1) & 7;
  const int arow = (wm * 128 + (lane & 31)) * 128, brow = 32768 + (wn * 64 + (lane & 31)) * 128;
  asm volatile("s_waitcnt vmcnt(0)" ::: "memory");
  __syncthreads();
  auto issue = [&](int kt, int stg) {
    const char* An = (const char*)(Ag + (size_t)kt * 64); const char* Bn = (const char*)(Bg + (size_t)kt * 64);
#pragma unroll
    for (int i = 0; i < 4; ++i) glds16a(An, aoff[i], dstA + stg * G2ST + i * 1024);
#pragma unroll
    for (int i = 0; i < 4; ++i) glds16a(Bn, boff[i], dstB + stg * G2ST + i * 1024);
  };
  issue(0, 0);
#pragma unroll 1
  for (int kt = 0; kt < nkt; ++kt) {
    asm volatile("s_waitcnt vmcnt(0)" ::: "memory");
    __builtin_amdgcn_s_barrier();
    asm volatile("" ::: "memory");
    if (kt + 1 < nkt) issue(kt + 1, (kt + 1) & 1);
    LDS_AS unsigned char* sa = smem + (kt & 1) * G2ST;
#pragma unroll
    for (int s = 0; s < 4; ++s) {
      const int co = ((2 * s + h) ^ swz) << 4;
      bf16x8 fa[4], fb[2];
#pragma unroll
      for (int bi = 0; bi < 4; ++bi) fa[bi] = lds128(sa + arow + bi * 32 * 128 + co);
#pragma unroll
      for (int bj = 0; bj < 2; ++bj) fb[bj] = lds128(sa + brow + bj * 32 * 128 + co);
#pragma unroll
      for (int bi = 0; bi < 4; ++bi)
#pragma unroll
        for (int bj = 0; bj < 2; ++bj) acc[bi][bj] = MFMA32(fb[bj], fa[bi], acc[bi][bj]);
    }
  }
}
DI void zero_acc2(f32x16 (&acc)[4][2]) {
#pragma unroll
  for (int a = 0; a < 4; ++a)
#pragma unroll
    for (int b = 0; b < 2; ++b)
#pragma unroll
      for (int i = 0; i < 16; ++i) acc[a][b][i] = 0.f;
}
template <int ACT, int HF> DI void stage_half(const f32x16 (&acc)[4][2], LDS_AS unsigned char* reg, int lane, int h) {
#pragma unroll
  for (int bi = 0; bi < 2; ++bi)
#pragma unroll
    for (int bj = 0; bj < 2; ++bj)
#pragma unroll
      for (int g = 0; g < 4; ++g) {
        f32x4 v;
#pragma unroll
        for (int j = 0; j < 4; ++j) { v[j] = acc[2 * HF + bi][bj][4 * g + j]; if (ACT == 1) { v[j] = fmaxf(v[j], 0.f); v[j] *= v[j]; } }
        *(LDS_AS f32x4*)(reg + (bi * 32 + (lane & 31)) * 272 + (bj * 32 + 8 * g + 4 * h) * 4) = v;
      }
}
template <int ACT, int HF> DI void epi2_half_bf16(const f32x16 (&acc)[4][2], bf16_t* dst, int ldc, int row0, int col0, int ncols, LDS_AS unsigned char* smem) {
  const int tid_ = tidx(), lane = tid_ & 63, wave = tid_ >> 6, h = lane >> 5, wm = wave >> 2, wn = wave & 3;
  LDS_AS unsigned char* reg = smem + wave * EPW;
  stage_half<ACT, HF>(acc, reg, lane, h);
  const int c = (lane & 7) * 8, col = col0 + wn * 64 + c;
#pragma unroll
  for (int i = 0; i < 8; ++i) {
    const int r = i * 8 + (lane >> 3);
    const f32x4 a = *(LDS_AS f32x4*)(reg + r * 272 + c * 4), b = *(LDS_AS f32x4*)(reg + r * 272 + c * 4 + 16);
    u32x4 w = {pk2(a[0], a[1]), pk2(a[2], a[3]), pk2(b[0], b[1]), pk2(b[2], b[3])};
    if (col < ncols) *(u32x4*)(dst + (size_t)(row0 + wm * 128 + HF * 64 + r) * ldc + col) = w;
  }
}
template <int ACT> DI void epi2_store_bf16(const f32x16 (&acc)[4][2], bf16_t* dst, int ldc, int row0, int col0, int ncols, LDS_AS unsigned char* smem) {
  __syncthreads();
  epi2_half_bf16<ACT, 0>(acc, dst, ldc, row0, col0, ncols, smem);
  epi2_half_bf16<ACT, 1>(acc, dst, ldc, row0, col0, ncols, smem);
}
template <int HF> DI void epi2_half_residual(const f32x16 (&acc)[4][2], const float* xin, float* xout, const float* gate, int row0, int col0, LDS_AS unsigned char* smem) {
  const int tid_ = tidx(), lane = tid_ & 63, wave = tid_ >> 6, h = lane >> 5, wm = wave >> 2, wn = wave & 3;
  LDS_AS unsigned char* reg = smem + wave * EPW;
  stage_half<0, HF>(acc, reg, lane, h);
  const int c = (lane & 15) * 4, col = col0 + wn * 64 + c;
  const f32x4 gv = *(const f32x4*)(gate + col);
#pragma unroll
  for (int i = 0; i < 16; ++i) {
    const int r = i * 4 + (lane >> 4);
    const size_t off = (size_t)(row0 + wm * 128 + HF * 64 + r) * 1024 + col;
    const f32x4 a = *(LDS_AS f32x4*)(reg + r * 272 + c * 4), xi = *(const f32x4*)(xin + off);
    f32x4 o;
#pragma unroll
    for (int j = 0; j < 4; ++j) o[j] = xi[j] + gv[j] * a[j];
    *(f32x4*)(xout + off) = o;
  }
}
DI void epi2_residual(const f32x16 (&acc)[4][2], const float* xin, float* xout, const float* gate, int row0, int col0, LDS_AS unsigned char* smem) {
  __syncthreads();
  epi2_half_residual<0>(acc, xin, xout, gate, row0, col0, smem);
  epi2_half_residual<1>(acc, xin, xout, gate, row0, col0, smem);
}

namespace pg8 {
typedef float f32x2v __attribute__((ext_vector_type(2)));
constexpr int BM = 256, BK = 64, HALF = 128, HTB = HALF * BK * 2, STAGE_BYTES = 8 * HTB, NXCD = 8, WGM = 8;
DI int lds_byte(int r, int c) { const int st = (r >> 4) * 2 + (c >> 5), rr = r & 15, cc = c & 31, ob = rr * 64 + cc * 2; return st * 1024 + (ob ^ (((ob >> 9) & 1) << 5)); }
DI void stage_rc(int b, int& R, int& C) { const int st = b / 1024, sb = b % 1024, swz = sb ^ (((sb >> 9) & 1) << 5); R = (st >> 1) * 16 + swz / 64; C = (st & 1) * 32 + (swz % 64) / 2; }
DI int perm32(int rho) { const int n = rho >> 4, i = rho & 15; return 8 * (i >> 2) + 4 * n + (i & 3); }
struct Unit { int pm, pn; };
struct Gemm { const bf16_t* A; const bf16_t* Bt; int M, N, K; };
struct StaticOrder {
    int nM, nN, nwg, G, c;
    DI void init(int M, int N, int G_, int c_) { nM = M / BM; nN = N / BM; nwg = nM * nN; G = G_; c = c_; }
    DI bool next(int i, Unit& u) const {
        const long L = (long)i * G + c; if (L >= nwg) return false;
        int wgid = (int)L; { const int q = nwg / NXCD, r = nwg % NXCD, xcd = wgid % NXCD, off = wgid / NXCD; wgid = (xcd < r ? xcd * (q + 1) : r * (q + 1) + (xcd - r) * q) + off; }
        const int nig = WGM * nN, gid = wgid / nig, fm = gid * WGM, gsz = (nM - fm) < WGM ? (nM - fm) : WGM;
        u.pm = fm + ((wgid % nig) % gsz); u.pn = (wgid % nig) / gsz; return true;
    }
    DI void a_ready(const Unit&) const {}
    DI void done(const Unit&) const {}
};
template <int ACT  > struct EpiBf16 {
    static constexpr bool PERM = true, AFTER_DRAIN = false;
    bf16_t* O; int ldc, ncols, dry;
    DI void operator()(const f32x4 (&acc)[2][2][4][2], const Unit& u, int wr, int wc, int fr, int fq) const {
        if (dry) return;
        const int row0 = u.pm * BM + wr * 64 + fr, col0 = u.pn * BM + wc * 32 + 8 * fq;
#pragma unroll
        for (int ai = 0; ai < 2; ++ai)
#pragma unroll
            for (int m = 0; m < 4; ++m) { bf16_t* rowp = O + (size_t)(row0 + ai * HALF + m * 16) * ldc + col0;
#pragma unroll
                for (int bj = 0; bj < 2; ++bj) { f32x4 v0 = acc[ai][bj][m][0], v1 = acc[ai][bj][m][1];
                    if (ACT == 1) {
#pragma unroll
                        for (int j = 0; j < 4; ++j) { v0[j] = fmaxf(v0[j], 0.f); v0[j] *= v0[j]; v1[j] = fmaxf(v1[j], 0.f); v1[j] *= v1[j]; } }
                    u32x4 w = {pk2(v0[0], v0[1]), pk2(v0[2], v0[3]), pk2(v1[0], v1[1]), pk2(v1[2], v1[3])};
                    if (col0 + bj * HALF < ncols) *(u32x4*)(rowp + bj * HALF) = w; } }
    }
};
struct EpiResid {
    static constexpr bool PERM = false, AFTER_DRAIN = false;
    const float* xin; float* xout; const float* gate; int dry;
    DI void operator()(const f32x4 (&acc)[2][2][4][2], const Unit& u, int wr, int wc, int fr, int fq) const {
        if (dry) return;
        const int row0 = u.pm * BM + wr * 64 + fr, col0 = u.pn * BM + wc * 32 + 4 * fq;
        const float* gv = gate + (size_t)((u.pm * BM) >> 13) * 6144 + col0;
        f32x4 g[2][2];
#pragma unroll
        for (int bj = 0; bj < 2; ++bj)
#pragma unroll
            for (int n = 0; n < 2; ++n) g[bj][n] = *(const f32x4*)(gv + bj * HALF + n * 16);
#pragma unroll
        for (int ai = 0; ai < 2; ++ai)
#pragma unroll
            for (int m = 0; m < 4; ++m) { const size_t off = (size_t)(row0 + ai * HALF + m * 16) * 1024 + col0;
#pragma unroll
                for (int bj = 0; bj < 2; ++bj)
#pragma unroll
                    for (int n = 0; n < 2; ++n) { const f32x4 xi = *(const f32x4*)(xin + off + bj * HALF + n * 16);
                        *(f32x4*)(xout + off + bj * HALF + n * 16) = xi + g[bj][n] * acc[ai][bj][m][n]; } }
    }
};
template <class Epi, class Sched, bool STAMP = false>
__device__ __forceinline__ void gemm_phase(LDS_AS unsigned char* lds, const Gemm g, const Sched& S, const Epi& E, unsigned long long* stamps) {
    const int tid = tidx(), wid = __builtin_amdgcn_readfirstlane(tid >> 6), lane = tid & 63, wr = wid >> 2, wc = wid & 3, fr = lane & 15, fq = lane >> 4;
    const int K = g.K, nt = K / BK;
    int ts_lo = 0, ts_hi = 0, nts = 0; const unsigned long long rt_entry = STAMP ? 0ull : 0ull;
#define PG8_STAMP() do { if (STAMP && wid == 0 && nts < 64) { const unsigned long long _c = (unsigned long long)clock64(); \
        ts_lo = (lane == nts) ? (int)(unsigned)_c : ts_lo; ts_hi = (lane == nts) ? (int)(unsigned)(_c >> 32) : ts_hi; ++nts; } } while (0)
    PG8_STAMP();
    unsigned voffA[2], voffB[2];
#pragma unroll
    for (int i = 0; i < 2; ++i) { int R, C; stage_rc(tid * 16 + i * 8192, R, C); const int Rb = Epi::PERM ? ((R & ~31) + perm32(R & 31)) : R;
        voffA[i] = (unsigned)(R * K + C) * 2u; voffB[i] = (unsigned)(Rb * K + C) * 2u; }
    const size_t kstep = (size_t)(BK * 2);
    const size_t hstep = (size_t)HALF * K * 2;
    const size_t tstep = 2 * hstep;
    const unsigned ldsw = (unsigned)wid * 1024u; const unsigned ldsbase = (unsigned)__builtin_amdgcn_readfirstlane((int)lds_u32(lds));
    const int aoff = lds_byte(wr * 64 + fr, fq * 8), boff = lds_byte(wc * 32 + fr, fq * 8);
#define PG8_SA(b, h) (((b) * 2 + (h)) * HTB)
#define PG8_SB(b, h) ((4 + (b) * 2 + (h)) * HTB)
#define PG8_STAGE(bufoff, gbase, voff) do { _Pragma("unroll") for (int _i = 0; _i < 2; ++_i) \
        glds16a((const void*)(gbase), (voff)[_i], ldsbase + (unsigned)(bufoff) + ldsw + (unsigned)_i * 8192u); } while (0)
#define PG8_LDA(dst, b, h) do { _Pragma("unroll") for (int m = 0; m < 4; ++m) _Pragma("unroll") for (int k = 0; k < 2; ++k) dst[m][k] = *(const LDS_AS bf16x8*)(lds + PG8_SA(b, h) + aoff + m * 2048 + k * 1024); } while (0)
#define PG8_LDB(dst, b, h) do { _Pragma("unroll") for (int n = 0; n < 2; ++n) _Pragma("unroll") for (int k = 0; k < 2; ++k) dst[n][k] = *(const LDS_AS bf16x8*)(lds + PG8_SB(b, h) + boff + n * 2048 + k * 1024); } while (0)
#define PG8_MMA(ai, bj, At, Bt) do { __builtin_amdgcn_s_setprio(1); _Pragma("unroll") for (int m = 0; m < 4; ++m) _Pragma("unroll") for (int n = 0; n < 2; ++n) _Pragma("unroll") for (int k = 0; k < 2; ++k) \
        acc[ai][bj][m][n] = __builtin_amdgcn_mfma_f32_16x16x32_bf16(Bt[n][k], At[m][k], acc[ai][bj][m][n], 0, 0, 0); __builtin_amdgcn_s_setprio(0); } while (0)
#define PG8_WAIT_V(n) asm volatile("s_waitcnt vmcnt(" #n ")" ::: "memory")
#define PG8_WAIT_L(n) asm volatile("s_waitcnt lgkmcnt(" #n ")" ::: "memory")
#define PG8_BAR __builtin_amdgcn_s_barrier()
#define PG8_SCHED __builtin_amdgcn_sched_barrier(0)
    Unit cur, nxt; int ui = 0;
    if (!S.next(0, cur)) return;
    f32x4 acc[2][2][4][2];
#pragma unroll
    for (int a = 0; a < 2; ++a)
#pragma unroll
        for (int b = 0; b < 2; ++b)
#pragma unroll
            for (int m = 0; m < 4; ++m)
#pragma unroll
                for (int n = 0; n < 2; ++n) acc[a][b][m][n] = (f32x4){0.f, 0.f, 0.f, 0.f};
    bf16x8 At[4][2], B0[2][2], B1[2][2];
    const char* cA = (const char*)g.A + (size_t)cur.pm * tstep; const char* cB = (const char*)g.Bt + (size_t)cur.pn * tstep;
    S.a_ready(cur);
    PG8_STAGE(PG8_SB(0, 0), cB, voffB); PG8_STAGE(PG8_SA(0, 0), cA, voffA); PG8_STAGE(PG8_SB(0, 1), cB + hstep, voffB); PG8_STAGE(PG8_SA(0, 1), cA + hstep, voffA);
    if (wr == 1) PG8_BAR;
    PG8_WAIT_V(4); PG8_BAR;
    PG8_STAGE(PG8_SB(1, 0), cB + kstep, voffB); PG8_STAGE(PG8_SA(1, 0), cA + kstep, voffA); PG8_STAGE(PG8_SB(1, 1), cB + hstep + kstep, voffB);
    PG8_WAIT_V(6); PG8_BAR;
    PG8_STAMP();
    for (;;) {
        const bool has_next = S.next(ui + 1, nxt);
        const char* nA = has_next ? (const char*)g.A + (size_t)nxt.pm * tstep : cA; const char* nB = has_next ? (const char*)g.Bt + (size_t)nxt.pn * tstep : cB;
        for (int t = 0; t < nt; t += 2) {
            const bool last = (t == nt - 2);
            const char* a1 = cA + (size_t)(t + 1) * kstep;
            const char* a2 = last ? nA : cA + (size_t)(t + 2) * kstep; const char* b2 = last ? nB : cB + (size_t)(t + 2) * kstep;
            const char* a3 = a2 + kstep; const char* b3 = b2 + kstep;
            if (last && has_next) S.a_ready(nxt);
            PG8_LDB(B0, 0, 0); PG8_SCHED; PG8_LDA(At, 0, 0); PG8_STAGE(PG8_SA(1, 1), a1 + hstep, voffA);
            PG8_WAIT_L(8); PG8_BAR; PG8_WAIT_L(0); PG8_MMA(0, 0, At, B0); PG8_BAR; PG8_SCHED;
            PG8_LDB(B1, 0, 1); PG8_STAGE(PG8_SB(0, 0), b2, voffB);
            PG8_BAR; PG8_WAIT_L(0); PG8_MMA(0, 1, At, B1); PG8_BAR;
            PG8_LDA(At, 0, 1); PG8_STAGE(PG8_SA(0, 0), a2, voffA);
            PG8_BAR; PG8_WAIT_L(0); PG8_MMA(1, 0, At, B0); PG8_BAR; PG8_SCHED;
            PG8_STAGE(PG8_SB(0, 1), b2 + hstep, voffB);
            PG8_WAIT_V(6); PG8_BAR; PG8_MMA(1, 1, At, B1); PG8_BAR;
            PG8_LDB(B0, 1, 0); PG8_SCHED; PG8_LDA(At, 1, 0); PG8_STAGE(PG8_SA(0, 1), a2 + hstep, voffA);
            PG8_WAIT_L(8); PG8_BAR; PG8_WAIT_L(0); PG8_MMA(0, 0, At, B0); PG8_BAR; PG8_SCHED;
            PG8_LDB(B1, 1, 1); PG8_STAGE(PG8_SB(1, 0), b3, voffB);
            PG8_BAR; PG8_WAIT_L(0); PG8_MMA(0, 1, At, B1); PG8_BAR;
            PG8_LDA(At, 1, 1); PG8_STAGE(PG8_SA(1, 0), a3, voffA);
            PG8_BAR; PG8_WAIT_L(0); PG8_MMA(1, 0, At, B0); PG8_BAR; PG8_SCHED;
            PG8_STAGE(PG8_SB(1, 1), b3 + hstep, voffB);
            PG8_WAIT_V(6); PG8_BAR; PG8_MMA(1, 1, At, B1); PG8_BAR;
        }
        PG8_STAMP();
        if constexpr (!Epi::AFTER_DRAIN) { E(acc, cur, wr, wc, fr, fq); S.done(cur); }
        PG8_STAMP();
        if (!has_next) break;
#pragma unroll
        for (int a = 0; a < 2; ++a)
#pragma unroll
            for (int b = 0; b < 2; ++b)
#pragma unroll
                for (int m = 0; m < 4; ++m)
#pragma unroll
                    for (int n = 0; n < 2; ++n) acc[a][b][m][n] = (f32x4){0.f, 0.f, 0.f, 0.f};
        cur = nxt; cA = nA; cB = nB; ++ui;
    }
    PG8_WAIT_V(0);
    if (wr == 0) PG8_BAR;
    PG8_BAR;
    if constexpr (Epi::AFTER_DRAIN) { E.fused(acc, cur, wr, wc, fr, fq, lds, wid, lane); S.done(cur); }
    PG8_STAMP();
    if (STAMP && wid == 0) { stamps[lane] = lane < nts ? (((unsigned long long)(unsigned)ts_hi << 32) | (unsigned)ts_lo) : 0ull;
        if (lane == 62) stamps[62] = rt_entry; if (lane == 63) stamps[63] = 0ull; }
#undef PG8_STAMP
#undef PG8_SA
#undef PG8_SB
#undef PG8_STAGE
#undef PG8_LDA
#undef PG8_LDB
#undef PG8_MMA
#undef PG8_WAIT_V
#undef PG8_WAIT_L
#undef PG8_BAR
#undef PG8_SCHED
}
}

DI void phase_gemm_in(const Params& p, int l, LDS_AS unsigned char* smem, int dry) {
  pg8::Gemm g; g.A = p.H; g.Bt = p.WB + (size_t)l * W_LAYER + W_IN; g.M = T; g.N = 2816; g.K = 1024;
  pg8::StaticOrder S; S.init(g.M, g.N, gridDim.x, blockIdx.x);
  pg8::EpiBf16<0> E; E.O = p.PROJ; E.ldc = PN; E.ncols = PN; E.dry = dry;
  __syncthreads();
  pg8::gemm_phase<pg8::EpiBf16<0>, pg8::StaticOrder, false>(smem, g, S, E, nullptr);
}
DI void phase_gemm_mla(const Params& p, int l, LDS_AS unsigned char* smem, int dry) {
  const bf16_t* WQ = p.WB + (size_t)l * W_LAYER + W_UQ; const bf16_t* WK = p.WB + (size_t)l * W_LAYER + W_UKV;
  const int NT = 7, ntiles = (T / 256) * NT;
  for (int i = blockIdx.x; i < ntiles; i += gridDim.x) {
    int mt, nt; tile_decode(xcd_remap(i, ntiles), NT, mt, nt);
    f32x16 acc[4][2]; zero_acc2(acc);
    if (nt < 3) {
      gemm_kloop2(p.PROJ + (size_t)mt * 256 * PN + C_QLAT, PN, WQ + (size_t)nt * 256 * 256, 256, 4, acc, smem);
      if (!dry) epi2_store_bf16<0>(acc, p.MQ, 768, mt * 256, nt * 256, 768, smem);
    } else {
      gemm_kloop2(p.PROJ + (size_t)mt * 256 * PN + C_KVLAT, PN, WK + (size_t)(nt - 3) * 256 * 128, 128, 2, acc, smem);
      if (!dry) epi2_store_bf16<0>(acc, p.KV, 1024, mt * 256, (nt - 3) * 256, 1024, smem);
    }
  }
}
DI void phase_merge(const Params& p, int l, LDS_AS unsigned char* smem, int dry) {
  const bf16_t* WL = p.WB + (size_t)l * W_LAYER;
  const int NT = 8, MT = (l == 1) ? TL / 256 : T / 256, ntiles = MT * NT;
  bf16_t* M = p.KV;
  for (int i = blockIdx.x; i < ntiles; i += gridDim.x) {
    int mt, nt; tile_decode(xcd_remap(i, ntiles), NT, mt, nt);
    unsigned tp[2][2][8];
#pragma unroll
    for (int a = 0; a < 2; ++a)
#pragma unroll
      for (int b = 0; b < 2; ++b)
#pragma unroll
        for (int e = 0; e < 8; ++e) tp[a][b][e] = 0u;
#pragma unroll 1
    for (int br = 0; br < 3; ++br) {
      unsigned gp[2][2][8];
      {
        f32x16 ag[2][2]; zero_acc(ag);
        gemm_kloop(p.H + (size_t)mt * 256 * 1024, 1024, 64, WL + W_IN + (size_t)(2816 + br * 1024 + nt * 128) * 1024, 1024, 16, ag, smem);
#pragma unroll
        for (int a = 0; a < 2; ++a)
#pragma unroll
          for (int b = 0; b < 2; ++b)
#pragma unroll
            for (int e = 0; e < 8; ++e)
              gp[a][b][e] = pk2(__builtin_amdgcn_rcpf(1.f + __builtin_amdgcn_exp2f(-LOG2E * ag[a][b][2 * e])),
                                __builtin_amdgcn_rcpf(1.f + __builtin_amdgcn_exp2f(-LOG2E * ag[a][b][2 * e + 1])));
      }
      f32x16 ay[2][2]; zero_acc(ay);
      const int lda = (br == 0) ? 768 : PN, kstep = (br == 0) ? 96 : 64;
      const size_t aofs = (br == 0) ? (size_t)T * PN : (size_t)(br == 1 ? C_SQ : C_DQ);
      __builtin_amdgcn_sched_barrier(0);
      gemm_kloop(p.PROJ + aofs + (size_t)mt * 256 * lda, lda, kstep, WL + W_UPM + (size_t)br * 1024 * 512 + (size_t)nt * 128 * 512, 512, 8, ay, smem);
#pragma unroll
      for (int a = 0; a < 2; ++a)
#pragma unroll
        for (int b = 0; b < 2; ++b)
#pragma unroll
          for (int e = 0; e < 8; ++e) {
            const float t0 = __uint_as_float(tp[a][b][e] << 16) + __uint_as_float(gp[a][b][e] << 16) * ay[a][b][2 * e];
            const float t1 = __uint_as_float(tp[a][b][e] & 0xffff0000u) + __uint_as_float(gp[a][b][e] & 0xffff0000u) * ay[a][b][2 * e + 1];
            tp[a][b][e] = pk2(t0, t1);
          }
    }
    if (!dry) {
      f32x16 tot[2][2];
#pragma unroll
      for (int a = 0; a < 2; ++a)
#pragma unroll
        for (int b = 0; b < 2; ++b)
#pragma unroll
          for (int e = 0; e < 8; ++e) { tot[a][b][2 * e] = __uint_as_float(tp[a][b][e] << 16); tot[a][b][2 * e + 1] = __uint_as_float(tp[a][b][e] & 0xffff0000u); }
      epi_store_bf16<0>(tot, M, 1024, mt * 256, nt * 128, 1024, smem);
    }
  }
}
DI void phase_residual_gemm(const Params& p, int l, int which, LDS_AS unsigned char* smem, int dry) {
  const bf16_t* WL = p.WB + (size_t)l * W_LAYER;
  const bf16_t* Abase = which == 0 ? (const bf16_t*)opq(p.KV) : (const bf16_t*)opq(p.PROJ);
  const int K = which == 0 ? 1024 : 4096;
  const bf16_t* W = WL + (which == 0 ? W_O : W_M2);
  const bool first = (which == 0 && l == 0);
  const float* px = opq(p.x); const float* pctx = opq(p.ctx); float* pout = opq(p.out); float* pcx = opq(p.CX);
  const float* slat = first ? px : (const float*)pout; const float* sctx = first ? pctx : (const float*)pcx;
  const float* gofs = p.modtab + (size_t)(l * 5) * 6144 + (which == 0 ? 2048 : 5120);
  {
    pg8::Gemm g; g.A = Abase; g.Bt = W; g.M = TL; g.N = 1024; g.K = K;
    pg8::StaticOrder S; S.init(g.M, g.N, gridDim.x, blockIdx.x);
    pg8::EpiResid E; E.xin = slat; E.xout = pout; E.gate = gofs; E.dry = dry;
    __syncthreads();
    pg8::gemm_phase<pg8::EpiResid, pg8::StaticOrder, false>(smem, g, S, E, nullptr);
  }
  if (l == 0) {
    const int i = (int)gridDim.x - 1 - (int)blockIdx.x;
    if (i < 32) {
      const int mt = TL / 256 + (i & 3), nt = i >> 2;
      f32x16 acc[2][2]; zero_acc(acc);
      gemm_kloop(Abase + (size_t)mt * 256 * K, K, 64, W + (size_t)nt * 128 * K, K, K / 64, acc, smem);
      if (!dry) epi_residual(acc, sctx, pcx, gofs + (size_t)4 * 6144, mt * 256 - TL, nt * 128, smem);
    }
  }
}
DI void phase_mlp_in(const Params& p, int l, LDS_AS unsigned char* smem, int dry) {
  pg8::Gemm g; g.A = p.H; g.Bt = p.WB + (size_t)l * W_LAYER + W_M1; g.M = (l == 1) ? TL : T; g.N = 4096; g.K = 1024;
  pg8::StaticOrder S; S.init(g.M, g.N, gridDim.x, blockIdx.x);
  pg8::EpiBf16<1> E; E.O = p.PROJ; E.ldc = 4096; E.ncols = 4096; E.dry = dry;
  __syncthreads();
  pg8::gemm_phase<pg8::EpiBf16<1>, pg8::StaticOrder, false>(smem, g, S, E, nullptr);
}

DI unsigned ld_u32(const bf16_t* p) { return *(const unsigned*)p; }
DI void unpack4(u32x2 raw, float (&v)[4]) {
  v[0] = __uint_as_float(raw[0] << 16); v[1] = __uint_as_float(raw[0] & 0xffff0000u); v[2] = __uint_as_float(raw[1] << 16); v[3] = __uint_as_float(raw[1] & 0xffff0000u);
}
DI void phase_prep_a(const Params& p, int l, int dry) {
  const int tid_ = tidx(), lane = tid_ & 63, wave = tid_ >> 6, vsel = lane >> 4, j16 = lane & 15;
  const f32x4 gsq = *(const f32x4*)(p.g_swa_q + l * 64 + 4 * j16), gsk = *(const f32x4*)(p.g_swa_k + l * 64 + 4 * j16);
  const f32x4 gdq = *(const f32x4*)(p.g_diff_q + l * 64 + 4 * j16), gdk = *(const f32x4*)(p.g_diff_k + l * 64 + 4 * j16);
  const f32x4 gql = *(const f32x4*)(p.g_q_lora + l * 256 + lane * 4);
  const f32x2 gkl = *(const f32x2*)(p.g_kv_lora + l * 128 + lane * 2);
  float freq[4];
#pragma unroll
  for (int jj = 0; jj < 4; ++jj) freq[jj] = __builtin_amdgcn_exp2f(-(float)(4 * (j16 & 3) + jj) * (13.287712379549449f / 16.f)) * 0.15915494309189535f;
  const float sgn = ((j16 >> 2) & 1) ? 1.f : -1.f;
  const int stride = gridDim.x * 8;
  for (int row0 = blockIdx.x * 8 + wave; row0 < T; row0 += 2 * stride) {
    u32x2 rq[2], rv[2][7]; unsigned rk[2];
#pragma unroll
    for (int t = 0; t < 2; ++t) {
      const int row = (row0 + t * stride < T) ? row0 + t * stride : row0;
      const bf16_t* base = p.PROJ + (size_t)row * PN;
      rq[t] = *(const u32x2*)(base + C_QLAT + lane * 4);
      rk[t] = ld_u32(base + C_KVLAT + lane * 2);
#pragma unroll
      for (int it = 0; it < 7; ++it) rv[t][it] = *(const u32x2*)(base + C_SQ + 64 * (4 * it + vsel) + 4 * j16);
    }
#pragma unroll
    for (int t = 0; t < 2; ++t) {
      const int row = row0 + t * stride;
      if (row >= T) break;
      bf16_t* base = p.PROJ + (size_t)row * PN;
      const bool islat = row < TL;
      float cs[4], sn[4];
      if (islat) {
        const int tt = row & 8191; const float pos = (float)((j16 >> 3) ? (tt & 63) : (tt >> 6));
#pragma unroll
        for (int jj = 0; jj < 4; ++jj) { const float rev = pos * freq[jj]; cs[jj] = __builtin_amdgcn_cosf(rev); sn[jj] = __builtin_amdgcn_sinf(rev); }
      } else {
#pragma unroll
        for (int jj = 0; jj < 4; ++jj) { cs[jj] = 1.f; sn[jj] = 0.f; }
      }
      {
        float v[4]; unpack4(rq[t], v);
        const float ss = wave_sum(v[0] * v[0] + v[1] * v[1] + v[2] * v[2] + v[3] * v[3]);
        const float rstd = rsqrtf(ss * (1.f / 256.f) + EPS);
        u32x2 w = {pk2(v[0] * rstd * gql[0], v[1] * rstd * gql[1]), pk2(v[2] * rstd * gql[2], v[3] * rstd * gql[3])};
        if (!dry) *(u32x2*)(base + C_QLAT + lane * 4) = w;
      }
      {
        const float v0 = __uint_as_float(rk[t] << 16), v1 = __uint_as_float(rk[t] & 0xffff0000u);
        const float ss = wave_sum(v0 * v0 + v1 * v1);
        const float rstd = rsqrtf(ss * (1.f / 128.f) + EPS);
        if (!dry) *(unsigned*)(base + C_KVLAT + lane * 2) = pk2(v0 * rstd * gkl[0], v1 * rstd * gkl[1]);
      }
#pragma unroll
      for (int it = 0; it < 7; ++it) {
        const f32x4 g = (it < 2) ? gsq : (it == 2 ? gsk : (it < 5 ? gdq : gdk));
        const float sc = (it < 2 || it == 3 || it == 4) ? 0.125f * LOG2E : 1.f;
        float v[4]; unpack4(rv[t][it], v);
        float ss = v[0] * v[0] + v[1] * v[1] + v[2] * v[2] + v[3] * v[3];
        ss += __shfl_xor(ss, 8); ss += __shfl_xor(ss, 4); ss += __shfl_xor(ss, 2); ss += __shfl_xor(ss, 1);
        const float rstd = rsqrtf(ss * (1.f / 64.f) + EPS);
        float y[4];
#pragma unroll
        for (int jj = 0; jj < 4; ++jj) {
          const float yy = v[jj] * rstd * g[jj];
          const float pr = __shfl_xor(yy, 4);
          y[jj] = (yy * cs[jj] + sgn * pr * sn[jj]) * sc;
        }
        u32x2 w = {pk2(y[0], y[1]), pk2(y[2], y[3])};
        if (!dry && (it != 2 || vsel < 2)) *(u32x2*)(base + C_SQ + 64 * (4 * it + vsel) + 4 * j16) = w;
      }
    }
  }
}
DI void phase_prep_c(const Params& p, int l, int dry) {
  const int tid_ = tidx(), lane = tid_ & 63, wave = tid_ >> 6, hd = lane >> 3, sub = lane & 7;
  f32x4 gq[3], gk[3];
#pragma unroll
  for (int i = 0; i < 3; ++i) { gq[i] = *(const f32x4*)(p.g_mla_q + l * 96 + 32 * i + 4 * sub); gk[i] = *(const f32x4*)(p.g_mla_k + l * 96 + 32 * i + 4 * sub); }
  float freq[4];
#pragma unroll
  for (int jj = 0; jj < 4; ++jj) freq[jj] = __builtin_amdgcn_exp2f(-(float)(4 * (sub & 1) + jj) * (13.287712379549449f / 8.f)) * 0.15915494309189535f;
  const float sgn = ((sub >> 1) & 1) ? 1.f : -1.f;
  const float qs = 0.10206207261596575f * LOG2E;
  const int stride = gridDim.x * 8;
  for (int row0 = blockIdx.x * 8 + wave; row0 < T; row0 += 2 * stride) {
    u32x2 rq[2][3], rkv[2][2], rpe[2];
#pragma unroll
    for (int t = 0; t < 2; ++t) {
      const int row = (row0 + t * stride < T) ? row0 + t * stride : row0;
#pragma unroll
      for (int i = 0; i < 3; ++i) rq[t][i] = *(const u32x2*)(p.MQ + (size_t)row * 768 + hd * 96 + 32 * i + 4 * sub);
#pragma unroll
      for (int i = 0; i < 2; ++i) rkv[t][i] = *(const u32x2*)(p.KV + (size_t)row * 1024 + hd * 128 + 32 * i + 4 * sub);
      rpe[t] = *(const u32x2*)(p.PROJ + (size_t)row * PN + C_KPE + 4 * sub);
    }
#pragma unroll
    for (int t = 0; t < 2; ++t) {
      const int row = row0 + t * stride;
      if (row >= T) break;
      const bool islat = row < TL;
      float cs[4], sn[4];
      if (islat) {
        const int tt = row & 8191; const float pos = (float)((sub >> 2) ? (tt & 63) : (tt >> 6));
#pragma unroll
        for (int jj = 0; jj < 4; ++jj) { const float rev = pos * freq[jj]; cs[jj] = __builtin_amdgcn_cosf(rev); sn[jj] = __builtin_amdgcn_sinf(rev); }
      } else {
#pragma unroll
        for (int jj = 0; jj < 4; ++jj) { cs[jj] = 1.f; sn[jj] = 0.f; }
      }
#pragma unroll
      for (int qk = 0; qk < 2; ++qk) {
        float v[3][4];
        if (qk == 0) { unpack4(rq[t][0], v[0]); unpack4(rq[t][1], v[1]); unpack4(rq[t][2], v[2]); }
        else { unpack4(rkv[t][0], v[0]); unpack4(rkv[t][1], v[1]); unpack4(rpe[t], v[2]); }
        float ss = 0.f;
#pragma unroll
        for (int i = 0; i < 3; ++i)
#pragma unroll
          for (int jj = 0; jj < 4; ++jj) ss += v[i][jj] * v[i][jj];
        ss += __shfl_xor(ss, 4); ss += __shfl_xor(ss, 2); ss += __shfl_xor(ss, 1);
        const float rstd = rsqrtf(ss * (1.f / 96.f) + EPS);
        const float osc = (qk == 0) ? qs : 1.f;
        u32x2 w[3];
#pragma unroll
        for (int i = 0; i < 3; ++i) {
          float y[4];
#pragma unroll
          for (int jj = 0; jj < 4; ++jj) {
            const float gg = (qk == 0) ? gq[i][jj] : gk[i][jj];
            float yy = v[i][jj] * rstd * gg;
            if (i == 2) { const float pr = __shfl_xor(yy, 2); yy = yy * cs[jj] + sgn * pr * sn[jj]; }
            y[jj] = yy * osc;
          }
          w[i][0] = pk2(y[0], y[1]); w[i][1] = pk2(y[2], y[3]);
        }
        bf16_t* dst = (qk == 0 ? p.MQ : p.KM) + (size_t)row * 768 + hd * 96 + 4 * sub;
        if (!dry) {
#pragma unroll
          for (int i = 0; i < 3; ++i) *(u32x2*)(dst + 32 * i) = w[i];
        }
      }
    }
  }
}

struct AttnArgs {
  const bf16_t* q; int qpitch;
  const bf16_t* k; int kpitch;
  const bf16_t* v; int vpitch;
  bf16_t* o; int opitch;
  int krow_ctx, krow_lat;
  int nct, lt0, lt1;
  int qrow0, qpos0;
  float mb, sinkterm;
  float lam, osc; const float* gsub;
  int dry;
  bf16_t* o0;
};

template <int QSTEPS> DI void load_q(const AttnArgs& a, int colofs, bf16x8 (&qf)[QSTEPS]) {
  const int tid_ = tidx(), lane = tid_ & 63, wave = tid_ >> 6, h = lane >> 5, l32 = lane & 31;
  const bf16_t* qr = a.q + (size_t)(a.qrow0 + wave * 32 + l32) * a.qpitch + 8 * h + colofs;
#pragma unroll
  for (int s = 0; s < QSTEPS; ++s) qf[s] = *(const bf16x8*)(qr + s * 16);
}
template <int NKA, bool KB, int DV, int EPI, bool WIN>
DI void attn_item(const AttnArgs& a, const bf16x8 (&qfr)[4 + (KB ? 2 : 0)], int kcolofs, LDS_AS unsigned char* smem) {
  const int tid_ = tidx(), lane = tid_ & 63, wave = tid_ >> 6, h = lane >> 5, l32 = lane & 31;
  constexpr int NMAP = 1;
  constexpr int QSTEPS = 4 + (KB ? 2 : 0);
  constexpr int NDB = DV / 32;
  constexpr int VP = DV * 2;
  constexpr int AST = 24576, NST = 4;
  constexpr int NLD = 1 + (KB ? 1 : 0) + (DV == 64 ? 1 : 2);
  const int ntile = a.nct + (a.lt1 - a.lt0);
  unsigned kaoff, kboff = 0, voff[DV == 64 ? 1 : 2];
  { const int r = wave * 8 + (lane >> 3), c = (lane & 7) ^ ((r >> 1) & 7); kaoff = (unsigned)(r * a.kpitch + c * 8) * 2u; }
  if (KB) { const int r = (wave & 3) * 16 + (lane >> 2), c = (lane & 3) ^ ((r >> 2) & 3); kboff = (unsigned)(r * a.kpitch + 64 + c * 8) * 2u; }
  if (DV == 64) {
    const int r = wave * 8 + (lane >> 3), c = (lane & 7) ^ (((r >> 1) & 1) << 2); voff[0] = (unsigned)(r * a.vpitch + c * 8) * 2u;
  } else {
#pragma unroll
    for (int j = 0; j < 2; ++j) { const int r = (j * 8 + wave) * 4 + (lane >> 4), c = (lane & 15) ^ ((r & 3) << 2); voff[j] = (unsigned)(r * a.vpitch + c * 8) * 2u; }
  }
  const unsigned ldst = (unsigned)__builtin_amdgcn_readfirstlane((int)(lds_u32(smem) + wave * 1024));
  const unsigned ldstb = (unsigned)__builtin_amdgcn_readfirstlane((int)(lds_u32(smem) + 16384 + (wave & 3) * 1024));
  auto issue = [&](int ti, int stg) {
    const int trow = (ti < a.nct) ? (a.krow_ctx + ti * 64) : (a.krow_lat + (a.lt0 + ti - a.nct) * 64);
    const char* kb = (const char*)(a.k + (size_t)trow * a.kpitch + kcolofs); const char* vb = (const char*)(a.v + (size_t)trow * a.vpitch);
    const unsigned d = ldst + stg * AST;
    glds16a(kb, kaoff, d);
    if (KB) glds16a(kb, kboff, ldstb + stg * AST);
#pragma unroll
    for (int j = 0; j < (DV == 64 ? 1 : 2); ++j) glds16a(vb, voff[j], d + 8192 + j * 8192);
  };
  const int kswzA = (lane >> 1) & 7, kswzB = (lane >> 2) & 3;
  const int krowA = l32 * 128, krowB = l32 * 64;
  int vbase[NDB];
  {
    const int l16 = lane & 15, qq = l16 >> 2, pp = l16 & 3, g16 = (lane >> 4) & 1;
#pragma unroll
    for (int db = 0; db < NDB; ++db) {
      const int cl = 2 * g16 + (pp >> 1);
      const int c = (DV == 64) ? (4 * (db ^ (qq >> 1)) + cl) : (4 * (db ^ qq) + cl);
      vbase[db] = (4 * h + qq) * VP + c * 16 + (pp & 1) * 8;
    }
  }
  f32x16 O[NMAP][NDB];
#pragma unroll
  for (int m = 0; m < NMAP; ++m)
#pragma unroll
    for (int db = 0; db < NDB; ++db)
#pragma unroll
      for (int i = 0; i < 16; ++i) O[m][db][i] = 0.f;
  float lsum[NMAP];
#pragma unroll
  for (int m = 0; m < NMAP; ++m) lsum[m] = 0.f;
  const float negmb = -a.mb;
  const int qpos = a.qpos0 + wave * 32 + l32;

#pragma unroll
  for (int s = 0; s < QSTEPS; ++s) asm volatile("" ::"v"(qfr[s]));
  asm volatile("s_waitcnt vmcnt(0)" ::: "memory");
  __syncthreads();
  issue(0, 0);
  if (ntile > 1) issue(1, 1);
  if (ntile > 2) issue(2, 2);
#pragma unroll 1
  for (int ti = 0; ti < ntile; ++ti) {
    const int rem = ntile - 1 - ti;
    if (rem >= 2) { if (NLD == 2) asm volatile("s_waitcnt vmcnt(4)" ::: "memory"); else asm volatile("s_waitcnt vmcnt(6)" ::: "memory"); }
    else if (rem == 1) { if (NLD == 2) asm volatile("s_waitcnt vmcnt(2)" ::: "memory"); else asm volatile("s_waitcnt vmcnt(3)" ::: "memory"); }
    else asm volatile("s_waitcnt vmcnt(0)" ::: "memory");
    __builtin_amdgcn_s_barrier();
    asm volatile("" ::: "memory");
    if (ti + 3 < ntile) issue(ti + 3, (ti + 3) & 3);
    __builtin_amdgcn_sched_barrier(0);
    LDS_AS unsigned char* st = smem + (ti & 3) * AST;
    LDS_AS unsigned char* sv = st + 8192;
    auto readK = [&](int kb, bf16x8 (&kf)[QSTEPS]) {
      LDS_AS unsigned char* ka = st + kb * 32 * 128 + krowA;
#pragma unroll
      for (int s = 0; s < 4; ++s) kf[s] = lds128(ka + (((2 * s + h) ^ kswzA) << 4));
      if (KB) {
        LDS_AS unsigned char* kbp = st + 16384 + kb * 32 * 64 + krowB;
#pragma unroll
        for (int s = 0; s < 2; ++s) kf[4 + s] = lds128(kbp + (((2 * s + h) ^ kswzB) << 4));
      }
    };
    auto readV = [&](int kb, bf16x8 (&vf)[2][NDB]) {
#pragma unroll
      for (int s = 0; s < 2; ++s)
#pragma unroll
        for (int db = 0; db < NDB; ++db) {
          const int rc = (kb * 32 + 16 * s) * VP;
          const s16x4 lo = __builtin_amdgcn_ds_read_tr16_b64_v4i16((LDS_AS s16x4*)(sv + vbase[db] + rc));
          const s16x4 hi = __builtin_amdgcn_ds_read_tr16_b64_v4i16((LDS_AS s16x4*)(sv + vbase[db] + rc + 8 * VP));
          vf[s][db] = __builtin_shufflevector(lo, hi, 0, 1, 2, 3, 4, 5, 6, 7);
        }
    };
    auto qk = [&](const bf16x8 (&kf)[QSTEPS], f32x16& S) {
#pragma unroll
      for (int i = 0; i < 16; ++i) S[i] = negmb;
#pragma unroll
      for (int s = 0; s < QSTEPS; ++s) S = MFMA32(kf[s], qfr[s], S);
    };
    auto softmax = [&](int kb, f32x16& S, bf16x8 (&pb)[2]) {
      if (WIN) {
        if (ti >= a.nct) {
          const int kp0 = (a.lt0 + ti - a.nct) * 64 + 4 * h - qpos + kb * 32;
#pragma unroll
          for (int i = 0; i < 16; ++i) {
            const int dlt = kp0 + (i & 3) + 8 * (i >> 2);
            if (dlt > 128 || dlt < -128) S[i] = -INFINITY;
          }
        }
      }
      float ls = 0.f;
#pragma unroll
      for (int i = 0; i < 16; ++i) { S[i] = __builtin_amdgcn_exp2f(S[i]); ls += S[i]; }
      lsum[0] += ls;
#pragma unroll
      for (int s = 0; s < 2; ++s) {
        u32x4 pw;
#pragma unroll
        for (int j = 0; j < 4; ++j) pw[j] = pk2(S[8 * s + 2 * j], S[8 * s + 2 * j + 1]);
        pb[s] = __builtin_bit_cast(bf16x8, pw);
      }
    };
    auto pv = [&](const bf16x8 (&vf)[2][NDB], const bf16x8 (&pb)[2]) {
#pragma unroll
      for (int s = 0; s < 2; ++s)
#pragma unroll
        for (int db = 0; db < NDB; ++db) O[0][db] = MFMA32(vf[s][db], pb[s], O[0][db]);
    };
    bool skip = false;
    if (WIN) {
      if (ti >= a.nct) {
        const int kp = (a.lt0 + ti - a.nct) * 64, r0 = a.qpos0 + __builtin_amdgcn_readfirstlane(wave) * 32;
        skip = (kp + 63 < r0 - 128) || (kp > r0 + 31 + 128);
      }
    }
    if (!skip) {
      bf16x8 kf0[QSTEPS], kf1[QSTEPS], vf0[2][NDB], vf1[2][NDB], p0[2], p1[2];
      f32x16 S0, S1;
      readK(0, kf0); readV(0, vf0);
      __builtin_amdgcn_sched_barrier(0);
      qk(kf0, S0);
      __builtin_amdgcn_sched_barrier(0);
      readK(1, kf1);
      __builtin_amdgcn_sched_barrier(0);
      qk(kf1, S1);
      __builtin_amdgcn_sched_barrier(0);
      softmax(0, S0, p0);
      __builtin_amdgcn_sched_barrier(0);
      pv(vf0, p0);
      __builtin_amdgcn_sched_barrier(0);
      readV(1, vf1);
      __builtin_amdgcn_sched_barrier(0);
      softmax(1, S1, p1);
      __builtin_amdgcn_sched_barrier(0);
      pv(vf1, p1);
      __builtin_amdgcn_sched_barrier(0);
    }
  }
  const float lt = lsum[0] + __shfl_xor(lsum[0], 32) + a.sinkterm;
  const float inv = 1.f / lt;
  bf16_t* orow = a.o + (size_t)(a.qrow0 + wave * 32 + l32) * a.opitch + 4 * h;
  if (a.dry) return;
  if (EPI == 0) {
#pragma unroll
    for (int db = 0; db < NDB; ++db)
#pragma unroll
      for (int g = 0; g < 4; ++g) {
        u32x2 w = {pk2(O[0][db][4 * g] * inv, O[0][db][4 * g + 1] * inv), pk2(O[0][db][4 * g + 2] * inv, O[0][db][4 * g + 3] * inv)};
        *(u32x2*)(orow + db * 32 + 8 * g) = w;
      }
  } else {
    const float c1 = inv * a.lam;
    float ss = 0.f;
#pragma unroll
    for (int db = 0; db < NDB; ++db)
#pragma unroll
      for (int g = 0; g < 4; ++g) {
        const u32x2 raw = *(const u32x2*)(a.o0 + (size_t)(a.qrow0 + wave * 32 + l32) * 512 + 4 * h + db * 32 + 8 * g);
        const float o0[4] = {__uint_as_float(raw[0] << 16), __uint_as_float(raw[0] & 0xffff0000u), __uint_as_float(raw[1] << 16), __uint_as_float(raw[1] & 0xffff0000u)};
#pragma unroll
        for (int j = 0; j < 4; ++j) { const float v = o0[j] - O[0][db][4 * g + j] * c1; O[0][db][4 * g + j] = v; ss += v * v; }
      }
    ss += __shfl_xor(ss, 32);
    const float rstd = rsqrtf(ss * (1.f / (float)DV) + EPS) * a.osc;
#pragma unroll
    for (int db = 0; db < NDB; ++db)
#pragma unroll
      for (int g = 0; g < 4; ++g) {
        const f32x4 gs = *(const f32x4*)(a.gsub + db * 32 + 8 * g + 4 * h);
        u32x2 w = {pk2(O[0][db][4 * g] * rstd * gs[0], O[0][db][4 * g + 1] * rstd * gs[1]), pk2(O[0][db][4 * g + 2] * rstd * gs[2], O[0][db][4 * g + 3] * rstd * gs[3])};
        *(u32x2*)(orow + db * 32 + 8 * g) = w;
      }
  }
}

DI void attn_diff_item(const AttnArgs& a, LDS_AS unsigned char* smem) {
  AttnArgs a0 = a; a0.o = a.o0; a0.opitch = 512; a0.dry = 0;
  { bf16x8 q0[4]; load_q<4>(a, 0, q0); attn_item<1, false, 128, 0, false>(a0, q0, 0, smem); }
  { bf16x8 q1[4]; load_q<4>(a, 64, q1); attn_item<1, false, 128, 1, false>(a, q1, 64, smem); }
}

DI int attn_fetch(unsigned* ctr, int myx, int per, volatile LDS_AS int* slot) {
  if (threadIdx.x == 0) {
    int res = -1;
    for (int t = 0; t < 8; ++t) {
      const int x = (myx + t) & 7;
      const unsigned k = __hip_atomic_fetch_add(ctr + x * 2, 1u, __ATOMIC_RELAXED, __HIP_MEMORY_SCOPE_AGENT);
      if (k < (unsigned)per) { res = x * per + (int)k; break; }
    }
    *slot = res;
  }
  __syncthreads();
  const int r = *slot;
  __syncthreads();
  return r;
}
DI void phase_attention(const Params& p, int l, LDS_AS unsigned char* smem, int dry) {
  __shared__ int attn_slot;
  volatile LDS_AS int* slot = (volatile LDS_AS int*)&attn_slot;
  const int myx = (int)(xb_xcc_id() & 7u);
  const float* cs = p.consts + l * 16;
  const float lam = cs[0], lam_init = cs[1], mb_mla = cs[2], mb_swa = cs[3], mb_diff = cs[4];
  const int nc_d = (l == 0) ? 16 : 0, nc_m = (l == 0) ? 32 : 0;
  {
    unsigned* ctr = p.bar + (l * 3 + 0) * 16;
    int cj = blockIdx.x; bool qdone = (dry != 0);
#pragma unroll 1
    for (;;) {
      int id = -1, j = -1;
      if (!qdone) { id = attn_fetch(ctr, myx, 64, slot); if (id < 0) qdone = true; }
      if (qdone) { if (cj >= nc_d) break; j = cj; cj += gridDim.x; }
      AttnArgs a; a.dry = dry;
      int b, hd;
      if (id >= 0) { const int pair = id >> 5, qb = id & 31; b = pair >> 2; hd = pair & 3; a.lt0 = 0; a.lt1 = 128; a.qrow0 = b * 8192 + qb * 256; }
      else { b = j >> 2; hd = j & 3; a.lt0 = 0; a.lt1 = 0; a.qrow0 = TL + b * 256; }
      a.q = p.PROJ + C_DQ + hd * 128; a.qpitch = PN; a.k = p.PROJ + C_DK + hd * 128; a.kpitch = PN; a.v = p.PROJ + C_DV + hd * 128; a.vpitch = PN;
      a.o = p.PROJ + C_DQ + hd * 128; a.opitch = PN; a.o0 = p.YD0 + hd * 128;
      a.krow_ctx = TL + b * 256; a.krow_lat = b * 8192; a.nct = 4; a.qpos0 = 0;
      a.mb = mb_diff; a.sinkterm = 0.f; a.lam = lam; a.osc = 1.f - lam_init; a.gsub = p.g_diff_sub + l * 128;
      attn_diff_item(a, smem);
    }
  }
  {
    unsigned* ctr = p.bar + (l * 3 + 1) * 16;
    int cj = blockIdx.x; bool qdone = (dry != 0);
#pragma unroll 1
    for (;;) {
      int id = -1, j = -1;
      if (!qdone) { id = attn_fetch(ctr, myx, 128, slot); if (id < 0) qdone = true; }
      if (qdone) { if (cj >= nc_m) break; j = cj; cj += gridDim.x; }
      AttnArgs a; a.dry = dry;
      int b, hd;
      if (id >= 0) { const int pair = id >> 5, qb = id & 31; b = pair >> 3; hd = pair & 7; a.lt0 = 0; a.lt1 = 128; a.qrow0 = b * 8192 + qb * 256; }
      else { b = j >> 3; hd = j & 7; a.lt0 = 0; a.lt1 = 0; a.qrow0 = TL + b * 256; }
      a.q = p.MQ + hd * 96; a.qpitch = 768; a.k = p.KM + hd * 96; a.kpitch = 768; a.v = p.KV + hd * 128 + 64; a.vpitch = 1024;
      a.o = p.MQ + hd * 96; a.opitch = 768; a.o0 = nullptr;
      a.krow_ctx = TL + b * 256; a.krow_lat = b * 8192; a.nct = 4; a.qpos0 = 0;
      a.mb = mb_mla; a.sinkterm = 0.f; a.lam = 0.f; a.osc = 0.f; a.gsub = nullptr;
      bf16x8 qf[6]; load_q<6>(a, 0, qf);
      attn_item<1, true, 64, 0, false>(a, qf, 0, smem);
    }
  }
  {
    unsigned* ctr = p.bar + (l * 3 + 2) * 16;
    int cj = blockIdx.x; bool qdone = (dry != 0);
#pragma unroll 1
    for (;;) {
      int id = -1, j = -1;
      if (!qdone) { id = attn_fetch(ctr, myx, 128, slot); if (id < 0) qdone = true; }
      if (qdone) { if (cj >= nc_m) break; j = cj; cj += gridDim.x; }
      AttnArgs a; a.dry = dry;
      int b, hq;
      if (id >= 0) {
        const int pair = id >> 5, qb = id & 31; b = pair >> 3; hq = pair & 7;
        a.lt0 = (4 * qb - 2 < 0) ? 0 : 4 * qb - 2; a.lt1 = (4 * qb + 6 > 128) ? 128 : 4 * qb + 6;
        a.qrow0 = b * 8192 + qb * 256; a.qpos0 = qb * 256;
      } else { b = j >> 3; hq = j & 7; a.lt0 = 0; a.lt1 = 0; a.qrow0 = TL + b * 256; a.qpos0 = 0; }
      const int kvh = hq >> 2;
      a.q = p.PROJ + C_SQ + hq * 64; a.qpitch = PN; a.k = p.PROJ + C_SK + kvh * 64; a.kpitch = PN; a.v = p.PROJ + C_SV + kvh * 64; a.vpitch = PN;
      a.o = p.PROJ + C_SQ + hq * 64; a.opitch = PN; a.o0 = nullptr;
      a.krow_ctx = TL + b * 256; a.krow_lat = b * 8192; a.nct = 4;
      a.mb = mb_swa; a.sinkterm = __builtin_amdgcn_exp2f(p.swa_sink[l * 8 + hq] * LOG2E - mb_swa); a.lam = 0.f; a.osc = 0.f; a.gsub = nullptr;
      bf16x8 qf[4]; load_q<4>(a, 0, qf);
      attn_item<1, false, 64, 0, true>(a, qf, 0, smem);
    }
  }
}

constexpr int NPH = 1 + 2 * 11;
DI void run_phase(const Params& p, int ph, LDS_AS unsigned char* smem, int dry) {
#ifdef ONLY_S
  if (ONLY_S == 99) { if (ph == 0) phase0(p, smem, dry); return; }
  if (ph == 0) return;
  const int l = (ph - 1) / 11, s = ONLY_S;
#else
  if (ph == 0) { phase0(p, smem, dry); return; }
  const int l = (ph - 1) / 11, s = (ph - 1) % 11;
#endif
  switch (s) {
    case 0: norm_phase(p, l, 0, dry); break;
    case 1: phase_gemm_in(p, l, smem, dry); break;
    case 2: phase_prep_a(p, l, dry); break;
    case 3: phase_gemm_mla(p, l, smem, dry); break;
    case 4: phase_prep_c(p, l, dry); break;
    case 5: phase_attention(p, l, smem, dry); break;
    case 6: phase_merge(p, l, smem, dry); break;
    case 7: phase_residual_gemm(p, l, 0, smem, dry); break;
    case 8: norm_phase(p, l, 1, dry); break;
    case 9: phase_mlp_in(p, l, smem, dry); break;
    default: phase_residual_gemm(p, l, 1, smem, dry); break;
  }
}

__global__ void __launch_bounds__(512, 2) mega_kernel(Params p) {
  __shared__ __attribute__((aligned(16))) unsigned char smem_raw[3 * GST];
  LDS_AS unsigned char* smem = (LDS_AS unsigned char*)smem_raw;
  __shared__ uint4 xb_words;
  cg::grid_group grid = cg::this_grid();
  if (threadIdx.x == 0) xb_words = make_uint4(0u, 0u, 0u, 0u);
  __syncthreads();
  const XcdBarrier xb = xcd_barrier_post(p.bar, (volatile LDS_AS unsigned*)&xb_words);
#pragma unroll 1
  for (int ph = 0; ph < NPH; ++ph) {
    const int st = (ph == 0) ? 31 : (ph - 1) % 11;
    const int nrep = (((unsigned)p.probe >> st) & 1u) ? 2 : 1;
    for (int rep = 0; rep < nrep; ++rep) run_phase(p, ph, smem, rep + 1 < nrep);
    if (ph + 1 < NPH) { if (ph == 0) grid.sync(); else xcd_barrier(xb); }
  }
}
#ifdef MK_MULTI
__global__ void __launch_bounds__(512, 2) phase_kernel(Params p, int ph) {
  __shared__ __attribute__((aligned(16))) unsigned char smem_raw[3 * GST];
  run_phase(p, ph, (LDS_AS unsigned char*)smem_raw, 0);
}
#endif

extern "C" void kernel_launch(void* const* d_in, const int* in_sizes, int n_in, void* d_out, int out_size, void* d_ws, size_t ws_size,
                              hipStream_t stream) {
  Params p{};
  const float* const* in = (const float* const*)d_in;
  p.x = in[0]; p.c = in[1]; p.ctx = in[2]; p.c_ctx = in[3]; p.w_mod = in[4]; p.b_mod = in[5]; p.g_norm_attn = in[6]; p.g_norm_mlp = in[7];
  p.w_in = in[8]; p.g_q_lora = in[9]; p.w_uq = in[10]; p.g_kv_lora = in[11]; p.w_ukv = in[12]; p.g_mla_q = in[13]; p.g_mla_k = in[14];
  p.w_up_mla = in[15]; p.g_swa_q = in[16]; p.g_swa_k = in[17]; p.swa_sink = in[18]; p.w_up_swa = in[19]; p.g_diff_q = in[20]; p.g_diff_k = in[21];
  p.lambda_q1 = in[22]; p.lambda_k1 = in[23]; p.lambda_q2 = in[24]; p.lambda_k2 = in[25]; p.g_diff_sub = in[26]; p.w_up_diff = in[27];
  p.w_o = in[28]; p.w_mlp_in = in[29]; p.w_mlp_out = in[30];
#ifndef PROBE_MASK
#define PROBE_MASK 0
#endif
  p.probe = PROBE_MASK; p.pad_ = 0;
  p.out = (float*)d_out;
  unsigned char* ws = (unsigned char*)d_ws;
  size_t off = 0;
  auto take = [&](size_t bytes) { unsigned char* r = ws + off; off += (bytes + 255) & ~(size_t)255; return r; };
  p.modtab = (float*)take(2 * 5 * 6144 * 4);
  p.consts = (float*)take(256);
  p.bar = (unsigned*)take(XCD_BAR_WORDS * 4);
  p.WB = (bf16_t*)take(2 * W_LAYER * 2);
  p.H = (bf16_t*)take((size_t)T * 1024 * 2);
  p.PROJ = (bf16_t*)take((size_t)T * PN * 2);
  p.MQ = (bf16_t*)take((size_t)T * 768 * 2);
  p.KV = (bf16_t*)take((size_t)T * 1024 * 2);
  p.KM = (bf16_t*)take((size_t)T * 768 * 2);
  p.CX = (float*)take((size_t)TC * 1024 * 4);
  p.YD0 = (bf16_t*)take((size_t)T * 512 * 2);
  if (off > ws_size) { fprintf(stderr, "workspace too small: need %zu have %zu\n", off, ws_size); return; }
  (void)hipMemsetAsync(p.modtab, 0, (size_t)((unsigned char*)p.bar - (unsigned char*)p.modtab) + XCD_BAR_WORDS * 4, stream);
#ifdef MK_MULTI
  for (int ph = 0; ph < NPH; ++ph) phase_kernel<<<256, 512, 0, stream>>>(p, ph);
#else
  static int grid_blocks = 0;
  if (!grid_blocks) {
    int dev = 0, cus = 0, per_cu = 0;
    hipGetDevice(&dev);
    hipDeviceGetAttribute(&cus, hipDeviceAttributeMultiprocessorCount, dev);
    hipOccupancyMaxActiveBlocksPerMultiprocessor(&per_cu, mega_kernel, 512, 0);
    if (per_cu > 1) per_cu = 1;
    grid_blocks = cus * per_cu;
    if (grid_blocks <= 0) grid_blocks = 256;
  }
  void* args[] = {&p};
  hipError_t e = hipLaunchCooperativeKernel((void*)mega_kernel, dim3(grid_blocks), dim3(512), args, 0, stream);
  if (e != hipSuccess) fprintf(stderr, "cooperative launch failed: %s (grid %d)\n", hipGetErrorString(e), grid_blocks);
#endif
}
```

```cpp
#include <hip/hip_runtime.h>
#include <hip/hip_cooperative_groups.h>
#include <cstdio>
#include <cstdint>
namespace cg = cooperative_groups;

typedef unsigned short bf16_t;
typedef short bf16x8 __attribute__((ext_vector_type(8)));
typedef short s16x4 __attribute__((ext_vector_type(4)));
typedef float f32x16 __attribute__((ext_vector_type(16)));
typedef float f32x4 __attribute__((ext_vector_type(4)));
typedef float f32x2 __attribute__((ext_vector_type(2)));
typedef __bf16 bf16x2_t __attribute__((ext_vector_type(2)));
typedef unsigned u32x2 __attribute__((ext_vector_type(2)));
typedef unsigned u32x4 __attribute__((ext_vector_type(4)));
#define LDS_AS __attribute__((address_space(3)))
#define DI __device__ __forceinline__

constexpr int D = 1024, NB = 4, SEQ = 8192, NCTX = 256;
constexpr int TL = NB * SEQ;
constexpr int TC = NB * NCTX;
constexpr int T = TL + TC;
constexpr int PN = 2720;
constexpr int C_QLAT = 0, C_KVLAT = 256, C_KPE = 384, C_SQ = 416, C_SK = 928, C_SV = 1056, C_DQ = 1184, C_DK = 1696, C_DV = 2208;
constexpr float EPS = 1e-6f;
constexpr float LOG2E = 1.4426950408889634f;
constexpr size_t W_IN = 0;
constexpr size_t W_UQ = W_IN + (size_t)5888 * 1024;
constexpr size_t W_UKV = W_UQ + 768 * 256;
constexpr size_t W_UPM = W_UKV + 1024 * 128;
constexpr size_t W_UPS = W_UPM + 1024 * 512;
constexpr size_t W_UPD = W_UPS + 1024 * 512;
constexpr size_t W_O = W_UPD + 1024 * 512;
constexpr size_t W_M1 = W_O + 1024 * 1024;
constexpr size_t W_M2 = W_M1 + (size_t)4096 * 1024;
constexpr size_t W_LAYER = W_M2 + (size_t)4096 * 1024;

struct Params {
  const float *x, *c, *ctx, *c_ctx, *w_mod, *b_mod, *g_norm_attn, *g_norm_mlp, *w_in, *g_q_lora, *w_uq, *g_kv_lora, *w_ukv,
      *g_mla_q, *g_mla_k, *w_up_mla, *g_swa_q, *g_swa_k, *swa_sink, *w_up_swa, *g_diff_q, *g_diff_k, *lambda_q1, *lambda_k1,
      *lambda_q2, *lambda_k2, *g_diff_sub, *w_up_diff, *w_o, *w_mlp_in, *w_mlp_out;
  float* out;
  float* modtab;
  float* consts;
  unsigned* bar;
  bf16_t* WB;
  bf16_t* H;
  bf16_t* PROJ;
  bf16_t* MQ;
  bf16_t* KV;
  bf16_t* KM;
  float* CX;
  bf16_t* YD0;
  int probe, pad_;
};

template <class Tp> DI Tp* opq(Tp* ptr) { asm volatile("" : "+s"(ptr)); return ptr; }
DI int tidx() { int t = threadIdx.x; asm volatile("" : "+v"(t)); return t; }
DI float bf2f(bf16_t v) { return __uint_as_float((unsigned)v << 16); }
DI unsigned pk2(float a, float b) { f32x2 v = {a, b}; bf16x2_t r = __builtin_convertvector(v, bf16x2_t); return __builtin_bit_cast(unsigned, r); }
DI bf16_t f2bf(float a) { return (bf16_t)(pk2(a, 0.f) & 0xffffu); }
DI float wave_sum(float v) {
#pragma unroll
  for (int o = 32; o; o >>= 1) v += __shfl_xor(v, o);
  return v;
}
DI float wave_max(float v) {
#pragma unroll
  for (int o = 32; o; o >>= 1) v = fmaxf(v, __shfl_xor(v, o));
  return v;
}
DI float silu(float x) { return x / (1.f + __expf(-x)); }
DI int xcd_remap(int L, int n) {
  const int q = n >> 3, r = n & 7, xcd = L & 7, off = L >> 3;
  return (xcd < r ? xcd * (q + 1) : r * (q + 1) + (xcd - r) * q) + off;
}
DI void glds16(const void* g, LDS_AS unsigned char* l) {
  __builtin_amdgcn_global_load_lds((const unsigned*)g, (LDS_AS unsigned*)l, 16, 0, 0);
}
DI void glds16a(const void* base, unsigned voff, unsigned ldsaddr) {
  unsigned keep;
  asm volatile("s_mov_b32 %0, m0\n\ts_mov_b32 m0, %3\n\ts_nop 0\n\tglobal_load_lds_dwordx4 %1, %2\n\ts_mov_b32 m0, %0"
               : "=&s"(keep) : "v"(voff), "s"(base), "s"(ldsaddr) : "memory");
}
DI unsigned lds_u32(LDS_AS unsigned char* p) { return (unsigned)(uintptr_t)p; }
DI bf16x8 lds128(LDS_AS unsigned char* p) { return *(LDS_AS bf16x8*)p; }
#define MFMA32(a, b, c) __builtin_amdgcn_mfma_f32_32x32x16_bf16((a), (b), (c), 0, 0, 0)

#define XB_TMO      128
#define XB_XCNT(j)  (256  + 64 * (j))
#define XB_XSUB(j)  (1280 + 64 * (j))
#define XB_XGEN(j)  (2304 + 64 * (j))
#define XB_TOP      3328
#define XB_TOPGEN   3392
#define XCD_BAR_WORDS 3456
#define XB_SPIN_CAP (1u << 22)
DI unsigned xb_ld(unsigned* p) { return __hip_atomic_load(p, __ATOMIC_RELAXED, __HIP_MEMORY_SCOPE_AGENT); }
DI unsigned xb_add(unsigned* p, unsigned v) { return __hip_atomic_fetch_add(p, v, __ATOMIC_RELAXED, __HIP_MEMORY_SCOPE_AGENT); }
DI unsigned xb_xcc_id() { return (unsigned)__builtin_amdgcn_s_getreg((3 << 11) | 20) & 0xFu; }
#define XB_SPIN(cond, bar) do { unsigned _sp = 0; while (cond) { __builtin_amdgcn_s_sleep(1); \
    if ((++_sp & 255u) == 0u) { if (xb_ld(&(bar)[XB_TMO])) break; if (_sp > XB_SPIN_CAP) { atomicAdd(&(bar)[XB_TMO], 1u); break; } } } } while (0)
struct XcdBarrier { unsigned* bar; unsigned x; volatile LDS_AS unsigned* st; };
DI XcdBarrier xcd_barrier_post(unsigned* bar, volatile LDS_AS unsigned* st) {
  XcdBarrier b; b.bar = bar; b.x = xb_xcc_id(); b.st = st;
  if (threadIdx.x == 0) (void)xb_add(&bar[XB_XCNT(b.x)], 1u);
  return b;
}
DI void xcd_barrier_complete(unsigned* bar, unsigned x, unsigned& nloc, unsigned& nx) {
  const unsigned G = gridDim.x * gridDim.y * gridDim.z;
  unsigned sum, cnt, mine, sp = 0u;
  for (;;) {
    sum = 0u; cnt = 0u; mine = 0u;
#pragma unroll
    for (unsigned j = 0; j < 16; ++j) { const unsigned c = xb_ld(&bar[XB_XCNT(j)]); sum += c; cnt += (c > 0u) ? 1u : 0u; mine = (j == x) ? c : mine; }
    if (sum == G) break;
    __builtin_amdgcn_s_sleep(1);
    if ((++sp & 255u) == 0u) { if (xb_ld(&bar[XB_TMO])) break; if (sp > XB_SPIN_CAP) { atomicAdd(&bar[XB_TMO], 1u); break; } }
  }
  nloc = mine > 0u ? mine : 1u; nx = cnt > 0u ? cnt : 1u;
}
DI void xcd_barrier(const XcdBarrier& b) {
  asm volatile("s_waitcnt vmcnt(0)" ::: "memory");
  __syncthreads();
  if (threadIdx.x == 0) {
    unsigned* bar = b.bar;
    __builtin_amdgcn_s_waitcnt(0);
    unsigned nloc = b.st[0], nx = b.st[1];
    if (nloc == 0u) { xcd_barrier_complete(bar, b.x, nloc, nx); b.st[0] = nloc; b.st[1] = nx; }
    const unsigned old = xb_add(&bar[XB_XSUB(b.x)], 1u);
    const unsigned gen = old / nloc;
    if (old + 1u == (gen + 1u) * nloc) {
      __builtin_amdgcn_fence(__ATOMIC_RELEASE, "agent");
      asm volatile("s_waitcnt vmcnt(0)" ::: "memory");
      const unsigned og = xb_add(&bar[XB_TOP], 1u);
      const unsigned tg = og / nx;
      if (og + 1u == (tg + 1u) * nx) xb_add(&bar[XB_TOPGEN], 1u);
      else XB_SPIN(xb_ld(&bar[XB_TOPGEN]) == tg, bar);
      __builtin_amdgcn_fence(__ATOMIC_ACQUIRE, "agent");
      xb_add(&bar[XB_XGEN(b.x)], 1u);
      asm volatile("s_waitcnt vmcnt(0)" ::: "memory");
    } else {
      XB_SPIN(xb_ld(&bar[XB_XGEN(b.x)]) == gen, bar);
      __builtin_amdgcn_fence(__ATOMIC_ACQUIRE, "agent");
      asm volatile("s_waitcnt vmcnt(0)" ::: "memory");
    }
  }
  __syncthreads();
}

DI int wq_fetch(unsigned* ctr, int myx, int per, volatile LDS_AS int* slot) {
  if (threadIdx.x == 0) {
    int res = -1;
    for (int t = 0; t < 8; ++t) {
      const int x = (myx + t) & 7;
      const unsigned k = __hip_atomic_fetch_add(ctr + x * 2, 1u, __ATOMIC_RELAXED, __HIP_MEMORY_SCOPE_AGENT);
      if (k < (unsigned)per) { res = x * per + (int)k; break; }
    }
    *slot = res;
  }
  __syncthreads();
  const int r = *slot;
  __syncthreads();
  return r;
}

struct ConvT { const float* src; bf16_t* dst; int ld, K, k0, n0, is_win; };
DI void conv_load(const ConvT& d, int tid, f32x4 (&v)[2]) {
  const int ty = tid >> 4, tx = tid & 15, n = d.n0 + 4 * tx;
  int sc = n;
  if (d.is_win) sc = (n < 2720) ? n : (n < 2816 ? -1 : n - 96);
#pragma unroll
  for (int i = 0; i < 2; ++i) {
    v[i] = (f32x4){0.f, 0.f, 0.f, 0.f};
    if (sc >= 0) v[i] = *(const f32x4*)(d.src + (size_t)(d.k0 + ty + 32 * i) * d.ld + sc);
  }
}
DI void conv_finish(const ConvT& d, int tid, const f32x4 (&v)[2], LDS_AS float* tile, int dry) {
  const int ty = tid >> 4, tx = tid & 15;
#pragma unroll
  for (int i = 0; i < 2; ++i) {
    const int k = ty + 32 * i;
    tile[k * 65 + 4 * tx + 0] = v[i][0]; tile[k * 65 + 4 * tx + 1] = v[i][1]; tile[k * 65 + 4 * tx + 2] = v[i][2]; tile[k * 65 + 4 * tx + 3] = v[i][3];
  }
  __syncthreads();
  {
    const int r = tid >> 3, c = tid & 7;
    u32x4 w;
    w[0] = pk2(tile[(8 * c + 0) * 65 + r], tile[(8 * c + 1) * 65 + r]);
    w[1] = pk2(tile[(8 * c + 2) * 65 + r], tile[(8 * c + 3) * 65 + r]);
    w[2] = pk2(tile[(8 * c + 4) * 65 + r], tile[(8 * c + 5) * 65 + r]);
    w[3] = pk2(tile[(8 * c + 6) * 65 + r], tile[(8 * c + 7) * 65 + r]);
    if (!dry) *(u32x4*)(d.dst + (size_t)(d.n0 + r) * d.K + d.k0 + 8 * c) = w;
  }
}
DI ConvT conv_decode(const Params& p, int t) {
  ConvT d; d.is_win = 0;
  const int l = t / 4240; int u = t % 4240; size_t doff;
  if (u < 1472) { d.src = p.w_in + (size_t)l * 1024 * 5792; d.ld = 5792; d.K = 1024; d.is_win = 1; doff = W_IN; }
  else if (u < 1520) { u -= 1472; d.src = p.w_uq + (size_t)l * 256 * 768; d.ld = 768; d.K = 256; doff = W_UQ; }
  else if (u < 1552) { u -= 1520; d.src = p.w_ukv + (size_t)l * 128 * 1024; d.ld = 1024; d.K = 128; doff = W_UKV; }
  else if (u < 1680) { u -= 1552; d.src = p.w_up_mla + (size_t)l * 512 * 1024; d.ld = 1024; d.K = 512; doff = W_UPM; }
  else if (u < 1808) { u -= 1680; d.src = p.w_up_swa + (size_t)l * 512 * 1024; d.ld = 1024; d.K = 512; doff = W_UPS; }
  else if (u < 1936) { u -= 1808; d.src = p.w_up_diff + (size_t)l * 512 * 1024; d.ld = 1024; d.K = 512; doff = W_UPD; }
  else if (u < 2192) { u -= 1936; d.src = p.w_o + (size_t)l * 1024 * 1024; d.ld = 1024; d.K = 1024; doff = W_O; }
  else if (u < 3216) { u -= 2192; d.src = p.w_mlp_in + (size_t)l * 1024 * 4096; d.ld = 4096; d.K = 1024; doff = W_M1; }
  else { u -= 3216; d.src = p.w_mlp_out + (size_t)l * 4096 * 1024; d.ld = 1024; d.K = 4096; doff = W_M2; }
  const int nkt = d.K >> 6;
  d.k0 = (u % nkt) * 64; d.n0 = (u / nkt) * 64; d.dst = p.WB + (size_t)l * W_LAYER + doff;
  return d;
}

DI void phase0(const Params& p, LDS_AS unsigned char* smem, int dry) {
  const int tid_ = tidx(), lane = tid_ & 63, wave = tid_ >> 6;
  if (blockIdx.x == 0 && wave == 0) {
    for (int l = 0; l < 2; ++l) {
      const float s1 = wave_sum(p.lambda_q1[l * 64 + lane] * p.lambda_k1[l * 64 + lane]);
      const float s2 = wave_sum(p.lambda_q2[l * 64 + lane] * p.lambda_k2[l * 64 + lane]);
      const float lam_init = 0.8f - 0.6f * expf(-0.3f * (float)l);
      const float lam = expf(s1) - expf(s2) + lam_init;
      float a = fabsf(p.g_mla_q[l * 96 + lane]); if (lane < 32) a = fmaxf(a, fabsf(p.g_mla_q[l * 96 + 64 + lane]));
      float b = fabsf(p.g_mla_k[l * 96 + lane]); if (lane < 32) b = fmaxf(b, fabsf(p.g_mla_k[l * 96 + 64 + lane]));
      const float mq = wave_max(a), mk = wave_max(b);
      const float sq = wave_max(fabsf(p.g_swa_q[l * 64 + lane])), sk = wave_max(fabsf(p.g_swa_k[l * 64 + lane]));
      const float dq = wave_max(fabsf(p.g_diff_q[l * 64 + lane])), dk = wave_max(fabsf(p.g_diff_k[l * 64 + lane]));
      if (lane == 0) {
        float* cs = p.consts + l * 16;
        cs[0] = lam; cs[1] = lam_init;
        cs[2] = LOG2E * sqrtf(96.f) * mq * mk;
        cs[3] = LOG2E * 8.f * sq * sk;
        cs[4] = LOG2E * 8.f * dq * dk;
      }
    }
  }
  for (int task = blockIdx.x * 8 + wave; task < 3072; task += gridDim.x * 8) {
    const int l = task / 1536, rem = task % 1536, chunk = rem >> 4, ks = rem & 15;
    const int n = chunk * 64 + lane;
    float acc[5] = {0.f, 0.f, 0.f, 0.f, 0.f};
    const float* w = p.w_mod + ((size_t)l * 1024 + ks * 64) * 6144 + n;
    float sil[5];
#pragma unroll
    for (int r = 0; r < 4; ++r) sil[r] = silu(p.c[r * 1024 + ks * 64 + lane]);
    sil[4] = silu(p.c_ctx[ks * 64 + lane]);
#pragma unroll 16
    for (int k = 0; k < 64; ++k) {
      const float wv = w[(size_t)k * 6144];
#pragma unroll
      for (int r = 0; r < 5; ++r) acc[r] += __int_as_float(__builtin_amdgcn_readlane(__float_as_int(sil[r]), k)) * wv;
    }
    const float bias = (ks == 0) ? p.b_mod[l * 6144 + n] : 0.f;
    if (!dry)
#pragma unroll
      for (int r = 0; r < 5; ++r) atomicAdd(p.modtab + (size_t)(l * 5 + r) * 6144 + n, acc[r] + bias);
  }
  {
    constexpr int NTI = 4, TBUF = 64 * 65 + 16;
    LDS_AS float* tile0 = (LDS_AS float*)smem;
    const int tid = tidx(), G = gridDim.x, NTOT = 2 * 4240;
    for (int t = blockIdx.x; t < NTOT; t += NTI * G) {
      ConvT d[NTI]; f32x4 v[NTI][2];
#pragma unroll
      for (int q = 0; q < NTI; ++q) { d[q] = conv_decode(p, (t + q * G < NTOT) ? t + q * G : t); conv_load(d[q], tid, v[q]); }
      __syncthreads();
#pragma unroll
      for (int q = 0; q < NTI; ++q)
        if (t + q * G < NTOT) conv_finish(d[q], tid, v[q], tile0 + q * TBUF, dry);
    }
    __syncthreads();
  }
}

DI void norm_phase(const Params& p, int l, int which, int dry) {
  const int tid_ = tidx(), lane = tid_ & 63, wave = tid_ >> 6;
  const float* g = (which == 0 ? p.g_norm_attn : p.g_norm_mlp) + l * 1024;
  const int shoff = which == 0 ? 0 : 3072, scoff = shoff + 1024;
  const int nrows = (which == 1 && l == 1) ? TL : T;
  const bool first = (which == 0 && l == 0);
  const float* px = opq(p.x); const float* pctx = opq(p.ctx); const float* pout = opq((const float*)p.out); const float* pcx = opq((const float*)p.CX);
  const float* slat = first ? px : pout; const float* sctx = first ? pctx : pcx;
  for (int row = blockIdx.x * 8 + wave; row < nrows; row += gridDim.x * 8) {
    const float* xr; int bidx;
    if (row < TL) { xr = slat + (size_t)row * 1024; bidx = row >> 13; }
    else { xr = sctx + (size_t)(row - TL) * 1024; bidx = 4; }
    const float* mod = p.modtab + (size_t)(l * 5 + bidx) * 6144;
    f32x4 v[4]; float ss = 0.f;
#pragma unroll
    for (int i = 0; i < 4; ++i) { v[i] = *(const f32x4*)(xr + i * 256 + lane * 4); ss += v[i][0] * v[i][0] + v[i][1] * v[i][1] + v[i][2] * v[i][2] + v[i][3] * v[i][3]; }
    ss = wave_sum(ss);
    const float rstd = rsqrtf(ss * (1.f / 1024.f) + EPS);
#pragma unroll
    for (int i = 0; i < 4; ++i) {
      const int col = i * 256 + lane * 4;
      const f32x4 gv = *(const f32x4*)(g + col), sh = *(const f32x4*)(mod + shoff + col), sc = *(const f32x4*)(mod + scoff + col);
      float o[4];
#pragma unroll
      for (int j = 0; j < 4; ++j) o[j] = (v[i][j] * rstd * gv[j]) * (1.f + sc[j]) + sh[j];
      u32x2 w = {pk2(o[0], o[1]), pk2(o[2], o[3])};
      if (!dry) *(u32x2*)(p.H + (size_t)row * 1024 + col) = w;
    }
  }
}

constexpr int GST = 49152;
DI void gemm_kloop(const bf16_t* Ag, int lda, int a_kstep, const bf16_t* Bg, int ldb, int nkt, f32x16 (&acc)[2][2], LDS_AS unsigned char* smem) {
  const int tid_ = tidx(), lane = tid_ & 63, wave = tid_ >> 6, h = lane >> 5, wm = wave >> 1, wn = wave & 1;
  unsigned aoff[4], boff[2];
#pragma unroll
  for (int i = 0; i < 4; ++i) {
    const int r = wave * 32 + i * 8 + (lane >> 3), c = (lane & 7) ^ ((r >> 1) & 7);
    aoff[i] = (unsigned)(r * lda + c * 8) * 2u;
  }
#pragma unroll
  for (int i = 0; i < 2; ++i) {
    const int r = wave * 16 + i * 8 + (lane >> 3), c = (lane & 7) ^ ((r >> 1) & 7);
    boff[i] = (unsigned)(r * ldb + c * 8) * 2u;
  }
  const unsigned dstA = (unsigned)__builtin_amdgcn_readfirstlane((int)(lds_u32(smem) + wave * 4096));
  const unsigned dstB = (unsigned)__builtin_amdgcn_readfirstlane((int)(lds_u32(smem) + 32768 + wave * 2048));
  const int swz = (lane >> 1) & 7;
  const int arow = (wm * 64 + (lane & 31)) * 128, brow = 32768 + (wn * 64 + (lane & 31)) * 128;
  asm volatile("s_waitcnt vmcnt(0)" ::: "memory");
  __syncthreads();
  auto issue = [&](int kt, int stg) {
    const char* An = (const char*)(Ag + (size_t)kt * a_kstep); const char* Bn = (const char*)(Bg + (size_t)kt * 64);
#pragma unroll
    for (int i = 0; i < 4; ++i) glds16a(An, aoff[i], dstA + stg * GST + i * 1024);
#pragma unroll
    for (int i = 0; i < 2; ++i) glds16a(Bn, boff[i], dstB + stg * GST + i * 1024);
  };
  issue(0, 0);
  if (nkt > 1) issue(1, 1);
  int st = 0;
#pragma unroll 1
  for (int kt = 0; kt < nkt; ++kt) {
    if (kt + 1 < nkt) asm volatile("s_waitcnt vmcnt(6)" ::: "memory"); else asm volatile("s_waitcnt vmcnt(0)" ::: "memory");
    __builtin_amdgcn_s_barrier();
    asm volatile("" ::: "memory");
    if (kt + 2 < nkt) issue(kt + 2, st >= 1 ? st - 1 : 2);
    LDS_AS unsigned char* sa = smem + st * GST;
#pragma unroll
    for (int s = 0; s < 4; ++s) {
      const int co = ((2 * s + h) ^ swz) << 4;
      const bf16x8 a0 = lds128(sa + arow + co), a1 = lds128(sa + arow + 32 * 128 + co);
      const bf16x8 b0 = lds128(sa + brow + co), b1 = lds128(sa + brow + 32 * 128 + co);
      acc[0][0] = MFMA32(b0, a0, acc[0][0]); acc[0][1] = MFMA32(b1, a0, acc[0][1]);
      acc[1][0] = MFMA32(b0, a1, acc[1][0]); acc[1][1] = MFMA32(b1, a1, acc[1][1]);
    }
    st = (st == 2) ? 0 : st + 1;
  }
}
DI void zero_acc(f32x16 (&acc)[2][2]) {
#pragma unroll
  for (int a = 0; a < 2; ++a)
#pragma unroll
    for (int b = 0; b < 2; ++b)
#pragma unroll
      for (int i = 0; i < 16; ++i) acc[a][b][i] = 0.f;
}
DI void tile_decode(int id, int NT, int& mt, int& nt) { const int per = 4 * NT, g = id / per, w = id % per; mt = g * 4 + (w & 3); nt = w >> 2; }

constexpr int EPW = 17408;
template <int ACT> DI LDS_AS unsigned char* stage_tile(const f32x16 (&acc)[2][2], LDS_AS unsigned char* smem) {
  const int tid_ = tidx(), lane = tid_ & 63, wave = tid_ >> 6, h = lane >> 5;
  __syncthreads();
  LDS_AS unsigned char* reg = smem + wave * EPW;
#pragma unroll
  for (int bi = 0; bi < 2; ++bi)
#pragma unroll
    for (int bj = 0; bj < 2; ++bj)
#pragma unroll
      for (int g = 0; g < 4; ++g) {
        f32x4 v;
#pragma unroll
        for (int j = 0; j < 4; ++j) { v[j] = acc[bi][bj][4 * g + j]; if (ACT == 1) { v[j] = fmaxf(v[j], 0.f); v[j] *= v[j]; } }
        *(LDS_AS f32x4*)(reg + (bi * 32 + (lane & 31)) * 272 + (bj * 32 + 8 * g + 4 * h) * 4) = v;
      }
  return reg;
}
template <int ACT> DI void epi_store_bf16(const f32x16 (&acc)[2][2], bf16_t* dst, int ldc, int row0, int col0, int ncols, LDS_AS unsigned char* smem) {
  LDS_AS unsigned char* reg = stage_tile<ACT>(acc, smem);
  const int tid_ = tidx(), lane = tid_ & 63, wave = tid_ >> 6, wm = wave >> 1, wn = wave & 1;
  const int c = (lane & 7) * 8, col = col0 + wn * 64 + c;
#pragma unroll
  for (int i = 0; i < 8; ++i) {
    const int r = i * 8 + (lane >> 3);
    const f32x4 a = *(LDS_AS f32x4*)(reg + r * 272 + c * 4), b = *(LDS_AS f32x4*)(reg + r * 272 + c * 4 + 16);
    u32x4 w = {pk2(a[0], a[1]), pk2(a[2], a[3]), pk2(b[0], b[1]), pk2(b[2], b[3])};
    if (col < ncols) *(u32x4*)(dst + (size_t)(row0 + wm * 64 + r) * ldc + col) = w;
  }
}
DI void epi_residual(const f32x16 (&acc)[2][2], const float* xin, float* xout, const float* gate, int row0, int col0, LDS_AS unsigned char* smem) {
  LDS_AS unsigned char* reg = stage_tile<0>(acc, smem);
  const int tid_ = tidx(), lane = tid_ & 63, wave = tid_ >> 6, wm = wave >> 1, wn = wave & 1;
  const int c = (lane & 15) * 4, col = col0 + wn * 64 + c;
  const f32x4 gv = *(const f32x4*)(gate + col);
#pragma unroll
  for (int i = 0; i < 16; ++i) {
    const int r = i * 4 + (lane >> 4);
    const size_t off = (size_t)(row0 + wm * 64 + r) * 1024 + col;
    const f32x4 a = *(LDS_AS f32x4*)(reg + r * 272 + c * 4), xi = *(const f32x4*)(xin + off);
    f32x4 o;
#pragma unroll
    for (int j = 0; j < 4; ++j) o[j] = xi[j] + gv[j] * a[j];
    *(f32x4*)(xout + off) = o;
  }
}

constexpr int G2ST = 65536;
DI void gemm_kloop2(const bf16_t* Ag, int lda, const bf16_t* Bg, int ldb, int nkt  , f32x16 (&acc)[4][2], LDS_AS unsigned char* smem) {
  const int tid_ = tidx(), lane = tid_ & 63, wave = tid_ >> 6, h = lane >> 5, wm = wave >> 2, wn = wave & 3;
  unsigned aoff[4], boff[4];
#pragma unroll
  for (int i = 0; i < 4; ++i) {
    const int r = wave * 32 + i * 8 + (lane >> 3), c = (lane & 7) ^ ((r >> 1) & 7);
    aoff[i] = (unsigned)(r * lda + c * 8) * 2u; boff[i] = (unsigned)(r * ldb + c * 8) * 2u;
  }
  const unsigned dstA = (unsigned)__builtin_amdgcn_readfirstlane((int)(lds_u32(smem) + wave * 4096));
  const unsigned dstB = dstA + 32768;
  const int swz = (lane >> 1) & 7;
  const int arow = (wm * 128 + (lane & 31)) * 128, brow = 32768 + (wn * 64 + (lane & 31)) * 128;
  asm volatile("s_waitcnt vmcnt(0)" ::: "memory");
  __syncthreads();
  auto issue = [&](int kt, int stg) {
    const char* An = (const char*)(Ag + (size_t)kt * 64); const char* Bn = (const char*)(Bg + (size_t)kt * 64);
#pragma unroll
    for (int i = 0; i < 4; ++i) glds16a(An, aoff[i], dstA + stg * G2ST + i * 1024);
#pragma unroll
    for (int i = 0; i < 4; ++i) glds16a(Bn, boff[i], dstB + stg * G2ST + i * 1024);
  };
  issue(0, 0);
#pragma unroll 1
  for (int kt = 0; kt < nkt; ++kt) {
    asm volatile("s_waitcnt vmcnt(0)" ::: "memory");
    __builtin_amdgcn_s_barrier();
    asm volatile("" ::: "memory");
    if (kt + 1 < nkt) issue(kt + 1, (kt + 1) & 1);
    LDS_AS unsigned char* sa = smem + (kt & 1) * G2ST;
#pragma unroll
    for (int s = 0; s < 4; ++s) {
      const int co = ((2 * s + h) ^ swz) << 4;
      bf16x8 fa[4], fb[2];
#pragma unroll
      for (int bi = 0; bi < 4; ++bi) fa[bi] = lds128(sa + arow + bi * 32 * 128 + co);
#pragma unroll
      for (int bj = 0; bj < 2; ++bj) fb[bj] = lds128(sa + brow + bj * 32 * 128 + co);
#pragma unroll
      for (int bi = 0; bi < 4; ++bi)
#pragma unroll
        for (int bj = 0; bj < 2; ++bj) acc[bi][bj] = MFMA32(fb[bj], fa[bi], acc[bi][bj]);
    }
  }
}
DI void zero_acc2(f32x16 (&acc)[4][2]) {
#pragma unroll
  for (int a = 0; a < 4; ++a)
#pragma unroll
    for (int b = 0; b < 2; ++b)
#pragma unroll
      for (int i = 0; i < 16; ++i) acc[a][b][i] = 0.f;
}
template <int ACT, int HF> DI void stage_half(const f32x16 (&acc)[4][2], LDS_AS unsigned char* reg, int lane, int h) {
#pragma unroll
  for (int bi = 0; bi < 2; ++bi)
#pragma unroll
    for (int bj = 0; bj < 2; ++bj)
#pragma unroll
      for (int g = 0; g < 4; ++g) {
        f32x4 v;
#pragma unroll
        for (int j = 0; j < 4; ++j) { v[j] = acc[2 * HF + bi][bj][4 * g + j]; if (ACT == 1) { v[j] = fmaxf(v[j], 0.f); v[j] *= v[j]; } }
        *(LDS_AS f32x4*)(reg + (bi * 32 + (lane & 31)) * 272 + (bj * 32 + 8 * g + 4 * h) * 4) = v;
      }
}
template <int ACT, int HF> DI void epi2_half_bf16(const f32x16 (&acc)[4][2], bf16_t* dst, int ldc, int row0, int col0, int ncols, LDS_AS unsigned char* smem) {
  const int tid_ = tidx(), lane = tid_ & 63, wave = tid_ >> 6, h = lane >> 5, wm = wave >> 2, wn = wave & 3;
  LDS_AS unsigned char* reg = smem + wave * EPW;
  stage_half<ACT, HF>(acc, reg, lane, h);
  const int c = (lane & 7) * 8, col = col0 + wn * 64 + c;
#pragma unroll
  for (int i = 0; i < 8; ++i) {
    const int r = i * 8 + (lane >> 3);
    const f32x4 a = *(LDS_AS f32x4*)(reg + r * 272 + c * 4), b = *(LDS_AS f32x4*)(reg + r * 272 + c * 4 + 16);
    u32x4 w = {pk2(a[0], a[1]), pk2(a[2], a[3]), pk2(b[0], b[1]), pk2(b[2], b[3])};
    if (col < ncols) *(u32x4*)(dst + (size_t)(row0 + wm * 128 + HF * 64 + r) * ldc + col) = w;
  }
}
template <int ACT> DI void epi2_store_bf16(const f32x16 (&acc)[4][2], bf16_t* dst, int ldc, int row0, int col0, int ncols, LDS_AS unsigned char* smem) {
  __syncthreads();
  epi2_half_bf16<ACT, 0>(acc, dst, ldc, row0, col0, ncols, smem);
  epi2_half_bf16<ACT, 1>(acc, dst, ldc, row0, col0, ncols, smem);
}
template <int HF> DI void epi2_half_residual(const f32x16 (&acc)[4][2], const float* xin, float* xout, const float* gate, int row0, int col0, LDS_AS unsigned char* smem) {
  const int tid_ = tidx(), lane = tid_ & 63, wave = tid_ >> 6, h = lane >> 5, wm = wave >> 2, wn = wave & 3;
  LDS_AS unsigned char* reg = smem + wave * EPW;
  stage_half<0, HF>(acc, reg, lane, h);
  const int c = (lane & 15) * 4, col = col0 + wn * 64 + c;
  const f32x4 gv = *(const f32x4*)(gate + col);
#pragma unroll
  for (int i = 0; i < 16; ++i) {
    const int r = i * 4 + (lane >> 4);
    const size_t off = (size_t)(row0 + wm * 128 + HF * 64 + r) * 1024 + col;
    const f32x4 a = *(LDS_AS f32x4*)(reg + r * 272 + c * 4), xi = *(const f32x4*)(xin + off);
    f32x4 o;
#pragma unroll
    for (int j = 0; j < 4; ++j) o[j] = xi[j] + gv[j] * a[j];
    *(f32x4*)(xout + off) = o;
  }
}
DI void epi2_residual(const f32x16 (&acc)[4][2], const float* xin, float* xout, const float* gate, int row0, int col0, LDS_AS unsigned char* smem) {
  __syncthreads();
  epi2_half_residual<0>(acc, xin, xout, gate, row0, col0, smem);
  epi2_half_residual<1>(acc, xin, xout, gate, row0, col0, smem);
}

namespace pg8 {
typedef float f32x2v __attribute__((ext_vector_type(2)));
constexpr int BM = 256, BK = 64, HALF = 128, HTB = HALF * BK * 2, STAGE_BYTES = 8 * HTB, NXCD = 8, WGM = 8;
DI int lds_byte(int r, int c) { const int st = (r >> 4) * 2 + (c >> 5), rr = r & 15, cc = c & 31, ob = rr * 64 + cc * 2; return st * 1024 + (ob ^ (((ob >> 9) & 1) << 5)); }
DI void stage_rc(int b, int& R, int& C) { const int st = b / 1024, sb = b % 1024, swz = sb ^ (((sb >> 9) & 1) << 5); R = (st >> 1) * 16 + swz / 64; C = (st & 1) * 32 + (swz % 64) / 2; }
DI int perm32(int rho) { const int n = rho >> 4, i = rho & 15; return 8 * (i >> 2) + 4 * n + (i & 3); }
struct Unit { int pm, pn; };
struct Gemm { const bf16_t* A; const bf16_t* Bt; int M, N, K; };
struct StaticOrder {
    int nM, nN, nwg, G, c;
    DI void init(int M, int N, int G_, int c_) { nM = M / BM; nN = N / BM; nwg = nM * nN; G = G_; c = c_; }
    DI bool next(int i, Unit& u) const {
        const long L = (long)i * G + c; if (L >= nwg) return false;
        int wgid = (int)L; { const int q = nwg / NXCD, r = nwg % NXCD, xcd = wgid % NXCD, off = wgid / NXCD; wgid = (xcd < r ? xcd * (q + 1) : r * (q + 1) + (xcd - r) * q) + off; }
        const int nig = WGM * nN, gid = wgid / nig, fm = gid * WGM, gsz = (nM - fm) < WGM ? (nM - fm) : WGM;
        u.pm = fm + ((wgid % nig) % gsz); u.pn = (wgid % nig) / gsz; return true;
    }
    DI void a_ready(const Unit&) const {}
    DI void done(const Unit&) const {}
};
template <int ACT  > struct EpiBf16 {
    static constexpr bool PERM = true, AFTER_DRAIN = false;
    bf16_t* O; int ldc, ncols, dry;
    DI void operator()(const f32x4 (&acc)[2][2][4][2], const Unit& u, int wr, int wc, int fr, int fq) const {
        if (dry) return;
        const int row0 = u.pm * BM + wr * 64 + fr, col0 = u.pn * BM + wc * 32 + 8 * fq;
#pragma unroll
        for (int ai = 0; ai < 2; ++ai)
#pragma unroll
            for (int m = 0; m < 4; ++m) { bf16_t* rowp = O + (size_t)(row0 + ai * HALF + m * 16) * ldc + col0;
#pragma unroll
                for (int bj = 0; bj < 2; ++bj) { f32x4 v0 = acc[ai][bj][m][0], v1 = acc[ai][bj][m][1];
                    if (ACT == 1) {
#pragma unroll
                        for (int j = 0; j < 4; ++j) { v0[j] = fmaxf(v0[j], 0.f); v0[j] *= v0[j]; v1[j] = fmaxf(v1[j], 0.f); v1[j] *= v1[j]; } }
                    u32x4 w = {pk2(v0[0], v0[1]), pk2(v0[2], v0[3]), pk2(v1[0], v1[1]), pk2(v1[2], v1[3])};
                    if (col0 + bj * HALF < ncols) *(u32x4*)(rowp + bj * HALF) = w; } }
    }
};
struct EpiResid {
    static constexpr bool PERM = false, AFTER_DRAIN = false;
    const float* xin; float* xout; const float* gate; int dry;
    DI void operator()(const f32x4 (&acc)[2][2][4][2], const Unit& u, int wr, int wc, int fr, int fq) const {
        if (dry) return;
        const int row0 = u.pm * BM + wr * 64 + fr, col0 = u.pn * BM + wc * 32 + 4 * fq;
        const float* gv = gate + (size_t)((u.pm * BM) >> 13) * 6144 + col0;
        f32x4 g[2][2];
#pragma unroll
        for (int bj = 0; bj < 2; ++bj)
#pragma unroll
            for (int n = 0; n < 2; ++n) g[bj][n] = *(const f32x4*)(gv + bj * HALF + n * 16);
#pragma unroll
        for (int ai = 0; ai < 2; ++ai)
#pragma unroll
            for (int m = 0; m < 4; ++m) { const size_t off = (size_t)(row0 + ai * HALF + m * 16) * 1024 + col0;
#pragma unroll
                for (int bj = 0; bj < 2; ++bj)
#pragma unroll
                    for (int n = 0; n < 2; ++n) { const f32x4 xi = *(const f32x4*)(xin + off + bj * HALF + n * 16);
                        *(f32x4*)(xout + off + bj * HALF + n * 16) = xi + g[bj][n] * acc[ai][bj][m][n]; } }
    }
};
template <class Epi, class Sched, bool STAMP = false>
__device__ __forceinline__ void gemm_phase(LDS_AS unsigned char* lds, const Gemm g, const Sched& S, const Epi& E, unsigned long long* stamps) {
    const int tid = tidx(), wid = __builtin_amdgcn_readfirstlane(tid >> 6), lane = tid & 63, wr = wid >> 2, wc = wid & 3, fr = lane & 15, fq = lane >> 4;
    const int K = g.K, nt = K / BK;
    int ts_lo = 0, ts_hi = 0, nts = 0; const unsigned long long rt_entry = STAMP ? 0ull : 0ull;
#define PG8_STAMP() do { if (STAMP && wid == 0 && nts < 64) { const unsigned long long _c = (unsigned long long)clock64(); \
        ts_lo = (lane == nts) ? (int)(unsigned)_c : ts_lo; ts_hi = (lane == nts) ? (int)(unsigned)(_c >> 32) : ts_hi; ++nts; } } while (0)
    PG8_STAMP();
    unsigned voffA[2], voffB[2];
#pragma unroll
    for (int i = 0; i < 2; ++i) { int R, C; stage_rc(tid * 16 + i * 8192, R, C); const int Rb = Epi::PERM ? ((R & ~31) + perm32(R & 31)) : R;
        voffA[i] = (unsigned)(R * K + C) * 2u; voffB[i] = (unsigned)(Rb * K + C) * 2u; }
    const size_t kstep = (size_t)(BK * 2);
    const size_t hstep = (size_t)HALF * K * 2;
    const size_t tstep = 2 * hstep;
    const unsigned ldsw = (unsigned)wid * 1024u; const unsigned ldsbase = (unsigned)__builtin_amdgcn_readfirstlane((int)lds_u32(lds));
    const int aoff = lds_byte(wr * 64 + fr, fq * 8), boff = lds_byte(wc * 32 + fr, fq * 8);
#define PG8_SA(b, h) (((b) * 2 + (h)) * HTB)
#define PG8_SB(b, h) ((4 + (b) * 2 + (h)) * HTB)
#define PG8_STAGE(bufoff, gbase, voff) do { _Pragma("unroll") for (int _i = 0; _i < 2; ++_i) \
        glds16a((const void*)(gbase), (voff)[_i], ldsbase + (unsigned)(bufoff) + ldsw + (unsigned)_i * 8192u); } while (0)
#define PG8_LDA(dst, b, h) do { _Pragma("unroll") for (int m = 0; m < 4; ++m) _Pragma("unroll") for (int k = 0; k < 2; ++k) dst[m][k] = *(const LDS_AS bf16x8*)(lds + PG8_SA(b, h) + aoff + m * 2048 + k * 1024); } while (0)
#define PG8_LDB(dst, b, h) do { _Pragma("unroll") for (int n = 0; n < 2; ++n) _Pragma("unroll") for (int k = 0; k < 2; ++k) dst[n][k] = *(const LDS_AS bf16x8*)(lds + PG8_SB(b, h) + boff + n * 2048 + k * 1024); } while (0)
#define PG8_MMA(ai, bj, At, Bt) do { __builtin_amdgcn_s_setprio(1); _Pragma("unroll") for (int m = 0; m < 4; ++m) _Pragma("unroll") for (int n = 0; n < 2; ++n) _Pragma("unroll") for (int k = 0; k < 2; ++k) \
        acc[ai][bj][m][n] = __builtin_amdgcn_mfma_f32_16x16x32_bf16(Bt[n][k], At[m][k], acc[ai][bj][m][n], 0, 0, 0); __builtin_amdgcn_s_setprio(0); } while (0)
#define PG8_WAIT_V(n) asm volatile("s_waitcnt vmcnt(" #n ")" ::: "memory")
#define PG8_WAIT_L(n) asm volatile("s_waitcnt lgkmcnt(" #n ")" ::: "memory")
#define PG8_BAR __builtin_amdgcn_s_barrier()
#define PG8_SCHED __builtin_amdgcn_sched_barrier(0)
    Unit cur, nxt; int ui = 0;
    if (!S.next(0, cur)) return;
    f32x4 acc[2][2][4][2];
#pragma unroll
    for (int a = 0; a < 2; ++a)
#pragma unroll
        for (int b = 0; b < 2; ++b)
#pragma unroll
            for (int m = 0; m < 4; ++m)
#pragma unroll
                for (int n = 0; n < 2; ++n) acc[a][b][m][n] = (f32x4){0.f, 0.f, 0.f, 0.f};
    bf16x8 At[4][2], B0[2][2], B1[2][2];
    const char* cA = (const char*)g.A + (size_t)cur.pm * tstep; const char* cB = (const char*)g.Bt + (size_t)cur.pn * tstep;
    S.a_ready(cur);
    PG8_STAGE(PG8_SB(0, 0), cB, voffB); PG8_STAGE(PG8_SA(0, 0), cA, voffA); PG8_STAGE(PG8_SB(0, 1), cB + hstep, voffB); PG8_STAGE(PG8_SA(0, 1), cA + hstep, voffA);
    if (wr == 1) PG8_BAR;
    PG8_WAIT_V(4); PG8_BAR;
    PG8_STAGE(PG8_SB(1, 0), cB + kstep, voffB); PG8_STAGE(PG8_SA(1, 0), cA + kstep, voffA); PG8_STAGE(PG8_SB(1, 1), cB + hstep + kstep, voffB);
    PG8_WAIT_V(6); PG8_BAR;
    PG8_STAMP();
    for (;;) {
        const bool has_next = S.next(ui + 1, nxt);
        const char* nA = has_next ? (const char*)g.A + (size_t)nxt.pm * tstep : cA; const char* nB = has_next ? (const char*)g.Bt + (size_t)nxt.pn * tstep : cB;
        for (int t = 0; t < nt; t += 2) {
            const bool last = (t == nt - 2);
            const char* a1 = cA + (size_t)(t + 1) * kstep;
            const char* a2 = last ? nA : cA + (size_t)(t + 2) * kstep; const char* b2 = last ? nB : cB + (size_t)(t + 2) * kstep;
            const char* a3 = a2 + kstep; const char* b3 = b2 + kstep;
            if (last && has_next) S.a_ready(nxt);
            PG8_LDB(B0, 0, 0); PG8_SCHED; PG8_LDA(At, 0, 0); PG8_STAGE(PG8_SA(1, 1), a1 + hstep, voffA);
            PG8_WAIT_L(8); PG8_BAR; PG8_WAIT_L(0); PG8_MMA(0, 0, At, B0); PG8_BAR; PG8_SCHED;
            PG8_LDB(B1, 0, 1); PG8_STAGE(PG8_SB(0, 0), b2, voffB);
            PG8_BAR; PG8_WAIT_L(0); PG8_MMA(0, 1, At, B1); PG8_BAR;
            PG8_LDA(At, 0, 1); PG8_STAGE(PG8_SA(0, 0), a2, voffA);
            PG8_BAR; PG8_WAIT_L(0); PG8_MMA(1, 0, At, B0); PG8_BAR; PG8_SCHED;
            PG8_STAGE(PG8_SB(0, 1), b2 + hstep, voffB);
            PG8_WAIT_V(6); PG8_BAR; PG8_MMA(1, 1, At, B1); PG8_BAR;
            PG8_LDB(B0, 1, 0); PG8_SCHED; PG8_LDA(At, 1, 0); PG8_STAGE(PG8_SA(0, 1), a2 + hstep, voffA);
            PG8_WAIT_L(8); PG8_BAR; PG8_WAIT_L(0); PG8_MMA(0, 0, At, B0); PG8_BAR; PG8_SCHED;
            PG8_LDB(B1, 1, 1); PG8_STAGE(PG8_SB(1, 0), b3, voffB);
            PG8_BAR; PG8_WAIT_L(0); PG8_MMA(0, 1, At, B1); PG8_BAR;
            PG8_LDA(At, 1, 1); PG8_STAGE(PG8_SA(1, 0), a3, voffA);
            PG8_BAR; PG8_WAIT_L(0); PG8_MMA(1, 0, At, B0); PG8_BAR; PG8_SCHED;
            PG8_STAGE(PG8_SB(1, 1), b3 + hstep, voffB);
            PG8_WAIT_V(6); PG8_BAR; PG8_MMA(1, 1, At, B1); PG8_BAR;
        }
        PG8_STAMP();
        if constexpr (!Epi::AFTER_DRAIN) { E(acc, cur, wr, wc, fr, fq); S.done(cur); }
        PG8_STAMP();
        if (!has_next) break;
#pragma unroll
        for (int a = 0; a < 2; ++a)
#pragma unroll
            for (int b = 0; b < 2; ++b)
#pragma unroll
                for (int m = 0; m < 4; ++m)
#pragma unroll
                    for (int n = 0; n < 2; ++n) acc[a][b][m][n] = (f32x4){0.f, 0.f, 0.f, 0.f};
        cur = nxt; cA = nA; cB = nB; ++ui;
    }
    PG8_WAIT_V(0);
    if (wr == 0) PG8_BAR;
    PG8_BAR;
    if constexpr (Epi::AFTER_DRAIN) { E.fused(acc, cur, wr, wc, fr, fq, lds, wid, lane); S.done(cur); }
    PG8_STAMP();
    if (STAMP && wid == 0) { stamps[lane] = lane < nts ? (((unsigned long long)(unsigned)ts_hi << 32) | (unsigned)ts_lo) : 0ull;
        if (lane == 62) stamps[62] = rt_entry; if (lane == 63) stamps[63] = 0ull; }
#undef PG8_STAMP
#undef PG8_SA
#undef PG8_SB
#undef PG8_STAGE
#undef PG8_LDA
#undef PG8_LDB
#undef PG8_MMA
#undef PG8_WAIT_V
#undef PG8_WAIT_L
#undef PG8_BAR
#undef PG8_SCHED
}
}

DI void phase_gemm_in(const Params& p, int l, LDS_AS unsigned char* smem, int dry) {
  pg8::Gemm g; g.A = p.H; g.Bt = p.WB + (size_t)l * W_LAYER + W_IN; g.M = T; g.N = 2816; g.K = 1024;
  pg8::StaticOrder S; S.init(g.M, g.N, gridDim.x, blockIdx.x);
  pg8::EpiBf16<0> E; E.O = p.PROJ; E.ldc = PN; E.ncols = PN; E.dry = dry;
  __syncthreads();
  pg8::gemm_phase<pg8::EpiBf16<0>, pg8::StaticOrder, false>(smem, g, S, E, nullptr);
}
DI void phase_gemm_mla(const Params& p, int l, LDS_AS unsigned char* smem, int dry) {
  const bf16_t* WQ = p.WB + (size_t)l * W_LAYER + W_UQ; const bf16_t* WK = p.WB + (size_t)l * W_LAYER + W_UKV;
  const int NT = 7, ntiles = (T / 256) * NT;
  for (int i = blockIdx.x; i < ntiles; i += gridDim.x) {
    int mt, nt; tile_decode(xcd_remap(i, ntiles), NT, mt, nt);
    f32x16 acc[4][2]; zero_acc2(acc);
    if (nt < 3) {
      gemm_kloop2(p.PROJ + (size_t)mt * 256 * PN + C_QLAT, PN, WQ + (size_t)nt * 256 * 256, 256, 4, acc, smem);
      if (!dry) epi2_store_bf16<0>(acc, p.MQ, 768, mt * 256, nt * 256, 768, smem);
    } else {
      gemm_kloop2(p.PROJ + (size_t)mt * 256 * PN + C_KVLAT, PN, WK + (size_t)(nt - 3) * 256 * 128, 128, 2, acc, smem);
      if (!dry) epi2_store_bf16<0>(acc, p.KV, 1024, mt * 256, (nt - 3) * 256, 1024, smem);
    }
  }
}
DI void phase_merge(const Params& p, int l, LDS_AS unsigned char* smem, int dry) {
  const bf16_t* WL = p.WB + (size_t)l * W_LAYER;
  const int NT = 8, MT = (l == 1) ? TL / 256 : T / 256, ntiles = MT * NT;
  bf16_t* M = p.KV;
  __shared__ int merge_slot;
  volatile LDS_AS int* slot = (volatile LDS_AS int*)&merge_slot;
  unsigned* ctr = p.bar + 96 + l * 16;
  const int myx = (int)(xb_xcc_id() & 7u);
  int si = blockIdx.x;
#pragma unroll 1
  for (;;) {
    int tid_q;
    if (dry) { if (si >= ntiles) break; tid_q = xcd_remap(si, ntiles); si += gridDim.x; }
    else { tid_q = wq_fetch(ctr, myx, ntiles >> 3, slot); if (tid_q < 0) break; }
    int mt, nt; tile_decode(tid_q, NT, mt, nt);
    unsigned tp[2][2][8];
#pragma unroll
    for (int a = 0; a < 2; ++a)
#pragma unroll
      for (int b = 0; b < 2; ++b)
#pragma unroll
        for (int e = 0; e < 8; ++e) tp[a][b][e] = 0u;
#pragma unroll 1
    for (int br = 0; br < 3; ++br) {
      unsigned gp[2][2][8];
      {
        f32x16 ag[2][2]; zero_acc(ag);
        gemm_kloop(p.H + (size_t)mt * 256 * 1024, 1024, 64, WL + W_IN + (size_t)(2816 + br * 1024 + nt * 128) * 1024, 1024, 16, ag, smem);
#pragma unroll
        for (int a = 0; a < 2; ++a)
#pragma unroll
          for (int b = 0; b < 2; ++b)
#pragma unroll
            for (int e = 0; e < 8; ++e)
              gp[a][b][e] = pk2(__builtin_amdgcn_rcpf(1.f + __builtin_amdgcn_exp2f(-LOG2E * ag[a][b][2 * e])),
                                __builtin_amdgcn_rcpf(1.f + __builtin_amdgcn_exp2f(-LOG2E * ag[a][b][2 * e + 1])));
      }
      f32x16 ay[2][2]; zero_acc(ay);
      const int lda = (br == 0) ? 768 : PN, kstep = (br == 0) ? 96 : 64;
      const size_t aofs = (br == 0) ? (size_t)T * PN : (size_t)(br == 1 ? C_SQ : C_DQ);
      __builtin_amdgcn_sched_barrier(0);
      gemm_kloop(p.PROJ + aofs + (size_t)mt * 256 * lda, lda, kstep, WL + W_UPM + (size_t)br * 1024 * 512 + (size_t)nt * 128 * 512, 512, 8, ay, smem);
#pragma unroll
      for (int a = 0; a < 2; ++a)
#pragma unroll
        for (int b = 0; b < 2; ++b)
#pragma unroll
          for (int e = 0; e < 8; ++e) {
            const float t0 = __uint_as_float(tp[a][b][e] << 16) + __uint_as_float(gp[a][b][e] << 16) * ay[a][b][2 * e];
            const float t1 = __uint_as_float(tp[a][b][e] & 0xffff0000u) + __uint_as_float(gp[a][b][e] & 0xffff0000u) * ay[a][b][2 * e + 1];
            tp[a][b][e] = pk2(t0, t1);
          }
    }
    if (!dry) {
      f32x16 tot[2][2];
#pragma unroll
      for (int a = 0; a < 2; ++a)
#pragma unroll
        for (int b = 0; b < 2; ++b)
#pragma unroll
          for (int e = 0; e < 8; ++e) { tot[a][b][2 * e] = __uint_as_float(tp[a][b][e] << 16); tot[a][b][2 * e + 1] = __uint_as_float(tp[a][b][e] & 0xffff0000u); }
      epi_store_bf16<0>(tot, M, 1024, mt * 256, nt * 128, 1024, smem);
    }
  }
}
DI void phase_residual_gemm(const Params& p, int l, int which, LDS_AS unsigned char* smem, int dry) {
  const bf16_t* WL = p.WB + (size_t)l * W_LAYER;
  const bf16_t* Abase = which == 0 ? (const bf16_t*)opq(p.KV) : (const bf16_t*)opq(p.PROJ);
  const int K = which == 0 ? 1024 : 4096;
  const bf16_t* W = WL + (which == 0 ? W_O : W_M2);
  const bool first = (which == 0 && l == 0);
  const float* px = opq(p.x); const float* pctx = opq(p.ctx); float* pout = opq(p.out); float* pcx = opq(p.CX);
  const float* slat = first ? px : (const float*)pout; const float* sctx = first ? pctx : (const float*)pcx;
  const float* gofs = p.modtab + (size_t)(l * 5) * 6144 + (which == 0 ? 2048 : 5120);
  {
    pg8::Gemm g; g.A = Abase; g.Bt = W; g.M = TL; g.N = 1024; g.K = K;
    pg8::StaticOrder S; S.init(g.M, g.N, gridDim.x, blockIdx.x);
    pg8::EpiResid E; E.xin = slat; E.xout = pout; E.gate = gofs; E.dry = dry;
    __syncthreads();
    pg8::gemm_phase<pg8::EpiResid, pg8::StaticOrder, false>(smem, g, S, E, nullptr);
  }
  if (l == 0) {
    const int i = (int)gridDim.x - 1 - (int)blockIdx.x;
    if (i < 32) {
      const int mt = TL / 256 + (i & 3), nt = i >> 2;
      f32x16 acc[2][2]; zero_acc(acc);
      gemm_kloop(Abase + (size_t)mt * 256 * K, K, 64, W + (size_t)nt * 128 * K, K, K / 64, acc, smem);
      if (!dry) epi_residual(acc, sctx, pcx, gofs + (size_t)4 * 6144, mt * 256 - TL, nt * 128, smem);
    }
  }
}
DI void phase_mlp_in(const Params& p, int l, LDS_AS unsigned char* smem, int dry) {
  pg8::Gemm g; g.A = p.H; g.Bt = p.WB + (size_t)l * W_LAYER + W_M1; g.M = (l == 1) ? TL : T; g.N = 4096; g.K = 1024;
  pg8::StaticOrder S; S.init(g.M, g.N, gridDim.x, blockIdx.x);
  pg8::EpiBf16<1> E; E.O = p.PROJ; E.ldc = 4096; E.ncols = 4096; E.dry = dry;
  __syncthreads();
  pg8::gemm_phase<pg8::EpiBf16<1>, pg8::StaticOrder, false>(smem, g, S, E, nullptr);
}

DI unsigned ld_u32(const bf16_t* p) { return *(const unsigned*)p; }
DI void unpack4(u32x2 raw, float (&v)[4]) {
  v[0] = __uint_as_float(raw[0] << 16); v[1] = __uint_as_float(raw[0] & 0xffff0000u); v[2] = __uint_as_float(raw[1] << 16); v[3] = __uint_as_float(raw[1] & 0xffff0000u);
}
DI void phase_prep_a(const Params& p, int l, int dry) {
  const int tid_ = tidx(), lane = tid_ & 63, wave = tid_ >> 6, vsel = lane >> 4, j16 = lane & 15;
  const f32x4 gsq = *(const f32x4*)(p.g_swa_q + l * 64 + 4 * j16), gsk = *(const f32x4*)(p.g_swa_k + l * 64 + 4 * j16);
  const f32x4 gdq = *(const f32x4*)(p.g_diff_q + l * 64 + 4 * j16), gdk = *(const f32x4*)(p.g_diff_k + l * 64 + 4 * j16);
  const f32x4 gql = *(const f32x4*)(p.g_q_lora + l * 256 + lane * 4);
  const f32x2 gkl = *(const f32x2*)(p.g_kv_lora + l * 128 + lane * 2);
  float freq[4];
#pragma unroll
  for (int jj = 0; jj < 4; ++jj) freq[jj] = __builtin_amdgcn_exp2f(-(float)(4 * (j16 & 3) + jj) * (13.287712379549449f / 16.f)) * 0.15915494309189535f;
  const float sgn = ((j16 >> 2) & 1) ? 1.f : -1.f;
  const int stride = gridDim.x * 8;
  for (int row0 = blockIdx.x * 8 + wave; row0 < T; row0 += 2 * stride) {
    u32x2 rq[2], rv[2][7]; unsigned rk[2];
#pragma unroll
    for (int t = 0; t < 2; ++t) {
      const int row = (row0 + t * stride < T) ? row0 + t * stride : row0;
      const bf16_t* base = p.PROJ + (size_t)row * PN;
      rq[t] = *(const u32x2*)(base + C_QLAT + lane * 4);
      rk[t] = ld_u32(base + C_KVLAT + lane * 2);
#pragma unroll
      for (int it = 0; it < 7; ++it) rv[t][it] = *(const u32x2*)(base + C_SQ + 64 * (4 * it + vsel) + 4 * j16);
    }
#pragma unroll
    for (int t = 0; t < 2; ++t) {
      const int row = row0 + t * stride;
      if (row >= T) break;
      bf16_t* base = p.PROJ + (size_t)row * PN;
      const bool islat = row < TL;
      float cs[4], sn[4];
      if (islat) {
        const int tt = row & 8191; const float pos = (float)((j16 >> 3) ? (tt & 63) : (tt >> 6));
#pragma unroll
        for (int jj = 0; jj < 4; ++jj) { const float rev = pos * freq[jj]; cs[jj] = __builtin_amdgcn_cosf(rev); sn[jj] = __builtin_amdgcn_sinf(rev); }
      } else {
#pragma unroll
        for (int jj = 0; jj < 4; ++jj) { cs[jj] = 1.f; sn[jj] = 0.f; }
      }
      {
        float v[4]; unpack4(rq[t], v);
        const float ss = wave_sum(v[0] * v[0] + v[1] * v[1] + v[2] * v[2] + v[3] * v[3]);
        const float rstd = rsqrtf(ss * (1.f / 256.f) + EPS);
        u32x2 w = {pk2(v[0] * rstd * gql[0], v[1] * rstd * gql[1]), pk2(v[2] * rstd * gql[2], v[3] * rstd * gql[3])};
        if (!dry) *(u32x2*)(base + C_QLAT + lane * 4) = w;
      }
      {
        const float v0 = __uint_as_float(rk[t] << 16), v1 = __uint_as_float(rk[t] & 0xffff0000u);
        const float ss = wave_sum(v0 * v0 + v1 * v1);
        const float rstd = rsqrtf(ss * (1.f / 128.f) + EPS);
        if (!dry) *(unsigned*)(base + C_KVLAT + lane * 2) = pk2(v0 * rstd * gkl[0], v1 * rstd * gkl[1]);
      }
#pragma unroll
      for (int it = 0; it < 7; ++it) {
        const f32x4 g = (it < 2) ? gsq : (it == 2 ? gsk : (it < 5 ? gdq : gdk));
        const float sc = (it < 2 || it == 3 || it == 4) ? 0.125f * LOG2E : 1.f;
        float v[4]; unpack4(rv[t][it], v);
        float ss = v[0] * v[0] + v[1] * v[1] + v[2] * v[2] + v[3] * v[3];
        ss += __shfl_xor(ss, 8); ss += __shfl_xor(ss, 4); ss += __shfl_xor(ss, 2); ss += __shfl_xor(ss, 1);
        const float rstd = rsqrtf(ss * (1.f / 64.f) + EPS);
        float y[4];
#pragma unroll
        for (int jj = 0; jj < 4; ++jj) {
          const float yy = v[jj] * rstd * g[jj];
          const float pr = __shfl_xor(yy, 4);
          y[jj] = (yy * cs[jj] + sgn * pr * sn[jj]) * sc;
        }
        u32x2 w = {pk2(y[0], y[1]), pk2(y[2], y[3])};
        if (!dry && (it != 2 || vsel < 2)) *(u32x2*)(base + C_SQ + 64 * (4 * it + vsel) + 4 * j16) = w;
      }
    }
  }
}
DI void phase_prep_c(const Params& p, int l, int dry) {
  const int tid_ = tidx(), lane = tid_ & 63, wave = tid_ >> 6, hd = lane >> 3, sub = lane & 7;
  f32x4 gq[3], gk[3];
#pragma unroll
  for (int i = 0; i < 3; ++i) { gq[i] = *(const f32x4*)(p.g_mla_q + l * 96 + 32 * i + 4 * sub); gk[i] = *(const f32x4*)(p.g_mla_k + l * 96 + 32 * i + 4 * sub); }
  float freq[4];
#pragma unroll
  for (int jj = 0; jj < 4; ++jj) freq[jj] = __builtin_amdgcn_exp2f(-(float)(4 * (sub & 1) + jj) * (13.287712379549449f / 8.f)) * 0.15915494309189535f;
  const float sgn = ((sub >> 1) & 1) ? 1.f : -1.f;
  const float qs = 0.10206207261596575f * LOG2E;
  const int stride = gridDim.x * 8;
  for (int row0 = blockIdx.x * 8 + wave; row0 < T; row0 += 2 * stride) {
    u32x2 rq[2][3], rkv[2][2], rpe[2];
#pragma unroll
    for (int t = 0; t < 2; ++t) {
      const int row = (row0 + t * stride < T) ? row0 + t * stride : row0;
#pragma unroll
      for (int i = 0; i < 3; ++i) rq[t][i] = *(const u32x2*)(p.MQ + (size_t)row * 768 + hd * 96 + 32 * i + 4 * sub);
#pragma unroll
      for (int i = 0; i < 2; ++i) rkv[t][i] = *(const u32x2*)(p.KV + (size_t)row * 1024 + hd * 128 + 32 * i + 4 * sub);
      rpe[t] = *(const u32x2*)(p.PROJ + (size_t)row * PN + C_KPE + 4 * sub);
    }
#pragma unroll
    for (int t = 0; t < 2; ++t) {
      const int row = row0 + t * stride;
      if (row >= T) break;
      const bool islat = row < TL;
      float cs[4], sn[4];
      if (islat) {
        const int tt = row & 8191; const float pos = (float)((sub >> 2) ? (tt & 63) : (tt >> 6));
#pragma unroll
        for (int jj = 0; jj < 4; ++jj) { const float rev = pos * freq[jj]; cs[jj] = __builtin_amdgcn_cosf(rev); sn[jj] = __builtin_amdgcn_sinf(rev); }
      } else {
#pragma unroll
        for (int jj = 0; jj < 4; ++jj) { cs[jj] = 1.f; sn[jj] = 0.f; }
      }
#pragma unroll
      for (int qk = 0; qk < 2; ++qk) {
        float v[3][4];
        if (qk == 0) { unpack4(rq[t][0], v[0]); unpack4(rq[t][1], v[1]); unpack4(rq[t][2], v[2]); }
        else { unpack4(rkv[t][0], v[0]); unpack4(rkv[t][1], v[1]); unpack4(rpe[t], v[2]); }
        float ss = 0.f;
#pragma unroll
        for (int i = 0; i < 3; ++i)
#pragma unroll
          for (int jj = 0; jj < 4; ++jj) ss += v[i][jj] * v[i][jj];
        ss += __shfl_xor(ss, 4); ss += __shfl_xor(ss, 2); ss += __shfl_xor(ss, 1);
        const float rstd = rsqrtf(ss * (1.f / 96.f) + EPS);
        const float osc = (qk == 0) ? qs : 1.f;
        u32x2 w[3];
#pragma unroll
        for (int i = 0; i < 3; ++i) {
          float y[4];
#pragma unroll
          for (int jj = 0; jj < 4; ++jj) {
            const float gg = (qk == 0) ? gq[i][jj] : gk[i][jj];
            float yy = v[i][jj] * rstd * gg;
            if (i == 2) { const float pr = __shfl_xor(yy, 2); yy = yy * cs[jj] + sgn * pr * sn[jj]; }
            y[jj] = yy * osc;
          }
          w[i][0] = pk2(y[0], y[1]); w[i][1] = pk2(y[2], y[3]);
        }
        bf16_t* dst = (qk == 0 ? p.MQ : p.KM) + (size_t)row * 768 + hd * 96 + 4 * sub;
        if (!dry) {
#pragma unroll
          for (int i = 0; i < 3; ++i) *(u32x2*)(dst + 32 * i) = w[i];
        }
      }
    }
  }
}

struct AttnArgs {
  const bf16_t* q; int qpitch;
  const bf16_t* k; int kpitch;
  const bf16_t* v; int vpitch;
  bf16_t* o; int opitch;
  int krow_ctx, krow_lat;
  int nct, lt0, lt1;
  int qrow0, qpos0;
  float mb, sinkterm;
  float lam, osc; const float* gsub;
  int dry;
  bf16_t* o0;
};

template <int QSTEPS> DI void load_q(const AttnArgs& a, int colofs, bf16x8 (&qf)[QSTEPS]) {
  const int tid_ = tidx(), lane = tid_ & 63, wave = tid_ >> 6, h = lane >> 5, l32 = lane & 31;
  const bf16_t* qr = a.q + (size_t)(a.qrow0 + wave * 32 + l32) * a.qpitch + 8 * h + colofs;
#pragma unroll
  for (int s = 0; s < QSTEPS; ++s) qf[s] = *(const bf16x8*)(qr + s * 16);
}
template <int NKA, bool KB, int DV, int EPI, bool WIN>
DI void attn_item(const AttnArgs& a, const bf16x8 (&qfr)[4 + (KB ? 2 : 0)], int kcolofs, LDS_AS unsigned char* smem) {
  const int tid_ = tidx(), lane = tid_ & 63, wave = tid_ >> 6, h = lane >> 5, l32 = lane & 31;
  constexpr int NMAP = 1;
  constexpr int QSTEPS = 4 + (KB ? 2 : 0);
  constexpr int NDB = DV / 32;
  constexpr int VP = DV * 2;
  constexpr int AST = 24576, NST = 4;
  constexpr int NLD = 1 + (KB ? 1 : 0) + (DV == 64 ? 1 : 2);
  const int ntile = a.nct + (a.lt1 - a.lt0);
  unsigned kaoff, kboff = 0, voff[DV == 64 ? 1 : 2];
  { const int r = wave * 8 + (lane >> 3), c = (lane & 7) ^ ((r >> 1) & 7); kaoff = (unsigned)(r * a.kpitch + c * 8) * 2u; }
  if (KB) { const int r = (wave & 3) * 16 + (lane >> 2), c = (lane & 3) ^ ((r >> 2) & 3); kboff = (unsigned)(r * a.kpitch + 64 + c * 8) * 2u; }
  if (DV == 64) {
    const int r = wave * 8 + (lane >> 3), c = (lane & 7) ^ (((r >> 1) & 1) << 2); voff[0] = (unsigned)(r * a.vpitch + c * 8) * 2u;
  } else {
#pragma unroll
    for (int j = 0; j < 2; ++j) { const int r = (j * 8 + wave) * 4 + (lane >> 4), c = (lane & 15) ^ ((r & 3) << 2); voff[j] = (unsigned)(r * a.vpitch + c * 8) * 2u; }
  }
  const unsigned ldst = (unsigned)__builtin_amdgcn_readfirstlane((int)(lds_u32(smem) + wave * 1024));
  const unsigned ldstb = (unsigned)__builtin_amdgcn_readfirstlane((int)(lds_u32(smem) + 16384 + (wave & 3) * 1024));
  auto issue = [&](int ti, int stg) {
    const int trow = (ti < a.nct) ? (a.krow_ctx + ti * 64) : (a.krow_lat + (a.lt0 + ti - a.nct) * 64);
    const char* kb = (const char*)(a.k + (size_t)trow * a.kpitch + kcolofs); const char* vb = (const char*)(a.v + (size_t)trow * a.vpitch);
    const unsigned d = ldst + stg * AST;
    glds16a(kb, kaoff, d);
    if (KB) glds16a(kb, kboff, ldstb + stg * AST);
#pragma unroll
    for (int j = 0; j < (DV == 64 ? 1 : 2); ++j) glds16a(vb, voff[j], d + 8192 + j * 8192);
  };
  const int kswzA = (lane >> 1) & 7, kswzB = (lane >> 2) & 3;
  const int krowA = l32 * 128, krowB = l32 * 64;
  int vbase[NDB];
  {
    const int l16 = lane & 15, qq = l16 >> 2, pp = l16 & 3, g16 = (lane >> 4) & 1;
#pragma unroll
    for (int db = 0; db < NDB; ++db) {
      const int cl = 2 * g16 + (pp >> 1);
      const int c = (DV == 64) ? (4 * (db ^ (qq >> 1)) + cl) : (4 * (db ^ qq) + cl);
      vbase[db] = (4 * h + qq) * VP + c * 16 + (pp & 1) * 8;
    }
  }
  f32x16 O[NMAP][NDB];
#pragma unroll
  for (int m = 0; m < NMAP; ++m)
#pragma unroll
    for (int db = 0; db < NDB; ++db)
#pragma unroll
      for (int i = 0; i < 16; ++i) O[m][db][i] = 0.f;
  float lsum[NMAP];
#pragma unroll
  for (int m = 0; m < NMAP; ++m) lsum[m] = 0.f;
  const float negmb = -a.mb;
  const int qpos = a.qpos0 + wave * 32 + l32;

#pragma unroll
  for (int s = 0; s < QSTEPS; ++s) asm volatile("" ::"v"(qfr[s]));
  asm volatile("s_waitcnt vmcnt(0)" ::: "memory");
  __syncthreads();
  issue(0, 0);
  if (ntile > 1) issue(1, 1);
  if (ntile > 2) issue(2, 2);
#pragma unroll 1
  for (int ti = 0; ti < ntile; ++ti) {
    const int rem = ntile - 1 - ti;
    if (rem >= 2) { if (NLD == 2) asm volatile("s_waitcnt vmcnt(4)" ::: "memory"); else asm volatile("s_waitcnt vmcnt(6)" ::: "memory"); }
    else if (rem == 1) { if (NLD == 2) asm volatile("s_waitcnt vmcnt(2)" ::: "memory"); else asm volatile("s_waitcnt vmcnt(3)" ::: "memory"); }
    else asm volatile("s_waitcnt vmcnt(0)" ::: "memory");
    __builtin_amdgcn_s_barrier();
    asm volatile("" ::: "memory");
    if (ti + 3 < ntile) issue(ti + 3, (ti + 3) & 3);
    __builtin_amdgcn_sched_barrier(0);
    LDS_AS unsigned char* st = smem + (ti & 3) * AST;
    LDS_AS unsigned char* sv = st + 8192;
    auto readK = [&](int kb, bf16x8 (&kf)[QSTEPS]) {
      LDS_AS unsigned char* ka = st + kb * 32 * 128 + krowA;
#pragma unroll
      for (int s = 0; s < 4; ++s) kf[s] = lds128(ka + (((2 * s + h) ^ kswzA) << 4));
      if (KB) {
        LDS_AS unsigned char* kbp = st + 16384 + kb * 32 * 64 + krowB;
#pragma unroll
        for (int s = 0; s < 2; ++s) kf[4 + s] = lds128(kbp + (((2 * s + h) ^ kswzB) << 4));
      }
    };
    auto readV = [&](int kb, bf16x8 (&vf)[2][NDB]) {
#pragma unroll
      for (int s = 0; s < 2; ++s)
#pragma unroll
        for (int db = 0; db < NDB; ++db) {
          const int rc = (kb * 32 + 16 * s) * VP;
          const s16x4 lo = __builtin_amdgcn_ds_read_tr16_b64_v4i16((LDS_AS s16x4*)(sv + vbase[db] + rc));
          const s16x4 hi = __builtin_amdgcn_ds_read_tr16_b64_v4i16((LDS_AS s16x4*)(sv + vbase[db] + rc + 8 * VP));
          vf[s][db] = __builtin_shufflevector(lo, hi, 0, 1, 2, 3, 4, 5, 6, 7);
        }
    };
    auto qk = [&](const bf16x8 (&kf)[QSTEPS], f32x16& S) {
#pragma unroll
      for (int i = 0; i < 16; ++i) S[i] = negmb;
#pragma unroll
      for (int s = 0; s < QSTEPS; ++s) S = MFMA32(kf[s], qfr[s], S);
    };
    auto softmax = [&](int kb, f32x16& S, bf16x8 (&pb)[2]) {
      if (WIN) {
        if (ti >= a.nct) {
          const int kp0 = (a.lt0 + ti - a.nct) * 64 + 4 * h - qpos + kb * 32;
#pragma unroll
          for (int i = 0; i < 16; ++i) {
            const int dlt = kp0 + (i & 3) + 8 * (i >> 2);
            if (dlt > 128 || dlt < -128) S[i] = -INFINITY;
          }
        }
      }
      float ls = 0.f;
#pragma unroll
      for (int i = 0; i < 16; ++i) { S[i] = __builtin_amdgcn_exp2f(S[i]); ls += S[i]; }
      lsum[0] += ls;
#pragma unroll
      for (int s = 0; s < 2; ++s) {
        u32x4 pw;
#pragma unroll
        for (int j = 0; j < 4; ++j) pw[j] = pk2(S[8 * s + 2 * j], S[8 * s + 2 * j + 1]);
        pb[s] = __builtin_bit_cast(bf16x8, pw);
      }
    };
    auto pv = [&](const bf16x8 (&vf)[2][NDB], const bf16x8 (&pb)[2]) {
#pragma unroll
      for (int s = 0; s < 2; ++s)
#pragma unroll
        for (int db = 0; db < NDB; ++db) O[0][db] = MFMA32(vf[s][db], pb[s], O[0][db]);
    };
    bool skip = false;
    if (WIN) {
      if (ti >= a.nct) {
        const int kp = (a.lt0 + ti - a.nct) * 64, r0 = a.qpos0 + __builtin_amdgcn_readfirstlane(wave) * 32;
        skip = (kp + 63 < r0 - 128) || (kp > r0 + 31 + 128);
      }
    }
    if (!skip) {
      bf16x8 kf0[QSTEPS], kf1[QSTEPS], vf0[2][NDB], vf1[2][NDB], p0[2], p1[2];
      f32x16 S0, S1;
      readK(0, kf0); readV(0, vf0);
      __builtin_amdgcn_sched_barrier(0);
      qk(kf0, S0);
      __builtin_amdgcn_sched_barrier(0);
      readK(1, kf1);
      __builtin_amdgcn_sched_barrier(0);
      qk(kf1, S1);
      __builtin_amdgcn_sched_barrier(0);
      softmax(0, S0, p0);
      __builtin_amdgcn_sched_barrier(0);
      pv(vf0, p0);
      __builtin_amdgcn_sched_barrier(0);
      readV(1, vf1);
      __builtin_amdgcn_sched_barrier(0);
      softmax(1, S1, p1);
      __builtin_amdgcn_sched_barrier(0);
      pv(vf1, p1);
      __builtin_amdgcn_sched_barrier(0);
    }
  }
  const float lt = lsum[0] + __shfl_xor(lsum[0], 32) + a.sinkterm;
  const float inv = 1.f / lt;
  bf16_t* orow = a.o + (size_t)(a.qrow0 + wave * 32 + l32) * a.opitch + 4 * h;
  if (a.dry) return;
  if (EPI == 0) {
#pragma unroll
    for (int db = 0; db < NDB; ++db)
#pragma unroll
      for (int g = 0; g < 4; ++g) {
        u32x2 w = {pk2(O[0][db][4 * g] * inv, O[0][db][4 * g + 1] * inv), pk2(O[0][db][4 * g + 2] * inv, O[0][db][4 * g + 3] * inv)};
        *(u32x2*)(orow + db * 32 + 8 * g) = w;
      }
  } else {
    const float c1 = inv * a.lam;
    float ss = 0.f;
#pragma unroll
    for (int db = 0; db < NDB; ++db)
#pragma unroll
      for (int g = 0; g < 4; ++g) {
        const u32x2 raw = *(const u32x2*)(a.o0 + (size_t)(a.qrow0 + wave * 32 + l32) * 512 + 4 * h + db * 32 + 8 * g);
        const float o0[4] = {__uint_as_float(raw[0] << 16), __uint_as_float(raw[0] & 0xffff0000u), __uint_as_float(raw[1] << 16), __uint_as_float(raw[1] & 0xffff0000u)};
#pragma unroll
        for (int j = 0; j < 4; ++j) { const float v = o0[j] - O[0][db][4 * g + j] * c1; O[0][db][4 * g + j] = v; ss += v * v; }
      }
    ss += __shfl_xor(ss, 32);
    const float rstd = rsqrtf(ss * (1.f / (float)DV) + EPS) * a.osc;
#pragma unroll
    for (int db = 0; db < NDB; ++db)
#pragma unroll
      for (int g = 0; g < 4; ++g) {
        const f32x4 gs = *(const f32x4*)(a.gsub + db * 32 + 8 * g + 4 * h);
        u32x2 w = {pk2(O[0][db][4 * g] * rstd * gs[0], O[0][db][4 * g + 1] * rstd * gs[1]), pk2(O[0][db][4 * g + 2] * rstd * gs[2], O[0][db][4 * g + 3] * rstd * gs[3])};
        *(u32x2*)(orow + db * 32 + 8 * g) = w;
      }
  }
}

DI void attn_diff_item(const AttnArgs& a, LDS_AS unsigned char* smem) {
  AttnArgs a0 = a; a0.o = a.o0; a0.opitch = 512; a0.dry = 0;
  { bf16x8 q0[4]; load_q<4>(a, 0, q0); attn_item<1, false, 128, 0, false>(a0, q0, 0, smem); }
  { bf16x8 q1[4]; load_q<4>(a, 64, q1); attn_item<1, false, 128, 1, false>(a, q1, 64, smem); }
}

DI void phase_attention(const Params& p, int l, LDS_AS unsigned char* smem, int dry) {
  __shared__ int attn_slot;
  volatile LDS_AS int* slot = (volatile LDS_AS int*)&attn_slot;
  const int myx = (int)(xb_xcc_id() & 7u);
  const float* cs = p.consts + l * 16;
  const float lam = cs[0], lam_init = cs[1], mb_mla = cs[2], mb_swa = cs[3], mb_diff = cs[4];
  const int nc_d = (l == 0) ? 16 : 0, nc_m = (l == 0) ? 32 : 0;
  {
    unsigned* ctr = p.bar + (l * 3 + 0) * 16;
    int cj = blockIdx.x; bool qdone = (dry != 0);
#pragma unroll 1
    for (;;) {
      int id = -1, j = -1;
      if (!qdone) { id = wq_fetch(ctr, myx, 64, slot); if (id < 0) qdone = true; }
      if (qdone) { if (cj >= nc_d) break; j = cj; cj += gridDim.x; }
      AttnArgs a; a.dry = dry;
      int b, hd;
      if (id >= 0) { const int pair = id >> 5, qb = id & 31; b = pair >> 2; hd = pair & 3; a.lt0 = 0; a.lt1 = 128; a.qrow0 = b * 8192 + qb * 256; }
      else { b = j >> 2; hd = j & 3; a.lt0 = 0; a.lt1 = 0; a.qrow0 = TL + b * 256; }
      a.q = p.PROJ + C_DQ + hd * 128; a.qpitch = PN; a.k = p.PROJ + C_DK + hd * 128; a.kpitch = PN; a.v = p.PROJ + C_DV + hd * 128; a.vpitch = PN;
      a.o = p.PROJ + C_DQ + hd * 128; a.opitch = PN; a.o0 = p.YD0 + hd * 128;
      a.krow_ctx = TL + b * 256; a.krow_lat = b * 8192; a.nct = 4; a.qpos0 = 0;
      a.mb = mb_diff; a.sinkterm = 0.f; a.lam = lam; a.osc = 1.f - lam_init; a.gsub = p.g_diff_sub + l * 128;
      attn_diff_item(a, smem);
    }
  }
  {
    unsigned* ctr = p.bar + (l * 3 + 1) * 16;
    int cj = blockIdx.x; bool qdone = (dry != 0);
#pragma unroll 1
    for (;;) {
      int id = -1, j = -1;
      if (!qdone) { id = wq_fetch(ctr, myx, 128, slot); if (id < 0) qdone = true; }
      if (qdone) { if (cj >= nc_m) break; j = cj; cj += gridDim.x; }
      AttnArgs a; a.dry = dry;
      int b, hd;
      if (id >= 0) { const int pair = id >> 5, qb = id & 31; b = pair >> 3; hd = pair & 7; a.lt0 = 0; a.lt1 = 128; a.qrow0 = b * 8192 + qb * 256; }
      else { b = j >> 3; hd = j & 7; a.lt0 = 0; a.lt1 = 0; a.qrow0 = TL + b * 256; }
      a.q = p.MQ + hd * 96; a.qpitch = 768; a.k = p.KM + hd * 96; a.kpitch = 768; a.v = p.KV + hd * 128 + 64; a.vpitch = 1024;
      a.o = p.MQ + hd * 96; a.opitch = 768; a.o0 = nullptr;
      a.krow_ctx = TL + b * 256; a.krow_lat = b * 8192; a.nct = 4; a.qpos0 = 0;
      a.mb = mb_mla; a.sinkterm = 0.f; a.lam = 0.f; a.osc = 0.f; a.gsub = nullptr;
      bf16x8 qf[6]; load_q<6>(a, 0, qf);
      attn_item<1, true, 64, 0, false>(a, qf, 0, smem);
    }
  }
  {
    unsigned* ctr = p.bar + (l * 3 + 2) * 16;
    int cj = blockIdx.x; bool qdone = (dry != 0);
#pragma unroll 1
    for (;;) {
      int id = -1, j = -1;
      if (!qdone) { id = wq_fetch(ctr, myx, 128, slot); if (id < 0) qdone = true; }
      if (qdone) { if (cj >= nc_m) break; j = cj; cj += gridDim.x; }
      AttnArgs a; a.dry = dry;
      int b, hq;
      if (id >= 0) {
        const int pair = id >> 5, qb = id & 31; b = pair >> 3; hq = pair & 7;
        a.lt0 = (4 * qb - 2 < 0) ? 0 : 4 * qb - 2; a.lt1 = (4 * qb + 6 > 128) ? 128 : 4 * qb + 6;
        a.qrow0 = b * 8192 + qb * 256; a.qpos0 = qb * 256;
      } else { b = j >> 3; hq = j & 7; a.lt0 = 0; a.lt1 = 0; a.qrow0 = TL + b * 256; a.qpos0 = 0; }
      const int kvh = hq >> 2;
      a.q = p.PROJ + C_SQ + hq * 64; a.qpitch = PN; a.k = p.PROJ + C_SK + kvh * 64; a.kpitch = PN; a.v = p.PROJ + C_SV + kvh * 64; a.vpitch = PN;
      a.o = p.PROJ + C_SQ + hq * 64; a.opitch = PN; a.o0 = nullptr;
      a.krow_ctx = TL + b * 256; a.krow_lat = b * 8192; a.nct = 4;
      a.mb = mb_swa; a.sinkterm = __builtin_amdgcn_exp2f(p.swa_sink[l * 8 + hq] * LOG2E - mb_swa); a.lam = 0.f; a.osc = 0.f; a.gsub = nullptr;
      bf16x8 qf[4]; load_q<4>(a, 0, qf);
      attn_item<1, false, 64, 0, true>(a, qf, 0, smem);
    }
  }
}

constexpr int NPH = 1 + 2 * 11;
DI void run_phase(const Params& p, int ph, LDS_AS unsigned char* smem, int dry) {
#ifdef ONLY_S
  if (ONLY_S == 99) { if (ph == 0) phase0(p, smem, dry); return; }
  if (ph == 0) return;
  const int l = (ph - 1) / 11, s = ONLY_S;
#else
  if (ph == 0) { phase0(p, smem, dry); return; }
  const int l = (ph - 1) / 11, s = (ph - 1) % 11;
#endif
  switch (s) {
    case 0: norm_phase(p, l, 0, dry); break;
    case 1: phase_gemm_in(p, l, smem, dry); break;
    case 2: phase_prep_a(p, l, dry); break;
    case 3: phase_gemm_mla(p, l, smem, dry); break;
    case 4: phase_prep_c(p, l, dry); break;
    case 5: phase_attention(p, l, smem, dry); break;
    case 6: phase_merge(p, l, smem, dry); break;
    case 7: phase_residual_gemm(p, l, 0, smem, dry); break;
    case 8: norm_phase(p, l, 1, dry); break;
    case 9: phase_mlp_in(p, l, smem, dry); break;
    default: phase_residual_gemm(p, l, 1, smem, dry); break;
  }
}

__global__ void __launch_bounds__(512, 2) mega_kernel(Params p) {
  __shared__ __attribute__((aligned(16))) unsigned char smem_raw[3 * GST];
  LDS_AS unsigned char* smem = (LDS_AS unsigned char*)smem_raw;
  __shared__ uint4 xb_words;
  cg::grid_group grid = cg::this_grid();
  if (threadIdx.x == 0) xb_words = make_uint4(0u, 0u, 0u, 0u);
  __syncthreads();
  const XcdBarrier xb = xcd_barrier_post(p.bar, (volatile LDS_AS unsigned*)&xb_words);
#pragma unroll 1
  for (int ph = 0; ph < NPH; ++ph) {
    const int st = (ph == 0) ? 31 : (ph - 1) % 11;
    const int nrep = (((unsigned)p.probe >> st) & 1u) ? 2 : 1;
    for (int rep = 0; rep < nrep; ++rep) run_phase(p, ph, smem, rep + 1 < nrep);
    if (ph + 1 < NPH) { if (ph == 0) grid.sync(); else xcd_barrier(xb); }
  }
}
#ifdef MK_MULTI
__global__ void __launch_bounds__(512, 2) phase_kernel(Params p, int ph) {
  __shared__ __attribute__((aligned(16))) unsigned char smem_raw[3 * GST];
  run_phase(p, ph, (LDS_AS unsigned char*)smem_raw, 0);
}
#endif

extern "C" void kernel_launch(void* const* d_in, const int* in_sizes, int n_in, void* d_out, int out_size, void* d_ws, size_t ws_size,
                              hipStream_t stream) {
  Params p{};
  const float* const* in = (const float* const*)d_in;
  p.x = in[0]; p.c = in[1]; p.ctx = in[2]; p.c_ctx = in[3]; p.w_mod = in[4]; p.b_mod = in[5]; p.g_norm_attn = in[6]; p.g_norm_mlp = in[7];
  p.w_in = in[8]; p.g_q_lora = in[9]; p.w_uq = in[10]; p.g_kv_lora = in[11]; p.w_ukv = in[12]; p.g_mla_q = in[13]; p.g_mla_k = in[14];
  p.w_up_mla = in[15]; p.g_swa_q = in[16]; p.g_swa_k = in[17]; p.swa_sink = in[18]; p.w_up_swa = in[19]; p.g_diff_q = in[20]; p.g_diff_k = in[21];
  p.lambda_q1 = in[22]; p.lambda_k1 = in[23]; p.lambda_q2 = in[24]; p.lambda_k2 = in[25]; p.g_diff_sub = in[26]; p.w_up_diff = in[27];
  p.w_o = in[28]; p.w_mlp_in = in[29]; p.w_mlp_out = in[30];
#ifndef PROBE_MASK
#define PROBE_MASK 0
#endif
  p.probe = PROBE_MASK; p.pad_ = 0;
  p.out = (float*)d_out;
  unsigned char* ws = (unsigned char*)d_ws;
  size_t off = 0;
  auto take = [&](size_t bytes) { unsigned char* r = ws + off; off += (bytes + 255) & ~(size_t)255; return r; };
  p.modtab = (float*)take(2 * 5 * 6144 * 4);
  p.consts = (float*)take(256);
  p.bar = (unsigned*)take(XCD_BAR_WORDS * 4);
  p.WB = (bf16_t*)take(2 * W_LAYER * 2);
  p.H = (bf16_t*)take((size_t)T * 1024 * 2);
  p.PROJ = (bf16_t*)take((size_t)T * PN * 2);
  p.MQ = (bf16_t*)take((size_t)T * 768 * 2);
  p.KV = (bf16_t*)take((size_t)T * 1024 * 2);
  p.KM = (bf16_t*)take((size_t)T * 768 * 2);
  p.CX = (float*)take((size_t)TC * 1024 * 4);
  p.YD0 = (bf16_t*)take((size_t)T * 512 * 2);
  if (off > ws_size) { fprintf(stderr, "workspace too small: need %zu have %zu\n", off, ws_size); return; }
  (void)hipMemsetAsync(p.modtab, 0, (size_t)((unsigned char*)p.bar - (unsigned char*)p.modtab) + XCD_BAR_WORDS * 4, stream);
#ifdef MK_MULTI
  for (int ph = 0; ph < NPH; ++ph) phase_kernel<<<256, 512, 0, stream>>>(p, ph);
#else
  static int grid_blocks = 0;
  if (!grid_blocks) {
    int dev = 0, cus = 0, per_cu = 0;
    hipGetDevice(&dev);
    hipDeviceGetAttribute(&cus, hipDeviceAttributeMultiprocessorCount, dev);
    hipOccupancyMaxActiveBlocksPerMultiprocessor(&per_cu, mega_kernel, 512, 0);
    if (per_cu > 1) per_cu = 1;
    grid_blocks = cus * per_cu;
    if (grid_blocks <= 0) grid_blocks = 256;
  }
  void* args[] = {&p};
  hipError_t e = hipLaunchCooperativeKernel((void*)mega_kernel, dim3(grid_blocks), dim3(512), args, 0, stream);
  if (e != hipSuccess) fprintf(stderr, "cooperative launch failed: %s (grid %d)\n", hipGetErrorString(e), grid_blocks);
#endif
}
```
